# Optimizing an MI355X kernel written in HIP

```python
import jax, jax.numpy as jnp
from jax import lax
import numpy as np

D_MODEL = 1024
BATCH = 8
SEQ = 4096
DEPTH = 1

D_MIX = D_MODEL
HEAD_DIM = 64
NSA_HEADS = 8
NSA_KV_HEADS = 2
NSA_GROUP = NSA_HEADS // NSA_KV_HEADS
D_NSA = NSA_HEADS * HEAD_DIM
D_KV = NSA_KV_HEADS * HEAD_DIM
D_CONV = D_MIX - D_NSA
CONV_GROUPS = D_CONV // HEAD_DIM
CONV_WIDTH = 3
N_BRANCH = 3
ROPE_THETA = 500000.0
ROT_DIM = HEAD_DIM // 4
CMP_LEN = 32
CMP_STRIDE = 16
CMP_HIDDEN = 2 * HEAD_DIM
SEL_BLOCK = 64
SEL_TOPK = 16
WINDOW = 512
Q_BLOCK = 64
EPS = 1e-6
NEG_INF = -1e30
FORCE_SCORE = 1e9
SPLIT_SIZES = (D_NSA, 6 * D_KV, N_BRANCH * NSA_HEADS, D_NSA, D_CONV, D_CONV, D_CONV, D_CONV)
D_IN = sum(SPLIT_SIZES)
SPLIT_POINTS = tuple(int(v) for v in np.cumsum(SPLIT_SIZES)[:-1])

kernel_name = "hybrid_nsa_shortconv_layer"


def rms_norm(x, w):
    xf = x.astype(jnp.float32)
    xf = xf * lax.rsqrt(jnp.mean(xf * xf, axis=-1, keepdims=True) + EPS)
    return (xf * w.astype(jnp.float32)).astype(x.dtype)


def apply_rope(x, pos):
    inv_freq = ROPE_THETA ** (-jnp.arange(0, ROT_DIM, 2, dtype=jnp.float32) / ROT_DIM)
    ang = pos.astype(jnp.float32)[:, None] * inv_freq[None, :]
    cos = jnp.cos(ang)[:, None, :]
    sin = jnp.sin(ang)[:, None, :]
    xr = x[..., :ROT_DIM].astype(jnp.float32)
    x1, x2 = xr[..., :ROT_DIM // 2], xr[..., ROT_DIM // 2:]
    rot = jnp.concatenate([x1 * cos - x2 * sin, x2 * cos + x1 * sin], axis=-1)
    return jnp.concatenate([rot.astype(x.dtype), x[..., ROT_DIM:]], axis=-1)


def masked_softmax(s, mask):
    p = jax.nn.softmax(jnp.where(mask, s, NEG_INF), axis=-1)
    return jnp.where(mask, p, 0.0)


def compress_blocks(kv, pos_emb, w1, b1, w2):
    B_, S_, G_, dh = kv.shape
    halves = kv.reshape(B_, S_ // CMP_STRIDE, CMP_STRIDE, G_, dh)
    blocks = jnp.concatenate([halves[:, :-1], halves[:, 1:]], axis=2)
    blocks = blocks + pos_emb[None, None, :, None, :]
    nc = blocks.shape[1]
    flat = jnp.moveaxis(blocks, 3, 2).reshape(B_, nc, G_, CMP_LEN * dh)
    hid = jax.nn.silu(jnp.einsum('bcgf,fh->bcgh', flat, w1) + b1)
    return jnp.einsum('bcgh,hd->bcgd', hid, w2)


def cmp_sel_overlap(nc, ns):
    cs = jnp.arange(nc) * CMP_STRIDE
    ce = cs + CMP_LEN
    ss = jnp.arange(ns) * SEL_BLOCK
    se = ss + SEL_BLOCK
    ov = jnp.clip(jnp.minimum(ce[:, None], se[None, :]) - jnp.maximum(cs[:, None], ss[None, :]), 0)
    return ov.astype(jnp.float32) / CMP_LEN


def hybrid_layer(x, norm_w, w_in, q_norm_w, k_norm_w, cmp_k_pos, cmp_k_w1, cmp_k_b1, cmp_k_w2,
                 cmp_v_pos, cmp_v_w1, cmp_v_b1, cmp_v_w2, conv_w, conv_b, w_out):
    B_, S_, _ = x.shape
    G, R, dh = NSA_KV_HEADS, NSA_GROUP, HEAD_DIM
    nc = S_ // CMP_STRIDE - 1
    ns = S_ // SEL_BLOCK
    n_sel = min(SEL_TOPK, ns)
    nqb = S_ // Q_BLOCK

    h = rms_norm(x, norm_w)
    proj = jnp.einsum('bsd,de->bse', h, w_in)
    q, kv_all, gate_logits, nsa_z, cv_h, cv_b, cv_c, cv_z = jnp.split(proj, SPLIT_POINTS, axis=-1)

    pos = jnp.arange(S_)
    q = apply_rope(rms_norm(q.reshape(B_, S_, NSA_HEADS, dh), q_norm_w), pos)
    k_c, v_c, k_s, v_s, k_w, v_w = [t.reshape(B_, S_, G, dh) for t in jnp.split(kv_all, 6, axis=-1)]
    cmp_end = jnp.arange(nc) * CMP_STRIDE + (CMP_LEN - 1)
    k_c = apply_rope(rms_norm(compress_blocks(k_c, cmp_k_pos, cmp_k_w1, cmp_k_b1, cmp_k_w2),
                              k_norm_w[0]), cmp_end)
    v_c = compress_blocks(v_c, cmp_v_pos, cmp_v_w1, cmp_v_b1, cmp_v_w2)
    k_s = apply_rope(rms_norm(k_s, k_norm_w[1]), pos)
    k_w = apply_rope(rms_norm(k_w, k_norm_w[2]), pos)
    k_sel_blk = k_s.reshape(B_, ns, SEL_BLOCK, G, dh).transpose(0, 3, 1, 2, 4)
    v_sel_blk = v_s.reshape(B_, ns, SEL_BLOCK, G, dh).transpose(0, 3, 1, 2, 4)
    pad = ((0, 0), (WINDOW, 0), (0, 0), (0, 0))
    k_w_pad = jnp.pad(k_w, pad)
    v_w_pad = jnp.pad(v_w, pad)
    overlap = cmp_sel_overlap(nc, ns)
    scale = HEAD_DIM ** -0.5
    b_ix = jnp.arange(B_)[:, None, None, None]
    g_ix = jnp.arange(G)[None, :, None, None]
    blk = jnp.arange(ns)
    tok_in_blk = jnp.arange(SEL_BLOCK)
    win_off = jnp.arange(Q_BLOCK + WINDOW)

    def query_block(args):
        qb, i = args
        t = i * Q_BLOCK + jnp.arange(Q_BLOCK)
        s_c = jnp.einsum('bgqrd,bcgd->bgqrc', qb, k_c).astype(jnp.float32) * scale
        p_c = masked_softmax(s_c, (cmp_end[None, :] <= t[:, None])[None, None, :, None, :])
        o_cmp = jnp.einsum('bgqrc,bcgd->bgqrd', p_c.astype(v_c.dtype), v_c)
        imp = jnp.einsum('bgqrc,cn->bgqn', p_c, overlap)
        cur = t[:, None] // SEL_BLOCK
        forced = (blk[None, :] == 0) | (blk[None, :] == cur) | (blk[None, :] == cur - 1)
        visible = blk[None, :] * SEL_BLOCK <= t[:, None]
        imp = jnp.where(forced, FORCE_SCORE, jnp.where(visible, imp, -1.0))
        _, idx = lax.top_k(imp, n_sel)
        k_g = k_sel_blk[b_ix, g_ix, idx]
        v_g = v_sel_blk[b_ix, g_ix, idx]
        s_s = jnp.einsum('bgqrd,bgqnld->bgqrnl', qb, k_g).astype(jnp.float32) * scale
        tok = idx[..., None] * SEL_BLOCK + tok_in_blk
        mask_s = tok <= t[None, None, :, None, None]
        n_tok = n_sel * SEL_BLOCK
        p_s = masked_softmax(s_s.reshape(B_, G, Q_BLOCK, R, n_tok),
                             mask_s.reshape(B_, G, Q_BLOCK, 1, n_tok))
        o_slc = jnp.einsum('bgqrm,bgqmd->bgqrd', p_s.astype(v_g.dtype),
                           v_g.reshape(B_, G, Q_BLOCK, n_tok, dh))
        start = i * Q_BLOCK
        k_wb = lax.dynamic_slice_in_dim(k_w_pad, start, Q_BLOCK + WINDOW, axis=1)
        v_wb = lax.dynamic_slice_in_dim(v_w_pad, start, Q_BLOCK + WINDOW, axis=1)
        key_pos = start - WINDOW + win_off
        mask_w = ((key_pos[None, :] <= t[:, None]) & (key_pos[None, :] > t[:, None] - WINDOW)
                  & (key_pos[None, :] >= 0))
        s_w = jnp.einsum('bgqrd,bkgd->bgqrk', qb, k_wb).astype(jnp.float32) * scale
        p_w = masked_softmax(s_w, mask_w[None, None, :, None, :])
        o_win = jnp.einsum('bgqrk,bkgd->bgqrd', p_w.astype(v_wb.dtype), v_wb)
        return o_cmp, o_slc, o_win

    q_blocks = q.reshape(B_, nqb, Q_BLOCK, G, R, dh).transpose(1, 0, 3, 2, 4, 5)
    o_cmp, o_slc, o_win = lax.map(query_block, (q_blocks, jnp.arange(nqb)))

    def unblock(o):
        return o.transpose(1, 0, 3, 2, 4, 5).reshape(B_, S_, NSA_HEADS, dh)

    gates = jax.nn.sigmoid(gate_logits.astype(jnp.float32)).astype(x.dtype)
    gates = gates.reshape(B_, S_, NSA_HEADS, N_BRANCH)
    o_nsa = (gates[..., 0:1] * unblock(o_cmp) + gates[..., 1:2] * unblock(o_slc)
             + gates[..., 2:3] * unblock(o_win))
    o_nsa = o_nsa.reshape(B_, S_, D_NSA) * jax.nn.silu(nsa_z)

    u = cv_c * cv_h
    conv = lax.conv_general_dilated(u, conv_w[:, None, :], window_strides=(1,),
                                    padding=[(CONV_WIDTH - 1, 0)],
                                    dimension_numbers=('NWC', 'WIO', 'NWC'),
                                    feature_group_count=D_CONV) + conv_b
    o_conv = cv_b * conv * jax.nn.silu(cv_z)

    mix = jnp.concatenate([o_nsa, o_conv], axis=-1)
    return x + jnp.einsum('bse,ed->bsd', mix, w_out)


def setup_inputs(seed: int = 0) -> dict:
    key = jax.random.key(seed)
    ks = jax.random.split(key, 17)
    L = DEPTH

    def nrm(k, shape, scale):
        return jax.random.normal(k, shape, jnp.float32) * scale

    f_in = CMP_LEN * HEAD_DIM
    return {
        "x": nrm(ks[0], (BATCH, SEQ, D_MODEL), 1.0),
        "norm_w": 1.0 + nrm(ks[1], (L, D_MODEL), 0.01),
        "w_in": nrm(ks[2], (L, D_MODEL, D_IN), D_MODEL ** -0.5),
        "q_norm_w": 1.0 + nrm(ks[3], (L, HEAD_DIM), 0.01),
        "k_norm_w": 1.0 + nrm(ks[4], (L, N_BRANCH, HEAD_DIM), 0.01),
        "cmp_k_pos": nrm(ks[5], (L, CMP_LEN, HEAD_DIM), 0.02),
        "cmp_k_w1": nrm(ks[6], (L, f_in, CMP_HIDDEN), f_in ** -0.5),
        "cmp_k_b1": nrm(ks[7], (L, CMP_HIDDEN), 0.01),
        "cmp_k_w2": nrm(ks[8], (L, CMP_HIDDEN, HEAD_DIM), CMP_HIDDEN ** -0.5),
        "cmp_v_pos": nrm(ks[9], (L, CMP_LEN, HEAD_DIM), 0.02),
        "cmp_v_w1": nrm(ks[10], (L, f_in, CMP_HIDDEN), f_in ** -0.5),
        "cmp_v_b1": nrm(ks[11], (L, CMP_HIDDEN), 0.01),
        "cmp_v_w2": nrm(ks[12], (L, CMP_HIDDEN, HEAD_DIM), CMP_HIDDEN ** -0.5),
        "conv_w": nrm(ks[13], (L, CONV_WIDTH, D_CONV), CONV_WIDTH ** -0.5),
        "conv_b": nrm(ks[14], (L, D_CONV), 0.01),
        "w_out": nrm(ks[15], (L, D_MIX, D_MODEL), D_MIX ** -0.5),
    }


def reference(x, norm_w, w_in, q_norm_w, k_norm_w, cmp_k_pos, cmp_k_w1, cmp_k_b1, cmp_k_w2,
              cmp_v_pos, cmp_v_w1, cmp_v_b1, cmp_v_w2, conv_w, conv_b, w_out):
    for l in range(DEPTH):
        x = hybrid_layer(x, norm_w[l], w_in[l], q_norm_w[l], k_norm_w[l], cmp_k_pos[l],
                         cmp_k_w1[l], cmp_k_b1[l], cmp_k_w2[l], cmp_v_pos[l], cmp_v_w1[l],
                         cmp_v_b1[l], cmp_v_w2[l], conv_w[l], conv_b[l], w_out[l])
    return x
```

```cpp
#include <hip/hip_runtime.h>
#include <hip/hip_cooperative_groups.h>
#include <cstdio>
#include <cstdint>
namespace cg = cooperative_groups;

#ifndef FUSED
#define FUSED 0
#endif

#define DI __device__ __forceinline__
typedef unsigned short u16;
using bf16x8 = __attribute__((ext_vector_type(8))) short;
using s16x4 = __attribute__((ext_vector_type(4))) short;
using f32x4 = __attribute__((ext_vector_type(4))) float;
using f32x16 = __attribute__((ext_vector_type(16))) float;
using u32x4 = __attribute__((ext_vector_type(4))) unsigned;
using u32x2 = __attribute__((ext_vector_type(2))) unsigned;
typedef __bf16 bf2_t __attribute__((ext_vector_type(2)));
typedef float fl2_t __attribute__((ext_vector_type(2)));

constexpr int NTHREADS = 512;
constexpr int SEQ = 4096, DM = 1024, DIN = 3864, NROWS = 32768;
constexpr float EPS = 1e-6f;
constexpr float QSCALE = 0.125f * 1.4426950408889634f;
constexpr int SMEM_BYTES = 110592;

__constant__ float c_invf[8] = {1.0f, 0.1939227432012558f, 0.03760603070259094f, 0.007292664609849453f,
                                0.0014142135623842478f, 0.00027424818836152554f, 5.3182957344688475e-05f, 1.0313385246263351e-05f};

DI unsigned cvtpk(float lo, float hi) {
  fl2_t f = {lo, hi};
  bf2_t b = __builtin_convertvector(f, bf2_t);
  return __builtin_bit_cast(unsigned, b);
}
DI u16 f2bf(float x) { return (u16)(cvtpk(x, 0.f) & 0xffffu); }
DI float bf2f(u16 v) { return __uint_as_float(((unsigned)v) << 16); }
DI float bflo(unsigned v) { return __uint_as_float(v << 16); }
DI float bfhi(unsigned v) { return __uint_as_float(v & 0xffff0000u); }
DI float sigmoidf_(float v) { return 1.0f / (1.0f + __expf(-v)); }
DI float siluf_(float v) { return v / (1.0f + __expf(-v)); }
#define MFMA16(a, b, c) __builtin_amdgcn_mfma_f32_16x16x32_bf16((a), (b), (c), 0, 0, 0)
#define MFMA32(a, b, c) __builtin_amdgcn_mfma_f32_32x32x16_bf16((a), (b), (c), 0, 0, 0)

struct Params {
  const float *x, *norm_w, *w_in, *q_norm_w, *k_norm_w, *ck_pos, *ck_w1, *ck_b1, *ck_w2, *cv_pos, *cv_w1, *cv_b1, *cv_w2, *conv_w, *conv_b, *w_out;
  float* out;
  u16 *xb, *winT, *woutT, *w1kT, *w1vT, *w2kT, *w2vT, *Q, *Ks, *Kw, *Vst, *Vwt, *kcraw, *vcraw, *Kc, *Vct, *zs, *cvb, *mix;
  float *rs, *ckpart, *rope, *gates;
  unsigned* counter;
};

DI void transpose_tile(const float* __restrict__ src, u16* __restrict__ dst, int K, int N, const float* __restrict__ scale, int kt, int nt, char* smem) {
  float* tile = (float*)smem;
  const int tid = threadIdx.x;
#pragma unroll
  for (int i = 0; i < 8; ++i) {
    const int kk = i * 8 + (tid >> 6), nn = tid & 63, n = nt * 64 + nn, k = kt * 64 + kk;
    float v = (n < N) ? src[(size_t)k * N + n] : 0.f;
    if (scale) v *= scale[k];
    tile[kk * 65 + nn] = v;
  }
  __syncthreads();
#pragma unroll
  for (int i = 0; i < 8; ++i) {
    const int nn = i * 8 + (tid >> 6), kk = tid & 63;
    dst[(size_t)(nt * 64 + nn) * K + kt * 64 + kk] = f2bf(tile[kk * 65 + nn]);
  }
  __syncthreads();
}

__device__ void phase_prep(const Params& p, char* smem, int bid, int nb) {
  const int tid = threadIdx.x, lane = tid & 63, wid = tid >> 6;
  constexpr int J_X = 4096, J_TW = 992, J_TO = 256, J_T1 = 64, J_T2 = 2, J_CK = 16, J_ROPE = 64;
  constexpr int TOTAL = J_X + J_TW + J_TO + 2 * J_T1 + 2 * J_T2 + J_CK + J_ROPE;
  if (bid == 0 && tid == 0) *p.counter = 0u;
  for (int j = bid; j < TOTAL; j += nb) {
    int jj = j;
    if (jj < J_X) {
      const int row = jj * 8 + wid;
      const float4* xr = (const float4*)(p.x + (size_t)row * DM);
      float4 v[4]; float ss = 0.f;
#pragma unroll
      for (int i = 0; i < 4; ++i) { v[i] = xr[i * 64 + lane]; ss += v[i].x * v[i].x + v[i].y * v[i].y + v[i].z * v[i].z + v[i].w * v[i].w; }
#pragma unroll
      for (int o = 32; o >= 1; o >>= 1) ss += __shfl_xor(ss, o);
      if (lane == 0) p.rs[row] = rsqrtf(ss * (1.0f / DM) + EPS);
#pragma unroll
      for (int i = 0; i < 4; ++i) {
        u32x2 o; o[0] = cvtpk(v[i].x, v[i].y); o[1] = cvtpk(v[i].z, v[i].w);
        *(u32x2*)(p.xb + (size_t)row * DM + (i * 64 + lane) * 4) = o;
      }
      continue;
    }
    jj -= J_X;
    if (jj < J_TW) { transpose_tile(p.w_in, p.winT, 1024, DIN, p.norm_w, jj & 15, jj >> 4, smem); continue; }
    jj -= J_TW;
    if (jj < J_TO) { transpose_tile(p.w_out, p.woutT, 1024, 1024, nullptr, jj & 15, jj >> 4, smem); continue; }
    jj -= J_TO;
    if (jj < J_T1) { transpose_tile(p.ck_w1, p.w1kT, 2048, 128, nullptr, jj & 31, jj >> 5, smem); continue; }
    jj -= J_T1;
    if (jj < J_T1) { transpose_tile(p.cv_w1, p.w1vT, 2048, 128, nullptr, jj & 31, jj >> 5, smem); continue; }
    jj -= J_T1;
    if (jj < J_T2) { transpose_tile(p.ck_w2, p.w2kT, 128, 64, nullptr, jj, 0, smem); continue; }
    jj -= J_T2;
    if (jj < J_T2) { transpose_tile(p.cv_w2, p.w2vT, 128, 64, nullptr, jj, 0, smem); continue; }
    jj -= J_T2;
    if (jj < J_CK) {
      const int which = jj >> 3, chunk = jj & 7, hh = tid & 127, sub = tid >> 7;
      const float* pos = which ? p.cv_pos : p.ck_pos;
      const float* w1 = which ? p.cv_w1 : p.ck_w1;
      float acc = 0.f;
      const int f0 = chunk * 256 + sub * 64;
#pragma unroll 8
      for (int f = 0; f < 64; ++f) acc += pos[f0 + f] * w1[(size_t)(f0 + f) * 128 + hh];
      float* red = (float*)smem;
      red[sub * 128 + hh] = acc;
      __syncthreads();
      if (tid < 128) p.ckpart[(which * 8 + chunk) * 128 + tid] = red[tid] + red[128 + tid] + red[256 + tid] + red[384 + tid];
      __syncthreads();
      continue;
    }
    jj -= J_CK;
    {
      const int idx = jj * 512 + tid, pos = idx >> 3, fi = idx & 7;
      const float ang = (float)pos * c_invf[fi];
      float s, c; sincosf(ang, &s, &c);
      p.rope[idx * 2] = c; p.rope[idx * 2 + 1] = s;
    }
  }
}

constexpr int G_ABYTES = 256 * 144, G_BBYTES = 128 * 144, G_BUF = G_ABYTES + G_BBYTES;

template <int EPI>
__device__ void gemm_phase(const Params& p, char* smem, int bid, int nb) {
  constexpr int K = 1024;
  constexpr int NT = EPI == 0 ? 31 : 8;
  constexpr int MT = 128;
  const u16* __restrict__ A = EPI == 0 ? p.xb : p.mix;
  const u16* __restrict__ Bt = EPI == 0 ? p.winT : p.woutT;
  const int tid = threadIdx.x, lane = tid & 63, wid = tid >> 6, fr = lane & 15, fq = lane >> 4;
  const int wr = wid >> 1, wc = wid & 1;
  const int srow = tid >> 3, skc = tid & 7;

  for (int tile = bid; tile < MT * NT; tile += nb) {
    const int mt = tile / NT, nt = tile - mt * NT;
    const int m0 = mt * 256, n0 = nt * 128;
    f32x4 acc[4][4];
#pragma unroll
    for (int m = 0; m < 4; ++m)
#pragma unroll
      for (int n = 0; n < 4; ++n) acc[m][n] = f32x4{0.f, 0.f, 0.f, 0.f};
    u32x4 ra[4], rb[2];
    const u16* Ag = A + (size_t)(m0 + srow) * K + skc * 8;
    const u16* Bg = Bt + (size_t)(n0 + srow) * K + skc * 8;
#define GLOAD(kt) do { _Pragma("unroll") for (int i_ = 0; i_ < 4; ++i_) ra[i_] = *(const u32x4*)(Ag + (size_t)i_ * 64 * K + (kt) * 64); \
                       _Pragma("unroll") for (int i_ = 0; i_ < 2; ++i_) rb[i_] = *(const u32x4*)(Bg + (size_t)i_ * 64 * K + (kt) * 64); } while (0)
#define LSTORE(b) do { char* base_ = smem + (b) * G_BUF + srow * 144 + skc * 16; \
                       _Pragma("unroll") for (int i_ = 0; i_ < 4; ++i_) *(u32x4*)(base_ + i_ * 64 * 144) = ra[i_]; \
                       _Pragma("unroll") for (int i_ = 0; i_ < 2; ++i_) *(u32x4*)(base_ + G_ABYTES + i_ * 64 * 144) = rb[i_]; } while (0)
    GLOAD(0); LSTORE(0); __syncthreads();
    for (int kt = 0; kt < 16; ++kt) {
      if (kt < 15) GLOAD(kt + 1);
      const char* ab = smem + (kt & 1) * G_BUF + (wr * 64 + fr) * 144 + fq * 16;
      const char* bb = smem + (kt & 1) * G_BUF + G_ABYTES + (wc * 64 + fr) * 144 + fq * 16;
#pragma unroll
      for (int ks = 0; ks < 2; ++ks) {
        bf16x8 af[4], bf[4];
#pragma unroll
        for (int m = 0; m < 4; ++m) af[m] = *(const bf16x8*)(ab + m * 16 * 144 + ks * 64);
#pragma unroll
        for (int n = 0; n < 4; ++n) bf[n] = *(const bf16x8*)(bb + n * 16 * 144 + ks * 64);
#pragma unroll
        for (int m = 0; m < 4; ++m)
#pragma unroll
          for (int n = 0; n < 4; ++n) acc[m][n] = MFMA16(af[m], bf[n], acc[m][n]);
      }
      if (kt < 15) LSTORE((kt + 1) & 1);
      __syncthreads();
    }
#undef GLOAD
#undef LSTORE
    const int rbase = m0 + wr * 64;
    const int cb = n0 + wc * 64;
    if constexpr (EPI == 1) {
#pragma unroll
      for (int m = 0; m < 4; ++m)
#pragma unroll
        for (int j = 0; j < 4; ++j) {
          const size_t row = rbase + m * 16 + fq * 4 + j;
#pragma unroll
          for (int n = 0; n < 4; ++n) {
            const size_t o = row * DM + cb + n * 16 + fr;
            p.out[o] = p.x[o] + acc[m][n][j];
          }
        }
    } else {
      const int b = m0 >> 12;
      const int tb = rbase & 4095;
#pragma unroll
      for (int m = 0; m < 4; ++m)
#pragma unroll
        for (int j = 0; j < 4; ++j) {
          const float r = p.rs[rbase + m * 16 + fq * 4 + j];
#pragma unroll
          for (int n = 0; n < 4; ++n) acc[m][n][j] *= r;
        }
      if (cb < 1280) {
        const int seg = cb >> 6;
        const int which = seg < 8 ? -1 : ((seg - 8) >> 1);
        const int g = seg < 8 ? (seg >> 2) : ((seg - 8) & 1);
        const bool need_norm = (seg < 8) || which == 2 || which == 4;
        if (need_norm) {
          const float* nw = seg < 8 ? p.q_norm_w : (p.k_norm_w + (which == 2 ? 64 : 128));
          float w[4];
#pragma unroll
          for (int n = 0; n < 4; ++n) w[n] = nw[n * 16 + fr];
          const float qs = seg < 8 ? QSCALE : 1.0f;
#pragma unroll
          for (int m = 0; m < 4; ++m)
#pragma unroll
            for (int j = 0; j < 4; ++j) {
              float ss = 0.f;
#pragma unroll
              for (int n = 0; n < 4; ++n) ss += acc[m][n][j] * acc[m][n][j];
              ss += __shfl_xor(ss, 1); ss += __shfl_xor(ss, 2); ss += __shfl_xor(ss, 4); ss += __shfl_xor(ss, 8);
              const float rr = rsqrtf(ss * (1.0f / 64.f) + EPS);
#pragma unroll
              for (int n = 0; n < 4; ++n) acc[m][n][j] = acc[m][n][j] * rr * w[n];
              const int t = tb + m * 16 + fq * 4 + j;
              const float2 cs = *(const float2*)(p.rope + ((size_t)t * 8 + (fr & 7)) * 2);
              const float v = acc[m][0][j];
              const float pr = __shfl_xor(v, 8);
              acc[m][0][j] = (fr < 8) ? (v * cs.x - pr * cs.y) : (v * cs.x + pr * cs.y);
#pragma unroll
              for (int n = 0; n < 4; ++n) acc[m][n][j] *= qs;
            }
        }
        if (seg < 8) {
          const int r = seg & 3;
#pragma unroll
          for (int m = 0; m < 4; ++m)
#pragma unroll
            for (int j = 0; j < 4; ++j) {
              const int t = tb + m * 16 + fq * 4 + j;
              u16* dst = p.Q + ((size_t)((b * 2 + g) * 4096 + t) * 4 + r) * 64 + fr;
#pragma unroll
              for (int n = 0; n < 4; ++n) dst[n * 16] = f2bf(acc[m][n][j]);
            }
        } else if (which == 3 || which == 5) {
          u16* vt = (which == 3 ? p.Vst : p.Vwt) + (size_t)((b * 2 + g) * 64 + (tb >> 6)) * 4096;
#pragma unroll
          for (int m = 0; m < 4; ++m)
#pragma unroll
            for (int n = 0; n < 4; ++n) {
              u32x2 o; o[0] = cvtpk(acc[m][n][0], acc[m][n][1]); o[1] = cvtpk(acc[m][n][2], acc[m][n][3]);
              *(u32x2*)(vt + (n * 16 + fr) * 64 + m * 16 + fq * 4) = o;
            }
        } else {
          u16* buf = which == 0 ? p.kcraw : which == 1 ? p.vcraw : which == 2 ? p.Ks : p.Kw;
#pragma unroll
          for (int m = 0; m < 4; ++m)
#pragma unroll
            for (int j = 0; j < 4; ++j) {
              const int t = tb + m * 16 + fq * 4 + j;
              u16* dst = buf + ((size_t)(b * 2 + g) * 4096 + t) * 64 + fr;
#pragma unroll
              for (int n = 0; n < 4; ++n) dst[n * 16] = f2bf(acc[m][n][j]);
            }
        }
      } else {
#pragma unroll
        for (int m = 0; m < 4; ++m)
#pragma unroll
          for (int j = 0; j < 4; ++j) {
            const size_t row = rbase + m * 16 + fq * 4 + j;
#pragma unroll
            for (int n = 0; n < 4; ++n) {
              const int col = cb + n * 16 + fr;
              const float v = acc[m][n][j];
              if (col < 1304) p.gates[row * 24 + (col - 1280)] = sigmoidf_(v);
              else if (col < 1816) p.zs[row * 512 + (col - 1304)] = f2bf(siluf_(v));
              else if (col < DIN) p.cvb[row * 2048 + (col - 1816)] = f2bf(v);
            }
          }
      }
    }
  }
}

__device__ void phase_cmp_conv(const Params& p, char* smem, int bid, int nb) {
  const int tid = threadIdx.x, lane = tid & 63, wid = tid >> 6, fr = lane & 15, fq = lane >> 4;
  const int gw = bid * 8 + wid, nw = nb * 8;
  char* hl = smem + wid * 4352;
  for (int job = gw; job < 512 + 2048; job += nw) {
    if (job < 512) {
      const int which = job >> 8, rest = job & 255, bg = rest >> 4, ct = rest & 15;
      const u16* raw = (which ? p.vcraw : p.kcraw) + (size_t)bg * 4096 * 64;
      const u16* w1T = which ? p.w1vT : p.w1kT;
      const u16* w2T = which ? p.w2vT : p.w2kT;
      const float* b1 = which ? p.cv_b1 : p.ck_b1;
      f32x4 acc[8];
#pragma unroll
      for (int n = 0; n < 8; ++n) acc[n] = f32x4{0.f, 0.f, 0.f, 0.f};
      const int c = ct * 16 + fr;
#pragma unroll 2
      for (int ks = 0; ks < 64; ++ks) {
        const int l = ks >> 1, d0 = (ks & 1) * 32 + fq * 8;
        int tt = c * 16 + l; tt = tt > 4095 ? 4095 : tt;
        const bf16x8 a = *(const bf16x8*)(raw + (size_t)tt * 64 + d0);
#pragma unroll
        for (int n = 0; n < 8; ++n) {
          const bf16x8 bb = *(const bf16x8*)(w1T + (size_t)(n * 16 + fr) * 2048 + ks * 32 + fq * 8);
          acc[n] = MFMA16(a, bb, acc[n]);
        }
      }
#pragma unroll
      for (int n = 0; n < 8; ++n) {
        const int hh = n * 16 + fr;
        float bias = b1[hh];
#pragma unroll
        for (int ch = 0; ch < 8; ++ch) bias += p.ckpart[(which * 8 + ch) * 128 + hh];
#pragma unroll
        for (int j = 0; j < 4; ++j) *(u16*)(hl + (fq * 4 + j) * 272 + hh * 2) = f2bf(siluf_(acc[n][j] + bias));
      }
      __builtin_amdgcn_wave_barrier();
      f32x4 o2[4];
#pragma unroll
      for (int n = 0; n < 4; ++n) o2[n] = f32x4{0.f, 0.f, 0.f, 0.f};
#pragma unroll
      for (int ks = 0; ks < 4; ++ks) {
        const bf16x8 a = *(const bf16x8*)(hl + fr * 272 + (ks * 32 + fq * 8) * 2);
#pragma unroll
        for (int n = 0; n < 4; ++n) {
          const bf16x8 bb = *(const bf16x8*)(w2T + (size_t)(n * 16 + fr) * 128 + ks * 32 + fq * 8);
          o2[n] = MFMA16(a, bb, o2[n]);
        }
      }
      __builtin_amdgcn_wave_barrier();
      if (which == 0) {
        float w[4];
#pragma unroll
        for (int n = 0; n < 4; ++n) w[n] = p.k_norm_w[n * 16 + fr];
#pragma unroll
        for (int j = 0; j < 4; ++j) {
          const int cc = ct * 16 + fq * 4 + j;
          float ss = 0.f;
#pragma unroll
          for (int n = 0; n < 4; ++n) ss += o2[n][j] * o2[n][j];
          ss += __shfl_xor(ss, 1); ss += __shfl_xor(ss, 2); ss += __shfl_xor(ss, 4); ss += __shfl_xor(ss, 8);
          const float rr = rsqrtf(ss * (1.0f / 64.f) + EPS);
          float v[4];
#pragma unroll
          for (int n = 0; n < 4; ++n) v[n] = o2[n][j] * rr * w[n];
          int pos = cc * 16 + 31; pos = pos > 4095 ? 4095 : pos;
          const float2 cs = *(const float2*)(p.rope + ((size_t)pos * 8 + (fr & 7)) * 2);
          const float pr = __shfl_xor(v[0], 8);
          v[0] = (fr < 8) ? (v[0] * cs.x - pr * cs.y) : (v[0] * cs.x + pr * cs.y);
          u16* dst = p.Kc + ((size_t)bg * 256 + cc) * 64 + fr;
#pragma unroll
          for (int n = 0; n < 4; ++n) dst[n * 16] = (cc < 255) ? f2bf(v[n]) : (u16)0;
        }
      } else {
        const int c0 = ct * 16 + fq * 4;
        u16* vt = p.Vct + (size_t)(bg * 4 + (c0 >> 6)) * 4096;
#pragma unroll
        for (int n = 0; n < 4; ++n) {
          const float v3 = (c0 + 3 < 255) ? o2[n][3] : 0.f;
          u32x2 o; o[0] = cvtpk(o2[n][0], o2[n][1]); o[1] = cvtpk(o2[n][2], v3);
          *(u32x2*)(vt + (n * 16 + fr) * 64 + (c0 & 63)) = o;
        }
      }
    } else {
      const int chunk = job - 512;
      const int r0 = chunk * 16, t0 = r0 & 4095;
      const int ch = lane * 8;
      float cw0[8], cw1[8], cw2[8], cbv[8], u1[8], u2[8];
#pragma unroll
      for (int e = 0; e < 8; ++e) { cw0[e] = p.conv_w[ch + e]; cw1[e] = p.conv_w[512 + ch + e]; cw2[e] = p.conv_w[1024 + ch + e]; cbv[e] = p.conv_b[ch + e]; u1[e] = 0.f; u2[e] = 0.f; }
      if (t0 > 0) {
#pragma unroll
        for (int q = 0; q < 2; ++q) {
          const u16* rp = p.cvb + (size_t)(r0 - 2 + q) * 2048 + ch;
          const u32x4 hv = *(const u32x4*)(rp), cv = *(const u32x4*)(rp + 1024);
#pragma unroll
          for (int e = 0; e < 4; ++e) {
            const float ua = bflo(hv[e]) * bflo(cv[e]), ub = bfhi(hv[e]) * bfhi(cv[e]);
            if (q == 0) { u2[2 * e] = ua; u2[2 * e + 1] = ub; } else { u1[2 * e] = ua; u1[2 * e + 1] = ub; }
          }
        }
      }
      for (int rr = 0; rr < 16; ++rr) {
        const u16* rp = p.cvb + (size_t)(r0 + rr) * 2048 + ch;
        const u32x4 hv = *(const u32x4*)(rp), bv = *(const u32x4*)(rp + 512), cv = *(const u32x4*)(rp + 1024), zv = *(const u32x4*)(rp + 1536);
        u32x4 ov;
#pragma unroll
        for (int e = 0; e < 4; ++e) {
          const float ua = bflo(hv[e]) * bflo(cv[e]), ub = bfhi(hv[e]) * bfhi(cv[e]);
          const float ca = cw0[2 * e] * u2[2 * e] + cw1[2 * e] * u1[2 * e] + cw2[2 * e] * ua + cbv[2 * e];
          const float cbb = cw0[2 * e + 1] * u2[2 * e + 1] + cw1[2 * e + 1] * u1[2 * e + 1] + cw2[2 * e + 1] * ub + cbv[2 * e + 1];
          const float oa = bflo(bv[e]) * ca * siluf_(bflo(zv[e]));
          const float ob = bfhi(bv[e]) * cbb * siluf_(bfhi(zv[e]));
          ov[e] = cvtpk(oa, ob);
          u2[2 * e] = u1[2 * e]; u2[2 * e + 1] = u1[2 * e + 1]; u1[2 * e] = ua; u1[2 * e + 1] = ub;
        }
        *(u32x4*)(p.mix + (size_t)(r0 + rr) * 1024 + 512 + ch) = ov;
      }
    }
  }
}

constexpr int AT_KB = 64 * 144, AT_VB = 64 * 136, AT_BUF = AT_KB + AT_VB;
constexpr int AT_IMPA = 2 * AT_BUF, AT_IMPB = AT_IMPA + 64 * 65 * 4, AT_VAL = AT_IMPB + 64 * 65 * 4, AT_SELM = AT_VAL + 64 * 65 * 4, AT_UNIT = AT_SELM + 512;

__device__ void phase_attn(const Params& p, char* smem, int bid, int nb) {
  const int tid = threadIdx.x, lane = tid & 63, wid = tid >> 6, c32 = lane & 31, h = lane >> 5;
  const float NINF = -__builtin_inff();
  float* impa = (float*)(smem + AT_IMPA);
  float* impb = (float*)(smem + AT_IMPB);
  float* vals = (float*)(smem + AT_VAL);
  unsigned* selm = (unsigned*)(smem + AT_SELM);
  volatile int* s_unit = (volatile int*)(smem + AT_UNIT);
  const int srow = tid >> 3, sc = tid & 7;
  while (true) {
    if (tid == 0) *s_unit = (int)atomicAdd(p.counter, 1u);
    __syncthreads();
    const int u = *s_unit;
    __syncthreads();
    if (u >= 1024) break;
    const int i = 63 - (u >> 4), bg = u & 15, b = bg >> 1, g = bg & 1;
    const int tl = wid * 8 + (c32 >> 2), hd = c32 & 3;
    const int t = i * 64 + tl;
    const u16* qrow = p.Q + ((size_t)(bg * 4096 + i * 64) * 4 + wid * 32 + c32) * 64;
    bf16x8 qf[4];
#pragma unroll
    for (int ks = 0; ks < 4; ++ks) qf[ks] = *(const bf16x8*)(qrow + ks * 16 + h * 8);
    const float* gp = p.gates + (size_t)(b * 4096 + t) * 24 + (g * 4 + hd) * 3;
    const float g0 = gp[0], g1 = gp[1], g2 = gp[2];
    const int ntc = (4 * i + 2) / 64 + 1, nsl = i + 1, nwin = (i < 8 ? i : 8) + 1;
    const int NT = 2 * ntc + nsl + nwin;
    const bool need_sel = i >= 16;

    f32x16 F0, F1, O0, O1;
#pragma unroll
    for (int r = 0; r < 16; ++r) { F0[r] = 0.f; F1[r] = 0.f; O0[r] = 0.f; O1[r] = 0.f; }
    float m_run = NINF, l_run = 0.f, inv_l = 0.f;
    unsigned sel_lo = 0xffffffffu, sel_hi = 0xffffffffu;
    u32x4 rk, rv;
#define TILE_PTRS(n, kp, vp) do { \
      if ((n) < 2 * ntc) { const int tt_ = (n) < ntc ? (n) : (n) - ntc; kp = p.Kc + ((size_t)bg * 256 + tt_ * 64) * 64; vp = p.Vct + (size_t)(bg * 4 + tt_) * 4096; } \
      else if ((n) < 2 * ntc + nsl) { const int j_ = (n) - 2 * ntc; kp = p.Ks + ((size_t)bg * 4096 + j_ * 64) * 64; vp = p.Vst + (size_t)(bg * 64 + j_) * 4096; } \
      else { const int j_ = i - nwin + 1 + ((n) - 2 * ntc - nsl); kp = p.Kw + ((size_t)bg * 4096 + j_ * 64) * 64; vp = p.Vwt + (size_t)(bg * 64 + j_) * 4096; } } while (0)
#define TLOAD(n) do { const u16 *kp_, *vp_; TILE_PTRS(n, kp_, vp_); rk = *(const u32x4*)(kp_ + tid * 8); rv = *(const u32x4*)(vp_ + tid * 8); } while (0)
#define TSTORE(bf_) do { char* kb_ = smem + (bf_) * AT_BUF; *(u32x4*)(kb_ + srow * 144 + sc * 16) = rk; \
      u32x2 lo_, hi_; lo_[0] = rv[0]; lo_[1] = rv[1]; hi_[0] = rv[2]; hi_[1] = rv[3]; \
      *(u32x2*)(kb_ + AT_KB + srow * 136 + sc * 16) = lo_; *(u32x2*)(kb_ + AT_KB + srow * 136 + sc * 16 + 8) = hi_; } while (0)
    TLOAD(0); TSTORE(0); __syncthreads();
    for (int n = 0; n < NT; ++n) {
      if (n + 1 < NT) TLOAD(n + 1);
      int mode, base, lo, hi;
      if (n < 2 * ntc) { mode = n < ntc ? 0 : 1; base = (n < ntc ? n : n - ntc) * 64; lo = -1; hi = (t - 31) >> 4; }
      else if (n < 2 * ntc + nsl) { const int j = n - 2 * ntc; mode = 2; base = j * 64; const unsigned bit = j < 32 ? (sel_lo >> j) & 1u : (sel_hi >> (j - 32)) & 1u; lo = -1; hi = bit ? t : -1; }
      else { const int j = i - nwin + 1 + (n - 2 * ntc - nsl); mode = 3; base = j * 64; lo = t - 512; hi = t; }
      const int lo_rel = lo - (base + 4 * h), hi_rel = hi - (base + 4 * h);
      const char* kb = smem + (n & 1) * AT_BUF;
      const char* vb = kb + AT_KB;
      f32x16 S0, S1;
#pragma unroll
      for (int r = 0; r < 16; ++r) { S0[r] = 0.f; S1[r] = 0.f; }
#pragma unroll
      for (int ks = 0; ks < 4; ++ks) {
        const bf16x8 k0 = *(const bf16x8*)(kb + c32 * 144 + (ks * 16 + h * 8) * 2);
        const bf16x8 k1 = *(const bf16x8*)(kb + (32 + c32) * 144 + (ks * 16 + h * 8) * 2);
        S0 = MFMA32(k0, qf[ks], S0);
        S1 = MFMA32(k1, qf[ks], S1);
      }
      float mx = NINF;
#pragma unroll
      for (int r = 0; r < 16; ++r) {
        const int off = (r & 3) + 8 * (r >> 2);
        S0[r] = (off > lo_rel && off <= hi_rel) ? S0[r] : NINF;
        S1[r] = (off + 32 > lo_rel && off + 32 <= hi_rel) ? S1[r] : NINF;
        mx = fmaxf(mx, fmaxf(S0[r], S1[r]));
      }
      float m_use;
      if (mode != 1) {
        mx = fmaxf(mx, __shfl_xor(mx, 32));
        const float m_new = fmaxf(m_run, mx);
        m_use = (m_new == NINF) ? 0.f : m_new;
        const float alpha = __builtin_amdgcn_exp2f(m_run - m_use);
        m_run = m_new;
        float ps = 0.f;
#pragma unroll
        for (int r = 0; r < 16; ++r) { S0[r] = __builtin_amdgcn_exp2f(S0[r] - m_use); S1[r] = __builtin_amdgcn_exp2f(S1[r] - m_use); ps += S0[r] + S1[r]; }
        l_run = l_run * alpha + ps;
        if (mode != 0) {
#pragma unroll
          for (int r = 0; r < 16; ++r) { O0[r] *= alpha; O1[r] *= alpha; }
        }
      } else {
        m_use = (m_run == NINF) ? 0.f : m_run;
#pragma unroll
        for (int r = 0; r < 16; ++r) { S0[r] = __builtin_amdgcn_exp2f(S0[r] - m_use); S1[r] = __builtin_amdgcn_exp2f(S1[r] - m_use); }
      }
      if (mode != 0) {
#pragma unroll
        for (int kk = 0; kk < 4; ++kk) {
          const int kr = kk >> 1, sp = kk & 1;
          u32x4 pw;
#pragma unroll
          for (int e = 0; e < 4; ++e) {
            const float a0 = kr ? S1[8 * sp + 2 * e] : S0[8 * sp + 2 * e];
            const float a1 = kr ? S1[8 * sp + 2 * e + 1] : S0[8 * sp + 2 * e + 1];
            pw[e] = cvtpk(a0, a1);
          }
          const bf16x8 pf = __builtin_bit_cast(bf16x8, pw);
#pragma unroll
          for (int dr = 0; dr < 2; ++dr) {
            const char* va = vb + (32 * dr + c32) * 136 + (32 * kr + 16 * sp + 4 * h) * 2;
            const s16x4 vlo = *(const s16x4*)(va), vhi = *(const s16x4*)(va + 16);
            const bf16x8 vf = __builtin_shufflevector(vlo, vhi, 0, 1, 2, 3, 4, 5, 6, 7);
            if (dr == 0) O0 = MFMA32(vf, pf, O0); else O1 = MFMA32(vf, pf, O1);
          }
        }
      }
      if (mode == 1 && need_sel) {
        const int tt = base >> 6;
#pragma unroll
        for (int kr = 0; kr < 2; ++kr)
#pragma unroll
          for (int rg = 0; rg < 4; ++rg) {
            float pv[4];
#pragma unroll
            for (int e = 0; e < 4; ++e) {
              float v = (kr ? S1[rg * 4 + e] : S0[rg * 4 + e]) * inv_l;
              v += __shfl_xor(v, 1); v += __shfl_xor(v, 2);
              pv[e] = v;
            }
            if (hd == 0) {
              const int nblk = tt * 16 + 8 * kr + 2 * rg + h;
              impa[tl * 65 + nblk] = pv[0] + pv[1] + pv[2] + 0.5f * pv[3];
              impb[tl * 65 + nblk] = 0.5f * pv[3];
            }
          }
      }
      if (n + 1 < NT) TSTORE((n + 1) & 1);
      if (n == ntc - 1) {
        const float lt = l_run + __shfl_xor(l_run, 32);
        inv_l = lt > 0.f ? 1.0f / lt : 0.f;
      } else if (n == 2 * ntc - 1) {
        const float wgt = g0 * inv_l;
#pragma unroll
        for (int r = 0; r < 16; ++r) { F0[r] += wgt * O0[r]; F1[r] += wgt * O1[r]; O0[r] = 0.f; O1[r] = 0.f; }
        m_run = NINF; l_run = 0.f;
        if (need_sel) {
          __syncthreads();
          const int tk = tid >> 3, nb0 = (tid & 7) * 8;
          float myv[8];
#pragma unroll
          for (int e = 0; e < 8; ++e) {
            const int nn = nb0 + e;
            const bool forced = (nn == 0) || (nn == i) || (nn == i - 1);
            float v = -1.0f;
            if (nn <= i) v = impa[tk * 65 + nn] + (nn > 0 ? impb[tk * 65 + nn - 1] : 0.f);
            if (forced) v = 1e9f;
            myv[e] = v;
            vals[tk * 65 + nn] = v;
          }
          __syncthreads();
          int cnt[8];
#pragma unroll
          for (int e = 0; e < 8; ++e) cnt[e] = 0;
          for (int mm = 0; mm < 64; ++mm) {
            const float vm = vals[tk * 65 + mm];
#pragma unroll
            for (int e = 0; e < 8; ++e) cnt[e] += (vm > myv[e] || (vm == myv[e] && mm < nb0 + e)) ? 1 : 0;
          }
          unsigned bits = 0;
#pragma unroll
          for (int e = 0; e < 8; ++e) bits |= (cnt[e] < 16 ? 1u : 0u) << e;
          unsigned wlo = (tid & 7) < 4 ? bits << (8 * (tid & 7)) : 0u;
          unsigned whi = (tid & 7) >= 4 ? bits << (8 * ((tid & 7) - 4)) : 0u;
          wlo |= __shfl_xor(wlo, 1); wlo |= __shfl_xor(wlo, 2); wlo |= __shfl_xor(wlo, 4);
          whi |= __shfl_xor(whi, 1); whi |= __shfl_xor(whi, 2); whi |= __shfl_xor(whi, 4);
          if ((tid & 7) == 0) { selm[tk * 2] = wlo; selm[tk * 2 + 1] = whi; }
          __syncthreads();
          sel_lo = selm[tl * 2]; sel_hi = selm[tl * 2 + 1];
        }
      } else if (n == 2 * ntc + nsl - 1 || n == NT - 1) {
        const float lt = l_run + __shfl_xor(l_run, 32);
        const float wgt = (n == NT - 1 ? g2 : g1) * (lt > 0.f ? 1.0f / lt : 0.f);
#pragma unroll
        for (int r = 0; r < 16; ++r) { F0[r] += wgt * O0[r]; F1[r] += wgt * O1[r]; O0[r] = 0.f; O1[r] = 0.f; }
        m_run = NINF; l_run = 0.f;
      }
      __syncthreads();
    }
#undef TILE_PTRS
#undef TLOAD
#undef TSTORE
    {
      const size_t rowo = (size_t)(b * 4096 + t);
      const u16* zp = p.zs + rowo * 512 + (g * 4 + hd) * 64;
      u16* mp = p.mix + rowo * 1024 + (g * 4 + hd) * 64;
#pragma unroll
      for (int dr = 0; dr < 2; ++dr)
#pragma unroll
        for (int rg = 0; rg < 4; ++rg) {
          const int d = 32 * dr + 8 * rg + 4 * h;
          const u32x2 zv = *(const u32x2*)(zp + d);
          const float f0 = dr ? F1[rg * 4 + 0] : F0[rg * 4 + 0], f1 = dr ? F1[rg * 4 + 1] : F0[rg * 4 + 1];
          const float f2 = dr ? F1[rg * 4 + 2] : F0[rg * 4 + 2], f3 = dr ? F1[rg * 4 + 3] : F0[rg * 4 + 3];
          u32x2 o;
          o[0] = cvtpk(f0 * bflo(zv[0]), f1 * bfhi(zv[0]));
          o[1] = cvtpk(f2 * bflo(zv[1]), f3 * bfhi(zv[1]));
          *(u32x2*)(mp + d) = o;
        }
    }
  }
}

#if FUSED
extern "C" __global__ void __launch_bounds__(NTHREADS) hybrid_fwd(Params p) {
  extern __shared__ __attribute__((aligned(16))) char smem[];
  cg::grid_group grid = cg::this_grid();
  const int bid = blockIdx.x, nb = gridDim.x;
  phase_prep(p, smem, bid, nb);
  grid.sync();
  gemm_phase<0>(p, smem, bid, nb);
  grid.sync();
  phase_cmp_conv(p, smem, bid, nb);
  grid.sync();
  phase_attn(p, smem, bid, nb);
  grid.sync();
  gemm_phase<1>(p, smem, bid, nb);
}
#else
template <int PH>
__global__ void __launch_bounds__(NTHREADS) phase_kernel(Params p) {
  extern __shared__ __attribute__((aligned(16))) char smem[];
  const int bid = blockIdx.x, nb = gridDim.x;
  if constexpr (PH == 0) phase_prep(p, smem, bid, nb);
  if constexpr (PH == 1) gemm_phase<0>(p, smem, bid, nb);
  if constexpr (PH == 2) phase_cmp_conv(p, smem, bid, nb);
  if constexpr (PH == 3) phase_attn(p, smem, bid, nb);
  if constexpr (PH == 4) gemm_phase<1>(p, smem, bid, nb);
}
#endif

extern "C" void kernel_launch(void* const* d_in, const int* in_sizes, int n_in, void* d_out, int out_size, void* d_ws, size_t ws_size, hipStream_t stream) {
  Params p{};
  p.x = (const float*)d_in[0]; p.norm_w = (const float*)d_in[1]; p.w_in = (const float*)d_in[2]; p.q_norm_w = (const float*)d_in[3];
  p.k_norm_w = (const float*)d_in[4]; p.ck_pos = (const float*)d_in[5]; p.ck_w1 = (const float*)d_in[6]; p.ck_b1 = (const float*)d_in[7];
  p.ck_w2 = (const float*)d_in[8]; p.cv_pos = (const float*)d_in[9]; p.cv_w1 = (const float*)d_in[10]; p.cv_b1 = (const float*)d_in[11];
  p.cv_w2 = (const float*)d_in[12]; p.conv_w = (const float*)d_in[13]; p.conv_b = (const float*)d_in[14]; p.w_out = (const float*)d_in[15];
  p.out = (float*)d_out;
  char* w = (char*)d_ws; size_t off = 0;
  auto carve = [&](size_t bytes) { char* r = w + off; off += (bytes + 255) & ~(size_t)255; return r; };
  p.xb = (u16*)carve((size_t)NROWS * DM * 2);
  p.winT = (u16*)carve((size_t)3968 * 1024 * 2);
  p.woutT = (u16*)carve((size_t)1024 * 1024 * 2);
  p.w1kT = (u16*)carve((size_t)128 * 2048 * 2);
  p.w1vT = (u16*)carve((size_t)128 * 2048 * 2);
  p.w2kT = (u16*)carve((size_t)64 * 128 * 2);
  p.w2vT = (u16*)carve((size_t)64 * 128 * 2);
  p.Q = (u16*)carve((size_t)NROWS * 512 * 2);
  p.Ks = (u16*)carve((size_t)16 * 4096 * 64 * 2);
  p.Kw = (u16*)carve((size_t)16 * 4096 * 64 * 2);
  p.Vst = (u16*)carve((size_t)16 * 4096 * 64 * 2);
  p.Vwt = (u16*)carve((size_t)16 * 4096 * 64 * 2);
  p.kcraw = (u16*)carve((size_t)16 * 4096 * 64 * 2 + 4096);
  p.vcraw = (u16*)carve((size_t)16 * 4096 * 64 * 2 + 4096);
  p.Kc = (u16*)carve((size_t)16 * 256 * 64 * 2);
  p.Vct = (u16*)carve((size_t)16 * 256 * 64 * 2);
  p.zs = (u16*)carve((size_t)NROWS * 512 * 2);
  p.cvb = (u16*)carve((size_t)NROWS * 2048 * 2);
  p.mix = (u16*)carve((size_t)NROWS * 1024 * 2);
  p.rs = (float*)carve((size_t)NROWS * 4);
  p.ckpart = (float*)carve(16 * 128 * 4);
  p.rope = (float*)carve((size_t)4096 * 8 * 2 * 4);
  p.gates = (float*)carve((size_t)NROWS * 24 * 4);
  p.counter = (unsigned*)carve(256);
  if (off > ws_size) { fprintf(stderr, "kernel_launch: workspace too small (%zu > %zu)\n", off, ws_size); return; }

#if FUSED
  static int grid_blocks = 0;
  if (!grid_blocks) {
    int dev = 0, cus = 0, per_cu = 0;
    hipGetDevice(&dev);
    hipDeviceGetAttribute(&cus, hipDeviceAttributeMultiprocessorCount, dev);
    hipFuncSetAttribute((const void*)hybrid_fwd, hipFuncAttributeMaxDynamicSharedMemorySize, SMEM_BYTES);
    hipOccupancyMaxActiveBlocksPerMultiprocessor(&per_cu, (const void*)hybrid_fwd, NTHREADS, SMEM_BYTES);
    if (per_cu < 1) per_cu = 1;
    grid_blocks = cus * per_cu;
  }
  void* args[] = {&p};
  hipError_t e = hipLaunchCooperativeKernel((const void*)hybrid_fwd, dim3(grid_blocks), dim3(NTHREADS), args, SMEM_BYTES, stream);
  if (e != hipSuccess) fprintf(stderr, "cooperative launch failed: %s (grid %d)\n", hipGetErrorString(e), grid_blocks);
#else
  static int attr_set = 0;
  if (!attr_set) {
    (void)hipFuncSetAttribute((const void*)phase_kernel<0>, hipFuncAttributeMaxDynamicSharedMemorySize, SMEM_BYTES);
    (void)hipFuncSetAttribute((const void*)phase_kernel<1>, hipFuncAttributeMaxDynamicSharedMemorySize, SMEM_BYTES);
    (void)hipFuncSetAttribute((const void*)phase_kernel<2>, hipFuncAttributeMaxDynamicSharedMemorySize, SMEM_BYTES);
    (void)hipFuncSetAttribute((const void*)phase_kernel<3>, hipFuncAttributeMaxDynamicSharedMemorySize, SMEM_BYTES);
    (void)hipFuncSetAttribute((const void*)phase_kernel<4>, hipFuncAttributeMaxDynamicSharedMemorySize, SMEM_BYTES);
    attr_set = 1;
  }
  const int G = 256;
  phase_kernel<0><<<G, NTHREADS, SMEM_BYTES, stream>>>(p);
  phase_kernel<1><<<G, NTHREADS, SMEM_BYTES, stream>>>(p);
  phase_kernel<2><<<G, NTHREADS, SMEM_BYTES, stream>>>(p);
  phase_kernel<3><<<G, NTHREADS, SMEM_BYTES, stream>>>(p);
  phase_kernel<4><<<G, NTHREADS, SMEM_BYTES, stream>>>(p);
#endif
}
```

```cpp
#include <hip/hip_runtime.h>
#include <hip/hip_cooperative_groups.h>
#include <cstdio>
#include <cstdint>
namespace cg = cooperative_groups;

#ifndef FUSED
#define FUSED 1
#endif

#define DI __device__ __forceinline__
typedef unsigned short u16;
using bf16x8 = __attribute__((ext_vector_type(8))) short;
using s16x4 = __attribute__((ext_vector_type(4))) short;
using f32x4 = __attribute__((ext_vector_type(4))) float;
using f32x16 = __attribute__((ext_vector_type(16))) float;
using u32x4 = __attribute__((ext_vector_type(4))) unsigned;
using u32x2 = __attribute__((ext_vector_type(2))) unsigned;
typedef __bf16 bf2_t __attribute__((ext_vector_type(2)));
typedef float fl2_t __attribute__((ext_vector_type(2)));

constexpr int NTHREADS = 512;
constexpr int SEQ = 4096, DM = 1024, DIN = 3864, NROWS = 32768;
constexpr float EPS = 1e-6f;
constexpr float QSCALE = 0.125f * 1.4426950408889634f;
constexpr int SMEM_BYTES = 135184;

__constant__ float c_invf[8] = {1.0f, 0.1939227432012558f, 0.03760603070259094f, 0.007292664609849453f,
                                0.0014142135623842478f, 0.00027424818836152554f, 5.3182957344688475e-05f, 1.0313385246263351e-05f};

DI unsigned cvtpk(float lo, float hi) {
  fl2_t f = {lo, hi};
  bf2_t b = __builtin_convertvector(f, bf2_t);
  return __builtin_bit_cast(unsigned, b);
}
DI u16 f2bf(float x) { return (u16)(cvtpk(x, 0.f) & 0xffffu); }
DI float bf2f(u16 v) { return __uint_as_float(((unsigned)v) << 16); }
DI float bflo(unsigned v) { return __uint_as_float(v << 16); }
DI float bfhi(unsigned v) { return __uint_as_float(v & 0xffff0000u); }
DI float sigmoidf_(float v) { return 1.0f / (1.0f + __expf(-v)); }
DI float siluf_(float v) { return v / (1.0f + __expf(-v)); }
#define MFMA16(a, b, c) __builtin_amdgcn_mfma_f32_16x16x32_bf16((a), (b), (c), 0, 0, 0)
#define MFMA32(a, b, c) __builtin_amdgcn_mfma_f32_32x32x16_bf16((a), (b), (c), 0, 0, 0)

struct Params {
  const float *x, *norm_w, *w_in, *q_norm_w, *k_norm_w, *ck_pos, *ck_w1, *ck_b1, *ck_w2, *cv_pos, *cv_w1, *cv_b1, *cv_w2, *conv_w, *conv_b, *w_out;
  float* out;
  u16 *xb, *winT, *woutT, *w1kT, *w1vT, *w2kT, *w2vT, *Q, *Ks, *Kw, *Vst, *Vwt, *kcraw, *vcraw, *Kc, *Vct, *zs, *cvb, *mix;
  float *rs, *ckpart, *rope, *gates;
  unsigned* counter;
};

DI void transpose_tile(const float* __restrict__ src, u16* __restrict__ dst, int K, int N, const float* __restrict__ scale, int kt, int nt, char* smem) {
  float* tile = (float*)smem;
  const int tid = threadIdx.x;
#pragma unroll
  for (int i = 0; i < 8; ++i) {
    const int kk = i * 8 + (tid >> 6), nn = tid & 63, n = nt * 64 + nn, k = kt * 64 + kk;
    float v = (n < N) ? src[(size_t)k * N + n] : 0.f;
    if (scale) v *= scale[k];
    tile[kk * 65 + nn] = v;
  }
  __syncthreads();
#pragma unroll
  for (int i = 0; i < 8; ++i) {
    const int nn = i * 8 + (tid >> 6), kk = tid & 63;
    dst[(size_t)(nt * 64 + nn) * K + kt * 64 + kk] = f2bf(tile[kk * 65 + nn]);
  }
  __syncthreads();
}

__device__ void phase_prep(const Params& p, char* smem, int bid, int nb) {
  const int tid = threadIdx.x, lane = tid & 63, wid = tid >> 6;
  constexpr int J_X = 4096, J_TW = 992, J_TO = 256, J_T1 = 64, J_T2 = 2, J_CK = 16, J_ROPE = 64;
  constexpr int TOTAL = J_X + J_TW + J_TO + 2 * J_T1 + 2 * J_T2 + J_CK + J_ROPE;
  if (bid == 0 && tid == 0) *p.counter = 0u;
  for (int j = bid; j < TOTAL; j += nb) {
    int jj = j;
    if (jj < J_X) {
      const int row = jj * 8 + wid;
      const float4* xr = (const float4*)(p.x + (size_t)row * DM);
      float4 v[4]; float ss = 0.f;
#pragma unroll
      for (int i = 0; i < 4; ++i) { v[i] = xr[i * 64 + lane]; ss += v[i].x * v[i].x + v[i].y * v[i].y + v[i].z * v[i].z + v[i].w * v[i].w; }
#pragma unroll
      for (int o = 32; o >= 1; o >>= 1) ss += __shfl_xor(ss, o);
      if (lane == 0) p.rs[row] = rsqrtf(ss * (1.0f / DM) + EPS);
#pragma unroll
      for (int i = 0; i < 4; ++i) {
        u32x2 o; o[0] = cvtpk(v[i].x, v[i].y); o[1] = cvtpk(v[i].z, v[i].w);
        *(u32x2*)(p.xb + (size_t)row * DM + (i * 64 + lane) * 4) = o;
      }
      continue;
    }
    jj -= J_X;
    if (jj < J_TW) { transpose_tile(p.w_in, p.winT, 1024, DIN, p.norm_w, jj & 15, jj >> 4, smem); continue; }
    jj -= J_TW;
    if (jj < J_TO) { transpose_tile(p.w_out, p.woutT, 1024, 1024, nullptr, jj & 15, jj >> 4, smem); continue; }
    jj -= J_TO;
    if (jj < J_T1) { transpose_tile(p.ck_w1, p.w1kT, 2048, 128, nullptr, jj & 31, jj >> 5, smem); continue; }
    jj -= J_T1;
    if (jj < J_T1) { transpose_tile(p.cv_w1, p.w1vT, 2048, 128, nullptr, jj & 31, jj >> 5, smem); continue; }
    jj -= J_T1;
    if (jj < J_T2) { transpose_tile(p.ck_w2, p.w2kT, 128, 64, nullptr, jj, 0, smem); continue; }
    jj -= J_T2;
    if (jj < J_T2) { transpose_tile(p.cv_w2, p.w2vT, 128, 64, nullptr, jj, 0, smem); continue; }
    jj -= J_T2;
    if (jj < J_CK) {
      const int which = jj >> 3, chunk = jj & 7, hh = tid & 127, sub = tid >> 7;
      const float* pos = which ? p.cv_pos : p.ck_pos;
      const float* w1 = which ? p.cv_w1 : p.ck_w1;
      float acc = 0.f;
      const int f0 = chunk * 256 + sub * 64;
#pragma unroll 8
      for (int f = 0; f < 64; ++f) acc += pos[f0 + f] * w1[(size_t)(f0 + f) * 128 + hh];
      float* red = (float*)smem;
      red[sub * 128 + hh] = acc;
      __syncthreads();
      if (tid < 128) p.ckpart[(which * 8 + chunk) * 128 + tid] = red[tid] + red[128 + tid] + red[256 + tid] + red[384 + tid];
      __syncthreads();
      continue;
    }
    jj -= J_CK;
    {
      const int idx = jj * 512 + tid, pos = idx >> 3, fi = idx & 7;
      const float ang = (float)pos * c_invf[fi];
      float s, c; sincosf(ang, &s, &c);
      p.rope[idx * 2] = c; p.rope[idx * 2 + 1] = s;
    }
  }
}

constexpr int G_ABYTES = 256 * 144, G_BBYTES = 128 * 144, G_BUF = G_ABYTES + G_BBYTES;

template <int EPI>
__device__ void gemm_phase(const Params& p, char* smem, int bid, int nb) {
  constexpr int K = 1024;
  constexpr int NT = EPI == 0 ? 31 : 8;
  constexpr int MT = 128;
  const u16* __restrict__ A = EPI == 0 ? p.xb : p.mix;
  const u16* __restrict__ Bt = EPI == 0 ? p.winT : p.woutT;
  const int tid = threadIdx.x, lane = tid & 63, wid = tid >> 6, fr = lane & 15, fq = lane >> 4;
  const int wr = wid >> 1, wc = wid & 1;
  const int srow = tid >> 3, skc = tid & 7;

  for (int tile = bid; tile < MT * NT; tile += nb) {
    const int mt = tile / NT, nt = tile - mt * NT;
    const int m0 = mt * 256, n0 = nt * 128;
    f32x4 acc[4][4];
#pragma unroll
    for (int m = 0; m < 4; ++m)
#pragma unroll
      for (int n = 0; n < 4; ++n) acc[m][n] = f32x4{0.f, 0.f, 0.f, 0.f};
    u32x4 ra[4], rb[2];
    const u16* Ag = A + (size_t)(m0 + srow) * K + skc * 8;
    const u16* Bg = Bt + (size_t)(n0 + srow) * K + skc * 8;
#define GLOAD(kt) do { _Pragma("unroll") for (int i_ = 0; i_ < 4; ++i_) ra[i_] = *(const u32x4*)(Ag + (size_t)i_ * 64 * K + (kt) * 64); \
                       _Pragma("unroll") for (int i_ = 0; i_ < 2; ++i_) rb[i_] = *(const u32x4*)(Bg + (size_t)i_ * 64 * K + (kt) * 64); } while (0)
#define LSTORE(b) do { char* base_ = smem + (b) * G_BUF + srow * 144 + skc * 16; \
                       _Pragma("unroll") for (int i_ = 0; i_ < 4; ++i_) *(u32x4*)(base_ + i_ * 64 * 144) = ra[i_]; \
                       _Pragma("unroll") for (int i_ = 0; i_ < 2; ++i_) *(u32x4*)(base_ + G_ABYTES + i_ * 64 * 144) = rb[i_]; } while (0)
    GLOAD(0); LSTORE(0); __syncthreads();
    for (int kt = 0; kt < 16; ++kt) {
      if (kt < 15) GLOAD(kt + 1);
      const char* ab = smem + (kt & 1) * G_BUF + (wr * 64 + fr) * 144 + fq * 16;
      const char* bb = smem + (kt & 1) * G_BUF + G_ABYTES + (wc * 64 + fr) * 144 + fq * 16;
#pragma unroll
      for (int ks = 0; ks < 2; ++ks) {
        bf16x8 af[4], bf[4];
#pragma unroll
        for (int m = 0; m < 4; ++m) af[m] = *(const bf16x8*)(ab + m * 16 * 144 + ks * 64);
#pragma unroll
        for (int n = 0; n < 4; ++n) bf[n] = *(const bf16x8*)(bb + n * 16 * 144 + ks * 64);
#pragma unroll
        for (int m = 0; m < 4; ++m)
#pragma unroll
          for (int n = 0; n < 4; ++n) acc[m][n] = MFMA16(af[m], bf[n], acc[m][n]);
      }
      if (kt < 15) LSTORE((kt + 1) & 1);
      __syncthreads();
    }
#undef GLOAD
#undef LSTORE
    const int rbase = m0 + wr * 64;
    const int cb = n0 + wc * 64;
    if constexpr (EPI == 1) {
#pragma unroll
      for (int m = 0; m < 4; ++m)
#pragma unroll
        for (int j = 0; j < 4; ++j) {
          const size_t row = rbase + m * 16 + fq * 4 + j;
#pragma unroll
          for (int n = 0; n < 4; ++n) {
            const size_t o = row * DM + cb + n * 16 + fr;
            p.out[o] = p.x[o] + acc[m][n][j];
          }
        }
    } else {
      const int b = m0 >> 12;
      const int tb = rbase & 4095;
#pragma unroll
      for (int m = 0; m < 4; ++m)
#pragma unroll
        for (int j = 0; j < 4; ++j) {
          const float r = p.rs[rbase + m * 16 + fq * 4 + j];
#pragma unroll
          for (int n = 0; n < 4; ++n) acc[m][n][j] *= r;
        }
      if (cb < 1280) {
        const int seg = cb >> 6;
        const int which = seg < 8 ? -1 : ((seg - 8) >> 1);
        const int g = seg < 8 ? (seg >> 2) : ((seg - 8) & 1);
        const bool need_norm = (seg < 8) || which == 2 || which == 4;
        if (need_norm) {
          const float* nw = seg < 8 ? p.q_norm_w : (p.k_norm_w + (which == 2 ? 64 : 128));
          float w[4];
#pragma unroll
          for (int n = 0; n < 4; ++n) w[n] = nw[n * 16 + fr];
          const float qs = seg < 8 ? QSCALE : 1.0f;
#pragma unroll
          for (int m = 0; m < 4; ++m)
#pragma unroll
            for (int j = 0; j < 4; ++j) {
              float ss = 0.f;
#pragma unroll
              for (int n = 0; n < 4; ++n) ss += acc[m][n][j] * acc[m][n][j];
              ss += __shfl_xor(ss, 1); ss += __shfl_xor(ss, 2); ss += __shfl_xor(ss, 4); ss += __shfl_xor(ss, 8);
              const float rr = rsqrtf(ss * (1.0f / 64.f) + EPS);
#pragma unroll
              for (int n = 0; n < 4; ++n) acc[m][n][j] = acc[m][n][j] * rr * w[n];
              const int t = tb + m * 16 + fq * 4 + j;
              const float2 cs = *(const float2*)(p.rope + ((size_t)t * 8 + (fr & 7)) * 2);
              const float v = acc[m][0][j];
              const float pr = __shfl_xor(v, 8);
              acc[m][0][j] = (fr < 8) ? (v * cs.x - pr * cs.y) : (v * cs.x + pr * cs.y);
#pragma unroll
              for (int n = 0; n < 4; ++n) acc[m][n][j] *= qs;
            }
        }
        if (seg < 8) {
          const int r = seg & 3;
#pragma unroll
          for (int m = 0; m < 4; ++m)
#pragma unroll
            for (int j = 0; j < 4; ++j) {
              const int t = tb + m * 16 + fq * 4 + j;
              u16* dst = p.Q + ((size_t)((b * 2 + g) * 4096 + t) * 4 + r) * 64 + fr;
#pragma unroll
              for (int n = 0; n < 4; ++n) dst[n * 16] = f2bf(acc[m][n][j]);
            }
        } else if (which == 3 || which == 5) {
          u16* vt = (which == 3 ? p.Vst : p.Vwt) + (size_t)((b * 2 + g) * 64 + (tb >> 6)) * 4096;
#pragma unroll
          for (int m = 0; m < 4; ++m)
#pragma unroll
            for (int n = 0; n < 4; ++n) {
              u32x2 o; o[0] = cvtpk(acc[m][n][0], acc[m][n][1]); o[1] = cvtpk(acc[m][n][2], acc[m][n][3]);
              *(u32x2*)(vt + (n * 16 + fr) * 64 + m * 16 + fq * 4) = o;
            }
        } else {
          u16* buf = which == 0 ? p.kcraw : which == 1 ? p.vcraw : which == 2 ? p.Ks : p.Kw;
#pragma unroll
          for (int m = 0; m < 4; ++m)
#pragma unroll
            for (int j = 0; j < 4; ++j) {
              const int t = tb + m * 16 + fq * 4 + j;
              u16* dst = buf + ((size_t)(b * 2 + g) * 4096 + t) * 64 + fr;
#pragma unroll
              for (int n = 0; n < 4; ++n) dst[n * 16] = f2bf(acc[m][n][j]);
            }
        }
      } else {
#pragma unroll
        for (int m = 0; m < 4; ++m)
#pragma unroll
          for (int j = 0; j < 4; ++j) {
            const size_t row = rbase + m * 16 + fq * 4 + j;
#pragma unroll
            for (int n = 0; n < 4; ++n) {
              const int col = cb + n * 16 + fr;
              const float v = acc[m][n][j];
              if (col < 1304) p.gates[row * 24 + (col - 1280)] = sigmoidf_(v);
              else if (col < 1816) p.zs[row * 512 + (col - 1304)] = f2bf(siluf_(v));
              else if (col < DIN) p.cvb[row * 2048 + (col - 1816)] = f2bf(v);
            }
          }
      }
    }
  }
}

__device__ void phase_cmp_conv(const Params& p, char* smem, int bid, int nb) {
  const int tid = threadIdx.x, lane = tid & 63, wid = tid >> 6, fr = lane & 15, fq = lane >> 4;
  const int gw = bid * 8 + wid, nw = nb * 8;
  char* hl = smem + wid * 4352;
  for (int job = gw; job < 512 + 2048; job += nw) {
    if (job < 512) {
      const int which = job >> 8, rest = job & 255, bg = rest >> 4, ct = rest & 15;
      const u16* raw = (which ? p.vcraw : p.kcraw) + (size_t)bg * 4096 * 64;
      const u16* w1T = which ? p.w1vT : p.w1kT;
      const u16* w2T = which ? p.w2vT : p.w2kT;
      const float* b1 = which ? p.cv_b1 : p.ck_b1;
      f32x4 acc[8];
#pragma unroll
      for (int n = 0; n < 8; ++n) acc[n] = f32x4{0.f, 0.f, 0.f, 0.f};
      const int c = ct * 16 + fr;
#pragma unroll 2
      for (int ks = 0; ks < 64; ++ks) {
        const int l = ks >> 1, d0 = (ks & 1) * 32 + fq * 8;
        int tt = c * 16 + l; tt = tt > 4095 ? 4095 : tt;
        const bf16x8 a = *(const bf16x8*)(raw + (size_t)tt * 64 + d0);
#pragma unroll
        for (int n = 0; n < 8; ++n) {
          const bf16x8 bb = *(const bf16x8*)(w1T + (size_t)(n * 16 + fr) * 2048 + ks * 32 + fq * 8);
          acc[n] = MFMA16(a, bb, acc[n]);
        }
      }
#pragma unroll
      for (int n = 0; n < 8; ++n) {
        const int hh = n * 16 + fr;
        float bias = b1[hh];
#pragma unroll
        for (int ch = 0; ch < 8; ++ch) bias += p.ckpart[(which * 8 + ch) * 128 + hh];
#pragma unroll
        for (int j = 0; j < 4; ++j) *(u16*)(hl + (fq * 4 + j) * 272 + hh * 2) = f2bf(siluf_(acc[n][j] + bias));
      }
      __builtin_amdgcn_wave_barrier();
      f32x4 o2[4];
#pragma unroll
      for (int n = 0; n < 4; ++n) o2[n] = f32x4{0.f, 0.f, 0.f, 0.f};
#pragma unroll
      for (int ks = 0; ks < 4; ++ks) {
        const bf16x8 a = *(const bf16x8*)(hl + fr * 272 + (ks * 32 + fq * 8) * 2);
#pragma unroll
        for (int n = 0; n < 4; ++n) {
          const bf16x8 bb = *(const bf16x8*)(w2T + (size_t)(n * 16 + fr) * 128 + ks * 32 + fq * 8);
          o2[n] = MFMA16(a, bb, o2[n]);
        }
      }
      __builtin_amdgcn_wave_barrier();
      if (which == 0) {
        float w[4];
#pragma unroll
        for (int n = 0; n < 4; ++n) w[n] = p.k_norm_w[n * 16 + fr];
#pragma unroll
        for (int j = 0; j < 4; ++j) {
          const int cc = ct * 16 + fq * 4 + j;
          float ss = 0.f;
#pragma unroll
          for (int n = 0; n < 4; ++n) ss += o2[n][j] * o2[n][j];
          ss += __shfl_xor(ss, 1); ss += __shfl_xor(ss, 2); ss += __shfl_xor(ss, 4); ss += __shfl_xor(ss, 8);
          const float rr = rsqrtf(ss * (1.0f / 64.f) + EPS);
          float v[4];
#pragma unroll
          for (int n = 0; n < 4; ++n) v[n] = o2[n][j] * rr * w[n];
          int pos = cc * 16 + 31; pos = pos > 4095 ? 4095 : pos;
          const float2 cs = *(const float2*)(p.rope + ((size_t)pos * 8 + (fr & 7)) * 2);
          const float pr = __shfl_xor(v[0], 8);
          v[0] = (fr < 8) ? (v[0] * cs.x - pr * cs.y) : (v[0] * cs.x + pr * cs.y);
          u16* dst = p.Kc + ((size_t)bg * 256 + cc) * 64 + fr;
#pragma unroll
          for (int n = 0; n < 4; ++n) dst[n * 16] = (cc < 255) ? f2bf(v[n]) : (u16)0;
        }
      } else {
        const int c0 = ct * 16 + fq * 4;
        u16* vt = p.Vct + (size_t)(bg * 4 + (c0 >> 6)) * 4096;
#pragma unroll
        for (int n = 0; n < 4; ++n) {
          const float v3 = (c0 + 3 < 255) ? o2[n][3] : 0.f;
          u32x2 o; o[0] = cvtpk(o2[n][0], o2[n][1]); o[1] = cvtpk(o2[n][2], v3);
          *(u32x2*)(vt + (n * 16 + fr) * 64 + (c0 & 63)) = o;
        }
      }
    } else {
      const int chunk = job - 512;
      const int r0 = chunk * 16, t0 = r0 & 4095;
      const int ch = lane * 8;
      float cw0[8], cw1[8], cw2[8], cbv[8], u1[8], u2[8];
#pragma unroll
      for (int e = 0; e < 8; ++e) { cw0[e] = p.conv_w[ch + e]; cw1[e] = p.conv_w[512 + ch + e]; cw2[e] = p.conv_w[1024 + ch + e]; cbv[e] = p.conv_b[ch + e]; u1[e] = 0.f; u2[e] = 0.f; }
      if (t0 > 0) {
#pragma unroll
        for (int q = 0; q < 2; ++q) {
          const u16* rp = p.cvb + (size_t)(r0 - 2 + q) * 2048 + ch;
          const u32x4 hv = *(const u32x4*)(rp), cv = *(const u32x4*)(rp + 1024);
#pragma unroll
          for (int e = 0; e < 4; ++e) {
            const float ua = bflo(hv[e]) * bflo(cv[e]), ub = bfhi(hv[e]) * bfhi(cv[e]);
            if (q == 0) { u2[2 * e] = ua; u2[2 * e + 1] = ub; } else { u1[2 * e] = ua; u1[2 * e + 1] = ub; }
          }
        }
      }
      for (int rr = 0; rr < 16; ++rr) {
        const u16* rp = p.cvb + (size_t)(r0 + rr) * 2048 + ch;
        const u32x4 hv = *(const u32x4*)(rp), bv = *(const u32x4*)(rp + 512), cv = *(const u32x4*)(rp + 1024), zv = *(const u32x4*)(rp + 1536);
        u32x4 ov;
#pragma unroll
        for (int e = 0; e < 4; ++e) {
          const float ua = bflo(hv[e]) * bflo(cv[e]), ub = bfhi(hv[e]) * bfhi(cv[e]);
          const float ca = cw0[2 * e] * u2[2 * e] + cw1[2 * e] * u1[2 * e] + cw2[2 * e] * ua + cbv[2 * e];
          const float cbb = cw0[2 * e + 1] * u2[2 * e + 1] + cw1[2 * e + 1] * u1[2 * e + 1] + cw2[2 * e + 1] * ub + cbv[2 * e + 1];
          const float oa = bflo(bv[e]) * ca * siluf_(bflo(zv[e]));
          const float ob = bfhi(bv[e]) * cbb * siluf_(bfhi(zv[e]));
          ov[e] = cvtpk(oa, ob);
          u2[2 * e] = u1[2 * e]; u2[2 * e + 1] = u1[2 * e + 1]; u1[2 * e] = ua; u1[2 * e + 1] = ub;
        }
        *(u32x4*)(p.mix + (size_t)(r0 + rr) * 1024 + 512 + ch) = ov;
      }
    }
  }
}

constexpr int AT_KB = 64 * 144, AT_VB = 64 * 136, AT_BUF = AT_KB + AT_VB;
constexpr int AT_IMPA = 2 * AT_BUF, AT_IMPB = AT_IMPA + 64 * 65 * 4, AT_VAL = AT_IMPA, AT_SELM = AT_IMPB + 64 * 65 * 4, AT_UNIT = AT_SELM + 512, AT_F = AT_UNIT + 16, AT_END = AT_F + 8 * 8192;

__device__ void phase_attn(const Params& p, char* smem, int bid, int nb) {
  const int tid = threadIdx.x, lane = tid & 63, wid = tid >> 6, c32 = lane & 31, h = lane >> 5;
  const float NINF = -__builtin_inff();
  float* impa = (float*)(smem + AT_IMPA);
  float* impb = (float*)(smem + AT_IMPB);
  float* vals = (float*)(smem + AT_VAL);
  unsigned* selm = (unsigned*)(smem + AT_SELM);
  volatile int* s_unit = (volatile int*)(smem + AT_UNIT);
  const int srow = tid >> 3, sc = tid & 7;
  while (true) {
    if (tid == 0) *s_unit = (int)atomicAdd(p.counter, 1u);
    __syncthreads();
    const int u = *s_unit;
    __syncthreads();
    if (u >= 1024) break;
    const int i = 63 - (u >> 4), bg = u & 15, b = bg >> 1, g = bg & 1;
    const int tl = wid * 8 + (c32 >> 2), hd = c32 & 3;
    const int t = i * 64 + tl;
    const u16* qrow = p.Q + ((size_t)(bg * 4096 + i * 64) * 4 + wid * 32 + c32) * 64;
    bf16x8 qf[4];
#pragma unroll
    for (int ks = 0; ks < 4; ++ks) qf[ks] = *(const bf16x8*)(qrow + ks * 16 + h * 8);
    const float* gp = p.gates + (size_t)(b * 4096 + t) * 24 + (g * 4 + hd) * 3;
    const float g0 = gp[0], g1 = gp[1], g2 = gp[2];
    const int ntc = (4 * i + 2) / 64 + 1, nsl = i + 1, nwin = (i < 8 ? i : 8) + 1;
    const int NT = 2 * ntc + nsl + nwin;
    const bool need_sel = i >= 16;

    f32x16 O0, O1;
#pragma unroll
    for (int r = 0; r < 16; ++r) { O0[r] = 0.f; O1[r] = 0.f; }
    float* fl = (float*)(smem + AT_F + wid * 8192) + lane;
    float m_run = NINF, l_run = 0.f, inv_l = 0.f;
    unsigned sel_lo = 0xffffffffu, sel_hi = 0xffffffffu;
    u32x4 rk, rv;
#define TILE_PTRS(n, kp, vp) do { \
      if ((n) < 2 * ntc) { const int tt_ = (n) < ntc ? (n) : (n) - ntc; kp = p.Kc + ((size_t)bg * 256 + tt_ * 64) * 64; vp = p.Vct + (size_t)(bg * 4 + tt_) * 4096; } \
      else if ((n) < 2 * ntc + nsl) { const int j_ = (n) - 2 * ntc; kp = p.Ks + ((size_t)bg * 4096 + j_ * 64) * 64; vp = p.Vst + (size_t)(bg * 64 + j_) * 4096; } \
      else { const int j_ = i - nwin + 1 + ((n) - 2 * ntc - nsl); kp = p.Kw + ((size_t)bg * 4096 + j_ * 64) * 64; vp = p.Vwt + (size_t)(bg * 64 + j_) * 4096; } } while (0)
#define TLOAD(n) do { const u16 *kp_, *vp_; TILE_PTRS(n, kp_, vp_); rk = *(const u32x4*)(kp_ + tid * 8); rv = *(const u32x4*)(vp_ + tid * 8); } while (0)
#define TSTORE(bf_) do { char* kb_ = smem + (bf_) * AT_BUF; *(u32x4*)(kb_ + srow * 144 + sc * 16) = rk; \
      u32x2 lo_, hi_; lo_[0] = rv[0]; lo_[1] = rv[1]; hi_[0] = rv[2]; hi_[1] = rv[3]; \
      *(u32x2*)(kb_ + AT_KB + srow * 136 + sc * 16) = lo_; *(u32x2*)(kb_ + AT_KB + srow * 136 + sc * 16 + 8) = hi_; } while (0)
    TLOAD(0); TSTORE(0); __syncthreads();
    for (int n = 0; n < NT; ++n) {
      if (n + 1 < NT) TLOAD(n + 1);
      int mode, base, lo, hi;
      if (n < 2 * ntc) { mode = n < ntc ? 0 : 1; base = (n < ntc ? n : n - ntc) * 64; lo = -1; hi = (t - 31) >> 4; }
      else if (n < 2 * ntc + nsl) { const int j = n - 2 * ntc; mode = 2; base = j * 64; const unsigned bit = j < 32 ? (sel_lo >> j) & 1u : (sel_hi >> (j - 32)) & 1u; lo = -1; hi = bit ? t : -1; }
      else { const int j = i - nwin + 1 + (n - 2 * ntc - nsl); mode = 3; base = j * 64; lo = t - 512; hi = t; }
      const int lo_rel = lo - (base + 4 * h), hi_rel = hi - (base + 4 * h);
      const char* kb = smem + (n & 1) * AT_BUF;
      const char* vb = kb + AT_KB;
      f32x16 S0, S1;
#pragma unroll
      for (int r = 0; r < 16; ++r) { S0[r] = 0.f; S1[r] = 0.f; }
#pragma unroll
      for (int ks = 0; ks < 4; ++ks) {
        const bf16x8 k0 = *(const bf16x8*)(kb + c32 * 144 + (ks * 16 + h * 8) * 2);
        const bf16x8 k1 = *(const bf16x8*)(kb + (32 + c32) * 144 + (ks * 16 + h * 8) * 2);
        S0 = MFMA32(k0, qf[ks], S0);
        S1 = MFMA32(k1, qf[ks], S1);
      }
      float mx = NINF;
#pragma unroll
      for (int r = 0; r < 16; ++r) {
        const int off = (r & 3) + 8 * (r >> 2);
        S0[r] = (off > lo_rel && off <= hi_rel) ? S0[r] : NINF;
        S1[r] = (off + 32 > lo_rel && off + 32 <= hi_rel) ? S1[r] : NINF;
        mx = fmaxf(mx, fmaxf(S0[r], S1[r]));
      }
      float m_use;
      if (mode != 1) {
        mx = fmaxf(mx, __shfl_xor(mx, 32));
        const float m_new = fmaxf(m_run, mx);
        m_use = (m_new == NINF) ? 0.f : m_new;
        const float alpha = __builtin_amdgcn_exp2f(m_run - m_use);
        m_run = m_new;
        float ps = 0.f;
#pragma unroll
        for (int r = 0; r < 16; ++r) { S0[r] = __builtin_amdgcn_exp2f(S0[r] - m_use); S1[r] = __builtin_amdgcn_exp2f(S1[r] - m_use); ps += S0[r] + S1[r]; }
        l_run = l_run * alpha + ps;
        if (mode != 0) {
#pragma unroll
          for (int r = 0; r < 16; ++r) { O0[r] *= alpha; O1[r] *= alpha; }
        }
      } else {
        m_use = (m_run == NINF) ? 0.f : m_run;
#pragma unroll
        for (int r = 0; r < 16; ++r) { S0[r] = __builtin_amdgcn_exp2f(S0[r] - m_use); S1[r] = __builtin_amdgcn_exp2f(S1[r] - m_use); }
      }
      if (mode != 0) {
#pragma unroll
        for (int kk = 0; kk < 4; ++kk) {
          const int kr = kk >> 1, sp = kk & 1;
          u32x4 pw;
#pragma unroll
          for (int e = 0; e < 4; ++e) {
            const float a0 = kr ? S1[8 * sp + 2 * e] : S0[8 * sp + 2 * e];
            const float a1 = kr ? S1[8 * sp + 2 * e + 1] : S0[8 * sp + 2 * e + 1];
            pw[e] = cvtpk(a0, a1);
          }
          const bf16x8 pf = __builtin_bit_cast(bf16x8, pw);
#pragma unroll
          for (int dr = 0; dr < 2; ++dr) {
            const char* va = vb + (32 * dr + c32) * 136 + (32 * kr + 16 * sp + 4 * h) * 2;
            const s16x4 vlo = *(const s16x4*)(va), vhi = *(const s16x4*)(va + 16);
            const bf16x8 vf = __builtin_shufflevector(vlo, vhi, 0, 1, 2, 3, 4, 5, 6, 7);
            if (dr == 0) O0 = MFMA32(vf, pf, O0); else O1 = MFMA32(vf, pf, O1);
          }
        }
      }
      if (mode == 1 && need_sel) {
        const int tt = base >> 6;
#pragma unroll
        for (int kr = 0; kr < 2; ++kr)
#pragma unroll
          for (int rg = 0; rg < 4; ++rg) {
            float pv[4];
#pragma unroll
            for (int e = 0; e < 4; ++e) {
              float v = (kr ? S1[rg * 4 + e] : S0[rg * 4 + e]) * inv_l;
              v += __shfl_xor(v, 1); v += __shfl_xor(v, 2);
              pv[e] = v;
            }
            if (hd == 0) {
              const int nblk = tt * 16 + 8 * kr + 2 * rg + h;
              impa[tl * 65 + nblk] = pv[0] + pv[1] + pv[2] + 0.5f * pv[3];
              impb[tl * 65 + nblk] = 0.5f * pv[3];
            }
          }
      }
      if (n + 1 < NT) TSTORE((n + 1) & 1);
      if (n == ntc - 1) {
        const float lt = l_run + __shfl_xor(l_run, 32);
        inv_l = lt > 0.f ? 1.0f / lt : 0.f;
      } else if (n == 2 * ntc - 1) {
        const float wgt = g0 * inv_l;
#pragma unroll
        for (int r = 0; r < 16; ++r) { fl[r * 64] = wgt * O0[r]; fl[(16 + r) * 64] = wgt * O1[r]; O0[r] = 0.f; O1[r] = 0.f; }
        m_run = NINF; l_run = 0.f;
        if (need_sel) {
          __syncthreads();
          const int tk = tid >> 3, nb0 = (tid & 7) * 8;
          float myv[8];
#pragma unroll
          for (int e = 0; e < 8; ++e) {
            const int nn = nb0 + e;
            const bool forced = (nn == 0) || (nn == i) || (nn == i - 1);
            float v = -1.0f;
            if (nn <= i) v = impa[tk * 65 + nn] + (nn > 0 ? impb[tk * 65 + nn - 1] : 0.f);
            if (forced) v = 1e9f;
            myv[e] = v;
            vals[tk * 65 + nn] = v;
          }
          __syncthreads();
          int cnt[8];
#pragma unroll
          for (int e = 0; e < 8; ++e) cnt[e] = 0;
          for (int mm = 0; mm < 64; ++mm) {
            const float vm = vals[tk * 65 + mm];
#pragma unroll
            for (int e = 0; e < 8; ++e) cnt[e] += (vm > myv[e] || (vm == myv[e] && mm < nb0 + e)) ? 1 : 0;
          }
          unsigned bits = 0;
#pragma unroll
          for (int e = 0; e < 8; ++e) bits |= (cnt[e] < 16 ? 1u : 0u) << e;
          unsigned wlo = (tid & 7) < 4 ? bits << (8 * (tid & 7)) : 0u;
          unsigned whi = (tid & 7) >= 4 ? bits << (8 * ((tid & 7) - 4)) : 0u;
          wlo |= __shfl_xor(wlo, 1); wlo |= __shfl_xor(wlo, 2); wlo |= __shfl_xor(wlo, 4);
          whi |= __shfl_xor(whi, 1); whi |= __shfl_xor(whi, 2); whi |= __shfl_xor(whi, 4);
          if ((tid & 7) == 0) { selm[tk * 2] = wlo; selm[tk * 2 + 1] = whi; }
          __syncthreads();
          sel_lo = selm[tl * 2]; sel_hi = selm[tl * 2 + 1];
        }
      } else if (n == 2 * ntc + nsl - 1) {
        const float lt = l_run + __shfl_xor(l_run, 32);
        const float wgt = g1 * (lt > 0.f ? 1.0f / lt : 0.f);
#pragma unroll
        for (int r = 0; r < 16; ++r) { fl[r * 64] += wgt * O0[r]; fl[(16 + r) * 64] += wgt * O1[r]; O0[r] = 0.f; O1[r] = 0.f; }
        m_run = NINF; l_run = 0.f;
      }
      __syncthreads();
    }
#undef TILE_PTRS
#undef TLOAD
#undef TSTORE
    {
      const float lt = l_run + __shfl_xor(l_run, 32);
      const float wgt = g2 * (lt > 0.f ? 1.0f / lt : 0.f);
      const size_t rowo = (size_t)(b * 4096 + t);
      const u16* zp = p.zs + rowo * 512 + (g * 4 + hd) * 64;
      u16* mp = p.mix + rowo * 1024 + (g * 4 + hd) * 64;
#pragma unroll
      for (int dr = 0; dr < 2; ++dr)
#pragma unroll
        for (int rg = 0; rg < 4; ++rg) {
          const int d = 32 * dr + 8 * rg + 4 * h;
          const u32x2 zv = *(const u32x2*)(zp + d);
          const float f0 = fl[(dr * 16 + rg * 4 + 0) * 64] + wgt * (dr ? O1[rg * 4 + 0] : O0[rg * 4 + 0]);
          const float f1 = fl[(dr * 16 + rg * 4 + 1) * 64] + wgt * (dr ? O1[rg * 4 + 1] : O0[rg * 4 + 1]);
          const float f2 = fl[(dr * 16 + rg * 4 + 2) * 64] + wgt * (dr ? O1[rg * 4 + 2] : O0[rg * 4 + 2]);
          const float f3 = fl[(dr * 16 + rg * 4 + 3) * 64] + wgt * (dr ? O1[rg * 4 + 3] : O0[rg * 4 + 3]);
          u32x2 o;
          o[0] = cvtpk(f0 * bflo(zv[0]), f1 * bfhi(zv[0]));
          o[1] = cvtpk(f2 * bflo(zv[1]), f3 * bfhi(zv[1]));
          *(u32x2*)(mp + d) = o;
        }
    }
  }
}

#if FUSED
extern "C" __global__ void __launch_bounds__(NTHREADS) hybrid_fwd(Params p) {
  extern __shared__ __attribute__((aligned(16))) char smem[];
  cg::grid_group grid = cg::this_grid();
  const int bid = blockIdx.x, nb = gridDim.x;
  phase_prep(p, smem, bid, nb);
  grid.sync();
  gemm_phase<0>(p, smem, bid, nb);
  grid.sync();
  phase_cmp_conv(p, smem, bid, nb);
  grid.sync();
  phase_attn(p, smem, bid, nb);
  grid.sync();
  gemm_phase<1>(p, smem, bid, nb);
}
#else
template <int PH>
__global__ void __launch_bounds__(NTHREADS) phase_kernel(Params p) {
  extern __shared__ __attribute__((aligned(16))) char smem[];
  const int bid = blockIdx.x, nb = gridDim.x;
  if constexpr (PH == 0) phase_prep(p, smem, bid, nb);
  if constexpr (PH == 1) gemm_phase<0>(p, smem, bid, nb);
  if constexpr (PH == 2) phase_cmp_conv(p, smem, bid, nb);
  if constexpr (PH == 3) phase_attn(p, smem, bid, nb);
  if constexpr (PH == 4) gemm_phase<1>(p, smem, bid, nb);
}
#endif

extern "C" void kernel_launch(void* const* d_in, const int* in_sizes, int n_in, void* d_out, int out_size, void* d_ws, size_t ws_size, hipStream_t stream) {
  Params p{};
  p.x = (const float*)d_in[0]; p.norm_w = (const float*)d_in[1]; p.w_in = (const float*)d_in[2]; p.q_norm_w = (const float*)d_in[3];
  p.k_norm_w = (const float*)d_in[4]; p.ck_pos = (const float*)d_in[5]; p.ck_w1 = (const float*)d_in[6]; p.ck_b1 = (const float*)d_in[7];
  p.ck_w2 = (const float*)d_in[8]; p.cv_pos = (const float*)d_in[9]; p.cv_w1 = (const float*)d_in[10]; p.cv_b1 = (const float*)d_in[11];
  p.cv_w2 = (const float*)d_in[12]; p.conv_w = (const float*)d_in[13]; p.conv_b = (const float*)d_in[14]; p.w_out = (const float*)d_in[15];
  p.out = (float*)d_out;
  char* w = (char*)d_ws; size_t off = 0;
  auto carve = [&](size_t bytes) { char* r = w + off; off += (bytes + 255) & ~(size_t)255; return r; };
  p.xb = (u16*)carve((size_t)NROWS * DM * 2);
  p.winT = (u16*)carve((size_t)3968 * 1024 * 2);
  p.woutT = (u16*)carve((size_t)1024 * 1024 * 2);
  p.w1kT = (u16*)carve((size_t)128 * 2048 * 2);
  p.w1vT = (u16*)carve((size_t)128 * 2048 * 2);
  p.w2kT = (u16*)carve((size_t)64 * 128 * 2);
  p.w2vT = (u16*)carve((size_t)64 * 128 * 2);
  p.Q = (u16*)carve((size_t)NROWS * 512 * 2);
  p.Ks = (u16*)carve((size_t)16 * 4096 * 64 * 2);
  p.Kw = (u16*)carve((size_t)16 * 4096 * 64 * 2);
  p.Vst = (u16*)carve((size_t)16 * 4096 * 64 * 2);
  p.Vwt = (u16*)carve((size_t)16 * 4096 * 64 * 2);
  p.kcraw = (u16*)carve((size_t)16 * 4096 * 64 * 2 + 4096);
  p.vcraw = (u16*)carve((size_t)16 * 4096 * 64 * 2 + 4096);
  p.Kc = (u16*)carve((size_t)16 * 256 * 64 * 2);
  p.Vct = (u16*)carve((size_t)16 * 256 * 64 * 2);
  p.zs = (u16*)carve((size_t)NROWS * 512 * 2);
  p.cvb = (u16*)carve((size_t)NROWS * 2048 * 2);
  p.mix = (u16*)carve((size_t)NROWS * 1024 * 2);
  p.rs = (float*)carve((size_t)NROWS * 4);
  p.ckpart = (float*)carve(16 * 128 * 4);
  p.rope = (float*)carve((size_t)4096 * 8 * 2 * 4);
  p.gates = (float*)carve((size_t)NROWS * 24 * 4);
  p.counter = (unsigned*)carve(256);
  if (off > ws_size) { fprintf(stderr, "kernel_launch: workspace too small (%zu > %zu)\n", off, ws_size); return; }

#if FUSED
  static int grid_blocks = 0;
  if (!grid_blocks) {
    int dev = 0, cus = 0, per_cu = 0;
    hipGetDevice(&dev);
    hipDeviceGetAttribute(&cus, hipDeviceAttributeMultiprocessorCount, dev);
    hipFuncSetAttribute((const void*)hybrid_fwd, hipFuncAttributeMaxDynamicSharedMemorySize, SMEM_BYTES);
    hipOccupancyMaxActiveBlocksPerMultiprocessor(&per_cu, (const void*)hybrid_fwd, NTHREADS, SMEM_BYTES);
    if (per_cu < 1) per_cu = 1;
    grid_blocks = cus * per_cu;
  }
  void* args[] = {&p};
  hipError_t e = hipLaunchCooperativeKernel((const void*)hybrid_fwd, dim3(grid_blocks), dim3(NTHREADS), args, SMEM_BYTES, stream);
  if (e != hipSuccess) fprintf(stderr, "cooperative launch failed: %s (grid %d)\n", hipGetErrorString(e), grid_blocks);
#else
  static int attr_set = 0;
  if (!attr_set) {
    (void)hipFuncSetAttribute((const void*)phase_kernel<0>, hipFuncAttributeMaxDynamicSharedMemorySize, SMEM_BYTES);
    (void)hipFuncSetAttribute((const void*)phase_kernel<1>, hipFuncAttributeMaxDynamicSharedMemorySize, SMEM_BYTES);
    (void)hipFuncSetAttribute((const void*)phase_kernel<2>, hipFuncAttributeMaxDynamicSharedMemorySize, SMEM_BYTES);
    (void)hipFuncSetAttribute((const void*)phase_kernel<3>, hipFuncAttributeMaxDynamicSharedMemorySize, SMEM_BYTES);
    (void)hipFuncSetAttribute((const void*)phase_kernel<4>, hipFuncAttributeMaxDynamicSharedMemorySize, SMEM_BYTES);
    attr_set = 1;
  }
  const int G = 256;
  phase_kernel<0><<<G, NTHREADS, SMEM_BYTES, stream>>>(p);
  phase_kernel<1><<<G, NTHREADS, SMEM_BYTES, stream>>>(p);
  phase_kernel<2><<<G, NTHREADS, SMEM_BYTES, stream>>>(p);
  phase_kernel<3><<<G, NTHREADS, SMEM_BYTES, stream>>>(p);
  phase_kernel<4><<<G, NTHREADS, SMEM_BYTES, stream>>>(p);
#endif
}
```

```cpp
#include <hip/hip_runtime.h>
#include <hip/hip_cooperative_groups.h>
#include <cstdio>
#include <cstdint>
namespace cg = cooperative_groups;

#ifndef FUSED
#define FUSED 1
#endif
#define REP0 1
#define REP1 1
#define REP2 1
#define REP3 1
#define REP4 1

#define DI __device__ __forceinline__
typedef unsigned short u16;
using bf16x8 = __attribute__((ext_vector_type(8))) short;
using s16x4 = __attribute__((ext_vector_type(4))) short;
using f32x4 = __attribute__((ext_vector_type(4))) float;
using f32x16 = __attribute__((ext_vector_type(16))) float;
using u32x4 = __attribute__((ext_vector_type(4))) unsigned;
using u32x2 = __attribute__((ext_vector_type(2))) unsigned;
typedef __bf16 bf2_t __attribute__((ext_vector_type(2)));
typedef float fl2_t __attribute__((ext_vector_type(2)));

constexpr int NTHREADS = 512;
constexpr int SEQ = 4096, DM = 1024, DIN = 3864, NROWS = 32768;
constexpr int LDK = 1088;
constexpr float EPS = 1e-6f;
constexpr float QSCALE = 0.125f * 1.4426950408889634f;
constexpr int SMEM_BYTES = 148000;

__constant__ float c_invf[8] = {1.0f, 0.1939227432012558f, 0.03760603070259094f, 0.007292664609849453f,
                                0.0014142135623842478f, 0.00027424818836152554f, 5.3182957344688475e-05f, 1.0313385246263351e-05f};

DI unsigned cvtpk(float lo, float hi) {
  fl2_t f = {lo, hi};
  bf2_t b = __builtin_convertvector(f, bf2_t);
  return __builtin_bit_cast(unsigned, b);
}
DI u16 f2bf(float x) { return (u16)(cvtpk(x, 0.f) & 0xffffu); }
DI float bf2f(u16 v) { return __uint_as_float(((unsigned)v) << 16); }
DI float bflo(unsigned v) { return __uint_as_float(v << 16); }
DI float bfhi(unsigned v) { return __uint_as_float(v & 0xffff0000u); }
DI float sigmoidf_(float v) { return 1.0f / (1.0f + __expf(-v)); }
DI float siluf_(float v) { return v / (1.0f + __expf(-v)); }
#define MFMA16(a, b, c) __builtin_amdgcn_mfma_f32_16x16x32_bf16((a), (b), (c), 0, 0, 0)
#define MFMA32(a, b, c) __builtin_amdgcn_mfma_f32_32x32x16_bf16((a), (b), (c), 0, 0, 0)

struct Params {
  const float *x, *norm_w, *w_in, *q_norm_w, *k_norm_w, *ck_pos, *ck_w1, *ck_b1, *ck_w2, *cv_pos, *cv_w1, *cv_b1, *cv_w2, *conv_w, *conv_b, *w_out;
  float* out;
  u16 *xb, *winT, *woutT, *w1kT, *w1vT, *w2kT, *w2vT, *Q, *Ks, *Kw, *Vst, *Vwt, *kcraw, *vcraw, *Kc, *Vct, *zs, *cvb, *mix;
  float *rs, *ckpart, *rope, *gates;
  unsigned* counter;
};

DI void transpose_tile(const float* __restrict__ src, u16* __restrict__ dst, int K, int N, const float* __restrict__ scale, int kt, int nt, char* smem, int ldd) {
  float* tile = (float*)smem;
  const int tid = threadIdx.x;
#pragma unroll
  for (int i = 0; i < 8; ++i) {
    const int kk = i * 8 + (tid >> 6), nn = tid & 63, n = nt * 64 + nn, k = kt * 64 + kk;
    float v = (n < N) ? src[(size_t)k * N + n] : 0.f;
    if (scale) v *= scale[k];
    tile[kk * 65 + nn] = v;
  }
  __syncthreads();
#pragma unroll
  for (int i = 0; i < 8; ++i) {
    const int nn = i * 8 + (tid >> 6), kk = tid & 63;
    dst[(size_t)(nt * 64 + nn) * ldd + kt * 64 + kk] = f2bf(tile[kk * 65 + nn]);
  }
  __syncthreads();
}

__device__ void phase_prep(const Params& p, char* smem, int bid, int nb) {
  const int tid = threadIdx.x, lane = tid & 63, wid = tid >> 6;
  constexpr int J_X = 1024, J_TW = 1024, J_TO = 256, J_T1 = 64, J_T2 = 2, J_CK = 16, J_ROPE = 64;
  constexpr int TOTAL = J_X + J_TW + J_TO + 2 * J_T1 + 2 * J_T2 + J_CK + J_ROPE;
  if (bid == 0 && tid < 8) p.counter[tid] = 0u;
  for (int j = bid; j < TOTAL; j += nb) {
    int jj = j;
    if (jj < J_X) {
      const int row0 = jj * 32 + wid * 4;
      float4 v[4][4]; float ss[4];
#pragma unroll
      for (int r = 0; r < 4; ++r) {
        const float4* xr = (const float4*)(p.x + (size_t)(row0 + r) * DM);
#pragma unroll
        for (int i = 0; i < 4; ++i) v[r][i] = xr[i * 64 + lane];
      }
#pragma unroll
      for (int r = 0; r < 4; ++r) {
        float a = 0.f;
#pragma unroll
        for (int i = 0; i < 4; ++i) a += v[r][i].x * v[r][i].x + v[r][i].y * v[r][i].y + v[r][i].z * v[r][i].z + v[r][i].w * v[r][i].w;
#pragma unroll
        for (int o = 32; o >= 1; o >>= 1) a += __shfl_xor(a, o);
        ss[r] = a;
      }
#pragma unroll
      for (int r = 0; r < 4; ++r) {
        if (lane == 0) p.rs[row0 + r] = rsqrtf(ss[r] * (1.0f / DM) + EPS);
#pragma unroll
        for (int i = 0; i < 4; ++i) {
          u32x2 o; o[0] = cvtpk(v[r][i].x, v[r][i].y); o[1] = cvtpk(v[r][i].z, v[r][i].w);
          *(u32x2*)(p.xb + (size_t)(row0 + r) * LDK + (i * 64 + lane) * 4) = o;
        }
      }
      continue;
    }
    jj -= J_X;
    if (jj < J_TW) { transpose_tile(p.w_in, p.winT, 1024, DIN, p.norm_w, jj & 15, jj >> 4, smem, LDK); continue; }
    jj -= J_TW;
    if (jj < J_TO) { transpose_tile(p.w_out, p.woutT, 1024, 1024, nullptr, jj & 15, jj >> 4, smem, LDK); continue; }
    jj -= J_TO;
    if (jj < J_T1) { transpose_tile(p.ck_w1, p.w1kT, 2048, 128, nullptr, jj & 31, jj >> 5, smem, 2048); continue; }
    jj -= J_T1;
    if (jj < J_T1) { transpose_tile(p.cv_w1, p.w1vT, 2048, 128, nullptr, jj & 31, jj >> 5, smem, 2048); continue; }
    jj -= J_T1;
    if (jj < J_T2) { transpose_tile(p.ck_w2, p.w2kT, 128, 64, nullptr, jj, 0, smem, 128); continue; }
    jj -= J_T2;
    if (jj < J_T2) { transpose_tile(p.cv_w2, p.w2vT, 128, 64, nullptr, jj, 0, smem, 128); continue; }
    jj -= J_T2;
    if (jj < J_CK) {
      const int which = jj >> 3, chunk = jj & 7, hh = tid & 127, sub = tid >> 7;
      const float* pos = which ? p.cv_pos : p.ck_pos;
      const float* w1 = which ? p.cv_w1 : p.ck_w1;
      float acc = 0.f;
      const int f0 = chunk * 256 + sub * 64;
#pragma unroll 8
      for (int f = 0; f < 64; ++f) acc += pos[f0 + f] * w1[(size_t)(f0 + f) * 128 + hh];
      float* red = (float*)smem;
      red[sub * 128 + hh] = acc;
      __syncthreads();
      if (tid < 128) p.ckpart[(which * 8 + chunk) * 128 + tid] = red[tid] + red[128 + tid] + red[256 + tid] + red[384 + tid];
      __syncthreads();
      continue;
    }
    jj -= J_CK;
    {
      const int idx = jj * 512 + tid, pos = idx >> 3, fi = idx & 7;
      const float ang = (float)pos * c_invf[fi];
      float s, c; sincosf(ang, &s, &c);
      p.rope[idx * 2] = c; p.rope[idx * 2 + 1] = s;
    }
  }
}

DI int kimg_off(int row, int d) { return row * 64 + (((d >> 3) ^ ((row >> 1) & 7)) * 8) + (d & 7); }
DI int vimg_off(int d, int key) { return d * 64 + (((key >> 3) ^ ((d >> 1) & 7)) * 8) + ((((key >> 2) & 1) ^ ((d >> 4) & 1)) * 4) + (key & 3); }

constexpr int G_ASZ = 256 * 128, G_BSZ = 256 * 128, G_STAGE = G_ASZ + G_BSZ;
#define WAIT_VM(n) asm volatile("s_waitcnt vmcnt(" #n ")" ::: "memory")

template <int EPI>
__device__ void gemm_phase(const Params& p, char* smem, int bid, int nb) {
  constexpr int NT = EPI == 0 ? 16 : 4;
  constexpr int MT = 128;
  const u16* __restrict__ A = EPI == 0 ? p.xb : p.mix;
  const u16* __restrict__ Bt = EPI == 0 ? p.winT : p.woutT;
  const int tid = threadIdx.x, lane = tid & 63, wid = tid >> 6, fr = lane & 15, fq = lane >> 4;
  const int wr = wid >> 2, wc = wid & 3;
  const bool xmap = (nb == 256);
  const int xcd = bid & 7, li = bid >> 3;
  const int ntiles = xmap ? (EPI == 0 ? 8 : 2) : (MT * NT - bid + nb - 1) / nb;
  auto tile_of = [&](int ti, int& m0, int& n0) {
    if (xmap) {
      const int sg = ti * 8 + xcd;
      if (EPI == 0) { m0 = ((sg >> 1) * 4 + (li >> 3)) * 256; n0 = ((sg & 1) * 8 + (li & 7)) * 256; }
      else { m0 = (sg * 8 + (li >> 2)) * 256; n0 = (li & 3) * 256; }
    } else { const int tile = bid + ti * nb; const int mt = tile / NT; m0 = mt * 256; n0 = (tile - mt * NT) * 256; }
  };
  const int nsteps = ntiles * 16;
  const int gsw = (lane & 7) ^ ((wid & 1) * 4 + (lane >> 4));
  const int grow = wid * 8 + (lane >> 3);
  auto issue = [&](int step, int stage) {
    int m0, n0; tile_of(step >> 4, m0, n0);
    const int kt = step & 15;
    const u16* ag = A + (size_t)(m0 + grow) * LDK + kt * 64 + gsw * 8;
    const int brow = EPI == 0 ? ((grow & ~31) | ((grow & 0x0C) << 1) | ((grow & 0x10) >> 2) | (grow & 3)) : grow;
    const u16* bg_ = Bt + (size_t)(n0 + brow) * LDK + kt * 64 + gsw * 8;
    char* dst = smem + stage * G_STAGE + wid * 1024 + lane * 16;
#pragma unroll
    for (int i = 0; i < 4; ++i) __builtin_amdgcn_global_load_lds((const unsigned*)(ag + (size_t)i * 64 * LDK), (unsigned*)(dst + i * 8192), 16, 0, 0);
#pragma unroll
    for (int i = 0; i < 4; ++i) __builtin_amdgcn_global_load_lds((const unsigned*)(bg_ + (size_t)i * 64 * LDK), (unsigned*)(dst + G_ASZ + i * 8192), 16, 0, 0);
  };
  const int ca0 = ((fq ^ (fr >> 1)) * 16), ca1 = (((4 + fq) ^ (fr >> 1)) * 16);
  f32x4 acc[8][4];
#pragma unroll
  for (int m = 0; m < 8; ++m)
#pragma unroll
    for (int n = 0; n < 4; ++n) acc[m][n] = f32x4{0.f, 0.f, 0.f, 0.f};
  __syncthreads();
  if (nsteps > 0) issue(0, 0);
  for (int s = 0; s < nsteps; ++s) {
    WAIT_VM(0);
    __builtin_amdgcn_s_barrier();
    if (s + 1 < nsteps) issue(s + 1, (s + 1) & 1);
    {
      const char* ab = smem + (s & 1) * G_STAGE + (wr * 128 + fr) * 128;
      const char* bb = smem + (s & 1) * G_STAGE + G_ASZ + (wc * 64 + fr) * 128;
#pragma unroll
      for (int ks = 0; ks < 2; ++ks) {
        bf16x8 af[8], bf[4];
        const int co = ks ? ca1 : ca0;
#pragma unroll
        for (int n = 0; n < 4; ++n) bf[n] = *(const bf16x8*)(bb + n * 16 * 128 + co);
#pragma unroll
        for (int m = 0; m < 8; ++m) af[m] = *(const bf16x8*)(ab + m * 16 * 128 + co);
#pragma unroll
        for (int m = 0; m < 8; ++m)
#pragma unroll
          for (int n = 0; n < 4; ++n) acc[m][n] = MFMA16(bf[n], af[m], acc[m][n]);
      }
    }
    if ((s & 15) != 15) continue;
    int m0, n0; tile_of(s >> 4, m0, n0);
    const int rbase = m0 + wr * 128;
    const int cb = n0 + wc * 64;
    if constexpr (EPI == 1) {
#pragma unroll
      for (int m = 0; m < 8; ++m) {
        const size_t ro = (size_t)(rbase + m * 16 + fr) * DM + cb + fq * 4;
#pragma unroll
        for (int n = 0; n < 4; ++n) {
          const float4 xv = *(const float4*)(p.x + ro + n * 16);
          float4 o; o.x = xv.x + acc[m][n][0]; o.y = xv.y + acc[m][n][1]; o.z = xv.z + acc[m][n][2]; o.w = xv.w + acc[m][n][3];
          *(float4*)(p.out + ro + n * 16) = o;
        }
        __builtin_amdgcn_sched_barrier(0);
      }
    } else {
      const int b = m0 >> 12;
      const int tb = rbase & 4095;
      if (cb < 1280) {
        const int seg = cb >> 6;
        const int which = seg < 8 ? -1 : ((seg - 8) >> 1);
        const int g = seg < 8 ? (seg >> 2) : ((seg - 8) & 1);
        const bool need_norm = (seg < 8) || which == 2 || which == 4;
        const float* nw = seg < 8 ? p.q_norm_w : (p.k_norm_w + (which == 2 ? 64 : 128));
        float w[16];
#pragma unroll
        for (int k = 0; k < 16; ++k) w[k] = need_norm ? nw[(k >> 3) * 32 + fq * 8 + (k & 7)] : 1.0f;
        const float qs = seg < 8 ? QSCALE : 1.0f;
#pragma unroll
        for (int m = 0; m < 8; ++m) {
          const int t = tb + m * 16 + fr;
          const float r = p.rs[rbase + m * 16 + fr];
          float v[16];
#pragma unroll
          for (int k = 0; k < 16; ++k) v[k] = acc[m][(k >> 3) * 2 + ((k & 7) >> 2)][k & 3] * r;
          if (need_norm) {
            float ss = 0.f;
#pragma unroll
            for (int k = 0; k < 16; ++k) ss += v[k] * v[k];
            ss += __shfl_xor(ss, 16); ss += __shfl_xor(ss, 32);
            const float rr = rsqrtf(ss * (1.0f / 64.f) + EPS);
#pragma unroll
            for (int k = 0; k < 16; ++k) v[k] = v[k] * rr * w[k];
            const float4* rp = (const float4*)(p.rope + (size_t)t * 16);
            const float4 c01 = rp[0], c23 = rp[1], c45 = rp[2], c67 = rp[3];
            const float cc[8] = {c01.x, c01.z, c23.x, c23.z, c45.x, c45.z, c67.x, c67.z};
            const float sn[8] = {c01.y, c01.w, c23.y, c23.w, c45.y, c45.w, c67.y, c67.w};
#pragma unroll
            for (int e = 0; e < 8; ++e) {
              const float pr = __shfl_xor(v[e], 16);
              const float rot = (fq == 0) ? (v[e] * cc[e] - pr * sn[e]) : (v[e] * cc[e] + pr * sn[e]);
              v[e] = (fq < 2) ? rot : v[e];
            }
#pragma unroll
            for (int k = 0; k < 16; ++k) v[k] *= qs;
          }
          if (which == 3 || which == 5) {
            int lz = 0; asm volatile("" : "+v"(lz));
            u16* vt = (which == 3 ? p.Vst : p.Vwt) + (size_t)((b * 2 + g) * 64 + (t >> 6)) * 4096 + lz;
            const int fqx = fq + lz, key = (t & 63) + lz;
#pragma unroll
            for (int k = 0; k < 16; ++k) vt[vimg_off((k >> 3) * 32 + fqx * 8 + (k & 7), key)] = f2bf(v[k]);
          } else {
            u16* dst;
            if (seg < 8) dst = p.Q + ((size_t)((b * 2 + g) * 4096 + t) * 4 + (seg & 3)) * 64;
            else { u16* buf = which == 0 ? p.kcraw : which == 1 ? p.vcraw : which == 2 ? p.Ks : p.Kw; dst = buf + ((size_t)(b * 2 + g) * 4096 + t) * 64; }
            const bool img = which >= 2;
#pragma unroll
            for (int n2 = 0; n2 < 2; ++n2) {
              u32x4 o;
#pragma unroll
              for (int e = 0; e < 4; ++e) o[e] = cvtpk(v[n2 * 8 + 2 * e], v[n2 * 8 + 2 * e + 1]);
              const int d0 = n2 * 32 + fq * 8;
              const int off = img ? (((d0 >> 3) ^ (((t & 63) >> 1) & 7)) * 8) : d0;
              *(u32x4*)(dst + off) = o;
            }
          }
          __builtin_amdgcn_sched_barrier(0);
        }
      } else {
#pragma unroll
        for (int m = 0; m < 8; ++m) {
          const size_t row = rbase + m * 16 + fr;
          const float r = p.rs[row];
#pragma unroll
          for (int n2 = 0; n2 < 2; ++n2) {
            const int c8 = cb + n2 * 32 + fq * 8;
            if (c8 >= DIN) continue;
            float v[8];
#pragma unroll
            for (int e = 0; e < 8; ++e) v[e] = acc[m][n2 * 2 + (e >> 2)][e & 3] * r;
            if (c8 < 1304) {
              float4 o0, o1;
              o0.x = sigmoidf_(v[0]); o0.y = sigmoidf_(v[1]); o0.z = sigmoidf_(v[2]); o0.w = sigmoidf_(v[3]);
              o1.x = sigmoidf_(v[4]); o1.y = sigmoidf_(v[5]); o1.z = sigmoidf_(v[6]); o1.w = sigmoidf_(v[7]);
              float* gp = p.gates + row * 24 + (c8 - 1280);
              *(float4*)gp = o0; *(float4*)(gp + 4) = o1;
            } else if (c8 < 1816) {
              u32x4 o;
#pragma unroll
              for (int e = 0; e < 4; ++e) o[e] = cvtpk(siluf_(v[2 * e]), siluf_(v[2 * e + 1]));
              *(u32x4*)(p.zs + row * 512 + (c8 - 1304)) = o;
            } else {
              u32x4 o;
#pragma unroll
              for (int e = 0; e < 4; ++e) o[e] = cvtpk(v[2 * e], v[2 * e + 1]);
              *(u32x4*)(p.cvb + row * 2048 + (c8 - 1816)) = o;
            }
          }
          __builtin_amdgcn_sched_barrier(0);
        }
      }
    }
#pragma unroll
    for (int m = 0; m < 8; ++m)
#pragma unroll
      for (int n = 0; n < 4; ++n) acc[m][n] = f32x4{0.f, 0.f, 0.f, 0.f};
  }
}

__device__ void phase_cmp_conv(const Params& p, char* smem, int bid, int nb) {
  const int tid = threadIdx.x, lane = tid & 63, wid = tid >> 6, fr = lane & 15, fq = lane >> 4;
  float* part = (float*)smem;
  char* hl = smem + 8 * 16 * 132 * 4;
  float* outl = (float*)(hl + 16 * 272);
  for (int job = bid; job < 512; job += nb) {
    const int which = job >> 8, rest = job & 255, bg = rest >> 4, ct = rest & 15;
    const u16* raw = (which ? p.vcraw : p.kcraw) + (size_t)bg * 4096 * 64;
    const u16* w1T = which ? p.w1vT : p.w1kT;
    const u16* w2T = which ? p.w2vT : p.w2kT;
    const float* b1 = which ? p.cv_b1 : p.ck_b1;
    f32x4 acc[8];
#pragma unroll
    for (int n = 0; n < 8; ++n) acc[n] = f32x4{0.f, 0.f, 0.f, 0.f};
    const int c = ct * 16 + fr;
#pragma unroll
    for (int k8 = 0; k8 < 8; ++k8) {
      const int ks = wid * 8 + k8;
      const int l = ks >> 1, d0 = (ks & 1) * 32 + fq * 8;
      int tt = c * 16 + l; tt = tt > 4095 ? 4095 : tt;
      const bf16x8 a = *(const bf16x8*)(raw + (size_t)tt * 64 + d0);
#pragma unroll
      for (int n = 0; n < 8; ++n) {
        const bf16x8 bb = *(const bf16x8*)(w1T + (size_t)(n * 16 + fr) * 2048 + ks * 32 + fq * 8);
        acc[n] = MFMA16(a, bb, acc[n]);
      }
    }
#pragma unroll
    for (int n = 0; n < 8; ++n)
#pragma unroll
      for (int j = 0; j < 4; ++j) part[(wid * 16 + fq * 4 + j) * 132 + n * 16 + fr] = acc[n][j];
    __syncthreads();
    {
      const int row = tid >> 5, c4 = (tid & 31) * 4;
      float4 sum = *(const float4*)(part + row * 132 + c4);
#pragma unroll
      for (int w = 1; w < 8; ++w) { const float4 v = *(const float4*)(part + (w * 16 + row) * 132 + c4); sum.x += v.x; sum.y += v.y; sum.z += v.z; sum.w += v.w; }
      float bias[4];
#pragma unroll
      for (int e = 0; e < 4; ++e) {
        float bsum = b1[c4 + e];
#pragma unroll
        for (int ch = 0; ch < 8; ++ch) bsum += p.ckpart[(which * 8 + ch) * 128 + c4 + e];
        bias[e] = bsum;
      }
      u32x2 o; o[0] = cvtpk(siluf_(sum.x + bias[0]), siluf_(sum.y + bias[1])); o[1] = cvtpk(siluf_(sum.z + bias[2]), siluf_(sum.w + bias[3]));
      *(u32x2*)(hl + row * 272 + c4 * 2) = o;
    }
    __syncthreads();
    if (wid < 4) {
      f32x4 o2 = f32x4{0.f, 0.f, 0.f, 0.f};
#pragma unroll
      for (int ks = 0; ks < 4; ++ks) {
        const bf16x8 a = *(const bf16x8*)(hl + fr * 272 + (ks * 32 + fq * 8) * 2);
        const bf16x8 bb = *(const bf16x8*)(w2T + (size_t)(wid * 16 + fr) * 128 + ks * 32 + fq * 8);
        o2 = MFMA16(a, bb, o2);
      }
#pragma unroll
      for (int j = 0; j < 4; ++j) outl[(fq * 4 + j) * 68 + wid * 16 + fr] = o2[j];
    }
    __syncthreads();
    if (tid < 256) {
      const int row = tid >> 4, d4 = (tid & 15) * 4;
      const int cc = ct * 16 + row;
      const float4 v = *(const float4*)(outl + row * 68 + d4);
      if (which == 0) {
        float ss = v.x * v.x + v.y * v.y + v.z * v.z + v.w * v.w;
        ss += __shfl_xor(ss, 1); ss += __shfl_xor(ss, 2); ss += __shfl_xor(ss, 4); ss += __shfl_xor(ss, 8);
        const float rr = rsqrtf(ss * (1.0f / 64.f) + EPS);
        float o[4] = {v.x * rr * p.k_norm_w[d4], v.y * rr * p.k_norm_w[d4 + 1], v.z * rr * p.k_norm_w[d4 + 2], v.w * rr * p.k_norm_w[d4 + 3]};
        if (d4 < 16) {
          int pos = cc * 16 + 31; pos = pos > 4095 ? 4095 : pos;
#pragma unroll
          for (int e = 0; e < 4; ++e) {
            const int d = d4 + e, dp = d ^ 8;
            const float pr = outl[row * 68 + dp] * rr * p.k_norm_w[dp];
            const float2 cs = *(const float2*)(p.rope + ((size_t)pos * 8 + (d & 7)) * 2);
            o[e] = (d < 8) ? (o[e] * cs.x - pr * cs.y) : (o[e] * cs.x + pr * cs.y);
          }
        }
        u32x2 ov; ov[0] = cvtpk(o[0], o[1]); ov[1] = cvtpk(o[2], o[3]);
        if (cc >= 255) { ov[0] = 0u; ov[1] = 0u; }
        *(u32x2*)(p.Kc + (size_t)(bg * 4 + (cc >> 6)) * 4096 + kimg_off(cc & 63, d4)) = ov;
      } else {
        const float z = (cc >= 255) ? 0.f : 1.f;
        u16* vt = p.Vct + (size_t)(bg * 4 + (cc >> 6)) * 4096;
        vt[vimg_off(d4 + 0, cc & 63)] = f2bf(v.x * z); vt[vimg_off(d4 + 1, cc & 63)] = f2bf(v.y * z);
        vt[vimg_off(d4 + 2, cc & 63)] = f2bf(v.z * z); vt[vimg_off(d4 + 3, cc & 63)] = f2bf(v.w * z);
      }
    }
    __syncthreads();
  }
  const int gw = bid * 8 + wid, nw = nb * 8;
  for (int chunk = gw; chunk < 2048; chunk += nw) {
    const int r0 = chunk * 16, t0 = r0 & 4095;
    const int ch = lane * 8;
    float cw0[8], cw1[8], cw2[8], cbv[8], u1[8], u2[8];
#pragma unroll
    for (int e = 0; e < 8; ++e) { cw0[e] = p.conv_w[ch + e]; cw1[e] = p.conv_w[512 + ch + e]; cw2[e] = p.conv_w[1024 + ch + e]; cbv[e] = p.conv_b[ch + e]; u1[e] = 0.f; u2[e] = 0.f; }
    if (t0 > 0) {
#pragma unroll
      for (int q = 0; q < 2; ++q) {
        const u16* rp = p.cvb + (size_t)(r0 - 2 + q) * 2048 + ch;
        const u32x4 hv = *(const u32x4*)(rp), cv = *(const u32x4*)(rp + 1024);
#pragma unroll
        for (int e = 0; e < 4; ++e) {
          const float ua = bflo(hv[e]) * bflo(cv[e]), ub = bfhi(hv[e]) * bfhi(cv[e]);
          if (q == 0) { u2[2 * e] = ua; u2[2 * e + 1] = ub; } else { u1[2 * e] = ua; u1[2 * e + 1] = ub; }
        }
      }
    }
#pragma unroll 4
    for (int rr = 0; rr < 16; ++rr) {
      const u16* rp = p.cvb + (size_t)(r0 + rr) * 2048 + ch;
      const u32x4 hv = *(const u32x4*)(rp), bv = *(const u32x4*)(rp + 512), cv = *(const u32x4*)(rp + 1024), zv = *(const u32x4*)(rp + 1536);
      u32x4 ov;
#pragma unroll
      for (int e = 0; e < 4; ++e) {
        const float ua = bflo(hv[e]) * bflo(cv[e]), ub = bfhi(hv[e]) * bfhi(cv[e]);
        const float ca = cw0[2 * e] * u2[2 * e] + cw1[2 * e] * u1[2 * e] + cw2[2 * e] * ua + cbv[2 * e];
        const float cbb = cw0[2 * e + 1] * u2[2 * e + 1] + cw1[2 * e + 1] * u1[2 * e + 1] + cw2[2 * e + 1] * ub + cbv[2 * e + 1];
        const float oa = bflo(bv[e]) * ca * siluf_(bflo(zv[e]));
        const float ob = bfhi(bv[e]) * cbb * siluf_(bfhi(zv[e]));
        ov[e] = cvtpk(oa, ob);
        u2[2 * e] = u1[2 * e]; u2[2 * e + 1] = u1[2 * e + 1]; u1[2 * e] = ua; u1[2 * e + 1] = ub;
      }
      *(u32x4*)(p.mix + (size_t)(r0 + rr) * LDK + 512 + ch) = ov;
    }
  }
}

constexpr int AT_NST = 5, AT_KB = 8192, AT_BUF = 16384;
constexpr int AT_F = AT_NST * AT_BUF, AT_IMPA = AT_F, AT_IMPB = AT_IMPA + 64 * 65 * 4, AT_VAL = AT_IMPA;
constexpr int AT_SELM = AT_F + 8 * 8192, AT_UNIT = AT_SELM + 512, AT_END = AT_UNIT + 16;
static_assert(AT_END <= SMEM_BYTES, "attention LDS layout exceeds the dynamic LDS size");

__device__ void phase_attn(const Params& p, char* smem, int bid, int nb, int rep) {
  const int tid = threadIdx.x, lane = tid & 63, wid = tid >> 6, c32 = lane & 31, h = lane >> 5;
  const float NINF = -__builtin_inff();
  float* impa = (float*)(smem + AT_IMPA);
  float* impb = (float*)(smem + AT_IMPB);
  float* vals = (float*)(smem + AT_VAL);
  unsigned* selm = (unsigned*)(smem + AT_SELM);
  volatile int* s_unit = (volatile int*)(smem + AT_UNIT);
  const int srow = tid >> 3, sc = tid & 7;
  while (true) {
    if (tid == 0) *s_unit = (int)atomicAdd(p.counter + rep, 1u);
    __syncthreads();
    const int u = *s_unit;
    __syncthreads();
    if (u >= 1024) break;
    const int i = 63 - (u >> 4), bg = u & 15, b = bg >> 1, g = bg & 1;
    const int tl = wid * 8 + (c32 >> 2), hd = c32 & 3;
    const int t = i * 64 + tl;
    const u16* qrow = p.Q + ((size_t)(bg * 4096 + i * 64) * 4 + wid * 32 + c32) * 64;
    bf16x8 qf[4];
#pragma unroll
    for (int ks = 0; ks < 4; ++ks) qf[ks] = *(const bf16x8*)(qrow + ks * 16 + h * 8);
    const float* gp = p.gates + (size_t)(b * 4096 + t) * 24 + (g * 4 + hd) * 3;
    const float g0 = gp[0], g1 = gp[1], g2 = gp[2];
    const int ntc = (4 * i + 2) / 64 + 1, nsl = i + 1, nwin = (i < 8 ? i : 8) + 1;
    const int NT = 2 * ntc + nsl + nwin;
    const bool need_sel = i >= 16;

    f32x16 O0, O1;
#pragma unroll
    for (int r = 0; r < 16; ++r) { O0[r] = 0.f; O1[r] = 0.f; }
    float* fl = (float*)(smem + AT_F + wid * 8192) + lane;
    float m_run = NINF, l_run = 0.f, inv_l = 0.f;
    unsigned sel_lo = 0xffffffffu, sel_hi = 0xffffffffu;
#define TILE_PTRS(n, kp, vp) do { \
      if ((n) < 2 * ntc) { const int tt_ = (n) < ntc ? (n) : (n) - ntc; kp = p.Kc + (size_t)(bg * 4 + tt_) * 4096; vp = p.Vct + (size_t)(bg * 4 + tt_) * 4096; } \
      else if ((n) < 2 * ntc + nsl) { const int j_ = (n) - 2 * ntc; kp = p.Ks + ((size_t)bg * 4096 + j_ * 64) * 64; vp = p.Vst + (size_t)(bg * 64 + j_) * 4096; } \
      else { const int j_ = i - nwin + 1 + ((n) - 2 * ntc - nsl); kp = p.Kw + ((size_t)bg * 4096 + j_ * 64) * 64; vp = p.Vwt + (size_t)(bg * 64 + j_) * 4096; } } while (0)
#define TISSUE(n, st_) do { const u16 *kp_, *vp_; TILE_PTRS(n, kp_, vp_); char* d_ = smem + (st_) * AT_BUF + tid * 16; \
      __builtin_amdgcn_global_load_lds((const unsigned*)(kp_ + tid * 8), (unsigned*)d_, 16, 0, 0); \
      __builtin_amdgcn_global_load_lds((const unsigned*)(vp_ + tid * 8), (unsigned*)(d_ + AT_KB), 16, 0, 0); } while (0)
    {
      const int npre = NT < AT_NST - 1 ? NT : AT_NST - 1;
      for (int n = 0; n < npre; ++n) TISSUE(n, n);
    }
    int st_cur = 0, st_iss = AT_NST - 1;
    const int ksw = (c32 >> 1) & 7, vhs = (c32 >> 4) & 1;
    for (int n = 0; n < NT; ++n) {
      {
        const int rem = NT - 1 - n;
        if (rem >= 3) WAIT_VM(6); else if (rem == 2) WAIT_VM(4); else if (rem == 1) WAIT_VM(2); else WAIT_VM(0);
        __builtin_amdgcn_s_barrier();
        if (n + AT_NST - 1 < NT) TISSUE(n + AT_NST - 1, st_iss);
      }
      int mode, base, lo, hi;
      if (n < 2 * ntc) { mode = n < ntc ? 0 : 1; base = (n < ntc ? n : n - ntc) * 64; lo = -1; hi = (t - 31) >> 4; }
      else if (n < 2 * ntc + nsl) { const int j = n - 2 * ntc; mode = 2; base = j * 64; const unsigned bit = j < 32 ? (sel_lo >> j) & 1u : (sel_hi >> (j - 32)) & 1u; lo = -1; hi = bit ? t : -1; }
      else { const int j = i - nwin + 1 + (n - 2 * ntc - nsl); mode = 3; base = j * 64; lo = t - 512; hi = t; }
      const int lo_rel = lo - (base + 4 * h), hi_rel = hi - (base + 4 * h);
      const char* kb = smem + st_cur * AT_BUF;
      const char* vb = kb + AT_KB;
      st_cur = st_cur == AT_NST - 1 ? 0 : st_cur + 1; st_iss = st_iss == AT_NST - 1 ? 0 : st_iss + 1;
      f32x16 S0, S1;
#pragma unroll
      for (int r = 0; r < 16; ++r) { S0[r] = 0.f; S1[r] = 0.f; }
#pragma unroll
      for (int ks = 0; ks < 4; ++ks) {
        const bf16x8 k0 = *(const bf16x8*)(kb + c32 * 128 + (((ks * 2 + h) ^ ksw) * 16));
        const bf16x8 k1 = *(const bf16x8*)(kb + (32 + c32) * 128 + (((ks * 2 + h) ^ ksw) * 16));
        S0 = MFMA32(k0, qf[ks], S0);
        S1 = MFMA32(k1, qf[ks], S1);
      }
      float mx = NINF;
#pragma unroll
      for (int r = 0; r < 16; ++r) {
        const int off = (r & 3) + 8 * (r >> 2);
        S0[r] = (off > lo_rel && off <= hi_rel) ? S0[r] : NINF;
        S1[r] = (off + 32 > lo_rel && off + 32 <= hi_rel) ? S1[r] : NINF;
        mx = fmaxf(mx, fmaxf(S0[r], S1[r]));
      }
      float m_use;
      if (mode != 1) {
        mx = fmaxf(mx, __shfl_xor(mx, 32));
        const float m_new = fmaxf(m_run, mx);
        m_use = (m_new == NINF) ? 0.f : m_new;
        const float alpha = __builtin_amdgcn_exp2f(m_run - m_use);
        m_run = m_new;
        float ps = 0.f;
#pragma unroll
        for (int r = 0; r < 16; ++r) { S0[r] = __builtin_amdgcn_exp2f(S0[r] - m_use); S1[r] = __builtin_amdgcn_exp2f(S1[r] - m_use); ps += S0[r] + S1[r]; }
        l_run = l_run * alpha + ps;
        if (mode != 0) {
#pragma unroll
          for (int r = 0; r < 16; ++r) { O0[r] *= alpha; O1[r] *= alpha; }
        }
      } else {
        m_use = (m_run == NINF) ? 0.f : m_run;
#pragma unroll
        for (int r = 0; r < 16; ++r) { S0[r] = __builtin_amdgcn_exp2f(S0[r] - m_use); S1[r] = __builtin_amdgcn_exp2f(S1[r] - m_use); }
      }
      if (mode != 0) {
#pragma unroll
        for (int kk = 0; kk < 4; ++kk) {
          const int kr = kk >> 1, sp = kk & 1;
          u32x4 pw;
#pragma unroll
          for (int e = 0; e < 4; ++e) {
            const float a0 = kr ? S1[8 * sp + 2 * e] : S0[8 * sp + 2 * e];
            const float a1 = kr ? S1[8 * sp + 2 * e + 1] : S0[8 * sp + 2 * e + 1];
            pw[e] = cvtpk(a0, a1);
          }
          const bf16x8 pf = __builtin_bit_cast(bf16x8, pw);
#pragma unroll
          for (int dr = 0; dr < 2; ++dr) {
            const char* va = vb + (32 * dr + c32) * 128 + ((h ^ vhs) * 8);
            const s16x4 vlo = *(const s16x4*)(va + (((4 * kr + 2 * sp) ^ ksw) * 16)), vhi = *(const s16x4*)(va + (((4 * kr + 2 * sp + 1) ^ ksw) * 16));
            const bf16x8 vf = __builtin_shufflevector(vlo, vhi, 0, 1, 2, 3, 4, 5, 6, 7);
            if (dr == 0) O0 = MFMA32(vf, pf, O0); else O1 = MFMA32(vf, pf, O1);
          }
        }
      }
      if (mode == 1 && need_sel) {
        const int tt = base >> 6;
#pragma unroll
        for (int kr = 0; kr < 2; ++kr)
#pragma unroll
          for (int rg = 0; rg < 4; ++rg) {
            float pv[4];
#pragma unroll
            for (int e = 0; e < 4; ++e) {
              float v = (kr ? S1[rg * 4 + e] : S0[rg * 4 + e]) * inv_l;
              v += __shfl_xor(v, 1); v += __shfl_xor(v, 2);
              pv[e] = v;
            }
            if (hd == 0) {
              const int nblk = tt * 16 + 8 * kr + 2 * rg + h;
              impa[tl * 65 + nblk] = pv[0] + pv[1] + pv[2] + 0.5f * pv[3];
              impb[tl * 65 + nblk] = 0.5f * pv[3];
            }
          }
      }
      if (n == ntc - 1) {
        const float lt = l_run + __shfl_xor(l_run, 32);
        inv_l = lt > 0.f ? 1.0f / lt : 0.f;
      } else if (n == 2 * ntc - 1) {
        if (need_sel) {
          __syncthreads();
          const int tk = tid >> 3, nb0 = (tid & 7) * 8;
          float myv[8];
#pragma unroll
          for (int e = 0; e < 8; ++e) {
            const int nn = nb0 + e;
            const bool forced = (nn == 0) || (nn == i) || (nn == i - 1);
            float v = -1.0f;
            if (nn <= i) v = impa[tk * 65 + nn] + (nn > 0 ? impb[tk * 65 + nn - 1] : 0.f);
            if (forced) v = 1e9f;
            myv[e] = v;
            vals[tk * 65 + nn] = v;
          }
          __syncthreads();
          int cnt[8];
#pragma unroll
          for (int e = 0; e < 8; ++e) cnt[e] = 0;
          for (int mm = 0; mm < 64; ++mm) {
            const float vm = vals[tk * 65 + mm];
#pragma unroll
            for (int e = 0; e < 8; ++e) cnt[e] += (vm > myv[e] || (vm == myv[e] && mm < nb0 + e)) ? 1 : 0;
          }
          unsigned bits = 0;
#pragma unroll
          for (int e = 0; e < 8; ++e) bits |= (cnt[e] < 16 ? 1u : 0u) << e;
          unsigned wlo = (tid & 7) < 4 ? bits << (8 * (tid & 7)) : 0u;
          unsigned whi = (tid & 7) >= 4 ? bits << (8 * ((tid & 7) - 4)) : 0u;
          wlo |= __shfl_xor(wlo, 1); wlo |= __shfl_xor(wlo, 2); wlo |= __shfl_xor(wlo, 4);
          whi |= __shfl_xor(whi, 1); whi |= __shfl_xor(whi, 2); whi |= __shfl_xor(whi, 4);
          if ((tid & 7) == 0) { selm[tk * 2] = wlo; selm[tk * 2 + 1] = whi; }
          __syncthreads();
          sel_lo = selm[tl * 2]; sel_hi = selm[tl * 2 + 1];
        }
        {
          const float wgt = g0 * inv_l;
#pragma unroll
          for (int r = 0; r < 16; ++r) { fl[r * 64] = wgt * O0[r]; fl[(16 + r) * 64] = wgt * O1[r]; O0[r] = 0.f; O1[r] = 0.f; }
          m_run = NINF; l_run = 0.f;
        }
      } else if (n == 2 * ntc + nsl - 1) {
        const float lt = l_run + __shfl_xor(l_run, 32);
        const float wgt = g1 * (lt > 0.f ? 1.0f / lt : 0.f);
#pragma unroll
        for (int r = 0; r < 16; ++r) { fl[r * 64] += wgt * O0[r]; fl[(16 + r) * 64] += wgt * O1[r]; O0[r] = 0.f; O1[r] = 0.f; }
        m_run = NINF; l_run = 0.f;
      }
    }
#undef TILE_PTRS
#undef TISSUE
    {
      const float lt = l_run + __shfl_xor(l_run, 32);
      const float wgt = g2 * (lt > 0.f ? 1.0f / lt : 0.f);
      const size_t rowo = (size_t)(b * 4096 + t);
      const u16* zp = p.zs + rowo * 512 + (g * 4 + hd) * 64;
      u16* mp = p.mix + rowo * LDK + (g * 4 + hd) * 64;
#pragma unroll
      for (int dr = 0; dr < 2; ++dr)
#pragma unroll
        for (int rg = 0; rg < 4; ++rg) {
          const int d = 32 * dr + 8 * rg + 4 * h;
          const u32x2 zv = *(const u32x2*)(zp + d);
          const float f0 = fl[(dr * 16 + rg * 4 + 0) * 64] + wgt * (dr ? O1[rg * 4 + 0] : O0[rg * 4 + 0]);
          const float f1 = fl[(dr * 16 + rg * 4 + 1) * 64] + wgt * (dr ? O1[rg * 4 + 1] : O0[rg * 4 + 1]);
          const float f2 = fl[(dr * 16 + rg * 4 + 2) * 64] + wgt * (dr ? O1[rg * 4 + 2] : O0[rg * 4 + 2]);
          const float f3 = fl[(dr * 16 + rg * 4 + 3) * 64] + wgt * (dr ? O1[rg * 4 + 3] : O0[rg * 4 + 3]);
          u32x2 o;
          o[0] = cvtpk(f0 * bflo(zv[0]), f1 * bfhi(zv[0]));
          o[1] = cvtpk(f2 * bflo(zv[1]), f3 * bfhi(zv[1]));
          *(u32x2*)(mp + d) = o;
        }
    }
  }
}

#if FUSED
extern "C" __global__ void __launch_bounds__(NTHREADS) hybrid_fwd(Params p) {
  extern __shared__ __attribute__((aligned(16))) char smem[];
  cg::grid_group grid = cg::this_grid();
  const int bid = blockIdx.x, nb = gridDim.x;
  for (int r = 0; r < REP0; ++r) { phase_prep(p, smem, bid, nb); grid.sync(); }
  for (int r = 0; r < REP1; ++r) { gemm_phase<0>(p, smem, bid, nb); grid.sync(); }
  for (int r = 0; r < REP2; ++r) { phase_cmp_conv(p, smem, bid, nb); grid.sync(); }
  for (int r = 0; r < REP3; ++r) { phase_attn(p, smem, bid, nb, r); grid.sync(); }
  for (int r = 0; r < REP4; ++r) { gemm_phase<1>(p, smem, bid, nb); }
}
#else
template <int PH>
__global__ void __launch_bounds__(NTHREADS) phase_kernel(Params p) {
  extern __shared__ __attribute__((aligned(16))) char smem[];
  const int bid = blockIdx.x, nb = gridDim.x;
  if constexpr (PH == 0) phase_prep(p, smem, bid, nb);
  if constexpr (PH == 1) gemm_phase<0>(p, smem, bid, nb);
  if constexpr (PH == 2) phase_cmp_conv(p, smem, bid, nb);
  if constexpr (PH == 3) phase_attn(p, smem, bid, nb, 0);
  if constexpr (PH == 4) gemm_phase<1>(p, smem, bid, nb);
}
#endif

extern "C" void kernel_launch(void* const* d_in, const int* in_sizes, int n_in, void* d_out, int out_size, void* d_ws, size_t ws_size, hipStream_t stream) {
  Params p{};
  p.x = (const float*)d_in[0]; p.norm_w = (const float*)d_in[1]; p.w_in = (const float*)d_in[2]; p.q_norm_w = (const float*)d_in[3];
  p.k_norm_w = (const float*)d_in[4]; p.ck_pos = (const float*)d_in[5]; p.ck_w1 = (const float*)d_in[6]; p.ck_b1 = (const float*)d_in[7];
  p.ck_w2 = (const float*)d_in[8]; p.cv_pos = (const float*)d_in[9]; p.cv_w1 = (const float*)d_in[10]; p.cv_b1 = (const float*)d_in[11];
  p.cv_w2 = (const float*)d_in[12]; p.conv_w = (const float*)d_in[13]; p.conv_b = (const float*)d_in[14]; p.w_out = (const float*)d_in[15];
  p.out = (float*)d_out;
  char* w = (char*)d_ws; size_t off = 0;
  auto carve = [&](size_t bytes) { char* r = w + off; off += (bytes + 255) & ~(size_t)255; return r; };
  p.xb = (u16*)carve((size_t)NROWS * LDK * 2);
  p.winT = (u16*)carve((size_t)4096 * LDK * 2);
  p.woutT = (u16*)carve((size_t)1024 * LDK * 2);
  p.w1kT = (u16*)carve((size_t)128 * 2048 * 2);
  p.w1vT = (u16*)carve((size_t)128 * 2048 * 2);
  p.w2kT = (u16*)carve((size_t)64 * 128 * 2);
  p.w2vT = (u16*)carve((size_t)64 * 128 * 2);
  p.Q = (u16*)carve((size_t)NROWS * 512 * 2);
  p.Ks = (u16*)carve((size_t)16 * 4096 * 64 * 2);
  p.Kw = (u16*)carve((size_t)16 * 4096 * 64 * 2);
  p.Vst = (u16*)carve((size_t)16 * 4096 * 64 * 2);
  p.Vwt = (u16*)carve((size_t)16 * 4096 * 64 * 2);
  p.kcraw = (u16*)carve((size_t)16 * 4096 * 64 * 2 + 4096);
  p.vcraw = (u16*)carve((size_t)16 * 4096 * 64 * 2 + 4096);
  p.Kc = (u16*)carve((size_t)16 * 256 * 64 * 2);
  p.Vct = (u16*)carve((size_t)16 * 256 * 64 * 2);
  p.zs = (u16*)carve((size_t)NROWS * 512 * 2);
  p.cvb = (u16*)carve((size_t)NROWS * 2048 * 2);
  p.mix = (u16*)carve((size_t)NROWS * LDK * 2);
  p.rs = (float*)carve((size_t)NROWS * 4);
  p.ckpart = (float*)carve(16 * 128 * 4);
  p.rope = (float*)carve((size_t)4096 * 8 * 2 * 4);
  p.gates = (float*)carve((size_t)NROWS * 24 * 4);
  p.counter = (unsigned*)carve(256);
  if (off > ws_size) { fprintf(stderr, "kernel_launch: workspace too small (%zu > %zu)\n", off, ws_size); return; }

#if FUSED
  static int grid_blocks = 0;
  if (!grid_blocks) {
    int dev = 0, cus = 0, per_cu = 0;
    hipGetDevice(&dev);
    hipDeviceGetAttribute(&cus, hipDeviceAttributeMultiprocessorCount, dev);
    hipFuncSetAttribute((const void*)hybrid_fwd, hipFuncAttributeMaxDynamicSharedMemorySize, SMEM_BYTES);
    hipOccupancyMaxActiveBlocksPerMultiprocessor(&per_cu, (const void*)hybrid_fwd, NTHREADS, SMEM_BYTES);
    if (per_cu < 1) per_cu = 1;
    grid_blocks = cus * per_cu;
  }
  void* args[] = {&p};
  hipError_t e = hipLaunchCooperativeKernel((const void*)hybrid_fwd, dim3(grid_blocks), dim3(NTHREADS), args, SMEM_BYTES, stream);
  if (e != hipSuccess) fprintf(stderr, "cooperative launch failed: %s (grid %d)\n", hipGetErrorString(e), grid_blocks);
#else
  static int attr_set = 0;
  if (!attr_set) {
    (void)hipFuncSetAttribute((const void*)phase_kernel<0>, hipFuncAttributeMaxDynamicSharedMemorySize, SMEM_BYTES);
    (void)hipFuncSetAttribute((const void*)phase_kernel<1>, hipFuncAttributeMaxDynamicSharedMemorySize, SMEM_BYTES);
    (void)hipFuncSetAttribute((const void*)phase_kernel<2>, hipFuncAttributeMaxDynamicSharedMemorySize, SMEM_BYTES);
    (void)hipFuncSetAttribute((const void*)phase_kernel<3>, hipFuncAttributeMaxDynamicSharedMemorySize, SMEM_BYTES);
    (void)hipFuncSetAttribute((const void*)phase_kernel<4>, hipFuncAttributeMaxDynamicSharedMemorySize, SMEM_BYTES);
    attr_set = 1;
  }
  const int G = 256;
  phase_kernel<0><<<G, NTHREADS, SMEM_BYTES, stream>>>(p);
  phase_kernel<1><<<G, NTHREADS, SMEM_BYTES, stream>>>(p);
  phase_kernel<2><<<G, NTHREADS, SMEM_BYTES, stream>>>(p);
  phase_kernel<3><<<G, NTHREADS, SMEM_BYTES, stream>>>(p);
  phase_kernel<4><<<G, NTHREADS, SMEM_BYTES, stream>>>(p);
#endif
}
```

```cpp
#include <hip/hip_runtime.h>
#include <hip/hip_cooperative_groups.h>
#include <cstdio>
#include <cstdint>
namespace cg = cooperative_groups;

#ifndef FUSED
#define FUSED 1
#endif
#define REP0 1
#define REP1 1
#define REP2 1
#define REP3 1
#define REP4 1

#define DI __device__ __forceinline__
typedef unsigned short u16;
using bf16x8 = __attribute__((ext_vector_type(8))) short;
using s16x4 = __attribute__((ext_vector_type(4))) short;
using f32x4 = __attribute__((ext_vector_type(4))) float;
using f32x16 = __attribute__((ext_vector_type(16))) float;
using u32x4 = __attribute__((ext_vector_type(4))) unsigned;
using u32x2 = __attribute__((ext_vector_type(2))) unsigned;
typedef __bf16 bf2_t __attribute__((ext_vector_type(2)));
typedef float fl2_t __attribute__((ext_vector_type(2)));

constexpr int NTHREADS = 512;
constexpr int SEQ = 4096, DM = 1024, DIN = 3864, NROWS = 32768;
constexpr int LDK = 1088;
constexpr float EPS = 1e-6f;
constexpr float QSCALE = 0.125f * 1.4426950408889634f;
constexpr int SMEM_BYTES = 148000;

__constant__ float c_invf[8] = {1.0f, 0.1939227432012558f, 0.03760603070259094f, 0.007292664609849453f,
                                0.0014142135623842478f, 0.00027424818836152554f, 5.3182957344688475e-05f, 1.0313385246263351e-05f};

DI unsigned cvtpk(float lo, float hi) {
  fl2_t f = {lo, hi};
  bf2_t b = __builtin_convertvector(f, bf2_t);
  return __builtin_bit_cast(unsigned, b);
}
DI u16 f2bf(float x) { return (u16)(cvtpk(x, 0.f) & 0xffffu); }
DI float bf2f(u16 v) { return __uint_as_float(((unsigned)v) << 16); }
DI float bflo(unsigned v) { return __uint_as_float(v << 16); }
DI float bfhi(unsigned v) { return __uint_as_float(v & 0xffff0000u); }
DI float sigmoidf_(float v) { return __builtin_amdgcn_rcpf(1.0f + __builtin_amdgcn_exp2f(-1.4426950408889634f * v)); }
DI float siluf_(float v) { return v * __builtin_amdgcn_rcpf(1.0f + __builtin_amdgcn_exp2f(-1.4426950408889634f * v)); }
#define MFMA16(a, b, c) __builtin_amdgcn_mfma_f32_16x16x32_bf16((a), (b), (c), 0, 0, 0)
#define MFMA32(a, b, c) __builtin_amdgcn_mfma_f32_32x32x16_bf16((a), (b), (c), 0, 0, 0)

struct Params {
  const float *x, *norm_w, *w_in, *q_norm_w, *k_norm_w, *ck_pos, *ck_w1, *ck_b1, *ck_w2, *cv_pos, *cv_w1, *cv_b1, *cv_w2, *conv_w, *conv_b, *w_out;
  float* out;
  u16 *xb, *winT, *woutT, *w1kT, *w1vT, *w2kT, *w2vT, *Q, *Ks, *Kw, *Vst, *Vwt, *kcraw, *vcraw, *Kc, *Vct, *zs, *cvb, *mix;
  float *rs, *ckpart, *rope, *gates;
  unsigned* counter;
};

DI void transpose_tile(const float* __restrict__ src, u16* __restrict__ dst, int K, int N, const float* __restrict__ scale, int kt, int nt, char* smem, int ldd) {
  float* tile = (float*)smem;
  const int tid = threadIdx.x;
#pragma unroll
  for (int i = 0; i < 8; ++i) {
    const int kk = i * 8 + (tid >> 6), nn = tid & 63, n = nt * 64 + nn, k = kt * 64 + kk;
    float v = (n < N) ? src[(size_t)k * N + n] : 0.f;
    if (scale) v *= scale[k];
    tile[kk * 65 + nn] = v;
  }
  __syncthreads();
#pragma unroll
  for (int i = 0; i < 8; ++i) {
    const int nn = i * 8 + (tid >> 6), kk = tid & 63;
    dst[(size_t)(nt * 64 + nn) * ldd + kt * 64 + kk] = f2bf(tile[kk * 65 + nn]);
  }
  __syncthreads();
}

__device__ void phase_prep(const Params& p, char* smem, int bid, int nb) {
  const int tid = threadIdx.x, lane = tid & 63, wid = tid >> 6;
  constexpr int J_X = 1024, J_TW = 1024, J_TO = 256, J_T1 = 64, J_T2 = 2, J_CK = 16, J_ROPE = 64;
  constexpr int TOTAL = J_X + J_TW + J_TO + 2 * J_T1 + 2 * J_T2 + J_CK + J_ROPE;
  if (bid == 0 && tid < 8) p.counter[tid] = 0u;
  for (int j = bid; j < TOTAL; j += nb) {
    int jj = j;
    if (jj < J_X) {
      const int row0 = jj * 32 + wid * 4;
      float4 v[4][4]; float ss[4];
#pragma unroll
      for (int r = 0; r < 4; ++r) {
        const float4* xr = (const float4*)(p.x + (size_t)(row0 + r) * DM);
#pragma unroll
        for (int i = 0; i < 4; ++i) v[r][i] = xr[i * 64 + lane];
      }
#pragma unroll
      for (int r = 0; r < 4; ++r) {
        float a = 0.f;
#pragma unroll
        for (int i = 0; i < 4; ++i) a += v[r][i].x * v[r][i].x + v[r][i].y * v[r][i].y + v[r][i].z * v[r][i].z + v[r][i].w * v[r][i].w;
#pragma unroll
        for (int o = 32; o >= 1; o >>= 1) a += __shfl_xor(a, o);
        ss[r] = a;
      }
#pragma unroll
      for (int r = 0; r < 4; ++r) {
        if (lane == 0) p.rs[row0 + r] = rsqrtf(ss[r] * (1.0f / DM) + EPS);
#pragma unroll
        for (int i = 0; i < 4; ++i) {
          u32x2 o; o[0] = cvtpk(v[r][i].x, v[r][i].y); o[1] = cvtpk(v[r][i].z, v[r][i].w);
          const int rr_ = row0 + r;
          *(u32x2*)(p.xb + ((size_t)((rr_ >> 8) * 16 + i * 4 + (lane >> 4)) * 256 + (rr_ & 255)) * 64 + (lane & 15) * 4) = o;
        }
      }
      continue;
    }
    jj -= J_X;
    if (jj < J_TW) { transpose_tile(p.w_in, p.winT, 1024, DIN, p.norm_w, jj & 15, jj >> 4, smem, LDK); continue; }
    jj -= J_TW;
    if (jj < J_TO) { transpose_tile(p.w_out, p.woutT, 1024, 1024, nullptr, jj & 15, jj >> 4, smem, LDK); continue; }
    jj -= J_TO;
    if (jj < J_T1) { transpose_tile(p.ck_w1, p.w1kT, 2048, 128, nullptr, jj & 31, jj >> 5, smem, 2048); continue; }
    jj -= J_T1;
    if (jj < J_T1) { transpose_tile(p.cv_w1, p.w1vT, 2048, 128, nullptr, jj & 31, jj >> 5, smem, 2048); continue; }
    jj -= J_T1;
    if (jj < J_T2) { transpose_tile(p.ck_w2, p.w2kT, 128, 64, nullptr, jj, 0, smem, 128); continue; }
    jj -= J_T2;
    if (jj < J_T2) { transpose_tile(p.cv_w2, p.w2vT, 128, 64, nullptr, jj, 0, smem, 128); continue; }
    jj -= J_T2;
    if (jj < J_CK) {
      const int which = jj >> 3, chunk = jj & 7, hh = tid & 127, sub = tid >> 7;
      const float* pos = which ? p.cv_pos : p.ck_pos;
      const float* w1 = which ? p.cv_w1 : p.ck_w1;
      float acc = 0.f;
      const int f0 = chunk * 256 + sub * 64;
#pragma unroll 8
      for (int f = 0; f < 64; ++f) acc += pos[f0 + f] * w1[(size_t)(f0 + f) * 128 + hh];
      float* red = (float*)smem;
      red[sub * 128 + hh] = acc;
      __syncthreads();
      if (tid < 128) p.ckpart[(which * 8 + chunk) * 128 + tid] = red[tid] + red[128 + tid] + red[256 + tid] + red[384 + tid];
      __syncthreads();
      continue;
    }
    jj -= J_CK;
    {
      const int idx = jj * 512 + tid, pos = idx >> 3, fi = idx & 7;
      const float ang = (float)pos * c_invf[fi];
      float s, c; sincosf(ang, &s, &c);
      p.rope[idx * 2] = c; p.rope[idx * 2 + 1] = s;
    }
  }
}

DI int kimg_off(int row, int d) { return row * 64 + (((d >> 3) ^ ((row >> 1) & 7)) * 8) + (d & 7); }
DI int vimg_off(int d, int key) { return d * 64 + (((key >> 3) ^ ((d >> 1) & 7)) * 8) + ((((key >> 2) & 1) ^ ((d >> 4) & 1)) * 4) + (key & 3); }

constexpr int G_ASZ = 256 * 128, G_BSZ = 256 * 128, G_STAGE = G_ASZ + G_BSZ;
#define WAIT_VM(n) asm volatile("s_waitcnt vmcnt(" #n ")" ::: "memory")

template <int EPI>
__device__ void gemm_phase(const Params& p, char* smem, int bid, int nb) {
  constexpr int NT = EPI == 0 ? 16 : 4;
  constexpr int MT = 128;
  const u16* __restrict__ A = EPI == 0 ? p.xb : p.mix;
  const u16* __restrict__ Bt = EPI == 0 ? p.winT : p.woutT;
  const int tid = threadIdx.x, lane = tid & 63, wid = tid >> 6, fr = lane & 15, fq = lane >> 4;
  const int wr = wid >> 2, wc = wid & 3;
  const bool xmap = (nb == 256);
  const int xcd = bid & 7, li = bid >> 3;
  const int ntiles = xmap ? (EPI == 0 ? 8 : 2) : (MT * NT - bid + nb - 1) / nb;
  auto tile_of = [&](int ti, int& m0, int& n0) {
    if (xmap) {
      const int sg = ti * 8 + xcd;
      if (EPI == 0) { m0 = ((sg >> 1) * 4 + (li >> 3)) * 256; n0 = ((sg & 1) * 8 + (li & 7)) * 256; }
      else { m0 = (sg * 8 + (li >> 2)) * 256; n0 = (li & 3) * 256; }
    } else { const int tile = bid + ti * nb; const int mt = tile / NT; m0 = mt * 256; n0 = (tile - mt * NT) * 256; }
  };
  const int nsteps = ntiles * 16;
  const int gsw = (lane & 7) ^ ((wid & 1) * 4 + (lane >> 4));
  const int grow = wid * 8 + (lane >> 3);
  auto issue = [&](int step, int stage) {
    int m0, n0; tile_of(step >> 4, m0, n0);
    const int kt = step & 15;
    const u16* ag = EPI == 0 ? A + ((size_t)((m0 >> 8) * 16 + kt) * 256 + grow) * 64 + gsw * 8 : A + (size_t)(m0 + grow) * LDK + kt * 64 + gsw * 8;
    const size_t astep = EPI == 0 ? (size_t)64 * 64 : (size_t)64 * LDK;
    const int brow = EPI == 0 ? ((grow & ~31) | ((grow & 0x0C) << 1) | ((grow & 0x10) >> 2) | (grow & 3)) : grow;
    const u16* bg_ = Bt + (size_t)(n0 + brow) * LDK + kt * 64 + gsw * 8;
    char* dst = smem + stage * G_STAGE + wid * 1024 + lane * 16;
#pragma unroll
    for (int i = 0; i < 4; ++i) __builtin_amdgcn_global_load_lds((const unsigned*)(ag + i * astep), (unsigned*)(dst + i * 8192), 16, 0, 0);
#pragma unroll
    for (int i = 0; i < 4; ++i) __builtin_amdgcn_global_load_lds((const unsigned*)(bg_ + (size_t)i * 64 * LDK), (unsigned*)(dst + G_ASZ + i * 8192), 16, 0, 0);
  };
  const int ca0 = ((fq ^ (fr >> 1)) * 16), ca1 = (((4 + fq) ^ (fr >> 1)) * 16);
  f32x4 acc[8][4];
#pragma unroll
  for (int m = 0; m < 8; ++m)
#pragma unroll
    for (int n = 0; n < 4; ++n) acc[m][n] = f32x4{0.f, 0.f, 0.f, 0.f};
  __syncthreads();
  if (nsteps > 0) issue(0, 0);
  for (int s = 0; s < nsteps; ++s) {
    WAIT_VM(0);
    __builtin_amdgcn_s_barrier();
    if (s + 1 < nsteps) issue(s + 1, (s + 1) & 1);
    {
      const char* ab = smem + (s & 1) * G_STAGE + (wr * 128 + fr) * 128;
      const char* bb = smem + (s & 1) * G_STAGE + G_ASZ + (wc * 64 + fr) * 128;
#pragma unroll
      for (int ks = 0; ks < 2; ++ks) {
        bf16x8 af[8], bf[4];
        const int co = ks ? ca1 : ca0;
#pragma unroll
        for (int n = 0; n < 4; ++n) bf[n] = *(const bf16x8*)(bb + n * 16 * 128 + co);
#pragma unroll
        for (int m = 0; m < 8; ++m) af[m] = *(const bf16x8*)(ab + m * 16 * 128 + co);
#pragma unroll
        for (int m = 0; m < 8; ++m)
#pragma unroll
          for (int n = 0; n < 4; ++n) acc[m][n] = MFMA16(bf[n], af[m], acc[m][n]);
      }
    }
    if ((s & 15) != 15) continue;
    int m0, n0; tile_of(s >> 4, m0, n0);
    const int rbase = m0 + wr * 128;
    const int cb = n0 + wc * 64;
    if constexpr (EPI == 1) {
#pragma unroll
      for (int m = 0; m < 8; ++m) {
        const size_t ro = (size_t)(rbase + m * 16 + fr) * DM + cb + fq * 4;
#pragma unroll
        for (int n = 0; n < 4; ++n) {
          const float4 xv = *(const float4*)(p.x + ro + n * 16);
          float4 o; o.x = xv.x + acc[m][n][0]; o.y = xv.y + acc[m][n][1]; o.z = xv.z + acc[m][n][2]; o.w = xv.w + acc[m][n][3];
          *(float4*)(p.out + ro + n * 16) = o;
        }
        __builtin_amdgcn_sched_barrier(0);
      }
    } else {
      const int b = m0 >> 12;
      const int tb = rbase & 4095;
      if (cb < 1280) {
        const int seg = cb >> 6;
        const int which = seg < 8 ? -1 : ((seg - 8) >> 1);
        const int g = seg < 8 ? (seg >> 2) : ((seg - 8) & 1);
        const bool need_norm = (seg < 8) || which == 2 || which == 4;
        const float* nw = seg < 8 ? p.q_norm_w : (p.k_norm_w + (which == 2 ? 64 : 128));
        float w[16];
#pragma unroll
        for (int k = 0; k < 16; ++k) w[k] = need_norm ? nw[(k >> 3) * 32 + fq * 8 + (k & 7)] : 1.0f;
        const float qs = seg < 8 ? QSCALE : 1.0f;
#pragma unroll
        for (int m = 0; m < 8; ++m) {
          const int t = tb + m * 16 + fr;
          const float r = p.rs[rbase + m * 16 + fr];
          float v[16];
#pragma unroll
          for (int k = 0; k < 16; ++k) v[k] = acc[m][(k >> 3) * 2 + ((k & 7) >> 2)][k & 3] * r;
          if (need_norm) {
            float ss = 0.f;
#pragma unroll
            for (int k = 0; k < 16; ++k) ss += v[k] * v[k];
            ss += __shfl_xor(ss, 16); ss += __shfl_xor(ss, 32);
            const float rr = rsqrtf(ss * (1.0f / 64.f) + EPS);
#pragma unroll
            for (int k = 0; k < 16; ++k) v[k] = v[k] * rr * w[k];
            const float4* rp = (const float4*)(p.rope + (size_t)t * 16);
            const float4 c01 = rp[0], c23 = rp[1], c45 = rp[2], c67 = rp[3];
            const float cc[8] = {c01.x, c01.z, c23.x, c23.z, c45.x, c45.z, c67.x, c67.z};
            const float sn[8] = {c01.y, c01.w, c23.y, c23.w, c45.y, c45.w, c67.y, c67.w};
#pragma unroll
            for (int e = 0; e < 8; ++e) {
              const float pr = __shfl_xor(v[e], 16);
              const float rot = (fq == 0) ? (v[e] * cc[e] - pr * sn[e]) : (v[e] * cc[e] + pr * sn[e]);
              v[e] = (fq < 2) ? rot : v[e];
            }
#pragma unroll
            for (int k = 0; k < 16; ++k) v[k] *= qs;
          }
          if (which == 3 || which == 5) {
            int lz = 0; asm volatile("" : "+v"(lz));
            u16* vt = (which == 3 ? p.Vst : p.Vwt) + (size_t)((b * 2 + g) * 64 + (t >> 6)) * 4096 + lz;
            const int fqx = fq + lz, key = (t & 63) + lz;
#pragma unroll
            for (int k = 0; k < 16; ++k) vt[vimg_off((k >> 3) * 32 + fqx * 8 + (k & 7), key)] = f2bf(v[k]);
          } else {
            u16* dst;
            if (seg < 8) dst = p.Q + ((size_t)((b * 2 + g) * 4096 + t) * 4 + (seg & 3)) * 64;
            else { u16* buf = which == 0 ? p.kcraw : which == 1 ? p.vcraw : which == 2 ? p.Ks : p.Kw; dst = buf + ((size_t)(b * 2 + g) * 4096 + t) * 64; }
            const bool img = which >= 2;
#pragma unroll
            for (int n2 = 0; n2 < 2; ++n2) {
              u32x4 o;
#pragma unroll
              for (int e = 0; e < 4; ++e) o[e] = cvtpk(v[n2 * 8 + 2 * e], v[n2 * 8 + 2 * e + 1]);
              const int d0 = n2 * 32 + fq * 8;
              const int off = img ? (((d0 >> 3) ^ (((t & 63) >> 1) & 7)) * 8) : d0;
              *(u32x4*)(dst + off) = o;
            }
          }
          __builtin_amdgcn_sched_barrier(0);
        }
      } else {
#pragma unroll
        for (int m = 0; m < 8; ++m) {
          const size_t row = rbase + m * 16 + fr;
          const float r = p.rs[row];
#pragma unroll
          for (int n2 = 0; n2 < 2; ++n2) {
            const int c8 = cb + n2 * 32 + fq * 8;
            if (c8 >= DIN) continue;
            float v[8];
#pragma unroll
            for (int e = 0; e < 8; ++e) v[e] = acc[m][n2 * 2 + (e >> 2)][e & 3] * r;
            if (c8 < 1304) {
              float4 o0, o1;
              o0.x = sigmoidf_(v[0]); o0.y = sigmoidf_(v[1]); o0.z = sigmoidf_(v[2]); o0.w = sigmoidf_(v[3]);
              o1.x = sigmoidf_(v[4]); o1.y = sigmoidf_(v[5]); o1.z = sigmoidf_(v[6]); o1.w = sigmoidf_(v[7]);
              float* gp = p.gates + row * 24 + (c8 - 1280);
              *(float4*)gp = o0; *(float4*)(gp + 4) = o1;
            } else if (c8 < 1816) {
              u32x4 o;
#pragma unroll
              for (int e = 0; e < 4; ++e) o[e] = cvtpk(siluf_(v[2 * e]), siluf_(v[2 * e + 1]));
              *(u32x4*)(p.zs + row * 512 + (c8 - 1304)) = o;
            } else {
              u32x4 o;
#pragma unroll
              for (int e = 0; e < 4; ++e) o[e] = cvtpk(v[2 * e], v[2 * e + 1]);
              *(u32x4*)(p.cvb + row * 2048 + (c8 - 1816)) = o;
            }
          }
          __builtin_amdgcn_sched_barrier(0);
        }
      }
    }
#pragma unroll
    for (int m = 0; m < 8; ++m)
#pragma unroll
      for (int n = 0; n < 4; ++n) acc[m][n] = f32x4{0.f, 0.f, 0.f, 0.f};
  }
}

__device__ void phase_cmp_conv(const Params& p, char* smem, int bid, int nb) {
  const int tid = threadIdx.x, lane = tid & 63, wid = tid >> 6, fr = lane & 15, fq = lane >> 4;
  float* part = (float*)smem;
  char* hl = smem + 8 * 16 * 132 * 4;
  float* outl = (float*)(hl + 16 * 272);
  for (int job = bid; job < 512; job += nb) {
    const int which = job >> 8, rest = job & 255, bg = rest >> 4, ct = rest & 15;
    const u16* raw = (which ? p.vcraw : p.kcraw) + (size_t)bg * 4096 * 64;
    const u16* w1T = which ? p.w1vT : p.w1kT;
    const u16* w2T = which ? p.w2vT : p.w2kT;
    const float* b1 = which ? p.cv_b1 : p.ck_b1;
    f32x4 acc[8];
#pragma unroll
    for (int n = 0; n < 8; ++n) acc[n] = f32x4{0.f, 0.f, 0.f, 0.f};
    const int c = ct * 16 + fr;
#pragma unroll
    for (int k8 = 0; k8 < 8; ++k8) {
      const int ks = wid * 8 + k8;
      const int l = ks >> 1, d0 = (ks & 1) * 32 + fq * 8;
      int tt = c * 16 + l; tt = tt > 4095 ? 4095 : tt;
      const bf16x8 a = *(const bf16x8*)(raw + (size_t)tt * 64 + d0);
#pragma unroll
      for (int n = 0; n < 8; ++n) {
        const bf16x8 bb = *(const bf16x8*)(w1T + (size_t)(n * 16 + fr) * 2048 + ks * 32 + fq * 8);
        acc[n] = MFMA16(a, bb, acc[n]);
      }
    }
#pragma unroll
    for (int n = 0; n < 8; ++n)
#pragma unroll
      for (int j = 0; j < 4; ++j) part[(wid * 16 + fq * 4 + j) * 132 + n * 16 + fr] = acc[n][j];
    __syncthreads();
    {
      const int row = tid >> 5, c4 = (tid & 31) * 4;
      float4 sum = *(const float4*)(part + row * 132 + c4);
#pragma unroll
      for (int w = 1; w < 8; ++w) { const float4 v = *(const float4*)(part + (w * 16 + row) * 132 + c4); sum.x += v.x; sum.y += v.y; sum.z += v.z; sum.w += v.w; }
      float bias[4];
#pragma unroll
      for (int e = 0; e < 4; ++e) {
        float bsum = b1[c4 + e];
#pragma unroll
        for (int ch = 0; ch < 8; ++ch) bsum += p.ckpart[(which * 8 + ch) * 128 + c4 + e];
        bias[e] = bsum;
      }
      u32x2 o; o[0] = cvtpk(siluf_(sum.x + bias[0]), siluf_(sum.y + bias[1])); o[1] = cvtpk(siluf_(sum.z + bias[2]), siluf_(sum.w + bias[3]));
      *(u32x2*)(hl + row * 272 + c4 * 2) = o;
    }
    __syncthreads();
    if (wid < 4) {
      f32x4 o2 = f32x4{0.f, 0.f, 0.f, 0.f};
#pragma unroll
      for (int ks = 0; ks < 4; ++ks) {
        const bf16x8 a = *(const bf16x8*)(hl + fr * 272 + (ks * 32 + fq * 8) * 2);
        const bf16x8 bb = *(const bf16x8*)(w2T + (size_t)(wid * 16 + fr) * 128 + ks * 32 + fq * 8);
        o2 = MFMA16(a, bb, o2);
      }
#pragma unroll
      for (int j = 0; j < 4; ++j) outl[(fq * 4 + j) * 68 + wid * 16 + fr] = o2[j];
    }
    __syncthreads();
    if (tid < 256) {
      const int row = tid >> 4, d4 = (tid & 15) * 4;
      const int cc = ct * 16 + row;
      const float4 v = *(const float4*)(outl + row * 68 + d4);
      if (which == 0) {
        float ss = v.x * v.x + v.y * v.y + v.z * v.z + v.w * v.w;
        ss += __shfl_xor(ss, 1); ss += __shfl_xor(ss, 2); ss += __shfl_xor(ss, 4); ss += __shfl_xor(ss, 8);
        const float rr = rsqrtf(ss * (1.0f / 64.f) + EPS);
        float o[4] = {v.x * rr * p.k_norm_w[d4], v.y * rr * p.k_norm_w[d4 + 1], v.z * rr * p.k_norm_w[d4 + 2], v.w * rr * p.k_norm_w[d4 + 3]};
        if (d4 < 16) {
          int pos = cc * 16 + 31; pos = pos > 4095 ? 4095 : pos;
#pragma unroll
          for (int e = 0; e < 4; ++e) {
            const int d = d4 + e, dp = d ^ 8;
            const float pr = outl[row * 68 + dp] * rr * p.k_norm_w[dp];
            const float2 cs = *(const float2*)(p.rope + ((size_t)pos * 8 + (d & 7)) * 2);
            o[e] = (d < 8) ? (o[e] * cs.x - pr * cs.y) : (o[e] * cs.x + pr * cs.y);
          }
        }
        u32x2 ov; ov[0] = cvtpk(o[0], o[1]); ov[1] = cvtpk(o[2], o[3]);
        if (cc >= 255) { ov[0] = 0u; ov[1] = 0u; }
        *(u32x2*)(p.Kc + (size_t)(bg * 4 + (cc >> 6)) * 4096 + kimg_off(cc & 63, d4)) = ov;
      } else {
        const float z = (cc >= 255) ? 0.f : 1.f;
        u16* vt = p.Vct + (size_t)(bg * 4 + (cc >> 6)) * 4096;
        vt[vimg_off(d4 + 0, cc & 63)] = f2bf(v.x * z); vt[vimg_off(d4 + 1, cc & 63)] = f2bf(v.y * z);
        vt[vimg_off(d4 + 2, cc & 63)] = f2bf(v.z * z); vt[vimg_off(d4 + 3, cc & 63)] = f2bf(v.w * z);
      }
    }
    __syncthreads();
  }
  const int gw = bid * 8 + wid, nw = nb * 8;
  for (int chunk = gw; chunk < 2048; chunk += nw) {
    const int r0 = chunk * 16, t0 = r0 & 4095;
    const int ch = lane * 8;
    float cw0[8], cw1[8], cw2[8], cbv[8], u1[8], u2[8];
#pragma unroll
    for (int e = 0; e < 8; ++e) { cw0[e] = p.conv_w[ch + e]; cw1[e] = p.conv_w[512 + ch + e]; cw2[e] = p.conv_w[1024 + ch + e]; cbv[e] = p.conv_b[ch + e]; u1[e] = 0.f; u2[e] = 0.f; }
    if (t0 > 0) {
#pragma unroll
      for (int q = 0; q < 2; ++q) {
        const u16* rp = p.cvb + (size_t)(r0 - 2 + q) * 2048 + ch;
        const u32x4 hv = *(const u32x4*)(rp), cv = *(const u32x4*)(rp + 1024);
#pragma unroll
        for (int e = 0; e < 4; ++e) {
          const float ua = bflo(hv[e]) * bflo(cv[e]), ub = bfhi(hv[e]) * bfhi(cv[e]);
          if (q == 0) { u2[2 * e] = ua; u2[2 * e + 1] = ub; } else { u1[2 * e] = ua; u1[2 * e + 1] = ub; }
        }
      }
    }
#pragma unroll 4
    for (int rr = 0; rr < 16; ++rr) {
      const u16* rp = p.cvb + (size_t)(r0 + rr) * 2048 + ch;
      const u32x4 hv = *(const u32x4*)(rp), bv = *(const u32x4*)(rp + 512), cv = *(const u32x4*)(rp + 1024), zv = *(const u32x4*)(rp + 1536);
      u32x4 ov;
#pragma unroll
      for (int e = 0; e < 4; ++e) {
        const float ua = bflo(hv[e]) * bflo(cv[e]), ub = bfhi(hv[e]) * bfhi(cv[e]);
        const float ca = cw0[2 * e] * u2[2 * e] + cw1[2 * e] * u1[2 * e] + cw2[2 * e] * ua + cbv[2 * e];
        const float cbb = cw0[2 * e + 1] * u2[2 * e + 1] + cw1[2 * e + 1] * u1[2 * e + 1] + cw2[2 * e + 1] * ub + cbv[2 * e + 1];
        const float oa = bflo(bv[e]) * ca * siluf_(bflo(zv[e]));
        const float ob = bfhi(bv[e]) * cbb * siluf_(bfhi(zv[e]));
        ov[e] = cvtpk(oa, ob);
        u2[2 * e] = u1[2 * e]; u2[2 * e + 1] = u1[2 * e + 1]; u1[2 * e] = ua; u1[2 * e + 1] = ub;
      }
      *(u32x4*)(p.mix + (size_t)(r0 + rr) * LDK + 512 + ch) = ov;
    }
  }
}

constexpr int AT_NST = 5, AT_KB = 8192, AT_BUF = 16384;
constexpr int AT_F = AT_NST * AT_BUF, AT_IMPA = AT_F, AT_IMPB = AT_IMPA + 64 * 65 * 4, AT_VAL = AT_IMPA;
constexpr int AT_SELM = AT_F + 8 * 8192, AT_UNIT = AT_SELM + 512, AT_END = AT_UNIT + 16;
static_assert(AT_END <= SMEM_BYTES, "attention LDS layout exceeds the dynamic LDS size");

__device__ void phase_attn(const Params& p, char* smem, int bid, int nb, int rep) {
  const int tid = threadIdx.x, lane = tid & 63, wid = tid >> 6, c32 = lane & 31, h = lane >> 5;
  const float NINF = -__builtin_inff();
  float* impa = (float*)(smem + AT_IMPA);
  float* impb = (float*)(smem + AT_IMPB);
  float* vals = (float*)(smem + AT_VAL);
  unsigned* selm = (unsigned*)(smem + AT_SELM);
  volatile int* s_unit = (volatile int*)(smem + AT_UNIT);
  const int srow = tid >> 3, sc = tid & 7;
  while (true) {
    if (tid == 0) *s_unit = (int)atomicAdd(p.counter + rep, 1u);
    __syncthreads();
    const int u = *s_unit;
    __syncthreads();
    if (u >= 1024) break;
    const int i = 63 - (u >> 4), bg = u & 15, b = bg >> 1, g = bg & 1;
    const int tl = wid * 8 + (c32 >> 2), hd = c32 & 3;
    const int t = i * 64 + tl;
    const u16* qrow = p.Q + ((size_t)(bg * 4096 + i * 64) * 4 + wid * 32 + c32) * 64;
    bf16x8 qf[4];
#pragma unroll
    for (int ks = 0; ks < 4; ++ks) qf[ks] = *(const bf16x8*)(qrow + ks * 16 + h * 8);
    const float* gp = p.gates + (size_t)(b * 4096 + t) * 24 + (g * 4 + hd) * 3;
    const float g0 = gp[0], g1 = gp[1], g2 = gp[2];
    const int ntc = (4 * i + 2) / 64 + 1, nsl = i + 1, nwin = (i < 8 ? i : 8) + 1;
    const int NT = 2 * ntc + nsl + nwin;
    const bool need_sel = i >= 16;

    f32x16 O0, O1;
#pragma unroll
    for (int r = 0; r < 16; ++r) { O0[r] = 0.f; O1[r] = 0.f; }
    float* fl = (float*)(smem + AT_F + wid * 8192) + lane;
    float m_run = NINF, l_run = 0.f, inv_l = 0.f;
    unsigned sel_lo = 0xffffffffu, sel_hi = 0xffffffffu;
#define TILE_PTRS(n, kp, vp) do { \
      if ((n) < 2 * ntc) { const int tt_ = (n) < ntc ? (n) : (n) - ntc; kp = p.Kc + (size_t)(bg * 4 + tt_) * 4096; vp = p.Vct + (size_t)(bg * 4 + tt_) * 4096; } \
      else if ((n) < 2 * ntc + nsl) { const int j_ = (n) - 2 * ntc; kp = p.Ks + ((size_t)bg * 4096 + j_ * 64) * 64; vp = p.Vst + (size_t)(bg * 64 + j_) * 4096; } \
      else { const int j_ = i - nwin + 1 + ((n) - 2 * ntc - nsl); kp = p.Kw + ((size_t)bg * 4096 + j_ * 64) * 64; vp = p.Vwt + (size_t)(bg * 64 + j_) * 4096; } } while (0)
#define TISSUE(n, st_) do { const u16 *kp_, *vp_; TILE_PTRS(n, kp_, vp_); char* d_ = smem + (st_) * AT_BUF + tid * 16; \
      __builtin_amdgcn_global_load_lds((const unsigned*)(kp_ + tid * 8), (unsigned*)d_, 16, 0, 0); \
      __builtin_amdgcn_global_load_lds((const unsigned*)(vp_ + tid * 8), (unsigned*)(d_ + AT_KB), 16, 0, 0); } while (0)
    {
      const int npre = NT < AT_NST - 1 ? NT : AT_NST - 1;
      for (int n = 0; n < npre; ++n) TISSUE(n, n);
    }
    int st_cur = 0, st_iss = AT_NST - 1;
    const int ksw = (c32 >> 1) & 7, vhs = (c32 >> 4) & 1;
    for (int n = 0; n < NT; ++n) {
      {
        const int rem = NT - 1 - n;
        if (rem >= 3) WAIT_VM(6); else if (rem == 2) WAIT_VM(4); else if (rem == 1) WAIT_VM(2); else WAIT_VM(0);
        __builtin_amdgcn_s_barrier();
        if (n + AT_NST - 1 < NT) TISSUE(n + AT_NST - 1, st_iss);
      }
      int mode, base, lo, hi;
      bool full = false, lane_on = true;
      if (n < 2 * ntc) { mode = n < ntc ? 0 : 1; base = (n < ntc ? n : n - ntc) * 64; lo = -1; hi = (t - 31) >> 4; }
      else if (n < 2 * ntc + nsl) { const int j = n - 2 * ntc; mode = 2; base = j * 64; const unsigned bit = j < 32 ? (sel_lo >> j) & 1u : (sel_hi >> (j - 32)) & 1u; lo = -1; hi = bit ? t : -1; full = j < i; lane_on = bit != 0u; }
      else { const int j = i - nwin + 1 + (n - 2 * ntc - nsl); mode = 3; base = j * 64; lo = t - 512; hi = t; full = (j < i) && (j > i - 8); }
      const int lo_rel = lo - (base + 4 * h), hi_rel = hi - (base + 4 * h);
      const char* kb = smem + st_cur * AT_BUF;
      const char* vb = kb + AT_KB;
      st_cur = st_cur == AT_NST - 1 ? 0 : st_cur + 1; st_iss = st_iss == AT_NST - 1 ? 0 : st_iss + 1;
      f32x16 S0, S1;
#pragma unroll
      for (int r = 0; r < 16; ++r) { S0[r] = 0.f; S1[r] = 0.f; }
#pragma unroll
      for (int ks = 0; ks < 4; ++ks) {
        const bf16x8 k0 = *(const bf16x8*)(kb + c32 * 128 + (((ks * 2 + h) ^ ksw) * 16));
        const bf16x8 k1 = *(const bf16x8*)(kb + (32 + c32) * 128 + (((ks * 2 + h) ^ ksw) * 16));
        S0 = MFMA32(k0, qf[ks], S0);
        S1 = MFMA32(k1, qf[ks], S1);
      }
      if (!full) {
#pragma unroll
        for (int r = 0; r < 16; ++r) {
          const int off = (r & 3) + 8 * (r >> 2);
          S0[r] = (off > lo_rel && off <= hi_rel) ? S0[r] : NINF;
          S1[r] = (off + 32 > lo_rel && off + 32 <= hi_rel) ? S1[r] : NINF;
        }
      }
      if (mode != 1) {
        float mx = fmaxf(fmaxf(S0[0], S0[1]), S1[0]);
        mx = fmaxf(fmaxf(mx, S1[1]), S0[2]);
#pragma unroll
        for (int r = 2; r < 16; r += 2) {
          if (r > 2) mx = fmaxf(fmaxf(mx, S0[r]), S1[r - 1]);
          mx = fmaxf(fmaxf(mx, S0[r + 1]), S1[r]);
        }
        mx = fmaxf(mx, S1[15]);
        if (full && !lane_on) mx = NINF;
        mx = fmaxf(mx, __shfl_xor(mx, 32));
        const bool mv = (mx - m_run) > 8.0f;
        if (__builtin_amdgcn_ballot_w64(mv) != 0ull) {
          const float alpha = mv ? __builtin_amdgcn_exp2f(m_run - mx) : 1.0f;
          m_run = mv ? mx : m_run;
          l_run *= alpha;
          if (mode != 0) {
#pragma unroll
            for (int r = 0; r < 16; ++r) { O0[r] *= alpha; O1[r] *= alpha; }
          }
        }
      }
      {
        const float m_use = (m_run == NINF) ? 0.f : m_run;
        const float msub = (full && !lane_on) ? __builtin_inff() : m_use;
        float ps0 = 0.f, ps1 = 0.f;
#pragma unroll
        for (int r = 0; r < 16; ++r) { S0[r] = __builtin_amdgcn_exp2f(S0[r] - msub); S1[r] = __builtin_amdgcn_exp2f(S1[r] - msub); ps0 += S0[r]; ps1 += S1[r]; }
        if (mode != 1) l_run += ps0 + ps1;
      }
      if (mode != 0) {
#pragma unroll
        for (int kk = 0; kk < 4; ++kk) {
          const int kr = kk >> 1, sp = kk & 1;
          u32x4 pw;
#pragma unroll
          for (int e = 0; e < 4; ++e) {
            const float a0 = kr ? S1[8 * sp + 2 * e] : S0[8 * sp + 2 * e];
            const float a1 = kr ? S1[8 * sp + 2 * e + 1] : S0[8 * sp + 2 * e + 1];
            pw[e] = cvtpk(a0, a1);
          }
          const bf16x8 pf = __builtin_bit_cast(bf16x8, pw);
#pragma unroll
          for (int dr = 0; dr < 2; ++dr) {
            const char* va = vb + (32 * dr + c32) * 128 + ((h ^ vhs) * 8);
            const s16x4 vlo = *(const s16x4*)(va + (((4 * kr + 2 * sp) ^ ksw) * 16)), vhi = *(const s16x4*)(va + (((4 * kr + 2 * sp + 1) ^ ksw) * 16));
            const bf16x8 vf = __builtin_shufflevector(vlo, vhi, 0, 1, 2, 3, 4, 5, 6, 7);
            if (dr == 0) O0 = MFMA32(vf, pf, O0); else O1 = MFMA32(vf, pf, O1);
          }
        }
      }
      if (mode == 1 && need_sel) {
        const int tt = base >> 6;
#pragma unroll
        for (int kr = 0; kr < 2; ++kr)
#pragma unroll
          for (int rg = 0; rg < 4; ++rg) {
            float pv[4];
#pragma unroll
            for (int e = 0; e < 4; ++e) {
              float v = (kr ? S1[rg * 4 + e] : S0[rg * 4 + e]) * inv_l;
              v += __shfl_xor(v, 1); v += __shfl_xor(v, 2);
              pv[e] = v;
            }
            if (hd == 0) {
              const int nblk = tt * 16 + 8 * kr + 2 * rg + h;
              impa[tl * 65 + nblk] = pv[0] + pv[1] + pv[2] + 0.5f * pv[3];
              impb[tl * 65 + nblk] = 0.5f * pv[3];
            }
          }
      }
      if (n == ntc - 1) {
        const float lt = l_run + __shfl_xor(l_run, 32);
        inv_l = lt > 0.f ? 1.0f / lt : 0.f;
      } else if (n == 2 * ntc - 1) {
        if (need_sel) {
          __syncthreads();
          const int tk = tid >> 3, nb0 = (tid & 7) * 8;
          float myv[8];
#pragma unroll
          for (int e = 0; e < 8; ++e) {
            const int nn = nb0 + e;
            const bool forced = (nn == 0) || (nn == i) || (nn == i - 1);
            float v = -1.0f;
            if (nn <= i) v = impa[tk * 65 + nn] + (nn > 0 ? impb[tk * 65 + nn - 1] : 0.f);
            if (forced) v = 1e9f;
            myv[e] = v;
            vals[tk * 65 + nn] = v;
          }
          __syncthreads();
          int cnt[8];
#pragma unroll
          for (int e = 0; e < 8; ++e) cnt[e] = 0;
          for (int mm = 0; mm < 64; ++mm) {
            const float vm = vals[tk * 65 + mm];
#pragma unroll
            for (int e = 0; e < 8; ++e) cnt[e] += (vm > myv[e] || (vm == myv[e] && mm < nb0 + e)) ? 1 : 0;
          }
          unsigned bits = 0;
#pragma unroll
          for (int e = 0; e < 8; ++e) bits |= (cnt[e] < 16 ? 1u : 0u) << e;
          unsigned wlo = (tid & 7) < 4 ? bits << (8 * (tid & 7)) : 0u;
          unsigned whi = (tid & 7) >= 4 ? bits << (8 * ((tid & 7) - 4)) : 0u;
          wlo |= __shfl_xor(wlo, 1); wlo |= __shfl_xor(wlo, 2); wlo |= __shfl_xor(wlo, 4);
          whi |= __shfl_xor(whi, 1); whi |= __shfl_xor(whi, 2); whi |= __shfl_xor(whi, 4);
          if ((tid & 7) == 0) { selm[tk * 2] = wlo; selm[tk * 2 + 1] = whi; }
          __syncthreads();
          sel_lo = selm[tl * 2]; sel_hi = selm[tl * 2 + 1];
        }
        {
          const float wgt = g0 * inv_l;
#pragma unroll
          for (int r = 0; r < 16; ++r) { fl[r * 64] = wgt * O0[r]; fl[(16 + r) * 64] = wgt * O1[r]; O0[r] = 0.f; O1[r] = 0.f; }
          m_run = NINF; l_run = 0.f;
        }
      } else if (n == 2 * ntc + nsl - 1) {
        const float lt = l_run + __shfl_xor(l_run, 32);
        const float wgt = g1 * (lt > 0.f ? 1.0f / lt : 0.f);
#pragma unroll
        for (int r = 0; r < 16; ++r) { fl[r * 64] += wgt * O0[r]; fl[(16 + r) * 64] += wgt * O1[r]; O0[r] = 0.f; O1[r] = 0.f; }
        m_run = NINF; l_run = 0.f;
      }
    }
#undef TILE_PTRS
#undef TISSUE
    {
      const float lt = l_run + __shfl_xor(l_run, 32);
      const float wgt = g2 * (lt > 0.f ? 1.0f / lt : 0.f);
      const size_t rowo = (size_t)(b * 4096 + t);
      const u16* zp = p.zs + rowo * 512 + (g * 4 + hd) * 64;
      u16* mp = p.mix + rowo * LDK + (g * 4 + hd) * 64;
#pragma unroll
      for (int dr = 0; dr < 2; ++dr)
#pragma unroll
        for (int rg = 0; rg < 4; ++rg) {
          const int d = 32 * dr + 8 * rg + 4 * h;
          const u32x2 zv = *(const u32x2*)(zp + d);
          const float f0 = fl[(dr * 16 + rg * 4 + 0) * 64] + wgt * (dr ? O1[rg * 4 + 0] : O0[rg * 4 + 0]);
          const float f1 = fl[(dr * 16 + rg * 4 + 1) * 64] + wgt * (dr ? O1[rg * 4 + 1] : O0[rg * 4 + 1]);
          const float f2 = fl[(dr * 16 + rg * 4 + 2) * 64] + wgt * (dr ? O1[rg * 4 + 2] : O0[rg * 4 + 2]);
          const float f3 = fl[(dr * 16 + rg * 4 + 3) * 64] + wgt * (dr ? O1[rg * 4 + 3] : O0[rg * 4 + 3]);
          u32x2 o;
          o[0] = cvtpk(f0 * bflo(zv[0]), f1 * bfhi(zv[0]));
          o[1] = cvtpk(f2 * bflo(zv[1]), f3 * bfhi(zv[1]));
          *(u32x2*)(mp + d) = o;
        }
    }
  }
}

#if FUSED
extern "C" __global__ void __launch_bounds__(NTHREADS) hybrid_fwd(Params p) {
  extern __shared__ __attribute__((aligned(16))) char smem[];
  cg::grid_group grid = cg::this_grid();
  const int bid = blockIdx.x, nb = gridDim.x;
  for (int r = 0; r < REP0; ++r) { phase_prep(p, smem, bid, nb); grid.sync(); }
  for (int r = 0; r < REP1; ++r) { gemm_phase<0>(p, smem, bid, nb); grid.sync(); }
  for (int r = 0; r < REP2; ++r) { phase_cmp_conv(p, smem, bid, nb); grid.sync(); }
  for (int r = 0; r < REP3; ++r) { phase_attn(p, smem, bid, nb, r); grid.sync(); }
  for (int r = 0; r < REP4; ++r) { gemm_phase<1>(p, smem, bid, nb); }
}
#else
template <int PH>
__global__ void __launch_bounds__(NTHREADS) phase_kernel(Params p) {
  extern __shared__ __attribute__((aligned(16))) char smem[];
  const int bid = blockIdx.x, nb = gridDim.x;
  if constexpr (PH == 0) phase_prep(p, smem, bid, nb);
  if constexpr (PH == 1) gemm_phase<0>(p, smem, bid, nb);
  if constexpr (PH == 2) phase_cmp_conv(p, smem, bid, nb);
  if constexpr (PH == 3) phase_attn(p, smem, bid, nb, 0);
  if constexpr (PH == 4) gemm_phase<1>(p, smem, bid, nb);
}
#endif

extern "C" void kernel_launch(void* const* d_in, const int* in_sizes, int n_in, void* d_out, int out_size, void* d_ws, size_t ws_size, hipStream_t stream) {
  Params p{};
  p.x = (const float*)d_in[0]; p.norm_w = (const float*)d_in[1]; p.w_in = (const float*)d_in[2]; p.q_norm_w = (const float*)d_in[3];
  p.k_norm_w = (const float*)d_in[4]; p.ck_pos = (const float*)d_in[5]; p.ck_w1 = (const float*)d_in[6]; p.ck_b1 = (const float*)d_in[7];
  p.ck_w2 = (const float*)d_in[8]; p.cv_pos = (const float*)d_in[9]; p.cv_w1 = (const float*)d_in[10]; p.cv_b1 = (const float*)d_in[11];
  p.cv_w2 = (const float*)d_in[12]; p.conv_w = (const float*)d_in[13]; p.conv_b = (const float*)d_in[14]; p.w_out = (const float*)d_in[15];
  p.out = (float*)d_out;
  char* w = (char*)d_ws; size_t off = 0;
  auto carve = [&](size_t bytes) { char* r = w + off; off += (bytes + 255) & ~(size_t)255; return r; };
  p.xb = (u16*)carve((size_t)NROWS * LDK * 2);
  p.winT = (u16*)carve((size_t)4096 * LDK * 2);
  p.woutT = (u16*)carve((size_t)1024 * LDK * 2);
  p.w1kT = (u16*)carve((size_t)128 * 2048 * 2);
  p.w1vT = (u16*)carve((size_t)128 * 2048 * 2);
  p.w2kT = (u16*)carve((size_t)64 * 128 * 2);
  p.w2vT = (u16*)carve((size_t)64 * 128 * 2);
  p.Q = (u16*)carve((size_t)NROWS * 512 * 2);
  p.Ks = (u16*)carve((size_t)16 * 4096 * 64 * 2);
  p.Kw = (u16*)carve((size_t)16 * 4096 * 64 * 2);
  p.Vst = (u16*)carve((size_t)16 * 4096 * 64 * 2);
  p.Vwt = (u16*)carve((size_t)16 * 4096 * 64 * 2);
  p.kcraw = (u16*)carve((size_t)16 * 4096 * 64 * 2 + 4096);
  p.vcraw = (u16*)carve((size_t)16 * 4096 * 64 * 2 + 4096);
  p.Kc = (u16*)carve((size_t)16 * 256 * 64 * 2);
  p.Vct = (u16*)carve((size_t)16 * 256 * 64 * 2);
  p.zs = (u16*)carve((size_t)NROWS * 512 * 2);
  p.cvb = (u16*)carve((size_t)NROWS * 2048 * 2);
  p.mix = (u16*)carve((size_t)NROWS * LDK * 2);
  p.rs = (float*)carve((size_t)NROWS * 4);
  p.ckpart = (float*)carve(16 * 128 * 4);
  p.rope = (float*)carve((size_t)4096 * 8 * 2 * 4);
  p.gates = (float*)carve((size_t)NROWS * 24 * 4);
  p.counter = (unsigned*)carve(256);
  if (off > ws_size) { fprintf(stderr, "kernel_launch: workspace too small (%zu > %zu)\n", off, ws_size); return; }

#if FUSED
  static int grid_blocks = 0;
  if (!grid_blocks) {
    int dev = 0, cus = 0, per_cu = 0;
    hipGetDevice(&dev);
    hipDeviceGetAttribute(&cus, hipDeviceAttributeMultiprocessorCount, dev);
    hipFuncSetAttribute((const void*)hybrid_fwd, hipFuncAttributeMaxDynamicSharedMemorySize, SMEM_BYTES);
    hipOccupancyMaxActiveBlocksPerMultiprocessor(&per_cu, (const void*)hybrid_fwd, NTHREADS, SMEM_BYTES);
    if (per_cu < 1) per_cu = 1;
    grid_blocks = cus * per_cu;
  }
  void* args[] = {&p};
  hipError_t e = hipLaunchCooperativeKernel((const void*)hybrid_fwd, dim3(grid_blocks), dim3(NTHREADS), args, SMEM_BYTES, stream);
  if (e != hipSuccess) fprintf(stderr, "cooperative launch failed: %s (grid %d)\n", hipGetErrorString(e), grid_blocks);
#else
  static int attr_set = 0;
  if (!attr_set) {
    (void)hipFuncSetAttribute((const void*)phase_kernel<0>, hipFuncAttributeMaxDynamicSharedMemorySize, SMEM_BYTES);
    (void)hipFuncSetAttribute((const void*)phase_kernel<1>, hipFuncAttributeMaxDynamicSharedMemorySize, SMEM_BYTES);
    (void)hipFuncSetAttribute((const void*)phase_kernel<2>, hipFuncAttributeMaxDynamicSharedMemorySize, SMEM_BYTES);
    (void)hipFuncSetAttribute((const void*)phase_kernel<3>, hipFuncAttributeMaxDynamicSharedMemorySize, SMEM_BYTES);
    (void)hipFuncSetAttribute((const void*)phase_kernel<4>, hipFuncAttributeMaxDynamicSharedMemorySize, SMEM_BYTES);
    attr_set = 1;
  }
  const int G = 256;
  phase_kernel<0><<<G, NTHREADS, SMEM_BYTES, stream>>>(p);
  phase_kernel<1><<<G, NTHREADS, SMEM_BYTES, stream>>>(p);
  phase_kernel<2><<<G, NTHREADS, SMEM_BYTES, stream>>>(p);
  phase_kernel<3><<<G, NTHREADS, SMEM_BYTES, stream>>>(p);
  phase_kernel<4><<<G, NTHREADS, SMEM_BYTES, stream>>>(p);
#endif
}
```

```cpp
#include <hip/hip_runtime.h>
#include <hip/hip_cooperative_groups.h>
#include <cstdio>
#include <cstdint>
namespace cg = cooperative_groups;

#ifndef FUSED
#define FUSED 1
#endif
#define REP0 1
#define REP1 1
#define REP2 1
#define REP3 1
#define REP4 1

#define DI __device__ __forceinline__
typedef unsigned short u16;
using bf16x8 = __attribute__((ext_vector_type(8))) short;
using s16x4 = __attribute__((ext_vector_type(4))) short;
using f32x4 = __attribute__((ext_vector_type(4))) float;
using f32x16 = __attribute__((ext_vector_type(16))) float;
using u32x4 = __attribute__((ext_vector_type(4))) unsigned;
using u32x2 = __attribute__((ext_vector_type(2))) unsigned;
typedef __bf16 bf2_t __attribute__((ext_vector_type(2)));
typedef float fl2_t __attribute__((ext_vector_type(2)));

constexpr int NTHREADS = 512;
constexpr int SEQ = 4096, DM = 1024, DIN = 3864, NROWS = 32768;
constexpr int LDK = 1088;
constexpr float EPS = 1e-6f;
constexpr float QSCALE = 0.125f * 1.4426950408889634f;
constexpr int SMEM_BYTES = 148480;

__constant__ float c_invf[8] = {1.0f, 0.1939227432012558f, 0.03760603070259094f, 0.007292664609849453f,
                                0.0014142135623842478f, 0.00027424818836152554f, 5.3182957344688475e-05f, 1.0313385246263351e-05f};

DI unsigned cvtpk(float lo, float hi) {
  fl2_t f = {lo, hi};
  bf2_t b = __builtin_convertvector(f, bf2_t);
  return __builtin_bit_cast(unsigned, b);
}
DI u16 f2bf(float x) { return (u16)(cvtpk(x, 0.f) & 0xffffu); }
DI float bf2f(u16 v) { return __uint_as_float(((unsigned)v) << 16); }
DI float bflo(unsigned v) { return __uint_as_float(v << 16); }
DI float bfhi(unsigned v) { return __uint_as_float(v & 0xffff0000u); }
DI float sigmoidf_(float v) { return __builtin_amdgcn_rcpf(1.0f + __builtin_amdgcn_exp2f(-1.4426950408889634f * v)); }
DI float siluf_(float v) { return v * __builtin_amdgcn_rcpf(1.0f + __builtin_amdgcn_exp2f(-1.4426950408889634f * v)); }
DI void glds16(const void* g, unsigned lds_base) {
  unsigned sv;
  asm volatile("s_mov_b32 %0, m0\n\ts_mov_b32 m0, %2\n\ts_nop 0\n\tglobal_load_lds_dwordx4 %1, off\n\ts_mov_b32 m0, %0" : "=&s"(sv) : "v"(g), "s"(lds_base) : "memory");
}
#define MFMA16(a, b, c) __builtin_amdgcn_mfma_f32_16x16x32_bf16((a), (b), (c), 0, 0, 0)
#define MFMA32(a, b, c) __builtin_amdgcn_mfma_f32_32x32x16_bf16((a), (b), (c), 0, 0, 0)

struct Params {
  const float *x, *norm_w, *w_in, *q_norm_w, *k_norm_w, *ck_pos, *ck_w1, *ck_b1, *ck_w2, *cv_pos, *cv_w1, *cv_b1, *cv_w2, *conv_w, *conv_b, *w_out;
  float* out;
  char* ws;
};
constexpr size_t al256(size_t v) { return (v + 255) & ~(size_t)255; }
constexpr size_t OFF_xb = 0;
DI u16* ws_xb(const Params& p) { return (u16*)(p.ws + OFF_xb); }
constexpr size_t OFF_winT = OFF_xb + al256((size_t)NROWS * LDK * 2);
DI u16* ws_winT(const Params& p) { return (u16*)(p.ws + OFF_winT); }
constexpr size_t OFF_woutT = OFF_winT + al256((size_t)4096 * LDK * 2);
DI u16* ws_woutT(const Params& p) { return (u16*)(p.ws + OFF_woutT); }
constexpr size_t OFF_w1kT = OFF_woutT + al256((size_t)1024 * LDK * 2);
DI u16* ws_w1kT(const Params& p) { return (u16*)(p.ws + OFF_w1kT); }
constexpr size_t OFF_w1vT = OFF_w1kT + al256((size_t)128 * 2048 * 2);
DI u16* ws_w1vT(const Params& p) { return (u16*)(p.ws + OFF_w1vT); }
constexpr size_t OFF_w2kT = OFF_w1vT + al256((size_t)128 * 2048 * 2);
DI u16* ws_w2kT(const Params& p) { return (u16*)(p.ws + OFF_w2kT); }
constexpr size_t OFF_w2vT = OFF_w2kT + al256((size_t)64 * 128 * 2);
DI u16* ws_w2vT(const Params& p) { return (u16*)(p.ws + OFF_w2vT); }
constexpr size_t OFF_Q = OFF_w2vT + al256((size_t)64 * 128 * 2);
DI u16* ws_Q(const Params& p) { return (u16*)(p.ws + OFF_Q); }
constexpr size_t OFF_Ks = OFF_Q + al256((size_t)NROWS * 512 * 2);
DI u16* ws_Ks(const Params& p) { return (u16*)(p.ws + OFF_Ks); }
constexpr size_t OFF_Kw = OFF_Ks + al256((size_t)16 * 4096 * 64 * 2);
DI u16* ws_Kw(const Params& p) { return (u16*)(p.ws + OFF_Kw); }
constexpr size_t OFF_Vst = OFF_Kw + al256((size_t)16 * 4096 * 64 * 2);
DI u16* ws_Vst(const Params& p) { return (u16*)(p.ws + OFF_Vst); }
constexpr size_t OFF_Vwt = OFF_Vst + al256((size_t)16 * 4096 * 64 * 2);
DI u16* ws_Vwt(const Params& p) { return (u16*)(p.ws + OFF_Vwt); }
constexpr size_t OFF_kcraw = OFF_Vwt + al256((size_t)16 * 4096 * 64 * 2);
DI u16* ws_kcraw(const Params& p) { return (u16*)(p.ws + OFF_kcraw); }
constexpr size_t OFF_vcraw = OFF_kcraw + al256((size_t)16 * 4096 * 64 * 2 + 4096);
DI u16* ws_vcraw(const Params& p) { return (u16*)(p.ws + OFF_vcraw); }
constexpr size_t OFF_Kc = OFF_vcraw + al256((size_t)16 * 4096 * 64 * 2 + 4096);
DI u16* ws_Kc(const Params& p) { return (u16*)(p.ws + OFF_Kc); }
constexpr size_t OFF_Vct = OFF_Kc + al256((size_t)16 * 256 * 64 * 2);
DI u16* ws_Vct(const Params& p) { return (u16*)(p.ws + OFF_Vct); }
constexpr size_t OFF_zs = OFF_Vct + al256((size_t)16 * 256 * 64 * 2);
DI u16* ws_zs(const Params& p) { return (u16*)(p.ws + OFF_zs); }
constexpr size_t OFF_cvb = OFF_zs + al256((size_t)NROWS * 512 * 2);
DI u16* ws_cvb(const Params& p) { return (u16*)(p.ws + OFF_cvb); }
constexpr size_t OFF_mix = OFF_cvb + al256((size_t)NROWS * 2048 * 2);
DI u16* ws_mix(const Params& p) { return (u16*)(p.ws + OFF_mix); }
constexpr size_t OFF_rs = OFF_mix + al256((size_t)NROWS * LDK * 2);
DI float* ws_rs(const Params& p) { return (float*)(p.ws + OFF_rs); }
constexpr size_t OFF_ckpart = OFF_rs + al256((size_t)NROWS * 4);
DI float* ws_ckpart(const Params& p) { return (float*)(p.ws + OFF_ckpart); }
constexpr size_t OFF_rope = OFF_ckpart + al256((size_t)16 * 128 * 4);
DI float* ws_rope(const Params& p) { return (float*)(p.ws + OFF_rope); }
constexpr size_t OFF_gates = OFF_rope + al256((size_t)4096 * 8 * 2 * 4);
DI float* ws_gates(const Params& p) { return (float*)(p.ws + OFF_gates); }
constexpr size_t OFF_counter = OFF_gates + al256((size_t)NROWS * 24 * 4);
DI unsigned* ws_counter(const Params& p) { return (unsigned*)(p.ws + OFF_counter); }
constexpr size_t WS_TOTAL = OFF_counter + al256((size_t)256);


DI void transpose_tile(const float* __restrict__ src, u16* __restrict__ dst, int K, int N, const float* __restrict__ scale, int kt, int nt, char* smem, int ldd) {
  float* tile = (float*)smem;
  const int tid = threadIdx.x;
#pragma unroll
  for (int i = 0; i < 8; ++i) {
    const int kk = i * 8 + (tid >> 6), nn = tid & 63, n = nt * 64 + nn, k = kt * 64 + kk;
    float v = (n < N) ? src[(size_t)k * N + n] : 0.f;
    if (scale) v *= scale[k];
    tile[kk * 65 + nn] = v;
  }
  __syncthreads();
#pragma unroll
  for (int i = 0; i < 8; ++i) {
    const int nn = i * 8 + (tid >> 6), kk = tid & 63;
    dst[(size_t)(nt * 64 + nn) * ldd + kt * 64 + kk] = f2bf(tile[kk * 65 + nn]);
  }
  __syncthreads();
}

__device__ void phase_prep(const Params& p, char* smem, int bid, int nb) {
  int tid_ = threadIdx.x; asm volatile("" : "+v"(tid_));
  const int tid = tid_, lane = tid & 63, wid = __builtin_amdgcn_readfirstlane(tid >> 6);
  constexpr int J_X = 1024, J_TW = 1024, J_TO = 256, J_T1 = 64, J_T2 = 2, J_CK = 16, J_ROPE = 64;
  constexpr int TOTAL = J_X + J_TW + J_TO + 2 * J_T1 + 2 * J_T2 + J_CK + J_ROPE;
  if (bid == 0 && tid < 8) ws_counter(p)[tid] = 0u;
  for (int j = bid; j < TOTAL; j += nb) {
    int jj = j;
    if (jj < J_X) {
      const int row0 = jj * 32 + wid * 4;
      float4 v[4][4]; float ss[4];
#pragma unroll
      for (int r = 0; r < 4; ++r) {
        const float4* xr = (const float4*)(p.x + (size_t)(row0 + r) * DM);
#pragma unroll
        for (int i = 0; i < 4; ++i) v[r][i] = xr[i * 64 + lane];
      }
#pragma unroll
      for (int r = 0; r < 4; ++r) {
        float a = 0.f;
#pragma unroll
        for (int i = 0; i < 4; ++i) a += v[r][i].x * v[r][i].x + v[r][i].y * v[r][i].y + v[r][i].z * v[r][i].z + v[r][i].w * v[r][i].w;
#pragma unroll
        for (int o = 32; o >= 1; o >>= 1) a += __shfl_xor(a, o);
        ss[r] = a;
      }
#pragma unroll
      for (int r = 0; r < 4; ++r) {
        if (lane == 0) ws_rs(p)[row0 + r] = rsqrtf(ss[r] * (1.0f / DM) + EPS);
#pragma unroll
        for (int i = 0; i < 4; ++i) {
          u32x2 o; o[0] = cvtpk(v[r][i].x, v[r][i].y); o[1] = cvtpk(v[r][i].z, v[r][i].w);
          const int rr_ = row0 + r;
          *(u32x2*)(ws_xb(p) + ((size_t)((rr_ >> 8) * 16 + i * 4 + (lane >> 4)) * 256 + (rr_ & 255)) * 64 + (lane & 15) * 4) = o;
        }
      }
      continue;
    }
    jj -= J_X;
    if (jj < J_TW) { transpose_tile(p.w_in, ws_winT(p), 1024, DIN, p.norm_w, jj & 15, jj >> 4, smem, LDK); continue; }
    jj -= J_TW;
    if (jj < J_TO) { transpose_tile(p.w_out, ws_woutT(p), 1024, 1024, nullptr, jj & 15, jj >> 4, smem, LDK); continue; }
    jj -= J_TO;
    if (jj < J_T1) { transpose_tile(p.ck_w1, ws_w1kT(p), 2048, 128, nullptr, jj & 31, jj >> 5, smem, 2048); continue; }
    jj -= J_T1;
    if (jj < J_T1) { transpose_tile(p.cv_w1, ws_w1vT(p), 2048, 128, nullptr, jj & 31, jj >> 5, smem, 2048); continue; }
    jj -= J_T1;
    if (jj < J_T2) { transpose_tile(p.ck_w2, ws_w2kT(p), 128, 64, nullptr, jj, 0, smem, 128); continue; }
    jj -= J_T2;
    if (jj < J_T2) { transpose_tile(p.cv_w2, ws_w2vT(p), 128, 64, nullptr, jj, 0, smem, 128); continue; }
    jj -= J_T2;
    if (jj < J_CK) {
      const int which = jj >> 3, chunk = jj & 7, hh = tid & 127, sub = tid >> 7;
      const float* pos = which ? p.cv_pos : p.ck_pos;
      const float* w1 = which ? p.cv_w1 : p.ck_w1;
      float acc = 0.f;
      const int f0 = chunk * 256 + sub * 64;
#pragma unroll 8
      for (int f = 0; f < 64; ++f) acc += pos[f0 + f] * w1[(size_t)(f0 + f) * 128 + hh];
      float* red = (float*)smem;
      red[sub * 128 + hh] = acc;
      __syncthreads();
      if (tid < 128) ws_ckpart(p)[(which * 8 + chunk) * 128 + tid] = red[tid] + red[128 + tid] + red[256 + tid] + red[384 + tid];
      __syncthreads();
      continue;
    }
    jj -= J_CK;
    {
      const int idx = jj * 512 + tid, pos = idx >> 3, fi = idx & 7;
      const float ang = (float)pos * c_invf[fi];
      float s, c; sincosf(ang, &s, &c);
      ws_rope(p)[idx * 2] = c; ws_rope(p)[idx * 2 + 1] = s;
    }
  }
}

DI int kimg_off(int row, int d) { return row * 64 + (((d >> 3) ^ ((row >> 1) & 7)) * 8) + (d & 7); }
DI int vimg_off(int d, int key) { return d * 64 + (((key >> 3) ^ ((d >> 1) & 7)) * 8) + ((((key >> 2) & 1) ^ ((d >> 4) & 1)) * 4) + (key & 3); }

constexpr int G_ASZ = 256 * 128, G_BSZ = 256 * 128, G_STAGE = G_ASZ + G_BSZ;
constexpr int G_ROPE = 2 * G_STAGE, G_RS = G_ROPE + 256 * 64;
static_assert(G_RS + 1024 <= SMEM_BYTES, "GEMM LDS layout exceeds the dynamic LDS size");
#define WAIT_VM(n) asm volatile("s_waitcnt vmcnt(" #n ")" ::: "memory")

template <int EPI>
__device__ void gemm_phase(const Params& p, char* smem, int bid, int nb) {
  constexpr int NT = EPI == 0 ? 16 : 4;
  constexpr int MT = 128;
  const u16* __restrict__ A = EPI == 0 ? ws_xb(p) : ws_mix(p);
  const u16* __restrict__ Bt = EPI == 0 ? ws_winT(p) : ws_woutT(p);
  int tid_ = threadIdx.x; asm volatile("" : "+v"(tid_));
  const int tid = tid_, lane = tid & 63, wid = __builtin_amdgcn_readfirstlane(tid >> 6), fr = lane & 15, fq = lane >> 4;
  const int wr = wid >> 2, wc = wid & 3;
  const bool xmap = (nb == 256);
  const int xcd = bid & 7, li = bid >> 3;
  const int ntiles = xmap ? (EPI == 0 ? 8 : 2) : (MT * NT - bid + nb - 1) / nb;
  auto tile_of = [&](int ti, int& m0, int& n0) {
    if (xmap) {
      const int sg = ti * 8 + xcd;
      if (EPI == 0) { m0 = ((sg >> 1) * 4 + (li >> 3)) * 256; n0 = ((sg & 1) * 8 + (li & 7)) * 256; }
      else { m0 = (sg * 8 + (li >> 2)) * 256; n0 = (li & 3) * 256; }
    } else { const int tile = bid + ti * nb; const int mt = tile / NT; m0 = mt * 256; n0 = (tile - mt * NT) * 256; }
  };
  const int nsteps = ntiles * 16;
  const unsigned lds0 = (unsigned)(uintptr_t)smem;
  const int gsw = (lane & 7) ^ ((wid & 1) * 4 + (lane >> 4));
  const int grow = wid * 8 + (lane >> 3);
  auto issue = [&](int step, int stage) {
    int m0, n0; tile_of(step >> 4, m0, n0);
    const int kt = step & 15;
    const u16* ag = EPI == 0 ? A + ((size_t)((m0 >> 8) * 16 + kt) * 256 + grow) * 64 + gsw * 8 : A + (size_t)(m0 + grow) * LDK + kt * 64 + gsw * 8;
    const size_t astep = EPI == 0 ? (size_t)64 * 64 : (size_t)64 * LDK;
    const int brow = EPI == 0 ? ((grow & ~31) | ((grow & 0x0C) << 1) | ((grow & 0x10) >> 2) | (grow & 3)) : grow;
    const u16* bg_ = Bt + (size_t)(n0 + brow) * LDK + kt * 64 + gsw * 8;
    const unsigned dst = (unsigned)__builtin_amdgcn_readfirstlane((int)(lds0 + stage * G_STAGE + wid * 1024));
#pragma unroll
    for (int i = 0; i < 4; ++i) glds16(ag + i * astep, dst + i * 8192);
#pragma unroll
    for (int i = 0; i < 4; ++i) glds16(bg_ + (size_t)i * 64 * LDK, dst + G_ASZ + i * 8192);
    if (EPI == 0 && kt == 8) {
      const int t0 = m0 & 4095;
      const unsigned sd = (unsigned)__builtin_amdgcn_readfirstlane((int)(lds0 + G_ROPE + wid * 1024));
      glds16(ws_rope(p) + (size_t)t0 * 16 + tid * 4, sd);
      glds16(ws_rope(p) + (size_t)t0 * 16 + (512 + tid) * 4, sd + 8192);
      if (wid == 0) glds16(ws_rs(p) + m0 + lane * 4, lds0 + G_RS);
    }
  };
  const int ca0 = ((fq ^ (fr >> 1)) * 16), ca1 = (((4 + fq) ^ (fr >> 1)) * 16);
  f32x4 acc[8][4];
#pragma unroll
  for (int m = 0; m < 8; ++m)
#pragma unroll
    for (int n = 0; n < 4; ++n) acc[m][n] = f32x4{0.f, 0.f, 0.f, 0.f};
  __syncthreads();
  if (nsteps > 0) issue(0, 0);
  for (int s = 0; s < nsteps; ++s) {
    WAIT_VM(0);
    __builtin_amdgcn_s_waitcnt(0x0F70);
    __builtin_amdgcn_s_barrier();
    if (s + 1 < nsteps) issue(s + 1, (s + 1) & 1);
    {
      const char* ab = smem + (s & 1) * G_STAGE + (wr * 128 + fr) * 128;
      const char* bb = smem + (s & 1) * G_STAGE + G_ASZ + (wc * 64 + fr) * 128;
#pragma unroll
      for (int ks = 0; ks < 2; ++ks) {
        bf16x8 af[8], bf[4];
        const int co = ks ? ca1 : ca0;
#pragma unroll
        for (int n = 0; n < 4; ++n) bf[n] = *(const bf16x8*)(bb + n * 16 * 128 + co);
#pragma unroll
        for (int m = 0; m < 8; ++m) af[m] = *(const bf16x8*)(ab + m * 16 * 128 + co);
#pragma unroll
        for (int m = 0; m < 8; ++m)
#pragma unroll
          for (int n = 0; n < 4; ++n) acc[m][n] = MFMA16(bf[n], af[m], acc[m][n]);
      }
    }
    if ((s & 15) != 15) continue;
    int m0, n0; tile_of(s >> 4, m0, n0);
    const int rbase = m0 + wr * 128;
    const int cb = n0 + wc * 64;
    if constexpr (EPI == 1) {
#pragma unroll
      for (int hm = 0; hm < 2; ++hm) {
        float4 xv[4][4];
#pragma unroll
        for (int mm = 0; mm < 4; ++mm) {
          const size_t ro = (size_t)(rbase + (hm * 4 + mm) * 16 + fr) * DM + cb + fq * 4;
#pragma unroll
          for (int n = 0; n < 4; ++n) xv[mm][n] = *(const float4*)(p.x + ro + n * 16);
        }
#pragma unroll
        for (int mm = 0; mm < 4; ++mm) {
          const int m = hm * 4 + mm;
          const size_t ro = (size_t)(rbase + m * 16 + fr) * DM + cb + fq * 4;
#pragma unroll
          for (int n = 0; n < 4; ++n) {
            float4 o; o.x = xv[mm][n].x + acc[m][n][0]; o.y = xv[mm][n].y + acc[m][n][1]; o.z = xv[mm][n].z + acc[m][n][2]; o.w = xv[mm][n].w + acc[m][n][3];
            *(float4*)(p.out + ro + n * 16) = o;
          }
        }
        __builtin_amdgcn_sched_barrier(0);
      }
    } else {
      const int b = m0 >> 12;
      const int tb = rbase & 4095;
      if (cb < 1280) {
        const int seg = cb >> 6;
        const int which = seg < 8 ? -1 : ((seg - 8) >> 1);
        const int g = seg < 8 ? (seg >> 2) : ((seg - 8) & 1);
        const bool need_norm = (seg < 8) || which == 2 || which == 4;
        const float* nw = seg < 8 ? p.q_norm_w : (p.k_norm_w + (which == 2 ? 64 : 128));
        float w[16];
#pragma unroll
        for (int k = 0; k < 16; ++k) w[k] = need_norm ? nw[(k >> 3) * 32 + fq * 8 + (k & 7)] : 1.0f;
        const float qs = seg < 8 ? QSCALE : 1.0f;
#pragma unroll
        for (int m = 0; m < 8; ++m) {
          const int t = tb + m * 16 + fr;
          const int lrow = wr * 128 + m * 16 + fr;
          const float r = *(const float*)(smem + G_RS + lrow * 4);
          float v[16];
#pragma unroll
          for (int k = 0; k < 16; ++k) v[k] = acc[m][(k >> 3) * 2 + ((k & 7) >> 2)][k & 3] * r;
          if (need_norm) {
            float ss = 0.f;
#pragma unroll
            for (int k = 0; k < 16; ++k) ss += v[k] * v[k];
            ss += __shfl_xor(ss, 16); ss += __shfl_xor(ss, 32);
            const float rr = rsqrtf(ss * (1.0f / 64.f) + EPS);
#pragma unroll
            for (int k = 0; k < 16; ++k) v[k] = v[k] * rr * w[k];
            const float4* rp = (const float4*)(smem + G_ROPE + lrow * 64);
            const float4 c01 = rp[0], c23 = rp[1], c45 = rp[2], c67 = rp[3];
            const float cc[8] = {c01.x, c01.z, c23.x, c23.z, c45.x, c45.z, c67.x, c67.z};
            const float sn[8] = {c01.y, c01.w, c23.y, c23.w, c45.y, c45.w, c67.y, c67.w};
#pragma unroll
            for (int e = 0; e < 8; ++e) {
              const float pr = __shfl_xor(v[e], 16);
              const float rot = (fq == 0) ? (v[e] * cc[e] - pr * sn[e]) : (v[e] * cc[e] + pr * sn[e]);
              v[e] = (fq < 2) ? rot : v[e];
            }
#pragma unroll
            for (int k = 0; k < 16; ++k) v[k] *= qs;
          }
          if (which == 3 || which == 5) {
            int lz = 0; asm volatile("" : "+v"(lz));
            u16* vt = (which == 3 ? ws_Vst(p) : ws_Vwt(p)) + (size_t)((b * 2 + g) * 64 + (t >> 6)) * 4096 + lz;
            const int fqx = fq + lz, key = (t & 63) + lz;
#pragma unroll
            for (int k = 0; k < 16; ++k) vt[vimg_off((k >> 3) * 32 + fqx * 8 + (k & 7), key)] = f2bf(v[k]);
          } else {
            u16* dst;
            if (seg < 8) dst = ws_Q(p) + ((size_t)((b * 2 + g) * 4096 + t) * 4 + (seg & 3)) * 64;
            else { u16* buf = which == 0 ? ws_kcraw(p) : which == 1 ? ws_vcraw(p) : which == 2 ? ws_Ks(p) : ws_Kw(p); dst = buf + ((size_t)(b * 2 + g) * 4096 + t) * 64; }
            const bool img = which >= 2;
#pragma unroll
            for (int n2 = 0; n2 < 2; ++n2) {
              u32x4 o;
#pragma unroll
              for (int e = 0; e < 4; ++e) o[e] = cvtpk(v[n2 * 8 + 2 * e], v[n2 * 8 + 2 * e + 1]);
              const int d0 = n2 * 32 + fq * 8;
              const int off = img ? (((d0 >> 3) ^ (((t & 63) >> 1) & 7)) * 8) : d0;
              *(u32x4*)(dst + off) = o;
            }
          }
          __builtin_amdgcn_sched_barrier(0);
        }
      } else {
#pragma unroll
        for (int m = 0; m < 8; ++m) {
          const size_t row = rbase + m * 16 + fr;
          const float r = *(const float*)(smem + G_RS + (wr * 128 + m * 16 + fr) * 4);
#pragma unroll
          for (int n2 = 0; n2 < 2; ++n2) {
            const int c8 = cb + n2 * 32 + fq * 8;
            if (c8 >= DIN) continue;
            float v[8];
#pragma unroll
            for (int e = 0; e < 8; ++e) v[e] = acc[m][n2 * 2 + (e >> 2)][e & 3] * r;
            if (c8 < 1304) {
              float4 o0, o1;
              o0.x = sigmoidf_(v[0]); o0.y = sigmoidf_(v[1]); o0.z = sigmoidf_(v[2]); o0.w = sigmoidf_(v[3]);
              o1.x = sigmoidf_(v[4]); o1.y = sigmoidf_(v[5]); o1.z = sigmoidf_(v[6]); o1.w = sigmoidf_(v[7]);
              float* gp = ws_gates(p) + row * 24 + (c8 - 1280);
              *(float4*)gp = o0; *(float4*)(gp + 4) = o1;
            } else if (c8 < 1816) {
              u32x4 o;
#pragma unroll
              for (int e = 0; e < 4; ++e) o[e] = cvtpk(siluf_(v[2 * e]), siluf_(v[2 * e + 1]));
              *(u32x4*)(ws_zs(p) + row * 512 + (c8 - 1304)) = o;
            } else {
              u32x4 o;
#pragma unroll
              for (int e = 0; e < 4; ++e) o[e] = cvtpk(v[2 * e], v[2 * e + 1]);
              *(u32x4*)(ws_cvb(p) + row * 2048 + (c8 - 1816)) = o;
            }
          }
          __builtin_amdgcn_sched_barrier(0);
        }
      }
    }
#pragma unroll
    for (int m = 0; m < 8; ++m)
#pragma unroll
      for (int n = 0; n < 4; ++n) acc[m][n] = f32x4{0.f, 0.f, 0.f, 0.f};
  }
}

__device__ void phase_cmp_conv(const Params& p, char* smem, int bid, int nb) {
  int tid_ = threadIdx.x; asm volatile("" : "+v"(tid_));
  const int tid = tid_, lane = tid & 63, wid = __builtin_amdgcn_readfirstlane(tid >> 6), fr = lane & 15, fq = lane >> 4;
  float* part = (float*)smem;
  char* hl = smem + 8 * 16 * 132 * 4;
  float* outl = (float*)(hl + 16 * 272);
  for (int job = bid; job < 512; job += nb) {
    const int which = job >> 8, rest = job & 255, bg = rest >> 4, ct = rest & 15;
    const u16* raw = (which ? ws_vcraw(p) : ws_kcraw(p)) + (size_t)bg * 4096 * 64;
    const u16* w1T = which ? ws_w1vT(p) : ws_w1kT(p);
    const u16* w2T = which ? ws_w2vT(p) : ws_w2kT(p);
    const float* b1 = which ? p.cv_b1 : p.ck_b1;
    f32x4 acc[8];
#pragma unroll
    for (int n = 0; n < 8; ++n) acc[n] = f32x4{0.f, 0.f, 0.f, 0.f};
    const int c = ct * 16 + fr;
#pragma unroll
    for (int k8 = 0; k8 < 8; ++k8) {
      const int ks = wid * 8 + k8;
      const int l = ks >> 1, d0 = (ks & 1) * 32 + fq * 8;
      int tt = c * 16 + l; tt = tt > 4095 ? 4095 : tt;
      const bf16x8 a = *(const bf16x8*)(raw + (size_t)tt * 64 + d0);
#pragma unroll
      for (int n = 0; n < 8; ++n) {
        const bf16x8 bb = *(const bf16x8*)(w1T + (size_t)(n * 16 + fr) * 2048 + ks * 32 + fq * 8);
        acc[n] = MFMA16(a, bb, acc[n]);
      }
    }
#pragma unroll
    for (int n = 0; n < 8; ++n)
#pragma unroll
      for (int j = 0; j < 4; ++j) part[(wid * 16 + fq * 4 + j) * 132 + n * 16 + fr] = acc[n][j];
    __syncthreads();
    {
      const int row = tid >> 5, c4 = (tid & 31) * 4;
      float4 sum = *(const float4*)(part + row * 132 + c4);
#pragma unroll
      for (int w = 1; w < 8; ++w) { const float4 v = *(const float4*)(part + (w * 16 + row) * 132 + c4); sum.x += v.x; sum.y += v.y; sum.z += v.z; sum.w += v.w; }
      float bias[4];
#pragma unroll
      for (int e = 0; e < 4; ++e) {
        float bsum = b1[c4 + e];
#pragma unroll
        for (int ch = 0; ch < 8; ++ch) bsum += ws_ckpart(p)[(which * 8 + ch) * 128 + c4 + e];
        bias[e] = bsum;
      }
      u32x2 o; o[0] = cvtpk(siluf_(sum.x + bias[0]), siluf_(sum.y + bias[1])); o[1] = cvtpk(siluf_(sum.z + bias[2]), siluf_(sum.w + bias[3]));
      *(u32x2*)(hl + row * 272 + c4 * 2) = o;
    }
    __syncthreads();
    if (wid < 4) {
      f32x4 o2 = f32x4{0.f, 0.f, 0.f, 0.f};
#pragma unroll
      for (int ks = 0; ks < 4; ++ks) {
        const bf16x8 a = *(const bf16x8*)(hl + fr * 272 + (ks * 32 + fq * 8) * 2);
        const bf16x8 bb = *(const bf16x8*)(w2T + (size_t)(wid * 16 + fr) * 128 + ks * 32 + fq * 8);
        o2 = MFMA16(a, bb, o2);
      }
#pragma unroll
      for (int j = 0; j < 4; ++j) outl[(fq * 4 + j) * 68 + wid * 16 + fr] = o2[j];
    }
    __syncthreads();
    if (tid < 256) {
      const int row = tid >> 4, d4 = (tid & 15) * 4;
      const int cc = ct * 16 + row;
      const float4 v = *(const float4*)(outl + row * 68 + d4);
      if (which == 0) {
        float ss = v.x * v.x + v.y * v.y + v.z * v.z + v.w * v.w;
        ss += __shfl_xor(ss, 1); ss += __shfl_xor(ss, 2); ss += __shfl_xor(ss, 4); ss += __shfl_xor(ss, 8);
        const float rr = rsqrtf(ss * (1.0f / 64.f) + EPS);
        float o[4] = {v.x * rr * p.k_norm_w[d4], v.y * rr * p.k_norm_w[d4 + 1], v.z * rr * p.k_norm_w[d4 + 2], v.w * rr * p.k_norm_w[d4 + 3]};
        if (d4 < 16) {
          int pos = cc * 16 + 31; pos = pos > 4095 ? 4095 : pos;
#pragma unroll
          for (int e = 0; e < 4; ++e) {
            const int d = d4 + e, dp = d ^ 8;
            const float pr = outl[row * 68 + dp] * rr * p.k_norm_w[dp];
            const float2 cs = *(const float2*)(ws_rope(p) + ((size_t)pos * 8 + (d & 7)) * 2);
            o[e] = (d < 8) ? (o[e] * cs.x - pr * cs.y) : (o[e] * cs.x + pr * cs.y);
          }
        }
        u32x2 ov; ov[0] = cvtpk(o[0], o[1]); ov[1] = cvtpk(o[2], o[3]);
        if (cc >= 255) { ov[0] = 0u; ov[1] = 0u; }
        *(u32x2*)(ws_Kc(p) + (size_t)(bg * 4 + (cc >> 6)) * 4096 + kimg_off(cc & 63, d4)) = ov;
      } else {
        const float z = (cc >= 255) ? 0.f : 1.f;
        u16* vt = ws_Vct(p) + (size_t)(bg * 4 + (cc >> 6)) * 4096;
        vt[vimg_off(d4 + 0, cc & 63)] = f2bf(v.x * z); vt[vimg_off(d4 + 1, cc & 63)] = f2bf(v.y * z);
        vt[vimg_off(d4 + 2, cc & 63)] = f2bf(v.z * z); vt[vimg_off(d4 + 3, cc & 63)] = f2bf(v.w * z);
      }
    }
    __syncthreads();
  }
  const int gw = bid * 8 + wid, nw = nb * 8;
  for (int chunk = gw; chunk < 2048; chunk += nw) {
    const int r0 = chunk * 16, t0 = r0 & 4095;
    const int ch = lane * 8;
    float cw0[8], cw1[8], cw2[8], cbv[8], u1[8], u2[8];
#pragma unroll
    for (int e = 0; e < 8; ++e) { cw0[e] = p.conv_w[ch + e]; cw1[e] = p.conv_w[512 + ch + e]; cw2[e] = p.conv_w[1024 + ch + e]; cbv[e] = p.conv_b[ch + e]; u1[e] = 0.f; u2[e] = 0.f; }
    if (t0 > 0) {
#pragma unroll
      for (int q = 0; q < 2; ++q) {
        const u16* rp = ws_cvb(p) + (size_t)(r0 - 2 + q) * 2048 + ch;
        const u32x4 hv = *(const u32x4*)(rp), cv = *(const u32x4*)(rp + 1024);
#pragma unroll
        for (int e = 0; e < 4; ++e) {
          const float ua = bflo(hv[e]) * bflo(cv[e]), ub = bfhi(hv[e]) * bfhi(cv[e]);
          if (q == 0) { u2[2 * e] = ua; u2[2 * e + 1] = ub; } else { u1[2 * e] = ua; u1[2 * e + 1] = ub; }
        }
      }
    }
#pragma unroll 4
    for (int rr = 0; rr < 16; ++rr) {
      const u16* rp = ws_cvb(p) + (size_t)(r0 + rr) * 2048 + ch;
      const u32x4 hv = *(const u32x4*)(rp), bv = *(const u32x4*)(rp + 512), cv = *(const u32x4*)(rp + 1024), zv = *(const u32x4*)(rp + 1536);
      u32x4 ov;
#pragma unroll
      for (int e = 0; e < 4; ++e) {
        const float ua = bflo(hv[e]) * bflo(cv[e]), ub = bfhi(hv[e]) * bfhi(cv[e]);
        const float ca = cw0[2 * e] * u2[2 * e] + cw1[2 * e] * u1[2 * e] + cw2[2 * e] * ua + cbv[2 * e];
        const float cbb = cw0[2 * e + 1] * u2[2 * e + 1] + cw1[2 * e + 1] * u1[2 * e + 1] + cw2[2 * e + 1] * ub + cbv[2 * e + 1];
        const float oa = bflo(bv[e]) * ca * siluf_(bflo(zv[e]));
        const float ob = bfhi(bv[e]) * cbb * siluf_(bfhi(zv[e]));
        ov[e] = cvtpk(oa, ob);
        u2[2 * e] = u1[2 * e]; u2[2 * e + 1] = u1[2 * e + 1]; u1[2 * e] = ua; u1[2 * e + 1] = ub;
      }
      *(u32x4*)(ws_mix(p) + (size_t)(r0 + rr) * LDK + 512 + ch) = ov;
    }
  }
}

constexpr int AT_NST = 5, AT_KB = 8192, AT_BUF = 16384;
constexpr int AT_F = AT_NST * AT_BUF, AT_IMPA = AT_F, AT_IMPB = AT_IMPA + 64 * 65 * 4, AT_VAL = AT_IMPA;
constexpr int AT_SELM = AT_F + 8 * 8192, AT_UNIT = AT_SELM + 512, AT_END = AT_UNIT + 16;
static_assert(AT_END <= SMEM_BYTES, "attention LDS layout exceeds the dynamic LDS size");

__device__ void phase_attn(const Params& p, char* smem, int bid, int nb, int rep) {
  int tid_ = threadIdx.x; asm volatile("" : "+v"(tid_));
  const int tid = tid_, lane = tid & 63, wid = __builtin_amdgcn_readfirstlane(tid >> 6), c32 = lane & 31, h = lane >> 5;
  const float NINF = -__builtin_inff();
  float* impa = (float*)(smem + AT_IMPA);
  float* impb = (float*)(smem + AT_IMPB);
  float* vals = (float*)(smem + AT_VAL);
  unsigned* selm = (unsigned*)(smem + AT_SELM);
  volatile int* s_unit = (volatile int*)(smem + AT_UNIT);
  const unsigned lds0 = (unsigned)(uintptr_t)smem;
  while (true) {
    if (tid == 0) *s_unit = (int)atomicAdd(ws_counter(p) + rep, 1u);
    __syncthreads();
    const int u = __builtin_amdgcn_readfirstlane(*s_unit);
    __syncthreads();
    if (u >= 1024) break;
    const int i = 63 - (u >> 4), bg = u & 15, b = bg >> 1, g = bg & 1;
    const int tl = wid * 8 + (c32 >> 2), hd = c32 & 3;
    const int t = i * 64 + tl;
    const u16* qrow = ws_Q(p) + ((size_t)(bg * 4096 + i * 64) * 4 + wid * 32 + c32) * 64;
    bf16x8 qf[4];
#pragma unroll
    for (int ks = 0; ks < 4; ++ks) qf[ks] = *(const bf16x8*)(qrow + ks * 16 + h * 8);
    const float* gp = ws_gates(p) + (size_t)(b * 4096 + t) * 24 + (g * 4 + hd) * 3;
    const float g0 = gp[0], g1 = gp[1], g2 = gp[2];
    asm volatile("" :: "v"(qf[0]), "v"(qf[1]), "v"(qf[2]), "v"(qf[3]), "v"(g0), "v"(g1), "v"(g2));
    const int ntc = (4 * i + 2) / 64 + 1, nsl = i + 1, nwin = (i < 8 ? i : 8) + 1;
    const int NT = 2 * ntc + nsl + nwin;
    const bool need_sel = i >= 16;

    f32x16 O0, O1;
#pragma unroll
    for (int r = 0; r < 16; ++r) { O0[r] = 0.f; O1[r] = 0.f; }
    float* fl = (float*)(smem + AT_F + wid * 8192) + lane;
    float m_run = NINF, l_run = 0.f, inv_l = 0.f;
    bool kill_o = false;
    unsigned sel_lo = 0xffffffffu, sel_hi = 0xffffffffu;
#define TILE_PTRS(n, kp, vp) do { \
      if ((n) < 2 * ntc) { const int tt_ = (n) < ntc ? (n) : (n) - ntc; kp = ws_Kc(p) + (size_t)(bg * 4 + tt_) * 4096; vp = ws_Vct(p) + (size_t)(bg * 4 + tt_) * 4096; } \
      else if ((n) < 2 * ntc + nsl) { const int j_ = (n) - 2 * ntc; kp = ws_Ks(p) + ((size_t)bg * 4096 + j_ * 64) * 64; vp = ws_Vst(p) + (size_t)(bg * 64 + j_) * 4096; } \
      else { const int j_ = i - nwin + 1 + ((n) - 2 * ntc - nsl); kp = ws_Kw(p) + ((size_t)bg * 4096 + j_ * 64) * 64; vp = ws_Vwt(p) + (size_t)(bg * 64 + j_) * 4096; } } while (0)
#define TISSUE(n, st_) do { const u16 *kp_, *vp_; TILE_PTRS(n, kp_, vp_); \
      const unsigned d_ = (unsigned)__builtin_amdgcn_readfirstlane((int)(lds0 + (st_) * AT_BUF + wid * 1024)); \
      glds16(kp_ + tid * 8, d_); glds16(vp_ + tid * 8, d_ + AT_KB); } while (0)
    {
      const int npre = NT < AT_NST - 1 ? NT : AT_NST - 1;
      for (int n = 0; n < npre; ++n) TISSUE(n, n);
    }
    int st_cur = 0, st_iss = AT_NST - 1;
    const int ksw = (c32 >> 1) & 7, vhs = (c32 >> 4) & 1;
    for (int n = 0; n < NT; ++n) {
      {
        const int rem = NT - 1 - n;
        if (rem >= 3) WAIT_VM(6); else if (rem == 2) WAIT_VM(4); else if (rem == 1) WAIT_VM(2); else WAIT_VM(0);
        __builtin_amdgcn_s_barrier();
        if (n + AT_NST - 1 < NT) TISSUE(n + AT_NST - 1, st_iss);
      }
      int mode, base, lo, hi;
      bool full = false, lane_on = true;
      if (n < 2 * ntc) { mode = n < ntc ? 0 : 1; base = (n < ntc ? n : n - ntc) * 64; lo = -1; hi = (t - 31) >> 4; }
      else if (n < 2 * ntc + nsl) { const int j = n - 2 * ntc; mode = 2; base = j * 64; const unsigned bit = j < 32 ? (sel_lo >> j) & 1u : (sel_hi >> (j - 32)) & 1u; lo = -1; hi = bit ? t : -1; full = j < i; lane_on = bit != 0u; }
      else { const int j = i - nwin + 1 + (n - 2 * ntc - nsl); mode = 3; base = j * 64; lo = t - 512; hi = t; full = (j < i) && (j > i - 8); }
      const int lo_rel = lo - (base + 4 * h), hi_rel = hi - (base + 4 * h);
      const char* kb = smem + st_cur * AT_BUF;
      const char* vb = kb + AT_KB;
      st_cur = st_cur == AT_NST - 1 ? 0 : st_cur + 1; st_iss = st_iss == AT_NST - 1 ? 0 : st_iss + 1;
      f32x16 S0, S1;
#pragma unroll
      for (int r = 0; r < 16; ++r) { S0[r] = 0.f; S1[r] = 0.f; }
#pragma unroll
      for (int ks = 0; ks < 4; ++ks) {
        const bf16x8 k0 = *(const bf16x8*)(kb + c32 * 128 + (((ks * 2 + h) ^ ksw) * 16));
        const bf16x8 k1 = *(const bf16x8*)(kb + (32 + c32) * 128 + (((ks * 2 + h) ^ ksw) * 16));
        S0 = MFMA32(k0, qf[ks], S0);
        S1 = MFMA32(k1, qf[ks], S1);
      }
      __builtin_amdgcn_sched_group_barrier(0x100, 8, 0);
      __builtin_amdgcn_sched_group_barrier(0x008, 8, 0);
#define ATT_BODY(MASKED) do { \
      if (MASKED) { \
        _Pragma("unroll") for (int r = 0; r < 16; ++r) { \
          const int off = (r & 3) + 8 * (r >> 2); \
          S0[r] = (off > lo_rel && off <= hi_rel) ? S0[r] : NINF; \
          S1[r] = (off + 32 > lo_rel && off + 32 <= hi_rel) ? S1[r] : NINF; \
        } \
      } \
      float alpha = 1.0f; \
      if (mode != 1) { \
        float mx = fmaxf(fmaxf(S0[0], S0[1]), S1[0]); \
        mx = fmaxf(fmaxf(mx, S1[1]), S0[2]); \
        _Pragma("unroll") for (int r = 2; r < 16; r += 2) { \
          if (r > 2) mx = fmaxf(fmaxf(mx, S0[r]), S1[r - 1]); \
          mx = fmaxf(fmaxf(mx, S0[r + 1]), S1[r]); \
        } \
        mx = fmaxf(mx, S1[15]); \
        if (!(MASKED) && !lane_on) mx = NINF; \
        mx = fmaxf(mx, __shfl_xor(mx, 32)); \
        const bool mv = (mx - m_run) > 8.0f;     \
        alpha = mv ? __builtin_amdgcn_exp2f(m_run - mx) : 1.0f; \
        m_run = mv ? mx : m_run; \
        l_run *= alpha; \
      } \
      if (kill_o) alpha = 0.f;                   \
      kill_o = false; \
      _Pragma("unroll") for (int r = 0; r < 16; ++r) { O0[r] *= alpha; O1[r] *= alpha; } \
      { \
        const float m_use = (m_run == NINF) ? 0.f : m_run; \
        const float msub = (!(MASKED) && !lane_on) ? __builtin_inff() : m_use; \
        float ps0 = 0.f, ps1 = 0.f; \
        _Pragma("unroll") for (int r = 0; r < 16; ++r) { S0[r] = __builtin_amdgcn_exp2f(S0[r] - msub); S1[r] = __builtin_amdgcn_exp2f(S1[r] - msub); ps0 += S0[r]; ps1 += S1[r]; } \
        if (mode != 1) l_run += ps0 + ps1; \
      } \
      _Pragma("unroll") for (int kk = 0; kk < 4; ++kk) {         \
        const int kr = kk >> 1, sp = kk & 1; \
        u32x4 pw; \
        _Pragma("unroll") for (int e = 0; e < 4; ++e) { \
          const float a0 = kr ? S1[8 * sp + 2 * e] : S0[8 * sp + 2 * e]; \
          const float a1 = kr ? S1[8 * sp + 2 * e + 1] : S0[8 * sp + 2 * e + 1]; \
          pw[e] = cvtpk(a0, a1); \
        } \
        const bf16x8 pf = __builtin_bit_cast(bf16x8, pw); \
        _Pragma("unroll") for (int dr = 0; dr < 2; ++dr) { \
          const char* va = vb + (32 * dr + c32) * 128 + ((h ^ vhs) * 8); \
          const s16x4 vlo = *(const s16x4*)(va + (((4 * kr + 2 * sp) ^ ksw) * 16)), vhi = *(const s16x4*)(va + (((4 * kr + 2 * sp + 1) ^ ksw) * 16)); \
          const bf16x8 vf = __builtin_shufflevector(vlo, vhi, 0, 1, 2, 3, 4, 5, 6, 7); \
          if (dr == 0) O0 = MFMA32(vf, pf, O0); else O1 = MFMA32(vf, pf, O1); \
        } \
      } \
      if ((MASKED) && mode == 1 && need_sel) {               \
        const int tt = base >> 6; \
        _Pragma("unroll") for (int kr = 0; kr < 2; ++kr) \
          _Pragma("unroll") for (int rg = 0; rg < 4; ++rg) { \
            float pv[4]; \
            _Pragma("unroll") for (int e = 0; e < 4; ++e) { \
              float v = (kr ? S1[rg * 4 + e] : S0[rg * 4 + e]) * inv_l; \
              v += __shfl_xor(v, 1); v += __shfl_xor(v, 2); \
              pv[e] = v; \
            } \
            if (hd == 0) { \
              const int nblk = tt * 16 + 8 * kr + 2 * rg + h; \
              impa[tl * 65 + nblk] = pv[0] + pv[1] + pv[2] + 0.5f * pv[3]; \
              impb[tl * 65 + nblk] = 0.5f * pv[3]; \
            } \
          } \
      } } while (0)
      if (full) ATT_BODY(false); else ATT_BODY(true);
#undef ATT_BODY
      if (n == ntc - 1) {
        const float lt = l_run + __shfl_xor(l_run, 32);
        inv_l = lt > 0.f ? 1.0f / lt : 0.f;
        kill_o = true;
      } else if (n == 2 * ntc - 1) {
        if (need_sel) {
          __syncthreads();
          const int tk = tid >> 3, nb0 = (tid & 7) * 8;
          float myv[8];
#pragma unroll
          for (int e = 0; e < 8; ++e) {
            const int nn = nb0 + e;
            const bool forced = (nn == 0) || (nn == i) || (nn == i - 1);
            float v = -1.0f;
            if (nn <= i) v = impa[tk * 65 + nn] + (nn > 0 ? impb[tk * 65 + nn - 1] : 0.f);
            if (forced) v = 1e9f;
            myv[e] = v;
            vals[tk * 65 + nn] = v;
          }
          __syncthreads();
          int cnt[8];
#pragma unroll
          for (int e = 0; e < 8; ++e) cnt[e] = 0;
          for (int mm = 0; mm < 64; ++mm) {
            const float vm = vals[tk * 65 + mm];
#pragma unroll
            for (int e = 0; e < 8; ++e) cnt[e] += (vm > myv[e] || (vm == myv[e] && mm < nb0 + e)) ? 1 : 0;
          }
          unsigned bits = 0;
#pragma unroll
          for (int e = 0; e < 8; ++e) bits |= (cnt[e] < 16 ? 1u : 0u) << e;
          unsigned wlo = (tid & 7) < 4 ? bits << (8 * (tid & 7)) : 0u;
          unsigned whi = (tid & 7) >= 4 ? bits << (8 * ((tid & 7) - 4)) : 0u;
          wlo |= __shfl_xor(wlo, 1); wlo |= __shfl_xor(wlo, 2); wlo |= __shfl_xor(wlo, 4);
          whi |= __shfl_xor(whi, 1); whi |= __shfl_xor(whi, 2); whi |= __shfl_xor(whi, 4);
          if ((tid & 7) == 0) { selm[tk * 2] = wlo; selm[tk * 2 + 1] = whi; }
          __syncthreads();
          sel_lo = selm[tl * 2]; sel_hi = selm[tl * 2 + 1];
        }
        {
          const float wgt = g0 * inv_l;
#pragma unroll
          for (int r = 0; r < 16; ++r) { fl[r * 64] = wgt * O0[r]; fl[(16 + r) * 64] = wgt * O1[r]; }
          m_run = NINF; l_run = 0.f; kill_o = true;
        }
      } else if (n == 2 * ntc + nsl - 1) {
        const float lt = l_run + __shfl_xor(l_run, 32);
        const float wgt = g1 * (lt > 0.f ? 1.0f / lt : 0.f);
#pragma unroll
        for (int r = 0; r < 16; ++r) { fl[r * 64] += wgt * O0[r]; fl[(16 + r) * 64] += wgt * O1[r]; }
        m_run = NINF; l_run = 0.f; kill_o = true;
      }
    }
#undef TILE_PTRS
#undef TISSUE
    {
      const float lt = l_run + __shfl_xor(l_run, 32);
      const float wgt = g2 * (lt > 0.f ? 1.0f / lt : 0.f);
      const size_t rowo = (size_t)(b * 4096 + t);
      const u16* zp = ws_zs(p) + rowo * 512 + (g * 4 + hd) * 64;
      u16* mp = ws_mix(p) + rowo * LDK + (g * 4 + hd) * 64;
#pragma unroll
      for (int dr = 0; dr < 2; ++dr)
#pragma unroll
        for (int rg = 0; rg < 4; ++rg) {
          const int d = 32 * dr + 8 * rg + 4 * h;
          const u32x2 zv = *(const u32x2*)(zp + d);
          const float f0 = fl[(dr * 16 + rg * 4 + 0) * 64] + wgt * (dr ? O1[rg * 4 + 0] : O0[rg * 4 + 0]);
          const float f1 = fl[(dr * 16 + rg * 4 + 1) * 64] + wgt * (dr ? O1[rg * 4 + 1] : O0[rg * 4 + 1]);
          const float f2 = fl[(dr * 16 + rg * 4 + 2) * 64] + wgt * (dr ? O1[rg * 4 + 2] : O0[rg * 4 + 2]);
          const float f3 = fl[(dr * 16 + rg * 4 + 3) * 64] + wgt * (dr ? O1[rg * 4 + 3] : O0[rg * 4 + 3]);
          u32x2 o;
          o[0] = cvtpk(f0 * bflo(zv[0]), f1 * bfhi(zv[0]));
          o[1] = cvtpk(f2 * bflo(zv[1]), f3 * bfhi(zv[1]));
          *(u32x2*)(mp + d) = o;
        }
    }
  }
}

#if FUSED
extern "C" __global__ void __launch_bounds__(NTHREADS) hybrid_fwd(Params p) {
  extern __shared__ __attribute__((aligned(16))) char smem[];
  cg::grid_group grid = cg::this_grid();
  const int bid = blockIdx.x, nb = gridDim.x;
  for (int r = 0; r < REP0; ++r) { phase_prep(p, smem, bid, nb); grid.sync(); }
  for (int r = 0; r < REP1; ++r) { gemm_phase<0>(p, smem, bid, nb); grid.sync(); }
  for (int r = 0; r < REP2; ++r) { phase_cmp_conv(p, smem, bid, nb); grid.sync(); }
  for (int r = 0; r < REP3; ++r) { phase_attn(p, smem, bid, nb, r); grid.sync(); }
  for (int r = 0; r < REP4; ++r) { gemm_phase<1>(p, smem, bid, nb); }
}
#else
template <int PH>
__global__ void __launch_bounds__(NTHREADS) phase_kernel(Params p) {
  extern __shared__ __attribute__((aligned(16))) char smem[];
  const int bid = blockIdx.x, nb = gridDim.x;
  if constexpr (PH == 0) phase_prep(p, smem, bid, nb);
  if constexpr (PH == 1) gemm_phase<0>(p, smem, bid, nb);
  if constexpr (PH == 2) phase_cmp_conv(p, smem, bid, nb);
  if constexpr (PH == 3) phase_attn(p, smem, bid, nb, 0);
  if constexpr (PH == 4) gemm_phase<1>(p, smem, bid, nb);
}
#endif

extern "C" void kernel_launch(void* const* d_in, const int* in_sizes, int n_in, void* d_out, int out_size, void* d_ws, size_t ws_size, hipStream_t stream) {
  Params p{};
  p.x = (const float*)d_in[0]; p.norm_w = (const float*)d_in[1]; p.w_in = (const float*)d_in[2]; p.q_norm_w = (const float*)d_in[3];
  p.k_norm_w = (const float*)d_in[4]; p.ck_pos = (const float*)d_in[5]; p.ck_w1 = (const float*)d_in[6]; p.ck_b1 = (const float*)d_in[7];
  p.ck_w2 = (const float*)d_in[8]; p.cv_pos = (const float*)d_in[9]; p.cv_w1 = (const float*)d_in[10]; p.cv_b1 = (const float*)d_in[11];
  p.cv_w2 = (const float*)d_in[12]; p.conv_w = (const float*)d_in[13]; p.conv_b = (const float*)d_in[14]; p.w_out = (const float*)d_in[15];
  p.out = (float*)d_out;
  p.ws = (char*)d_ws;
  const size_t off = WS_TOTAL;
  if (off > ws_size) { fprintf(stderr, "kernel_launch: workspace too small (%zu > %zu)\n", off, ws_size); return; }

#if FUSED
  static int grid_blocks = 0;
  if (!grid_blocks) {
    int dev = 0, cus = 0, per_cu = 0;
    hipGetDevice(&dev);
    hipDeviceGetAttribute(&cus, hipDeviceAttributeMultiprocessorCount, dev);
    hipFuncSetAttribute((const void*)hybrid_fwd, hipFuncAttributeMaxDynamicSharedMemorySize, SMEM_BYTES);
    hipOccupancyMaxActiveBlocksPerMultiprocessor(&per_cu, (const void*)hybrid_fwd, NTHREADS, SMEM_BYTES);
    if (per_cu < 1) per_cu = 1;
    grid_blocks = cus * per_cu;
  }
  void* args[] = {&p};
  hipError_t e = hipLaunchCooperativeKernel((const void*)hybrid_fwd, dim3(grid_blocks), dim3(NTHREADS), args, SMEM_BYTES, stream);
  if (e != hipSuccess) fprintf(stderr, "cooperative launch failed: %s (grid %d)\n", hipGetErrorString(e), grid_blocks);
#else
  static int attr_set = 0;
  if (!attr_set) {
    (void)hipFuncSetAttribute((const void*)phase_kernel<0>, hipFuncAttributeMaxDynamicSharedMemorySize, SMEM_BYTES);
    (void)hipFuncSetAttribute((const void*)phase_kernel<1>, hipFuncAttributeMaxDynamicSharedMemorySize, SMEM_BYTES);
    (void)hipFuncSetAttribute((const void*)phase_kernel<2>, hipFuncAttributeMaxDynamicSharedMemorySize, SMEM_BYTES);
    (void)hipFuncSetAttribute((const void*)phase_kernel<3>, hipFuncAttributeMaxDynamicSharedMemorySize, SMEM_BYTES);
    (void)hipFuncSetAttribute((const void*)phase_kernel<4>, hipFuncAttributeMaxDynamicSharedMemorySize, SMEM_BYTES);
    attr_set = 1;
  }
  const int G = 256;
  phase_kernel<0><<<G, NTHREADS, SMEM_BYTES, stream>>>(p);
  phase_kernel<1><<<G, NTHREADS, SMEM_BYTES, stream>>>(p);
  phase_kernel<2><<<G, NTHREADS, SMEM_BYTES, stream>>>(p);
  phase_kernel<3><<<G, NTHREADS, SMEM_BYTES, stream>>>(p);
  phase_kernel<4><<<G, NTHREADS, SMEM_BYTES, stream>>>(p);
#endif
}
```

```cpp
#include <hip/hip_runtime.h>
#include <hip/hip_cooperative_groups.h>
#include <cstdio>
#include <cstdint>
namespace cg = cooperative_groups;

#ifndef FUSED
#define FUSED 1
#endif
#define REP0 1
#define REP1 1
#define REP2 1
#define REP3 1
#define REP4 1

#define DI __device__ __forceinline__
typedef unsigned short u16;
using bf16x8 = __attribute__((ext_vector_type(8))) short;
using s16x4 = __attribute__((ext_vector_type(4))) short;
using f32x4 = __attribute__((ext_vector_type(4))) float;
using f32x16 = __attribute__((ext_vector_type(16))) float;
using u32x4 = __attribute__((ext_vector_type(4))) unsigned;
using u32x2 = __attribute__((ext_vector_type(2))) unsigned;
typedef __bf16 bf2_t __attribute__((ext_vector_type(2)));
typedef float fl2_t __attribute__((ext_vector_type(2)));

constexpr int NTHREADS = 512;
constexpr int SEQ = 4096, DM = 1024, DIN = 3864, NROWS = 32768;
constexpr int LDK = 1088;
constexpr float EPS = 1e-6f;
constexpr float QSCALE = 0.125f * 1.4426950408889634f;
constexpr int SMEM_BYTES = 148480;

__constant__ float c_invf[8] = {1.0f, 0.1939227432012558f, 0.03760603070259094f, 0.007292664609849453f,
                                0.0014142135623842478f, 0.00027424818836152554f, 5.3182957344688475e-05f, 1.0313385246263351e-05f};

DI unsigned cvtpk(float lo, float hi) {
  fl2_t f = {lo, hi};
  bf2_t b = __builtin_convertvector(f, bf2_t);
  return __builtin_bit_cast(unsigned, b);
}
DI u16 f2bf(float x) { return (u16)(cvtpk(x, 0.f) & 0xffffu); }
DI float bf2f(u16 v) { return __uint_as_float(((unsigned)v) << 16); }
DI float bflo(unsigned v) { return __uint_as_float(v << 16); }
DI float bfhi(unsigned v) { return __uint_as_float(v & 0xffff0000u); }
DI float sigmoidf_(float v) { return __builtin_amdgcn_rcpf(1.0f + __builtin_amdgcn_exp2f(-1.4426950408889634f * v)); }
DI float siluf_(float v) { return v * __builtin_amdgcn_rcpf(1.0f + __builtin_amdgcn_exp2f(-1.4426950408889634f * v)); }
DI void glds16(const void* g, unsigned lds_base) {
  unsigned sv;
  asm volatile("s_mov_b32 %0, m0\n\ts_mov_b32 m0, %2\n\ts_nop 0\n\tglobal_load_lds_dwordx4 %1, off\n\ts_mov_b32 m0, %0" : "=&s"(sv) : "v"(g), "s"(lds_base) : "memory");
}
#define MFMA16(a, b, c) __builtin_amdgcn_mfma_f32_16x16x32_bf16((a), (b), (c), 0, 0, 0)
#define MFMA32(a, b, c) __builtin_amdgcn_mfma_f32_32x32x16_bf16((a), (b), (c), 0, 0, 0)

struct Params {
  const float *x, *norm_w, *w_in, *q_norm_w, *k_norm_w, *ck_pos, *ck_w1, *ck_b1, *ck_w2, *cv_pos, *cv_w1, *cv_b1, *cv_w2, *conv_w, *conv_b, *w_out;
  float* out;
  char* ws;
};
constexpr size_t al256(size_t v) { return (v + 255) & ~(size_t)255; }
constexpr size_t OFF_xb = 0;
DI u16* ws_xb(const Params& p) { return (u16*)(p.ws + OFF_xb); }
constexpr size_t OFF_winT = OFF_xb + al256((size_t)NROWS * LDK * 2);
DI u16* ws_winT(const Params& p) { return (u16*)(p.ws + OFF_winT); }
constexpr size_t OFF_woutT = OFF_winT + al256((size_t)4096 * LDK * 2);
DI u16* ws_woutT(const Params& p) { return (u16*)(p.ws + OFF_woutT); }
constexpr size_t OFF_w1kT = OFF_woutT + al256((size_t)1024 * LDK * 2);
DI u16* ws_w1kT(const Params& p) { return (u16*)(p.ws + OFF_w1kT); }
constexpr size_t OFF_w1vT = OFF_w1kT + al256((size_t)128 * 2048 * 2);
DI u16* ws_w1vT(const Params& p) { return (u16*)(p.ws + OFF_w1vT); }
constexpr size_t OFF_w2kT = OFF_w1vT + al256((size_t)128 * 2048 * 2);
DI u16* ws_w2kT(const Params& p) { return (u16*)(p.ws + OFF_w2kT); }
constexpr size_t OFF_w2vT = OFF_w2kT + al256((size_t)64 * 128 * 2);
DI u16* ws_w2vT(const Params& p) { return (u16*)(p.ws + OFF_w2vT); }
constexpr size_t OFF_Q = OFF_w2vT + al256((size_t)64 * 128 * 2);
DI u16* ws_Q(const Params& p) { return (u16*)(p.ws + OFF_Q); }
constexpr size_t OFF_Ks = OFF_Q + al256((size_t)NROWS * 512 * 2);
DI u16* ws_Ks(const Params& p) { return (u16*)(p.ws + OFF_Ks); }
constexpr size_t OFF_Kw = OFF_Ks + al256((size_t)16 * 4096 * 64 * 2);
DI u16* ws_Kw(const Params& p) { return (u16*)(p.ws + OFF_Kw); }
constexpr size_t OFF_Vst = OFF_Kw + al256((size_t)16 * 4096 * 64 * 2);
DI u16* ws_Vst(const Params& p) { return (u16*)(p.ws + OFF_Vst); }
constexpr size_t OFF_Vwt = OFF_Vst + al256((size_t)16 * 4096 * 64 * 2);
DI u16* ws_Vwt(const Params& p) { return (u16*)(p.ws + OFF_Vwt); }
constexpr size_t OFF_kcraw = OFF_Vwt + al256((size_t)16 * 4096 * 64 * 2);
DI u16* ws_kcraw(const Params& p) { return (u16*)(p.ws + OFF_kcraw); }
constexpr size_t OFF_vcraw = OFF_kcraw + al256((size_t)16 * 4096 * 64 * 2 + 4096);
DI u16* ws_vcraw(const Params& p) { return (u16*)(p.ws + OFF_vcraw); }
constexpr size_t OFF_Kc = OFF_vcraw + al256((size_t)16 * 4096 * 64 * 2 + 4096);
DI u16* ws_Kc(const Params& p) { return (u16*)(p.ws + OFF_Kc); }
constexpr size_t OFF_Vct = OFF_Kc + al256((size_t)16 * 256 * 64 * 2);
DI u16* ws_Vct(const Params& p) { return (u16*)(p.ws + OFF_Vct); }
constexpr size_t OFF_zs = OFF_Vct + al256((size_t)16 * 256 * 64 * 2);
DI u16* ws_zs(const Params& p) { return (u16*)(p.ws + OFF_zs); }
constexpr size_t OFF_cvb = OFF_zs + al256((size_t)NROWS * 512 * 2);
DI u16* ws_cvb(const Params& p) { return (u16*)(p.ws + OFF_cvb); }
constexpr size_t OFF_mix = OFF_cvb + al256((size_t)NROWS * 2048 * 2);
DI u16* ws_mix(const Params& p) { return (u16*)(p.ws + OFF_mix); }
constexpr size_t OFF_rs = OFF_mix + al256((size_t)NROWS * LDK * 2);
DI float* ws_rs(const Params& p) { return (float*)(p.ws + OFF_rs); }
constexpr size_t OFF_ckpart = OFF_rs + al256((size_t)NROWS * 4);
DI float* ws_ckpart(const Params& p) { return (float*)(p.ws + OFF_ckpart); }
constexpr size_t OFF_rope = OFF_ckpart + al256((size_t)16 * 128 * 4);
DI float* ws_rope(const Params& p) { return (float*)(p.ws + OFF_rope); }
constexpr size_t OFF_gates = OFF_rope + al256((size_t)4096 * 8 * 2 * 4);
DI float* ws_gates(const Params& p) { return (float*)(p.ws + OFF_gates); }
constexpr size_t OFF_counter = OFF_gates + al256((size_t)NROWS * 24 * 4);
DI unsigned* ws_counter(const Params& p) { return (unsigned*)(p.ws + OFF_counter); }
constexpr size_t WS_TOTAL = OFF_counter + al256((size_t)256);


DI void transpose_tile(const float* __restrict__ src, u16* __restrict__ dst, int K, int N, const float* __restrict__ scale, int kt, int nt, char* smem, int ldd) {
  float* tile = (float*)smem;
  const int tid = threadIdx.x;
#pragma unroll
  for (int i = 0; i < 8; ++i) {
    const int kk = i * 8 + (tid >> 6), nn = tid & 63, n = nt * 64 + nn, k = kt * 64 + kk;
    float v = (n < N) ? src[(size_t)k * N + n] : 0.f;
    if (scale) v *= scale[k];
    tile[kk * 65 + nn] = v;
  }
  __syncthreads();
#pragma unroll
  for (int i = 0; i < 8; ++i) {
    const int nn = i * 8 + (tid >> 6), kk = tid & 63;
    dst[(size_t)(nt * 64 + nn) * ldd + kt * 64 + kk] = f2bf(tile[kk * 65 + nn]);
  }
  __syncthreads();
}

__device__ void phase_prep(const Params& p, char* smem, int bid, int nb) {
  int tid_ = threadIdx.x; asm volatile("" : "+v"(tid_));
  const int tid = tid_, lane = tid & 63, wid = __builtin_amdgcn_readfirstlane(tid >> 6);
  constexpr int J_X = 1024, J_TW = 1024, J_TO = 256, J_T1 = 64, J_T2 = 2, J_CK = 16, J_ROPE = 64;
  constexpr int TOTAL = J_X + J_TW + J_TO + 2 * J_T1 + 2 * J_T2 + J_CK + J_ROPE;
  if (bid == 0 && tid < 8) ws_counter(p)[tid] = 0u;
  for (int j = bid; j < TOTAL; j += nb) {
    int jj = j;
    if (jj < J_X) {
      const int row0 = jj * 32 + wid * 4;
      float4 v[4][4]; float ss[4];
#pragma unroll
      for (int r = 0; r < 4; ++r) {
        const float4* xr = (const float4*)(p.x + (size_t)(row0 + r) * DM);
#pragma unroll
        for (int i = 0; i < 4; ++i) v[r][i] = xr[i * 64 + lane];
      }
#pragma unroll
      for (int r = 0; r < 4; ++r) {
        float a = 0.f;
#pragma unroll
        for (int i = 0; i < 4; ++i) a += v[r][i].x * v[r][i].x + v[r][i].y * v[r][i].y + v[r][i].z * v[r][i].z + v[r][i].w * v[r][i].w;
#pragma unroll
        for (int o = 32; o >= 1; o >>= 1) a += __shfl_xor(a, o);
        ss[r] = a;
      }
#pragma unroll
      for (int r = 0; r < 4; ++r) {
        if (lane == 0) ws_rs(p)[row0 + r] = rsqrtf(ss[r] * (1.0f / DM) + EPS);
#pragma unroll
        for (int i = 0; i < 4; ++i) {
          u32x2 o; o[0] = cvtpk(v[r][i].x, v[r][i].y); o[1] = cvtpk(v[r][i].z, v[r][i].w);
          const int rr_ = row0 + r;
          *(u32x2*)(ws_xb(p) + ((size_t)((rr_ >> 8) * 16 + i * 4 + (lane >> 4)) * 256 + (rr_ & 255)) * 64 + (lane & 15) * 4) = o;
        }
      }
      continue;
    }
    jj -= J_X;
    if (jj < J_TW) { transpose_tile(p.w_in, ws_winT(p), 1024, DIN, p.norm_w, jj & 15, jj >> 4, smem, LDK); continue; }
    jj -= J_TW;
    if (jj < J_TO) { transpose_tile(p.w_out, ws_woutT(p), 1024, 1024, nullptr, jj & 15, jj >> 4, smem, LDK); continue; }
    jj -= J_TO;
    if (jj < J_T1) { transpose_tile(p.ck_w1, ws_w1kT(p), 2048, 128, nullptr, jj & 31, jj >> 5, smem, 2048); continue; }
    jj -= J_T1;
    if (jj < J_T1) { transpose_tile(p.cv_w1, ws_w1vT(p), 2048, 128, nullptr, jj & 31, jj >> 5, smem, 2048); continue; }
    jj -= J_T1;
    if (jj < J_T2) { transpose_tile(p.ck_w2, ws_w2kT(p), 128, 64, nullptr, jj, 0, smem, 128); continue; }
    jj -= J_T2;
    if (jj < J_T2) { transpose_tile(p.cv_w2, ws_w2vT(p), 128, 64, nullptr, jj, 0, smem, 128); continue; }
    jj -= J_T2;
    if (jj < J_CK) {
      const int which = jj >> 3, chunk = jj & 7, hh = tid & 127, sub = tid >> 7;
      const float* pos = which ? p.cv_pos : p.ck_pos;
      const float* w1 = which ? p.cv_w1 : p.ck_w1;
      float acc = 0.f;
      const int f0 = chunk * 256 + sub * 64;
#pragma unroll 8
      for (int f = 0; f < 64; ++f) acc += pos[f0 + f] * w1[(size_t)(f0 + f) * 128 + hh];
      float* red = (float*)smem;
      red[sub * 128 + hh] = acc;
      __syncthreads();
      if (tid < 128) ws_ckpart(p)[(which * 8 + chunk) * 128 + tid] = red[tid] + red[128 + tid] + red[256 + tid] + red[384 + tid];
      __syncthreads();
      continue;
    }
    jj -= J_CK;
    {
      const int idx = jj * 512 + tid, pos = idx >> 3, fi = idx & 7;
      const float ang = (float)pos * c_invf[fi];
      float s, c; sincosf(ang, &s, &c);
      ws_rope(p)[idx * 2] = c; ws_rope(p)[idx * 2 + 1] = s;
    }
  }
}

DI int kimg_off(int row, int d) { return row * 64 + (((d >> 3) ^ ((row >> 1) & 7)) * 8) + (d & 7); }
DI int vimg_off(int d, int key) {
  const int kp = (key & ~12) | ((key & 4) << 1) | ((key & 8) >> 1);
  return d * 64 + (((kp >> 3) ^ ((d >> 1) & 7)) * 8) + (kp & 7);
}

constexpr int G_ASZ = 256 * 128, G_BSZ = 256 * 128, G_STAGE = G_ASZ + G_BSZ;
constexpr int G_ROPE = 2 * G_STAGE, G_RS = G_ROPE + 256 * 64;
static_assert(G_RS + 1024 <= SMEM_BYTES, "GEMM LDS layout exceeds the dynamic LDS size");
#define WAIT_VM(n) asm volatile("s_waitcnt vmcnt(" #n ")" ::: "memory")

template <int EPI>
__device__ void gemm_phase(const Params& p, char* smem, int bid, int nb) {
  constexpr int NT = EPI == 0 ? 16 : 4;
  constexpr int MT = 128;
  const u16* __restrict__ A = EPI == 0 ? ws_xb(p) : ws_mix(p);
  const u16* __restrict__ Bt = EPI == 0 ? ws_winT(p) : ws_woutT(p);
  int tid_ = threadIdx.x; asm volatile("" : "+v"(tid_));
  const int tid = tid_, lane = tid & 63, wid = __builtin_amdgcn_readfirstlane(tid >> 6), fr = lane & 15, fq = lane >> 4;
  const int wr = wid >> 2, wc = wid & 3;
  const bool xmap = (nb == 256);
  const int xcd = bid & 7, li = bid >> 3;
  const int ntiles = xmap ? (EPI == 0 ? 8 : 2) : (MT * NT - bid + nb - 1) / nb;
  auto tile_of = [&](int ti, int& m0, int& n0) {
    if (xmap) {
      const int sg = ti * 8 + xcd;
      if (EPI == 0) { m0 = ((sg >> 1) * 4 + (li >> 3)) * 256; n0 = ((sg & 1) * 8 + (li & 7)) * 256; }
      else { m0 = (sg * 8 + (li >> 2)) * 256; n0 = (li & 3) * 256; }
    } else { const int tile = bid + ti * nb; const int mt = tile / NT; m0 = mt * 256; n0 = (tile - mt * NT) * 256; }
  };
  const int nsteps = ntiles * 16;
  const unsigned lds0 = (unsigned)(uintptr_t)smem;
  const int gsw = (lane & 7) ^ ((wid & 1) * 4 + (lane >> 4));
  const int grow = wid * 8 + (lane >> 3);
  auto issue = [&](int step, int stage) {
    int m0, n0; tile_of(step >> 4, m0, n0);
    const int kt = step & 15;
    const u16* ag = EPI == 0 ? A + ((size_t)((m0 >> 8) * 16 + kt) * 256 + grow) * 64 + gsw * 8 : A + (size_t)(m0 + grow) * LDK + kt * 64 + gsw * 8;
    const size_t astep = EPI == 0 ? (size_t)64 * 64 : (size_t)64 * LDK;
    const int brow = EPI == 0 ? ((grow & ~31) | ((grow & 0x0C) << 1) | ((grow & 0x10) >> 2) | (grow & 3)) : grow;
    const u16* bg_ = Bt + (size_t)(n0 + brow) * LDK + kt * 64 + gsw * 8;
    const unsigned dst = (unsigned)__builtin_amdgcn_readfirstlane((int)(lds0 + stage * G_STAGE + wid * 1024));
#pragma unroll
    for (int i = 0; i < 4; ++i) glds16(ag + i * astep, dst + i * 8192);
#pragma unroll
    for (int i = 0; i < 4; ++i) glds16(bg_ + (size_t)i * 64 * LDK, dst + G_ASZ + i * 8192);
    if (EPI == 0 && kt == 8) {
      const int t0 = m0 & 4095;
      const unsigned sd = (unsigned)__builtin_amdgcn_readfirstlane((int)(lds0 + G_ROPE + wid * 1024));
      glds16(ws_rope(p) + (size_t)t0 * 16 + tid * 4, sd);
      glds16(ws_rope(p) + (size_t)t0 * 16 + (512 + tid) * 4, sd + 8192);
      if (wid == 0) glds16(ws_rs(p) + m0 + lane * 4, lds0 + G_RS);
    }
  };
  const int ca0 = ((fq ^ (fr >> 1)) * 16), ca1 = (((4 + fq) ^ (fr >> 1)) * 16);
  f32x4 acc[8][4];
#pragma unroll
  for (int m = 0; m < 8; ++m)
#pragma unroll
    for (int n = 0; n < 4; ++n) acc[m][n] = f32x4{0.f, 0.f, 0.f, 0.f};
  __syncthreads();
  if (nsteps > 0) issue(0, 0);
  for (int s = 0; s < nsteps; ++s) {
    WAIT_VM(0);
    __builtin_amdgcn_s_waitcnt(0x0F70);
    __builtin_amdgcn_s_barrier();
    if (s + 1 < nsteps) issue(s + 1, (s + 1) & 1);
    {
      const char* ab = smem + (s & 1) * G_STAGE + (wr * 128 + fr) * 128;
      const char* bb = smem + (s & 1) * G_STAGE + G_ASZ + (wc * 64 + fr) * 128;
#pragma unroll
      for (int ks = 0; ks < 2; ++ks) {
        bf16x8 af[8], bf[4];
        const int co = ks ? ca1 : ca0;
#pragma unroll
        for (int n = 0; n < 4; ++n) bf[n] = *(const bf16x8*)(bb + n * 16 * 128 + co);
#pragma unroll
        for (int m = 0; m < 8; ++m) af[m] = *(const bf16x8*)(ab + m * 16 * 128 + co);
#pragma unroll
        for (int m = 0; m < 8; ++m)
#pragma unroll
          for (int n = 0; n < 4; ++n) acc[m][n] = MFMA16(bf[n], af[m], acc[m][n]);
      }
    }
    if ((s & 15) != 15) continue;
    int m0, n0; tile_of(s >> 4, m0, n0);
    const int rbase = m0 + wr * 128;
    const int cb = n0 + wc * 64;
    if constexpr (EPI == 1) {
#pragma unroll
      for (int hm = 0; hm < 2; ++hm) {
        float4 xv[4][4];
#pragma unroll
        for (int mm = 0; mm < 4; ++mm) {
          const size_t ro = (size_t)(rbase + (hm * 4 + mm) * 16 + fr) * DM + cb + fq * 4;
#pragma unroll
          for (int n = 0; n < 4; ++n) xv[mm][n] = *(const float4*)(p.x + ro + n * 16);
        }
#pragma unroll
        for (int mm = 0; mm < 4; ++mm) {
          const int m = hm * 4 + mm;
          const size_t ro = (size_t)(rbase + m * 16 + fr) * DM + cb + fq * 4;
#pragma unroll
          for (int n = 0; n < 4; ++n) {
            float4 o; o.x = xv[mm][n].x + acc[m][n][0]; o.y = xv[mm][n].y + acc[m][n][1]; o.z = xv[mm][n].z + acc[m][n][2]; o.w = xv[mm][n].w + acc[m][n][3];
            *(float4*)(p.out + ro + n * 16) = o;
          }
        }
        __builtin_amdgcn_sched_barrier(0);
      }
    } else {
      const int b = m0 >> 12;
      const int tb = rbase & 4095;
      if (cb < 1280) {
        const int seg = cb >> 6;
        const int which = seg < 8 ? -1 : ((seg - 8) >> 1);
        const int g = seg < 8 ? (seg >> 2) : ((seg - 8) & 1);
        const bool need_norm = (seg < 8) || which == 2 || which == 4;
        const float* nw = seg < 8 ? p.q_norm_w : (p.k_norm_w + (which == 2 ? 64 : 128));
        float w[16];
#pragma unroll
        for (int k = 0; k < 16; ++k) w[k] = need_norm ? nw[(k >> 3) * 32 + fq * 8 + (k & 7)] : 1.0f;
        const float qs = seg < 8 ? QSCALE : 1.0f;
#pragma unroll
        for (int m = 0; m < 8; ++m) {
          const int t = tb + m * 16 + fr;
          const int lrow = wr * 128 + m * 16 + fr;
          const float r = *(const float*)(smem + G_RS + lrow * 4);
          float v[16];
#pragma unroll
          for (int k = 0; k < 16; ++k) v[k] = acc[m][(k >> 3) * 2 + ((k & 7) >> 2)][k & 3] * r;
          if (need_norm) {
            float ss = 0.f;
#pragma unroll
            for (int k = 0; k < 16; ++k) ss += v[k] * v[k];
            ss += __shfl_xor(ss, 16); ss += __shfl_xor(ss, 32);
            const float rr = rsqrtf(ss * (1.0f / 64.f) + EPS);
#pragma unroll
            for (int k = 0; k < 16; ++k) v[k] = v[k] * rr * w[k];
            const float4* rp = (const float4*)(smem + G_ROPE + lrow * 64);
            const float4 c01 = rp[0], c23 = rp[1], c45 = rp[2], c67 = rp[3];
            const float cc[8] = {c01.x, c01.z, c23.x, c23.z, c45.x, c45.z, c67.x, c67.z};
            const float sn[8] = {c01.y, c01.w, c23.y, c23.w, c45.y, c45.w, c67.y, c67.w};
#pragma unroll
            for (int e = 0; e < 8; ++e) {
              const float pr = __shfl_xor(v[e], 16);
              const float rot = (fq == 0) ? (v[e] * cc[e] - pr * sn[e]) : (v[e] * cc[e] + pr * sn[e]);
              v[e] = (fq < 2) ? rot : v[e];
            }
#pragma unroll
            for (int k = 0; k < 16; ++k) v[k] *= qs;
          }
          if (which == 3 || which == 5) {
            int lz = 0; asm volatile("" : "+v"(lz));
            u16* vt = (which == 3 ? ws_Vst(p) : ws_Vwt(p)) + (size_t)((b * 2 + g) * 64 + (t >> 6)) * 4096 + lz;
            const int fqx = fq + lz, key = (t & 63) + lz;
#pragma unroll
            for (int k = 0; k < 16; ++k) vt[vimg_off((k >> 3) * 32 + fqx * 8 + (k & 7), key)] = f2bf(v[k]);
          } else {
            u16* dst;
            if (seg < 8) dst = ws_Q(p) + ((size_t)((b * 2 + g) * 4096 + t) * 4 + (seg & 3)) * 64;
            else { u16* buf = which == 0 ? ws_kcraw(p) : which == 1 ? ws_vcraw(p) : which == 2 ? ws_Ks(p) : ws_Kw(p); dst = buf + ((size_t)(b * 2 + g) * 4096 + t) * 64; }
            const bool img = which >= 2;
#pragma unroll
            for (int n2 = 0; n2 < 2; ++n2) {
              u32x4 o;
#pragma unroll
              for (int e = 0; e < 4; ++e) o[e] = cvtpk(v[n2 * 8 + 2 * e], v[n2 * 8 + 2 * e + 1]);
              const int d0 = n2 * 32 + fq * 8;
              const int off = img ? (((d0 >> 3) ^ (((t & 63) >> 1) & 7)) * 8) : d0;
              *(u32x4*)(dst + off) = o;
            }
          }
          __builtin_amdgcn_sched_barrier(0);
        }
      } else {
#pragma unroll
        for (int m = 0; m < 8; ++m) {
          const size_t row = rbase + m * 16 + fr;
          const float r = *(const float*)(smem + G_RS + (wr * 128 + m * 16 + fr) * 4);
#pragma unroll
          for (int n2 = 0; n2 < 2; ++n2) {
            const int c8 = cb + n2 * 32 + fq * 8;
            if (c8 >= DIN) continue;
            float v[8];
#pragma unroll
            for (int e = 0; e < 8; ++e) v[e] = acc[m][n2 * 2 + (e >> 2)][e & 3] * r;
            if (c8 < 1304) {
              float4 o0, o1;
              o0.x = sigmoidf_(v[0]); o0.y = sigmoidf_(v[1]); o0.z = sigmoidf_(v[2]); o0.w = sigmoidf_(v[3]);
              o1.x = sigmoidf_(v[4]); o1.y = sigmoidf_(v[5]); o1.z = sigmoidf_(v[6]); o1.w = sigmoidf_(v[7]);
              float* gp = ws_gates(p) + row * 24 + (c8 - 1280);
              *(float4*)gp = o0; *(float4*)(gp + 4) = o1;
            } else if (c8 < 1816) {
              u32x4 o;
#pragma unroll
              for (int e = 0; e < 4; ++e) o[e] = cvtpk(siluf_(v[2 * e]), siluf_(v[2 * e + 1]));
              *(u32x4*)(ws_zs(p) + row * 512 + (c8 - 1304)) = o;
            } else {
              u32x4 o;
#pragma unroll
              for (int e = 0; e < 4; ++e) o[e] = cvtpk(v[2 * e], v[2 * e + 1]);
              *(u32x4*)(ws_cvb(p) + row * 2048 + (c8 - 1816)) = o;
            }
          }
          __builtin_amdgcn_sched_barrier(0);
        }
      }
    }
#pragma unroll
    for (int m = 0; m < 8; ++m)
#pragma unroll
      for (int n = 0; n < 4; ++n) acc[m][n] = f32x4{0.f, 0.f, 0.f, 0.f};
  }
}

__device__ void phase_cmp_conv(const Params& p, char* smem, int bid, int nb) {
  int tid_ = threadIdx.x; asm volatile("" : "+v"(tid_));
  const int tid = tid_, lane = tid & 63, wid = __builtin_amdgcn_readfirstlane(tid >> 6), fr = lane & 15, fq = lane >> 4;
  float* part = (float*)smem;
  char* hl = smem + 8 * 16 * 132 * 4;
  float* outl = (float*)(hl + 2 * 4352);
  for (int job = bid; job < 256; job += nb) {
    const int which = wid >> 2, w4 = wid & 3, bg = job >> 4, ct = job & 15;
    const u16* raw = (which ? ws_vcraw(p) : ws_kcraw(p)) + (size_t)bg * 4096 * 64;
    const u16* w1T = which ? ws_w1vT(p) : ws_w1kT(p);
    const u16* w2T = which ? ws_w2vT(p) : ws_w2kT(p);
    const float* b1 = which ? p.cv_b1 : p.ck_b1;
    f32x4 acc[8];
#pragma unroll
    for (int n = 0; n < 8; ++n) acc[n] = f32x4{0.f, 0.f, 0.f, 0.f};
    const int c = ct * 16 + fr;
    const int ht = tid & 255, rrow = ht >> 4, c8 = (ht & 15) * 8;
    float bias[8];
#pragma unroll
    for (int e = 0; e < 8; ++e) {
      float bsum = b1[c8 + e];
#pragma unroll
      for (int ch = 0; ch < 8; ++ch) bsum += ws_ckpart(p)[(which * 8 + ch) * 128 + c8 + e];
      bias[e] = bsum;
    }
    bf16x8 w2f[4];
#pragma unroll
    for (int ks = 0; ks < 4; ++ks) w2f[ks] = *(const bf16x8*)(w2T + (size_t)(w4 * 16 + fr) * 128 + ks * 32 + fq * 8);
    const int orow = ht >> 4, d4 = (ht & 15) * 4;
    const int cc = ct * 16 + orow;
    float nwv[4], nwp[4]; float2 csv[4];
    {
      int pos = cc * 16 + 31; pos = pos > 4095 ? 4095 : pos;
#pragma unroll
      for (int e = 0; e < 4; ++e) {
        const int d = d4 + e;
        nwv[e] = p.k_norm_w[d]; nwp[e] = p.k_norm_w[d ^ 8];
        csv[e] = *(const float2*)(ws_rope(p) + ((size_t)pos * 8 + (d & 7)) * 2);
      }
    }
#pragma unroll 4
    for (int k16 = 0; k16 < 16; ++k16) {
      const int ks = w4 * 16 + k16;
      const int l = ks >> 1, d0 = (ks & 1) * 32 + fq * 8;
      int tt = c * 16 + l; tt = tt > 4095 ? 4095 : tt;
      const bf16x8 a = *(const bf16x8*)(raw + (size_t)tt * 64 + d0);
#pragma unroll
      for (int n = 0; n < 8; ++n) {
        const bf16x8 bb = *(const bf16x8*)(w1T + (size_t)(n * 16 + fr) * 2048 + ks * 32 + fq * 8);
        acc[n] = MFMA16(a, bb, acc[n]);
      }
    }
#pragma unroll
    for (int n = 0; n < 8; ++n)
#pragma unroll
      for (int j = 0; j < 4; ++j) part[(wid * 16 + fq * 4 + j) * 132 + n * 16 + fr] = acc[n][j];
    __syncthreads();
    {
      float sum[8];
#pragma unroll
      for (int e = 0; e < 8; ++e) sum[e] = bias[e];
#pragma unroll
      for (int w = 0; w < 4; ++w) {
        const float4 v0 = *(const float4*)(part + ((which * 4 + w) * 16 + rrow) * 132 + c8), v1 = *(const float4*)(part + ((which * 4 + w) * 16 + rrow) * 132 + c8 + 4);
        sum[0] += v0.x; sum[1] += v0.y; sum[2] += v0.z; sum[3] += v0.w; sum[4] += v1.x; sum[5] += v1.y; sum[6] += v1.z; sum[7] += v1.w;
      }
      u32x4 o;
#pragma unroll
      for (int e = 0; e < 4; ++e) o[e] = cvtpk(siluf_(sum[2 * e]), siluf_(sum[2 * e + 1]));
      *(u32x4*)(hl + which * 4352 + rrow * 272 + c8 * 2) = o;
    }
    __syncthreads();
    {
      f32x4 o2 = f32x4{0.f, 0.f, 0.f, 0.f};
#pragma unroll
      for (int ks = 0; ks < 4; ++ks) {
        const bf16x8 a = *(const bf16x8*)(hl + which * 4352 + fr * 272 + (ks * 32 + fq * 8) * 2);
        o2 = MFMA16(a, w2f[ks], o2);
      }
#pragma unroll
      for (int j = 0; j < 4; ++j) outl[which * 1088 + (fq * 4 + j) * 68 + w4 * 16 + fr] = o2[j];
    }
    __syncthreads();
    {
      const float* ol = outl + which * 1088;
      const float4 v = *(const float4*)(ol + orow * 68 + d4);
      if (which == 0) {
        float ss = v.x * v.x + v.y * v.y + v.z * v.z + v.w * v.w;
        ss += __shfl_xor(ss, 1); ss += __shfl_xor(ss, 2); ss += __shfl_xor(ss, 4); ss += __shfl_xor(ss, 8);
        const float rr = rsqrtf(ss * (1.0f / 64.f) + EPS);
        float o[4] = {v.x * rr * nwv[0], v.y * rr * nwv[1], v.z * rr * nwv[2], v.w * rr * nwv[3]};
        if (d4 < 16) {
#pragma unroll
          for (int e = 0; e < 4; ++e) {
            const int d = d4 + e, dp = d ^ 8;
            const float pr = ol[orow * 68 + dp] * rr * nwp[e];
            o[e] = (d < 8) ? (o[e] * csv[e].x - pr * csv[e].y) : (o[e] * csv[e].x + pr * csv[e].y);
          }
        }
        u32x2 ov; ov[0] = cvtpk(o[0], o[1]); ov[1] = cvtpk(o[2], o[3]);
        if (cc >= 255) { ov[0] = 0u; ov[1] = 0u; }
        *(u32x2*)(ws_Kc(p) + (size_t)(bg * 4 + (cc >> 6)) * 4096 + kimg_off(cc & 63, d4)) = ov;
      } else {
        const float z = (cc >= 255) ? 0.f : 1.f;
        u16* vt = ws_Vct(p) + (size_t)(bg * 4 + (cc >> 6)) * 4096;
        vt[vimg_off(d4 + 0, cc & 63)] = f2bf(v.x * z); vt[vimg_off(d4 + 1, cc & 63)] = f2bf(v.y * z);
        vt[vimg_off(d4 + 2, cc & 63)] = f2bf(v.z * z); vt[vimg_off(d4 + 3, cc & 63)] = f2bf(v.w * z);
      }
    }
    __syncthreads();
  }
  const int gw = bid * 8 + wid, nw = nb * 8;
  for (int chunk = gw; chunk < 2048; chunk += nw) {
    const int r0 = chunk * 16, t0 = r0 & 4095;
    const int ch = lane * 8;
    float cw0[8], cw1[8], cw2[8], cbv[8], u1[8], u2[8];
#pragma unroll
    for (int e = 0; e < 8; ++e) { cw0[e] = p.conv_w[ch + e]; cw1[e] = p.conv_w[512 + ch + e]; cw2[e] = p.conv_w[1024 + ch + e]; cbv[e] = p.conv_b[ch + e]; u1[e] = 0.f; u2[e] = 0.f; }
    if (t0 > 0) {
#pragma unroll
      for (int q = 0; q < 2; ++q) {
        const u16* rp = ws_cvb(p) + (size_t)(r0 - 2 + q) * 2048 + ch;
        const u32x4 hv = *(const u32x4*)(rp), cv = *(const u32x4*)(rp + 1024);
#pragma unroll
        for (int e = 0; e < 4; ++e) {
          const float ua = bflo(hv[e]) * bflo(cv[e]), ub = bfhi(hv[e]) * bfhi(cv[e]);
          if (q == 0) { u2[2 * e] = ua; u2[2 * e + 1] = ub; } else { u1[2 * e] = ua; u1[2 * e + 1] = ub; }
        }
      }
    }
#pragma unroll 4
    for (int rr = 0; rr < 16; ++rr) {
      const u16* rp = ws_cvb(p) + (size_t)(r0 + rr) * 2048 + ch;
      const u32x4 hv = *(const u32x4*)(rp), bv = *(const u32x4*)(rp + 512), cv = *(const u32x4*)(rp + 1024), zv = *(const u32x4*)(rp + 1536);
      u32x4 ov;
#pragma unroll
      for (int e = 0; e < 4; ++e) {
        const float ua = bflo(hv[e]) * bflo(cv[e]), ub = bfhi(hv[e]) * bfhi(cv[e]);
        const float ca = cw0[2 * e] * u2[2 * e] + cw1[2 * e] * u1[2 * e] + cw2[2 * e] * ua + cbv[2 * e];
        const float cbb = cw0[2 * e + 1] * u2[2 * e + 1] + cw1[2 * e + 1] * u1[2 * e + 1] + cw2[2 * e + 1] * ub + cbv[2 * e + 1];
        const float oa = bflo(bv[e]) * ca * siluf_(bflo(zv[e]));
        const float ob = bfhi(bv[e]) * cbb * siluf_(bfhi(zv[e]));
        ov[e] = cvtpk(oa, ob);
        u2[2 * e] = u1[2 * e]; u2[2 * e + 1] = u1[2 * e + 1]; u1[2 * e] = ua; u1[2 * e + 1] = ub;
      }
      *(u32x4*)(ws_mix(p) + (size_t)(r0 + rr) * LDK + 512 + ch) = ov;
    }
  }
}

constexpr int AT_NST = 5, AT_KB = 8192, AT_BUF = 16384;
constexpr int AT_F = AT_NST * AT_BUF, AT_IMPA = AT_F, AT_IMPB = AT_IMPA + 64 * 65 * 4, AT_VAL = AT_IMPA;
constexpr int AT_SELM = AT_F + 8 * 8192, AT_UNIT = AT_SELM + 512, AT_END = AT_UNIT + 16;
static_assert(AT_END <= SMEM_BYTES, "attention LDS layout exceeds the dynamic LDS size");

__device__ void phase_attn(const Params& p, char* smem, int bid, int nb, int rep) {
  int tid_ = threadIdx.x; asm volatile("" : "+v"(tid_));
  const int tid = tid_, lane = tid & 63, wid = __builtin_amdgcn_readfirstlane(tid >> 6), c32 = lane & 31, h = lane >> 5;
  const float NINF = -__builtin_inff();
  float* impa = (float*)(smem + AT_IMPA);
  float* impb = (float*)(smem + AT_IMPB);
  float* vals = (float*)(smem + AT_VAL);
  unsigned* selm = (unsigned*)(smem + AT_SELM);
  volatile int* s_unit = (volatile int*)(smem + AT_UNIT);
  const unsigned lds0 = (unsigned)(uintptr_t)smem;
  while (true) {
    if (tid == 0) *s_unit = (int)atomicAdd(ws_counter(p) + rep, 1u);
    __syncthreads();
    const int u = __builtin_amdgcn_readfirstlane(*s_unit);
    __syncthreads();
    if (u >= 1024) break;
    const int i = 63 - (u >> 4), bg = u & 15, b = bg >> 1, g = bg & 1;
    const int tl = wid * 8 + (c32 >> 2), hd = c32 & 3;
    const int t = i * 64 + tl;
    const u16* qrow = ws_Q(p) + ((size_t)(bg * 4096 + i * 64) * 4 + wid * 32 + c32) * 64;
    bf16x8 qf[4];
#pragma unroll
    for (int ks = 0; ks < 4; ++ks) qf[ks] = *(const bf16x8*)(qrow + ks * 16 + h * 8);
    const float* gp = ws_gates(p) + (size_t)(b * 4096 + t) * 24 + (g * 4 + hd) * 3;
    const float g0 = gp[0], g1 = gp[1], g2 = gp[2];
    asm volatile("" :: "v"(qf[0]), "v"(qf[1]), "v"(qf[2]), "v"(qf[3]), "v"(g0), "v"(g1), "v"(g2));
    const int ntc = (4 * i + 2) / 64 + 1, nsl = i + 1, nwin = (i < 8 ? i : 8) + 1;
    const int NT = 2 * ntc + nsl + nwin;
    const bool need_sel = i >= 16;

    f32x16 O0, O1;
#pragma unroll
    for (int r = 0; r < 16; ++r) { O0[r] = 0.f; O1[r] = 0.f; }
    float* fl = (float*)(smem + AT_F + wid * 8192) + lane;
    float m_run = NINF, l_run = 0.f, inv_l = 0.f;
    bool kill_o = false;
    unsigned sel_lo = 0xffffffffu, sel_hi = 0xffffffffu;
#define TILE_PTRS(n, kp, vp) do { \
      if ((n) < 2 * ntc) { const int tt_ = (n) < ntc ? (n) : (n) - ntc; kp = ws_Kc(p) + (size_t)(bg * 4 + tt_) * 4096; vp = ws_Vct(p) + (size_t)(bg * 4 + tt_) * 4096; } \
      else if ((n) < 2 * ntc + nsl) { const int j_ = (n) - 2 * ntc; kp = ws_Ks(p) + ((size_t)bg * 4096 + j_ * 64) * 64; vp = ws_Vst(p) + (size_t)(bg * 64 + j_) * 4096; } \
      else { const int j_ = i - nwin + 1 + ((n) - 2 * ntc - nsl); kp = ws_Kw(p) + ((size_t)bg * 4096 + j_ * 64) * 64; vp = ws_Vwt(p) + (size_t)(bg * 64 + j_) * 4096; } } while (0)
#define TISSUE(n, st_) do { const u16 *kp_, *vp_; TILE_PTRS(n, kp_, vp_); \
      const unsigned d_ = (unsigned)__builtin_amdgcn_readfirstlane((int)(lds0 + (st_) * AT_BUF + wid * 1024)); \
      glds16(kp_ + tid * 8, d_); glds16(vp_ + tid * 8, d_ + AT_KB); } while (0)
    {
      const int npre = NT < AT_NST - 1 ? NT : AT_NST - 1;
      for (int n = 0; n < npre; ++n) TISSUE(n, n);
    }
    int st_cur = 0, st_iss = AT_NST - 1;
    const int ksw = (c32 >> 1) & 7;
    for (int n = 0; n < NT; ++n) {
      {
        const int rem = NT - 1 - n;
        if (rem >= 3) WAIT_VM(6); else if (rem == 2) WAIT_VM(4); else if (rem == 1) WAIT_VM(2); else WAIT_VM(0);
        __builtin_amdgcn_s_barrier();
        if (n + AT_NST - 1 < NT) TISSUE(n + AT_NST - 1, st_iss);
      }
      int mode, base, lo, hi;
      bool full = false, lane_on = true;
      if (n < 2 * ntc) { mode = n < ntc ? 0 : 1; base = (n < ntc ? n : n - ntc) * 64; lo = -1; hi = (t - 31) >> 4; }
      else if (n < 2 * ntc + nsl) { const int j = n - 2 * ntc; mode = 2; base = j * 64; const unsigned bit = j < 32 ? (sel_lo >> j) & 1u : (sel_hi >> (j - 32)) & 1u; lo = -1; hi = bit ? t : -1; full = j < i; lane_on = bit != 0u; }
      else { const int j = i - nwin + 1 + (n - 2 * ntc - nsl); mode = 3; base = j * 64; lo = t - 512; hi = t; full = (j < i) && (j > i - 8); }
      const int lo_rel = lo - (base + 4 * h), hi_rel = hi - (base + 4 * h);
      const char* kb = smem + st_cur * AT_BUF;
      const char* vb = kb + AT_KB;
      st_cur = st_cur == AT_NST - 1 ? 0 : st_cur + 1; st_iss = st_iss == AT_NST - 1 ? 0 : st_iss + 1;
      f32x16 S0, S1;
#pragma unroll
      for (int r = 0; r < 16; ++r) { S0[r] = 0.f; S1[r] = 0.f; }
#pragma unroll
      for (int ks = 0; ks < 4; ++ks) {
        const bf16x8 k0 = *(const bf16x8*)(kb + c32 * 128 + (((ks * 2 + h) ^ ksw) * 16));
        const bf16x8 k1 = *(const bf16x8*)(kb + (32 + c32) * 128 + (((ks * 2 + h) ^ ksw) * 16));
        S0 = MFMA32(k0, qf[ks], S0);
        S1 = MFMA32(k1, qf[ks], S1);
      }
      __builtin_amdgcn_sched_group_barrier(0x100, 8, 0);
      __builtin_amdgcn_sched_group_barrier(0x008, 8, 0);
      bf16x8 vfa[4];
#pragma unroll
      for (int kk = 0; kk < 2; ++kk)
#pragma unroll
        for (int dr = 0; dr < 2; ++dr) vfa[kk * 2 + dr] = *(const bf16x8*)(vb + (32 * dr + c32) * 128 + (((2 * kk + h) ^ ksw) * 16));
      __builtin_amdgcn_sched_group_barrier(0x100, 4, 0);
#define ATT_BODY(MASKED) do { \
      if (MASKED) { \
        _Pragma("unroll") for (int r = 0; r < 16; ++r) { \
          const int off = (r & 3) + 8 * (r >> 2); \
          S0[r] = (off > lo_rel && off <= hi_rel) ? S0[r] : NINF; \
          S1[r] = (off + 32 > lo_rel && off + 32 <= hi_rel) ? S1[r] : NINF; \
        } \
      } \
      float alpha = 1.0f; \
      if (mode != 1) { \
        float mx = fmaxf(fmaxf(S0[0], S0[1]), S1[0]); \
        mx = fmaxf(fmaxf(mx, S1[1]), S0[2]); \
        _Pragma("unroll") for (int r = 2; r < 16; r += 2) { \
          if (r > 2) mx = fmaxf(fmaxf(mx, S0[r]), S1[r - 1]); \
          mx = fmaxf(fmaxf(mx, S0[r + 1]), S1[r]); \
        } \
        mx = fmaxf(mx, S1[15]); \
        if (!(MASKED) && !lane_on) mx = NINF; \
        mx = fmaxf(mx, __shfl_xor(mx, 32)); \
        const bool mv = (mx - m_run) > 8.0f;     \
        alpha = mv ? __builtin_amdgcn_exp2f(m_run - mx) : 1.0f; \
        m_run = mv ? mx : m_run; \
        l_run *= alpha; \
      } \
      if (kill_o) alpha = 0.f;                   \
      kill_o = false; \
      _Pragma("unroll") for (int r = 0; r < 16; ++r) { O0[r] *= alpha; O1[r] *= alpha; } \
      { \
        const float m_use = (m_run == NINF) ? 0.f : m_run; \
        const float msub = (!(MASKED) && !lane_on) ? __builtin_inff() : m_use; \
        float ps0 = 0.f, ps1 = 0.f; \
        _Pragma("unroll") for (int r = 0; r < 16; ++r) { S0[r] = __builtin_amdgcn_exp2f(S0[r] - msub); S1[r] = __builtin_amdgcn_exp2f(S1[r] - msub); ps0 += S0[r]; ps1 += S1[r]; } \
        if (mode != 1) l_run += ps0 + ps1; \
      } \
      _Pragma("unroll") for (int kk = 0; kk < 4; ++kk) {         \
        const int kr = kk >> 1, sp = kk & 1; \
        u32x4 pw; \
        _Pragma("unroll") for (int e = 0; e < 4; ++e) { \
          const float a0 = kr ? S1[8 * sp + 2 * e] : S0[8 * sp + 2 * e]; \
          const float a1 = kr ? S1[8 * sp + 2 * e + 1] : S0[8 * sp + 2 * e + 1]; \
          pw[e] = cvtpk(a0, a1); \
        } \
        const bf16x8 pf = __builtin_bit_cast(bf16x8, pw); \
        _Pragma("unroll") for (int dr = 0; dr < 2; ++dr) { \
          const bf16x8 vf = kk < 2 ? vfa[(kk & 1) * 2 + dr] : *(const bf16x8*)(vb + (32 * dr + c32) * 128 + (((2 * kk + h) ^ ksw) * 16)); \
          if (dr == 0) O0 = MFMA32(vf, pf, O0); else O1 = MFMA32(vf, pf, O1); \
        } \
      } \
      if ((MASKED) && mode == 1 && need_sel) {               \
        const int tt = base >> 6; \
        _Pragma("unroll") for (int kr = 0; kr < 2; ++kr) \
          _Pragma("unroll") for (int rg = 0; rg < 4; ++rg) { \
            float pv[4]; \
            _Pragma("unroll") for (int e = 0; e < 4; ++e) { \
              float v = (kr ? S1[rg * 4 + e] : S0[rg * 4 + e]) * inv_l; \
              v += __shfl_xor(v, 1); v += __shfl_xor(v, 2); \
              pv[e] = v; \
            } \
            if (hd == 0) { \
              const int nblk = tt * 16 + 8 * kr + 2 * rg + h; \
              impa[tl * 65 + nblk] = pv[0] + pv[1] + pv[2] + 0.5f * pv[3]; \
              impb[tl * 65 + nblk] = 0.5f * pv[3]; \
            } \
          } \
      } } while (0)
      if (full) ATT_BODY(false); else ATT_BODY(true);
#undef ATT_BODY
      if (n == ntc - 1) {
        const float lt = l_run + __shfl_xor(l_run, 32);
        inv_l = lt > 0.f ? 1.0f / lt : 0.f;
        kill_o = true;
      } else if (n == 2 * ntc - 1) {
        if (need_sel) {
          __syncthreads();
          const int tk = tid >> 3, nb0 = (tid & 7) * 8;
          float myv[8];
#pragma unroll
          for (int e = 0; e < 8; ++e) {
            const int nn = nb0 + e;
            const bool forced = (nn == 0) || (nn == i) || (nn == i - 1);
            float v = -1.0f;
            if (nn <= i) v = impa[tk * 65 + nn] + (nn > 0 ? impb[tk * 65 + nn - 1] : 0.f);
            if (forced) v = 1e9f;
            myv[e] = v;
            vals[tk * 65 + nn] = v;
          }
          __syncthreads();
          int cnt[8];
#pragma unroll
          for (int e = 0; e < 8; ++e) cnt[e] = 0;
          for (int mm = 0; mm < 64; ++mm) {
            const float vm = vals[tk * 65 + mm];
#pragma unroll
            for (int e = 0; e < 8; ++e) cnt[e] += (vm > myv[e] || (vm == myv[e] && mm < nb0 + e)) ? 1 : 0;
          }
          unsigned bits = 0;
#pragma unroll
          for (int e = 0; e < 8; ++e) bits |= (cnt[e] < 16 ? 1u : 0u) << e;
          unsigned wlo = (tid & 7) < 4 ? bits << (8 * (tid & 7)) : 0u;
          unsigned whi = (tid & 7) >= 4 ? bits << (8 * ((tid & 7) - 4)) : 0u;
          wlo |= __shfl_xor(wlo, 1); wlo |= __shfl_xor(wlo, 2); wlo |= __shfl_xor(wlo, 4);
          whi |= __shfl_xor(whi, 1); whi |= __shfl_xor(whi, 2); whi |= __shfl_xor(whi, 4);
          if ((tid & 7) == 0) { selm[tk * 2] = wlo; selm[tk * 2 + 1] = whi; }
          __syncthreads();
          sel_lo = selm[tl * 2]; sel_hi = selm[tl * 2 + 1];
        }
        {
          const float wgt = g0 * inv_l;
#pragma unroll
          for (int r = 0; r < 16; ++r) { fl[r * 64] = wgt * O0[r]; fl[(16 + r) * 64] = wgt * O1[r]; }
          m_run = NINF; l_run = 0.f; kill_o = true;
        }
      } else if (n == 2 * ntc + nsl - 1) {
        const float lt = l_run + __shfl_xor(l_run, 32);
        const float wgt = g1 * (lt > 0.f ? 1.0f / lt : 0.f);
#pragma unroll
        for (int r = 0; r < 16; ++r) { fl[r * 64] += wgt * O0[r]; fl[(16 + r) * 64] += wgt * O1[r]; }
        m_run = NINF; l_run = 0.f; kill_o = true;
      }
    }
#undef TILE_PTRS
#undef TISSUE
    {
      const float lt = l_run + __shfl_xor(l_run, 32);
      const float wgt = g2 * (lt > 0.f ? 1.0f / lt : 0.f);
      const size_t rowo = (size_t)(b * 4096 + t);
      const u16* zp = ws_zs(p) + rowo * 512 + (g * 4 + hd) * 64;
      u16* mp = ws_mix(p) + rowo * LDK + (g * 4 + hd) * 64;
#pragma unroll
      for (int dr = 0; dr < 2; ++dr)
#pragma unroll
        for (int rg = 0; rg < 4; ++rg) {
          const int d = 32 * dr + 8 * rg + 4 * h;
          const u32x2 zv = *(const u32x2*)(zp + d);
          const float f0 = fl[(dr * 16 + rg * 4 + 0) * 64] + wgt * (dr ? O1[rg * 4 + 0] : O0[rg * 4 + 0]);
          const float f1 = fl[(dr * 16 + rg * 4 + 1) * 64] + wgt * (dr ? O1[rg * 4 + 1] : O0[rg * 4 + 1]);
          const float f2 = fl[(dr * 16 + rg * 4 + 2) * 64] + wgt * (dr ? O1[rg * 4 + 2] : O0[rg * 4 + 2]);
          const float f3 = fl[(dr * 16 + rg * 4 + 3) * 64] + wgt * (dr ? O1[rg * 4 + 3] : O0[rg * 4 + 3]);
          u32x2 o;
          o[0] = cvtpk(f0 * bflo(zv[0]), f1 * bfhi(zv[0]));
          o[1] = cvtpk(f2 * bflo(zv[1]), f3 * bfhi(zv[1]));
          *(u32x2*)(mp + d) = o;
        }
    }
  }
}

#if FUSED
extern "C" __global__ void __launch_bounds__(NTHREADS) hybrid_fwd(Params p) {
  extern __shared__ __attribute__((aligned(16))) char smem[];
  cg::grid_group grid = cg::this_grid();
  const int bid = blockIdx.x, nb = gridDim.x;
  for (int r = 0; r < REP0; ++r) { phase_prep(p, smem, bid, nb); grid.sync(); }
  for (int r = 0; r < REP1; ++r) { gemm_phase<0>(p, smem, bid, nb); grid.sync(); }
  for (int r = 0; r < REP2; ++r) { phase_cmp_conv(p, smem, bid, nb); grid.sync(); }
  for (int r = 0; r < REP3; ++r) { phase_attn(p, smem, bid, nb, r); grid.sync(); }
  for (int r = 0; r < REP4; ++r) { gemm_phase<1>(p, smem, bid, nb); }
}
#else
template <int PH>
__global__ void __launch_bounds__(NTHREADS) phase_kernel(Params p) {
  extern __shared__ __attribute__((aligned(16))) char smem[];
  const int bid = blockIdx.x, nb = gridDim.x;
  if constexpr (PH == 0) phase_prep(p, smem, bid, nb);
  if constexpr (PH == 1) gemm_phase<0>(p, smem, bid, nb);
  if constexpr (PH == 2) phase_cmp_conv(p, smem, bid, nb);
  if constexpr (PH == 3) phase_attn(p, smem, bid, nb, 0);
  if constexpr (PH == 4) gemm_phase<1>(p, smem, bid, nb);
}
#endif

extern "C" void kernel_launch(void* const* d_in, const int* in_sizes, int n_in, void* d_out, int out_size, void* d_ws, size_t ws_size, hipStream_t stream) {
  Params p{};
  p.x = (const float*)d_in[0]; p.norm_w = (const float*)d_in[1]; p.w_in = (const float*)d_in[2]; p.q_norm_w = (const float*)d_in[3];
  p.k_norm_w = (const float*)d_in[4]; p.ck_pos = (const float*)d_in[5]; p.ck_w1 = (const float*)d_in[6]; p.ck_b1 = (const float*)d_in[7];
  p.ck_w2 = (const float*)d_in[8]; p.cv_pos = (const float*)d_in[9]; p.cv_w1 = (const float*)d_in[10]; p.cv_b1 = (const float*)d_in[11];
  p.cv_w2 = (const float*)d_in[12]; p.conv_w = (const float*)d_in[13]; p.conv_b = (const float*)d_in[14]; p.w_out = (const float*)d_in[15];
  p.out = (float*)d_out;
  p.ws = (char*)d_ws;
  const size_t off = WS_TOTAL;
  if (off > ws_size) { fprintf(stderr, "kernel_launch: workspace too small (%zu > %zu)\n", off, ws_size); return; }

#if FUSED
  static int grid_blocks = 0;
  if (!grid_blocks) {
    int dev = 0, cus = 0, per_cu = 0;
    hipGetDevice(&dev);
    hipDeviceGetAttribute(&cus, hipDeviceAttributeMultiprocessorCount, dev);
    hipFuncSetAttribute((const void*)hybrid_fwd, hipFuncAttributeMaxDynamicSharedMemorySize, SMEM_BYTES);
    hipOccupancyMaxActiveBlocksPerMultiprocessor(&per_cu, (const void*)hybrid_fwd, NTHREADS, SMEM_BYTES);
    if (per_cu < 1) per_cu = 1;
    grid_blocks = cus * per_cu;
  }
  void* args[] = {&p};
  hipError_t e = hipLaunchCooperativeKernel((const void*)hybrid_fwd, dim3(grid_blocks), dim3(NTHREADS), args, SMEM_BYTES, stream);
  if (e != hipSuccess) fprintf(stderr, "cooperative launch failed: %s (grid %d)\n", hipGetErrorString(e), grid_blocks);
#else
  static int attr_set = 0;
  if (!attr_set) {
    (void)hipFuncSetAttribute((const void*)phase_kernel<0>, hipFuncAttributeMaxDynamicSharedMemorySize, SMEM_BYTES);
    (void)hipFuncSetAttribute((const void*)phase_kernel<1>, hipFuncAttributeMaxDynamicSharedMemorySize, SMEM_BYTES);
    (void)hipFuncSetAttribute((const void*)phase_kernel<2>, hipFuncAttributeMaxDynamicSharedMemorySize, SMEM_BYTES);
    (void)hipFuncSetAttribute((const void*)phase_kernel<3>, hipFuncAttributeMaxDynamicSharedMemorySize, SMEM_BYTES);
    (void)hipFuncSetAttribute((const void*)phase_kernel<4>, hipFuncAttributeMaxDynamicSharedMemorySize, SMEM_BYTES);
    attr_set = 1;
  }
  const int G = 256;
  phase_kernel<0><<<G, NTHREADS, SMEM_BYTES, stream>>>(p);
  phase_kernel<1><<<G, NTHREADS, SMEM_BYTES, stream>>>(p);
  phase_kernel<2><<<G, NTHREADS, SMEM_BYTES, stream>>>(p);
  phase_kernel<3><<<G, NTHREADS, SMEM_BYTES, stream>>>(p);
  phase_kernel<4><<<G, NTHREADS, SMEM_BYTES, stream>>>(p);
#endif
}
```

```cpp
#include <hip/hip_runtime.h>
#include <hip/hip_cooperative_groups.h>
#include <cstdio>
#include <cstdint>
namespace cg = cooperative_groups;

#ifndef FUSED
#define FUSED 1
#endif
#define REP0 1
#define REP1 1
#define REP2 1
#define REP3 1
#define REP4 1

#define DI __device__ __forceinline__
typedef unsigned short u16;
using bf16x8 = __attribute__((ext_vector_type(8))) short;
using s16x4 = __attribute__((ext_vector_type(4))) short;
using f32x4 = __attribute__((ext_vector_type(4))) float;
using f32x16 = __attribute__((ext_vector_type(16))) float;
using u32x4 = __attribute__((ext_vector_type(4))) unsigned;
using u32x2 = __attribute__((ext_vector_type(2))) unsigned;
typedef __bf16 bf2_t __attribute__((ext_vector_type(2)));
typedef float fl2_t __attribute__((ext_vector_type(2)));

constexpr int NTHREADS = 512;
constexpr int SEQ = 4096, DM = 1024, DIN = 3864, NROWS = 32768;
constexpr int LDK = 1088;
constexpr float EPS = 1e-6f;
constexpr float QSCALE = 0.125f * 1.4426950408889634f;
constexpr int SMEM_BYTES = 148480;

__constant__ float c_invf[8] = {1.0f, 0.1939227432012558f, 0.03760603070259094f, 0.007292664609849453f,
                                0.0014142135623842478f, 0.00027424818836152554f, 5.3182957344688475e-05f, 1.0313385246263351e-05f};

DI unsigned cvtpk(float lo, float hi) {
  fl2_t f = {lo, hi};
  bf2_t b = __builtin_convertvector(f, bf2_t);
  return __builtin_bit_cast(unsigned, b);
}
DI u16 f2bf(float x) { return (u16)(cvtpk(x, 0.f) & 0xffffu); }
DI float bf2f(u16 v) { return __uint_as_float(((unsigned)v) << 16); }
DI float bflo(unsigned v) { return __uint_as_float(v << 16); }
DI float bfhi(unsigned v) { return __uint_as_float(v & 0xffff0000u); }
DI float sigmoidf_(float v) { return __builtin_amdgcn_rcpf(1.0f + __builtin_amdgcn_exp2f(-1.4426950408889634f * v)); }
DI float siluf_(float v) { return v * __builtin_amdgcn_rcpf(1.0f + __builtin_amdgcn_exp2f(-1.4426950408889634f * v)); }
DI void glds16(const void* g, unsigned lds_base) {
  unsigned sv;
  asm volatile("s_mov_b32 %0, m0\n\ts_mov_b32 m0, %2\n\ts_nop 0\n\tglobal_load_lds_dwordx4 %1, off\n\ts_mov_b32 m0, %0" : "=&s"(sv) : "v"(g), "s"(lds_base) : "memory");
}
#define MFMA16(a, b, c) __builtin_amdgcn_mfma_f32_16x16x32_bf16((a), (b), (c), 0, 0, 0)
#define MFMA32(a, b, c) __builtin_amdgcn_mfma_f32_32x32x16_bf16((a), (b), (c), 0, 0, 0)

struct Params {
  const float *x, *norm_w, *w_in, *q_norm_w, *k_norm_w, *ck_pos, *ck_w1, *ck_b1, *ck_w2, *cv_pos, *cv_w1, *cv_b1, *cv_w2, *conv_w, *conv_b, *w_out;
  float* out;
  char* ws;
};
constexpr size_t al256(size_t v) { return (v + 255) & ~(size_t)255; }
constexpr size_t OFF_xb = 0;
DI u16* ws_xb(const Params& p) { return (u16*)(p.ws + OFF_xb); }
constexpr size_t OFF_winT = OFF_xb + al256((size_t)NROWS * LDK * 2);
DI u16* ws_winT(const Params& p) { return (u16*)(p.ws + OFF_winT); }
constexpr size_t OFF_woutT = OFF_winT + al256((size_t)4096 * LDK * 2);
DI u16* ws_woutT(const Params& p) { return (u16*)(p.ws + OFF_woutT); }
constexpr size_t OFF_w1kT = OFF_woutT + al256((size_t)1024 * LDK * 2);
DI u16* ws_w1kT(const Params& p) { return (u16*)(p.ws + OFF_w1kT); }
constexpr size_t OFF_w1vT = OFF_w1kT + al256((size_t)128 * 2048 * 2);
DI u16* ws_w1vT(const Params& p) { return (u16*)(p.ws + OFF_w1vT); }
constexpr size_t OFF_w2kT = OFF_w1vT + al256((size_t)128 * 2048 * 2);
DI u16* ws_w2kT(const Params& p) { return (u16*)(p.ws + OFF_w2kT); }
constexpr size_t OFF_w2vT = OFF_w2kT + al256((size_t)64 * 128 * 2);
DI u16* ws_w2vT(const Params& p) { return (u16*)(p.ws + OFF_w2vT); }
constexpr size_t OFF_Q = OFF_w2vT + al256((size_t)64 * 128 * 2);
DI u16* ws_Q(const Params& p) { return (u16*)(p.ws + OFF_Q); }
constexpr size_t OFF_Ks = OFF_Q + al256((size_t)NROWS * 512 * 2);
DI u16* ws_Ks(const Params& p) { return (u16*)(p.ws + OFF_Ks); }
constexpr size_t OFF_Kw = OFF_Ks + al256((size_t)16 * 4096 * 64 * 2);
DI u16* ws_Kw(const Params& p) { return (u16*)(p.ws + OFF_Kw); }
constexpr size_t OFF_Vst = OFF_Kw + al256((size_t)16 * 4096 * 64 * 2);
DI u16* ws_Vst(const Params& p) { return (u16*)(p.ws + OFF_Vst); }
constexpr size_t OFF_Vwt = OFF_Vst + al256((size_t)16 * 4096 * 64 * 2);
DI u16* ws_Vwt(const Params& p) { return (u16*)(p.ws + OFF_Vwt); }
constexpr size_t OFF_kcraw = OFF_Vwt + al256((size_t)16 * 4096 * 64 * 2);
DI u16* ws_kcraw(const Params& p) { return (u16*)(p.ws + OFF_kcraw); }
constexpr size_t OFF_vcraw = OFF_kcraw + al256((size_t)16 * 4096 * 64 * 2 + 4096);
DI u16* ws_vcraw(const Params& p) { return (u16*)(p.ws + OFF_vcraw); }
constexpr size_t OFF_Kc = OFF_vcraw + al256((size_t)16 * 4096 * 64 * 2 + 4096);
DI u16* ws_Kc(const Params& p) { return (u16*)(p.ws + OFF_Kc); }
constexpr size_t OFF_Vct = OFF_Kc + al256((size_t)16 * 256 * 64 * 2);
DI u16* ws_Vct(const Params& p) { return (u16*)(p.ws + OFF_Vct); }
constexpr size_t OFF_zs = OFF_Vct + al256((size_t)16 * 256 * 64 * 2);
DI u16* ws_zs(const Params& p) { return (u16*)(p.ws + OFF_zs); }
constexpr size_t OFF_cvb = OFF_zs + al256((size_t)NROWS * 512 * 2);
DI u16* ws_cvb(const Params& p) { return (u16*)(p.ws + OFF_cvb); }
constexpr size_t OFF_mix = OFF_cvb + al256((size_t)NROWS * 2048 * 2);
DI u16* ws_mix(const Params& p) { return (u16*)(p.ws + OFF_mix); }
constexpr size_t OFF_rs = OFF_mix + al256((size_t)NROWS * LDK * 2);
DI float* ws_rs(const Params& p) { return (float*)(p.ws + OFF_rs); }
constexpr size_t OFF_ckpart = OFF_rs + al256((size_t)NROWS * 4);
DI float* ws_ckpart(const Params& p) { return (float*)(p.ws + OFF_ckpart); }
constexpr size_t OFF_rope = OFF_ckpart + al256((size_t)16 * 128 * 4);
DI float* ws_rope(const Params& p) { return (float*)(p.ws + OFF_rope); }
constexpr size_t OFF_gates = OFF_rope + al256((size_t)4096 * 8 * 2 * 4);
DI float* ws_gates(const Params& p) { return (float*)(p.ws + OFF_gates); }
constexpr size_t OFF_counter = OFF_gates + al256((size_t)NROWS * 24 * 4);
DI unsigned* ws_counter(const Params& p) { return (unsigned*)(p.ws + OFF_counter); }
constexpr size_t WS_TOTAL = OFF_counter + al256((size_t)256);


DI void transpose_tile(const float* __restrict__ src, u16* __restrict__ dst, int K, int N, const float* __restrict__ scale, int kt, int nt, char* smem, int ldd) {
  float* tile = (float*)smem;
  const int tid = threadIdx.x;
#pragma unroll
  for (int i = 0; i < 8; ++i) {
    const int kk = i * 8 + (tid >> 6), nn = tid & 63, n = nt * 64 + nn, k = kt * 64 + kk;
    float v = (n < N) ? src[(size_t)k * N + n] : 0.f;
    if (scale) v *= scale[k];
    tile[kk * 65 + nn] = v;
  }
  __syncthreads();
#pragma unroll
  for (int i = 0; i < 8; ++i) {
    const int nn = i * 8 + (tid >> 6), kk = tid & 63;
    dst[(size_t)(nt * 64 + nn) * ldd + kt * 64 + kk] = f2bf(tile[kk * 65 + nn]);
  }
  __syncthreads();
}

__device__ void phase_prep(const Params& p, char* smem, int bid, int nb) {
  int tid_ = threadIdx.x; asm volatile("" : "+v"(tid_));
  const int tid = tid_, lane = tid & 63, wid = __builtin_amdgcn_readfirstlane(tid >> 6);
  constexpr int J_X = 1024, J_TW = 1024, J_TO = 256, J_T1 = 64, J_T2 = 2, J_CK = 16, J_ROPE = 64;
  constexpr int TOTAL = J_X + J_TW + J_TO + 2 * J_T1 + 2 * J_T2 + J_CK + J_ROPE;
  if (bid == 0 && tid < 8) ws_counter(p)[tid] = 0u;
  for (int j = bid; j < TOTAL; j += nb) {
    int jj = j;
    if (jj < J_X) {
      const int row0 = jj * 32 + wid * 4;
      float4 v[4][4]; float ss[4];
#pragma unroll
      for (int r = 0; r < 4; ++r) {
        const float4* xr = (const float4*)(p.x + (size_t)(row0 + r) * DM);
#pragma unroll
        for (int i = 0; i < 4; ++i) v[r][i] = xr[i * 64 + lane];
      }
#pragma unroll
      for (int r = 0; r < 4; ++r) {
        float a = 0.f;
#pragma unroll
        for (int i = 0; i < 4; ++i) a += v[r][i].x * v[r][i].x + v[r][i].y * v[r][i].y + v[r][i].z * v[r][i].z + v[r][i].w * v[r][i].w;
#pragma unroll
        for (int o = 32; o >= 1; o >>= 1) a += __shfl_xor(a, o);
        ss[r] = a;
      }
#pragma unroll
      for (int r = 0; r < 4; ++r) {
        if (lane == 0) ws_rs(p)[row0 + r] = rsqrtf(ss[r] * (1.0f / DM) + EPS);
#pragma unroll
        for (int i = 0; i < 4; ++i) {
          u32x2 o; o[0] = cvtpk(v[r][i].x, v[r][i].y); o[1] = cvtpk(v[r][i].z, v[r][i].w);
          const int rr_ = row0 + r;
          *(u32x2*)(ws_xb(p) + ((size_t)((rr_ >> 8) * 16 + i * 4 + (lane >> 4)) * 256 + (rr_ & 255)) * 64 + (lane & 15) * 4) = o;
        }
      }
      continue;
    }
    jj -= J_X;
    if (jj < J_TW) { transpose_tile(p.w_in, ws_winT(p), 1024, DIN, p.norm_w, jj & 15, jj >> 4, smem, LDK); continue; }
    jj -= J_TW;
    if (jj < J_TO) { transpose_tile(p.w_out, ws_woutT(p), 1024, 1024, nullptr, jj & 15, jj >> 4, smem, LDK); continue; }
    jj -= J_TO;
    if (jj < J_T1) { transpose_tile(p.ck_w1, ws_w1kT(p), 2048, 128, nullptr, jj & 31, jj >> 5, smem, 2048); continue; }
    jj -= J_T1;
    if (jj < J_T1) { transpose_tile(p.cv_w1, ws_w1vT(p), 2048, 128, nullptr, jj & 31, jj >> 5, smem, 2048); continue; }
    jj -= J_T1;
    if (jj < J_T2) { transpose_tile(p.ck_w2, ws_w2kT(p), 128, 64, nullptr, jj, 0, smem, 128); continue; }
    jj -= J_T2;
    if (jj < J_T2) { transpose_tile(p.cv_w2, ws_w2vT(p), 128, 64, nullptr, jj, 0, smem, 128); continue; }
    jj -= J_T2;
    if (jj < J_CK) {
      const int which = jj >> 3, chunk = jj & 7, hh = tid & 127, sub = tid >> 7;
      const float* pos = which ? p.cv_pos : p.ck_pos;
      const float* w1 = which ? p.cv_w1 : p.ck_w1;
      float acc = 0.f;
      const int f0 = chunk * 256 + sub * 64;
#pragma unroll 8
      for (int f = 0; f < 64; ++f) acc += pos[f0 + f] * w1[(size_t)(f0 + f) * 128 + hh];
      float* red = (float*)smem;
      red[sub * 128 + hh] = acc;
      __syncthreads();
      if (tid < 128) ws_ckpart(p)[(which * 8 + chunk) * 128 + tid] = red[tid] + red[128 + tid] + red[256 + tid] + red[384 + tid];
      __syncthreads();
      continue;
    }
    jj -= J_CK;
    {
      const int idx = jj * 512 + tid, pos = idx >> 3, fi = idx & 7;
      const float ang = (float)pos * c_invf[fi];
      float s, c; sincosf(ang, &s, &c);
      ws_rope(p)[idx * 2] = c; ws_rope(p)[idx * 2 + 1] = s;
    }
  }
}

DI int kimg_off(int row, int d) { return row * 64 + (((d >> 3) ^ ((row >> 1) & 7)) * 8) + (d & 7); }
DI int vimg_off(int d, int key) {
  const int kp = (key & ~12) | ((key & 4) << 1) | ((key & 8) >> 1);
  return d * 64 + (((kp >> 3) ^ ((d >> 1) & 7)) * 8) + (kp & 7);
}

constexpr int G_ASZ = 256 * 128, G_BSZ = 256 * 128, G_STAGE = G_ASZ + G_BSZ;
constexpr int G_ROPE = 2 * G_STAGE, G_RS = G_ROPE + 256 * 64;
static_assert(G_RS + 1024 <= SMEM_BYTES, "GEMM LDS layout exceeds the dynamic LDS size");
#define WAIT_VM(n) asm volatile("s_waitcnt vmcnt(" #n ")" ::: "memory")

template <int EPI>
__device__ void gemm_phase(const Params& p, char* smem, int bid, int nb) {
  constexpr int NT = EPI == 0 ? 16 : 4;
  constexpr int MT = 128;
  const u16* __restrict__ A = EPI == 0 ? ws_xb(p) : ws_mix(p);
  const u16* __restrict__ Bt = EPI == 0 ? ws_winT(p) : ws_woutT(p);
  int tid_ = threadIdx.x; asm volatile("" : "+v"(tid_));
  const int tid = tid_, lane = tid & 63, wid = __builtin_amdgcn_readfirstlane(tid >> 6), fr = lane & 15, fq = lane >> 4;
  const int wr = wid >> 2, wc = wid & 3;
  const bool xmap = (nb == 256);
  const int xcd = bid & 7, li = bid >> 3;
  const int ntiles = xmap ? (EPI == 0 ? 8 : 2) : (MT * NT - bid + nb - 1) / nb;
  auto tile_of = [&](int ti, int& m0, int& n0) {
    if (xmap) {
      const int sg = ti * 8 + xcd;
      if (EPI == 0) { m0 = ((sg >> 1) * 4 + (li >> 3)) * 256; n0 = ((sg & 1) * 8 + (li & 7)) * 256; }
      else { m0 = (sg * 8 + (li >> 2)) * 256; n0 = (li & 3) * 256; }
    } else { const int tile = bid + ti * nb; const int mt = tile / NT; m0 = mt * 256; n0 = (tile - mt * NT) * 256; }
  };
  const int nsteps = ntiles * 16;
  const unsigned lds0 = (unsigned)(uintptr_t)smem;
  const int gsw = (lane & 7) ^ ((wid & 1) * 4 + (lane >> 4));
  const int grow = wid * 8 + (lane >> 3);
  auto issue = [&](int step, int stage) {
    int m0, n0; tile_of(step >> 4, m0, n0);
    const int kt = step & 15;
    const u16* ag = EPI == 0 ? A + ((size_t)((m0 >> 8) * 16 + kt) * 256 + grow) * 64 + gsw * 8 : A + (size_t)(m0 + grow) * LDK + kt * 64 + gsw * 8;
    const size_t astep = EPI == 0 ? (size_t)64 * 64 : (size_t)64 * LDK;
    const int brow = EPI == 0 ? ((grow & ~31) | ((grow & 0x0C) << 1) | ((grow & 0x10) >> 2) | (grow & 3)) : grow;
    const u16* bg_ = Bt + (size_t)(n0 + brow) * LDK + kt * 64 + gsw * 8;
    const unsigned dst = (unsigned)__builtin_amdgcn_readfirstlane((int)(lds0 + stage * G_STAGE + wid * 1024));
#pragma unroll
    for (int i = 0; i < 4; ++i) glds16(ag + i * astep, dst + i * 8192);
#pragma unroll
    for (int i = 0; i < 4; ++i) glds16(bg_ + (size_t)i * 64 * LDK, dst + G_ASZ + i * 8192);
    if (EPI == 0 && kt == 8) {
      const int t0 = m0 & 4095;
      const unsigned sd = (unsigned)__builtin_amdgcn_readfirstlane((int)(lds0 + G_ROPE + wid * 1024));
      glds16(ws_rope(p) + (size_t)t0 * 16 + tid * 4, sd);
      glds16(ws_rope(p) + (size_t)t0 * 16 + (512 + tid) * 4, sd + 8192);
      if (wid == 0) glds16(ws_rs(p) + m0 + lane * 4, lds0 + G_RS);
    }
  };
  const int ca0 = ((fq ^ (fr >> 1)) * 16), ca1 = (((4 + fq) ^ (fr >> 1)) * 16);
  f32x4 acc[8][4];
#pragma unroll
  for (int m = 0; m < 8; ++m)
#pragma unroll
    for (int n = 0; n < 4; ++n) acc[m][n] = f32x4{0.f, 0.f, 0.f, 0.f};
  __syncthreads();
  if (nsteps > 0) issue(0, 0);
  for (int s = 0; s < nsteps; ++s) {
    WAIT_VM(0);
    __builtin_amdgcn_s_waitcnt(0x0F70);
    __builtin_amdgcn_s_barrier();
    if (s + 1 < nsteps) issue(s + 1, (s + 1) & 1);
    {
      const char* ab = smem + (s & 1) * G_STAGE + (wr * 128 + fr) * 128;
      const char* bb = smem + (s & 1) * G_STAGE + G_ASZ + (wc * 64 + fr) * 128;
#pragma unroll
      for (int ks = 0; ks < 2; ++ks) {
        bf16x8 af[8], bf[4];
        const int co = ks ? ca1 : ca0;
#pragma unroll
        for (int n = 0; n < 4; ++n) bf[n] = *(const bf16x8*)(bb + n * 16 * 128 + co);
#pragma unroll
        for (int m = 0; m < 8; ++m) af[m] = *(const bf16x8*)(ab + m * 16 * 128 + co);
#pragma unroll
        for (int m = 0; m < 8; ++m)
#pragma unroll
          for (int n = 0; n < 4; ++n) acc[m][n] = MFMA16(bf[n], af[m], acc[m][n]);
      }
    }
    if ((s & 15) != 15) continue;
    int m0, n0; tile_of(s >> 4, m0, n0);
    const int rbase = m0 + wr * 128;
    const int cb = n0 + wc * 64;
    if constexpr (EPI == 1) {
#pragma unroll
      for (int hm = 0; hm < 2; ++hm) {
        float4 xv[4][4];
#pragma unroll
        for (int mm = 0; mm < 4; ++mm) {
          const size_t ro = (size_t)(rbase + (hm * 4 + mm) * 16 + fr) * DM + cb + fq * 4;
#pragma unroll
          for (int n = 0; n < 4; ++n) xv[mm][n] = *(const float4*)(p.x + ro + n * 16);
        }
#pragma unroll
        for (int mm = 0; mm < 4; ++mm) {
          const int m = hm * 4 + mm;
          const size_t ro = (size_t)(rbase + m * 16 + fr) * DM + cb + fq * 4;
#pragma unroll
          for (int n = 0; n < 4; ++n) {
            float4 o; o.x = xv[mm][n].x + acc[m][n][0]; o.y = xv[mm][n].y + acc[m][n][1]; o.z = xv[mm][n].z + acc[m][n][2]; o.w = xv[mm][n].w + acc[m][n][3];
            *(float4*)(p.out + ro + n * 16) = o;
          }
        }
        __builtin_amdgcn_sched_barrier(0);
      }
    } else {
      const int b = m0 >> 12;
      const int tb = rbase & 4095;
      if (cb < 1280) {
        const int seg = cb >> 6;
        const int which = seg < 8 ? -1 : ((seg - 8) >> 1);
        const int g = seg < 8 ? (seg >> 2) : ((seg - 8) & 1);
        const bool need_norm = (seg < 8) || which == 2 || which == 4;
        const float* nw = seg < 8 ? p.q_norm_w : (p.k_norm_w + (which == 2 ? 64 : 128));
        float w[16];
#pragma unroll
        for (int k = 0; k < 16; ++k) w[k] = need_norm ? nw[(k >> 3) * 32 + fq * 8 + (k & 7)] : 1.0f;
        const float qs = seg < 8 ? QSCALE : 1.0f;
#pragma unroll
        for (int m = 0; m < 8; ++m) {
          const int t = tb + m * 16 + fr;
          const int lrow = wr * 128 + m * 16 + fr;
          const float r = *(const float*)(smem + G_RS + lrow * 4);
          float v[16];
#pragma unroll
          for (int k = 0; k < 16; ++k) v[k] = acc[m][(k >> 3) * 2 + ((k & 7) >> 2)][k & 3] * r;
          if (need_norm) {
            float ss = 0.f;
#pragma unroll
            for (int k = 0; k < 16; ++k) ss += v[k] * v[k];
            ss += __shfl_xor(ss, 16); ss += __shfl_xor(ss, 32);
            const float rr = rsqrtf(ss * (1.0f / 64.f) + EPS);
#pragma unroll
            for (int k = 0; k < 16; ++k) v[k] = v[k] * rr * w[k];
            const float4* rp = (const float4*)(smem + G_ROPE + lrow * 64);
            const float4 c01 = rp[0], c23 = rp[1], c45 = rp[2], c67 = rp[3];
            const float cc[8] = {c01.x, c01.z, c23.x, c23.z, c45.x, c45.z, c67.x, c67.z};
            const float sn[8] = {c01.y, c01.w, c23.y, c23.w, c45.y, c45.w, c67.y, c67.w};
#pragma unroll
            for (int e = 0; e < 8; ++e) {
              const float pr = __shfl_xor(v[e], 16);
              const float rot = (fq == 0) ? (v[e] * cc[e] - pr * sn[e]) : (v[e] * cc[e] + pr * sn[e]);
              v[e] = (fq < 2) ? rot : v[e];
            }
#pragma unroll
            for (int k = 0; k < 16; ++k) v[k] *= qs;
          }
          if (which == 3 || which == 5) {
            int lz = 0; asm volatile("" : "+v"(lz));
            u16* vt = (which == 3 ? ws_Vst(p) : ws_Vwt(p)) + (size_t)((b * 2 + g) * 64 + (t >> 6)) * 4096 + lz;
            const int fqx = fq + lz, key = (t & 63) + lz;
#pragma unroll
            for (int k = 0; k < 16; ++k) vt[vimg_off((k >> 3) * 32 + fqx * 8 + (k & 7), key)] = f2bf(v[k]);
          } else {
            u16* dst;
            if (seg < 8) dst = ws_Q(p) + ((size_t)((b * 2 + g) * 4096 + t) * 4 + (seg & 3)) * 64;
            else { u16* buf = which == 0 ? ws_kcraw(p) : which == 1 ? ws_vcraw(p) : which == 2 ? ws_Ks(p) : ws_Kw(p); dst = buf + ((size_t)(b * 2 + g) * 4096 + t) * 64; }
            const bool img = which >= 2;
#pragma unroll
            for (int n2 = 0; n2 < 2; ++n2) {
              u32x4 o;
#pragma unroll
              for (int e = 0; e < 4; ++e) o[e] = cvtpk(v[n2 * 8 + 2 * e], v[n2 * 8 + 2 * e + 1]);
              const int d0 = n2 * 32 + fq * 8;
              const int off = img ? (((d0 >> 3) ^ (((t & 63) >> 1) & 7)) * 8) : d0;
              *(u32x4*)(dst + off) = o;
            }
          }
          __builtin_amdgcn_sched_barrier(0);
        }
      } else {
#pragma unroll
        for (int m = 0; m < 8; ++m) {
          const size_t row = rbase + m * 16 + fr;
          const float r = *(const float*)(smem + G_RS + (wr * 128 + m * 16 + fr) * 4);
#pragma unroll
          for (int n2 = 0; n2 < 2; ++n2) {
            const int c8 = cb + n2 * 32 + fq * 8;
            if (c8 >= DIN) continue;
            float v[8];
#pragma unroll
            for (int e = 0; e < 8; ++e) v[e] = acc[m][n2 * 2 + (e >> 2)][e & 3] * r;
            if (c8 < 1304) {
              float4 o0, o1;
              o0.x = sigmoidf_(v[0]); o0.y = sigmoidf_(v[1]); o0.z = sigmoidf_(v[2]); o0.w = sigmoidf_(v[3]);
              o1.x = sigmoidf_(v[4]); o1.y = sigmoidf_(v[5]); o1.z = sigmoidf_(v[6]); o1.w = sigmoidf_(v[7]);
              float* gp = ws_gates(p) + row * 24 + (c8 - 1280);
              *(float4*)gp = o0; *(float4*)(gp + 4) = o1;
            } else if (c8 < 1816) {
              u32x4 o;
#pragma unroll
              for (int e = 0; e < 4; ++e) o[e] = cvtpk(siluf_(v[2 * e]), siluf_(v[2 * e + 1]));
              *(u32x4*)(ws_zs(p) + row * 512 + (c8 - 1304)) = o;
            } else {
              u32x4 o;
#pragma unroll
              for (int e = 0; e < 4; ++e) o[e] = cvtpk(v[2 * e], v[2 * e + 1]);
              *(u32x4*)(ws_cvb(p) + row * 2048 + (c8 - 1816)) = o;
            }
          }
          __builtin_amdgcn_sched_barrier(0);
        }
      }
    }
#pragma unroll
    for (int m = 0; m < 8; ++m)
#pragma unroll
      for (int n = 0; n < 4; ++n) acc[m][n] = f32x4{0.f, 0.f, 0.f, 0.f};
  }
}

__device__ void phase_cmp_conv(const Params& p, char* smem, int bid, int nb) {
  int tid_ = threadIdx.x; asm volatile("" : "+v"(tid_));
  const int tid = tid_, lane = tid & 63, wid = __builtin_amdgcn_readfirstlane(tid >> 6), fr = lane & 15, fq = lane >> 4;
  float* part = (float*)smem;
  char* hl = smem + 8 * 16 * 132 * 4;
  float* outl = (float*)(hl + 2 * 4352);
  for (int job = bid; job < 256; job += nb) {
    const int which = wid >> 2, w4 = wid & 3, bg = job >> 4, ct = job & 15;
    const u16* raw = (which ? ws_vcraw(p) : ws_kcraw(p)) + (size_t)bg * 4096 * 64;
    const u16* w1T = which ? ws_w1vT(p) : ws_w1kT(p);
    const u16* w2T = which ? ws_w2vT(p) : ws_w2kT(p);
    const float* b1 = which ? p.cv_b1 : p.ck_b1;
    f32x4 acc[8];
#pragma unroll
    for (int n = 0; n < 8; ++n) acc[n] = f32x4{0.f, 0.f, 0.f, 0.f};
    const int c = ct * 16 + fr;
    const int ht = tid & 255, rrow = ht >> 4, c8 = (ht & 15) * 8;
    float bias[8];
#pragma unroll
    for (int e = 0; e < 8; ++e) {
      float bsum = b1[c8 + e];
#pragma unroll
      for (int ch = 0; ch < 8; ++ch) bsum += ws_ckpart(p)[(which * 8 + ch) * 128 + c8 + e];
      bias[e] = bsum;
    }
    bf16x8 w2f[4];
#pragma unroll
    for (int ks = 0; ks < 4; ++ks) w2f[ks] = *(const bf16x8*)(w2T + (size_t)(w4 * 16 + fr) * 128 + ks * 32 + fq * 8);
    const int orow = ht >> 4, d4 = (ht & 15) * 4;
    const int cc = ct * 16 + orow;
    float nwv[4], nwp[4]; float2 csv[4];
    {
      int pos = cc * 16 + 31; pos = pos > 4095 ? 4095 : pos;
#pragma unroll
      for (int e = 0; e < 4; ++e) {
        const int d = d4 + e;
        nwv[e] = p.k_norm_w[d]; nwp[e] = p.k_norm_w[d ^ 8];
        csv[e] = *(const float2*)(ws_rope(p) + ((size_t)pos * 8 + (d & 7)) * 2);
      }
    }
#pragma unroll 4
    for (int k16 = 0; k16 < 16; ++k16) {
      const int ks = w4 * 16 + k16;
      const int l = ks >> 1, d0 = (ks & 1) * 32 + fq * 8;
      int tt = c * 16 + l; tt = tt > 4095 ? 4095 : tt;
      const bf16x8 a = *(const bf16x8*)(raw + (size_t)tt * 64 + d0);
#pragma unroll
      for (int n = 0; n < 8; ++n) {
        const bf16x8 bb = *(const bf16x8*)(w1T + (size_t)(n * 16 + fr) * 2048 + ks * 32 + fq * 8);
        acc[n] = MFMA16(a, bb, acc[n]);
      }
    }
#pragma unroll
    for (int n = 0; n < 8; ++n)
#pragma unroll
      for (int j = 0; j < 4; ++j) part[(wid * 16 + fq * 4 + j) * 132 + n * 16 + fr] = acc[n][j];
    __syncthreads();
    {
      float sum[8];
#pragma unroll
      for (int e = 0; e < 8; ++e) sum[e] = bias[e];
#pragma unroll
      for (int w = 0; w < 4; ++w) {
        const float4 v0 = *(const float4*)(part + ((which * 4 + w) * 16 + rrow) * 132 + c8), v1 = *(const float4*)(part + ((which * 4 + w) * 16 + rrow) * 132 + c8 + 4);
        sum[0] += v0.x; sum[1] += v0.y; sum[2] += v0.z; sum[3] += v0.w; sum[4] += v1.x; sum[5] += v1.y; sum[6] += v1.z; sum[7] += v1.w;
      }
      u32x4 o;
#pragma unroll
      for (int e = 0; e < 4; ++e) o[e] = cvtpk(siluf_(sum[2 * e]), siluf_(sum[2 * e + 1]));
      *(u32x4*)(hl + which * 4352 + rrow * 272 + c8 * 2) = o;
    }
    __syncthreads();
    {
      f32x4 o2 = f32x4{0.f, 0.f, 0.f, 0.f};
#pragma unroll
      for (int ks = 0; ks < 4; ++ks) {
        const bf16x8 a = *(const bf16x8*)(hl + which * 4352 + fr * 272 + (ks * 32 + fq * 8) * 2);
        o2 = MFMA16(a, w2f[ks], o2);
      }
#pragma unroll
      for (int j = 0; j < 4; ++j) outl[which * 1088 + (fq * 4 + j) * 68 + w4 * 16 + fr] = o2[j];
    }
    __syncthreads();
    {
      const float* ol = outl + which * 1088;
      const float4 v = *(const float4*)(ol + orow * 68 + d4);
      if (which == 0) {
        float ss = v.x * v.x + v.y * v.y + v.z * v.z + v.w * v.w;
        ss += __shfl_xor(ss, 1); ss += __shfl_xor(ss, 2); ss += __shfl_xor(ss, 4); ss += __shfl_xor(ss, 8);
        const float rr = rsqrtf(ss * (1.0f / 64.f) + EPS);
        float o[4] = {v.x * rr * nwv[0], v.y * rr * nwv[1], v.z * rr * nwv[2], v.w * rr * nwv[3]};
        if (d4 < 16) {
#pragma unroll
          for (int e = 0; e < 4; ++e) {
            const int d = d4 + e, dp = d ^ 8;
            const float pr = ol[orow * 68 + dp] * rr * nwp[e];
            o[e] = (d < 8) ? (o[e] * csv[e].x - pr * csv[e].y) : (o[e] * csv[e].x + pr * csv[e].y);
          }
        }
        u32x2 ov; ov[0] = cvtpk(o[0], o[1]); ov[1] = cvtpk(o[2], o[3]);
        if (cc >= 255) { ov[0] = 0u; ov[1] = 0u; }
        *(u32x2*)(ws_Kc(p) + (size_t)(bg * 4 + (cc >> 6)) * 4096 + kimg_off(cc & 63, d4)) = ov;
      } else {
        const float z = (cc >= 255) ? 0.f : 1.f;
        u16* vt = ws_Vct(p) + (size_t)(bg * 4 + (cc >> 6)) * 4096;
        vt[vimg_off(d4 + 0, cc & 63)] = f2bf(v.x * z); vt[vimg_off(d4 + 1, cc & 63)] = f2bf(v.y * z);
        vt[vimg_off(d4 + 2, cc & 63)] = f2bf(v.z * z); vt[vimg_off(d4 + 3, cc & 63)] = f2bf(v.w * z);
      }
    }
    __syncthreads();
  }
  const int gw = bid * 8 + wid, nw = nb * 8;
  for (int chunk = gw; chunk < 2048; chunk += nw) {
    const int r0 = chunk * 16, t0 = r0 & 4095;
    const int ch = lane * 8;
    float cw0[8], cw1[8], cw2[8], cbv[8], u1[8], u2[8];
#pragma unroll
    for (int e = 0; e < 8; ++e) { cw0[e] = p.conv_w[ch + e]; cw1[e] = p.conv_w[512 + ch + e]; cw2[e] = p.conv_w[1024 + ch + e]; cbv[e] = p.conv_b[ch + e]; u1[e] = 0.f; u2[e] = 0.f; }
    if (t0 > 0) {
#pragma unroll
      for (int q = 0; q < 2; ++q) {
        const u16* rp = ws_cvb(p) + (size_t)(r0 - 2 + q) * 2048 + ch;
        const u32x4 hv = *(const u32x4*)(rp), cv = *(const u32x4*)(rp + 1024);
#pragma unroll
        for (int e = 0; e < 4; ++e) {
          const float ua = bflo(hv[e]) * bflo(cv[e]), ub = bfhi(hv[e]) * bfhi(cv[e]);
          if (q == 0) { u2[2 * e] = ua; u2[2 * e + 1] = ub; } else { u1[2 * e] = ua; u1[2 * e + 1] = ub; }
        }
      }
    }
#pragma unroll 4
    for (int rr = 0; rr < 16; ++rr) {
      const u16* rp = ws_cvb(p) + (size_t)(r0 + rr) * 2048 + ch;
      const u32x4 hv = *(const u32x4*)(rp), bv = *(const u32x4*)(rp + 512), cv = *(const u32x4*)(rp + 1024), zv = *(const u32x4*)(rp + 1536);
      u32x4 ov;
#pragma unroll
      for (int e = 0; e < 4; ++e) {
        const float ua = bflo(hv[e]) * bflo(cv[e]), ub = bfhi(hv[e]) * bfhi(cv[e]);
        const float ca = cw0[2 * e] * u2[2 * e] + cw1[2 * e] * u1[2 * e] + cw2[2 * e] * ua + cbv[2 * e];
        const float cbb = cw0[2 * e + 1] * u2[2 * e + 1] + cw1[2 * e + 1] * u1[2 * e + 1] + cw2[2 * e + 1] * ub + cbv[2 * e + 1];
        const float oa = bflo(bv[e]) * ca * siluf_(bflo(zv[e]));
        const float ob = bfhi(bv[e]) * cbb * siluf_(bfhi(zv[e]));
        ov[e] = cvtpk(oa, ob);
        u2[2 * e] = u1[2 * e]; u2[2 * e + 1] = u1[2 * e + 1]; u1[2 * e] = ua; u1[2 * e + 1] = ub;
      }
      *(u32x4*)(ws_mix(p) + (size_t)(r0 + rr) * LDK + 512 + ch) = ov;
    }
  }
}

constexpr int AT_NST = 5, AT_KB = 8192, AT_BUF = 16384;
constexpr int AT_F = AT_NST * AT_BUF, AT_IMPA = AT_F, AT_IMPB = AT_IMPA + 64 * 65 * 4, AT_VAL = AT_IMPA;
constexpr int AT_SELM = AT_F + 8 * 8192, AT_UNIT = AT_SELM + 512, AT_END = AT_UNIT + 16;
static_assert(AT_END <= SMEM_BYTES, "attention LDS layout exceeds the dynamic LDS size");

__device__ void phase_attn(const Params& p, char* smem, int bid, int nb, int rep) {
  int tid_ = threadIdx.x; asm volatile("" : "+v"(tid_));
  const int tid = tid_, lane = tid & 63, wid = __builtin_amdgcn_readfirstlane(tid >> 6), c32 = lane & 31, h = lane >> 5;
  const float NINF = -__builtin_inff();
  float* impa = (float*)(smem + AT_IMPA);
  float* impb = (float*)(smem + AT_IMPB);
  float* vals = (float*)(smem + AT_VAL);
  unsigned* selm = (unsigned*)(smem + AT_SELM);
  volatile int* s_unit = (volatile int*)(smem + AT_UNIT);
  const unsigned lds0 = (unsigned)(uintptr_t)smem;
  while (true) {
    if (tid == 0) *s_unit = (int)atomicAdd(ws_counter(p) + rep, 1u);
    __syncthreads();
    const int u = __builtin_amdgcn_readfirstlane(*s_unit);
    __syncthreads();
    if (u >= 1024) break;
    const int i = 63 - (u >> 4), bg = u & 15, b = bg >> 1, g = bg & 1;
    const int tl = wid * 8 + (c32 >> 2), hd = c32 & 3;
    const int t = i * 64 + tl;
    const u16* qrow = ws_Q(p) + ((size_t)(bg * 4096 + i * 64) * 4 + wid * 32 + c32) * 64;
    bf16x8 qf[4];
#pragma unroll
    for (int ks = 0; ks < 4; ++ks) qf[ks] = *(const bf16x8*)(qrow + ks * 16 + h * 8);
    const float* gp = ws_gates(p) + (size_t)(b * 4096 + t) * 24 + (g * 4 + hd) * 3;
    const float g0 = gp[0], g1 = gp[1], g2 = gp[2];
    asm volatile("" :: "v"(qf[0]), "v"(qf[1]), "v"(qf[2]), "v"(qf[3]), "v"(g0), "v"(g1), "v"(g2));
    const int ntc = (4 * i + 2) / 64 + 1, nsl = i + 1, nwin = (i < 8 ? i : 8) + 1;
    const int NT = 2 * ntc + nsl + nwin;
    const bool need_sel = i >= 16;

    f32x16 O0, O1;
#pragma unroll
    for (int r = 0; r < 16; ++r) { O0[r] = 0.f; O1[r] = 0.f; }
    float* fl = (float*)(smem + AT_F + wid * 8192) + lane;
    float m_run = NINF, l_run = 0.f, inv_l = 0.f;
    float oscale = 1.0f;
    unsigned sel_lo = 0xffffffffu, sel_hi = 0xffffffffu;
#define TILE_PTRS(n, kp, vp) do { \
      if ((n) < 2 * ntc) { const int tt_ = (n) < ntc ? (n) : (n) - ntc; kp = ws_Kc(p) + (size_t)(bg * 4 + tt_) * 4096; vp = ws_Vct(p) + (size_t)(bg * 4 + tt_) * 4096; } \
      else if ((n) < 2 * ntc + nsl) { const int j_ = (n) - 2 * ntc; kp = ws_Ks(p) + ((size_t)bg * 4096 + j_ * 64) * 64; vp = ws_Vst(p) + (size_t)(bg * 64 + j_) * 4096; } \
      else { const int j_ = i - nwin + 1 + ((n) - 2 * ntc - nsl); kp = ws_Kw(p) + ((size_t)bg * 4096 + j_ * 64) * 64; vp = ws_Vwt(p) + (size_t)(bg * 64 + j_) * 4096; } } while (0)
#define TISSUE(n, st_) do { const u16 *kp_, *vp_; TILE_PTRS(n, kp_, vp_); \
      const unsigned d_ = (unsigned)__builtin_amdgcn_readfirstlane((int)(lds0 + (st_) * AT_BUF + wid * 1024)); \
      glds16(kp_ + tid * 8, d_); glds16(vp_ + tid * 8, d_ + AT_KB); } while (0)
    {
      const int npre = NT < AT_NST - 1 ? NT : AT_NST - 1;
      for (int n = 0; n < npre; ++n) TISSUE(n, n);
    }
    int st_cur = 0, st_iss = AT_NST - 1;
    const int ksw = (c32 >> 1) & 7;
    for (int n = 0; n < NT; ++n) {
      {
        const int rem = NT - 1 - n;
        if (rem >= 3) WAIT_VM(6); else if (rem == 2) WAIT_VM(4); else if (rem == 1) WAIT_VM(2); else WAIT_VM(0);
        __builtin_amdgcn_s_barrier();
        if (n + AT_NST - 1 < NT) TISSUE(n + AT_NST - 1, st_iss);
      }
      int mode, base, lo, hi;
      bool full = false, lane_on = true;
      if (n < 2 * ntc) { mode = n < ntc ? 0 : 1; base = (n < ntc ? n : n - ntc) * 64; lo = -1; hi = (t - 31) >> 4; }
      else if (n < 2 * ntc + nsl) { const int j = n - 2 * ntc; mode = 2; base = j * 64; const unsigned bit = j < 32 ? (sel_lo >> j) & 1u : (sel_hi >> (j - 32)) & 1u; lo = -1; hi = bit ? t : -1; full = j < i; lane_on = bit != 0u; }
      else { const int j = i - nwin + 1 + (n - 2 * ntc - nsl); mode = 3; base = j * 64; lo = t - 512; hi = t; full = (j < i) && (j > i - 8); }
      const int lo_rel = lo - (base + 4 * h), hi_rel = hi - (base + 4 * h);
#pragma unroll
      for (int r = 0; r < 16; ++r) { O0[r] *= oscale; O1[r] *= oscale; }
      const char* kb = smem + st_cur * AT_BUF;
      const char* vb = kb + AT_KB;
      st_cur = st_cur == AT_NST - 1 ? 0 : st_cur + 1; st_iss = st_iss == AT_NST - 1 ? 0 : st_iss + 1;
      f32x16 S0, S1;
#define ATT_BODY(MASKED) do { \
      _Pragma("unroll") for (int r = 0; r < 16; ++r) { S0[r] = 0.f; S1[r] = 0.f; } \
      { \
        bf16x8 kf0[4], kf1[4]; \
        _Pragma("unroll") for (int ks = 0; ks < 4; ++ks) { \
          kf0[ks] = *(const bf16x8*)(kb + c32 * 128 + (((ks * 2 + h) ^ ksw) * 16)); \
          kf1[ks] = *(const bf16x8*)(kb + (32 + c32) * 128 + (((ks * 2 + h) ^ ksw) * 16)); \
        } \
        _Pragma("unroll") for (int ks = 0; ks < 4; ++ks) S0 = MFMA32(kf0[ks], qf[ks], S0);     \
        _Pragma("unroll") for (int ks = 0; ks < 4; ++ks) S1 = MFMA32(kf1[ks], qf[ks], S1); \
      } \
        \
      if (MASKED) { \
        _Pragma("unroll") for (int r = 0; r < 16; ++r) { \
          const int off = (r & 3) + 8 * (r >> 2); \
          S0[r] = (off > lo_rel && off <= hi_rel) ? S0[r] : NINF; \
          S1[r] = (off + 32 > lo_rel && off + 32 <= hi_rel) ? S1[r] : NINF; \
        } \
      } \
      const float m_use = (m_run == NINF) ? 0.f : m_run; \
      const float msub = (!(MASKED) && !lane_on) ? __builtin_inff() : m_use; \
      float ps0 = 0.f, ps1 = 0.f; \
      bf16x8 vfa[4]; \
      _Pragma("unroll") for (int kk = 0; kk < 2; ++kk) \
        _Pragma("unroll") for (int dr = 0; dr < 2; ++dr) vfa[kk * 2 + dr] = *(const bf16x8*)(vb + (32 * dr + c32) * 128 + (((2 * kk + h) ^ ksw) * 16)); \
      _Pragma("unroll") for (int r = 0; r < 16; ++r) { S0[r] = __builtin_amdgcn_exp2f(S0[r] - msub); ps0 += S0[r]; } \
      _Pragma("unroll") for (int kk = 0; kk < 2; ++kk) { \
        u32x4 pw; \
        _Pragma("unroll") for (int e = 0; e < 4; ++e) pw[e] = cvtpk(S0[8 * kk + 2 * e], S0[8 * kk + 2 * e + 1]); \
        const bf16x8 pf = __builtin_bit_cast(bf16x8, pw); \
        O0 = MFMA32(vfa[kk * 2], pf, O0); O1 = MFMA32(vfa[kk * 2 + 1], pf, O1); \
      } \
      __builtin_amdgcn_sched_group_barrier(0x100, 12, 0);     \
      __builtin_amdgcn_sched_group_barrier(0x008, 4, 0);      \
      _Pragma("unroll") for (int q_ = 0; q_ < 4; ++q_) { __builtin_amdgcn_sched_group_barrier(0x008, 1, 0); __builtin_amdgcn_sched_group_barrier(0x002, 9, 0); }     \
      __builtin_amdgcn_sched_barrier(0); \
      _Pragma("unroll") for (int r = 0; r < 16; ++r) { S1[r] = __builtin_amdgcn_exp2f(S1[r] - msub); ps1 += S1[r]; } \
      _Pragma("unroll") for (int kk = 0; kk < 2; ++kk) { \
        u32x4 pw; \
        _Pragma("unroll") for (int e = 0; e < 4; ++e) pw[e] = cvtpk(S1[8 * kk + 2 * e], S1[8 * kk + 2 * e + 1]); \
        const bf16x8 pf = __builtin_bit_cast(bf16x8, pw); \
        const bf16x8 va0 = *(const bf16x8*)(vb + c32 * 128 + (((2 * (kk + 2) + h) ^ ksw) * 16)), va1 = *(const bf16x8*)(vb + (32 + c32) * 128 + (((2 * (kk + 2) + h) ^ ksw) * 16)); \
        O0 = MFMA32(va0, pf, O0); O1 = MFMA32(va1, pf, O1); \
      } \
      __builtin_amdgcn_sched_barrier(0); \
      oscale = 1.0f; \
      if (mode != 1) { \
        float mxp = fmaxf(fmaxf(S0[0], S0[1]), S1[0]); \
        mxp = fmaxf(fmaxf(mxp, S1[1]), S0[2]); \
        _Pragma("unroll") for (int r = 2; r < 16; r += 2) { \
          if (r > 2) mxp = fmaxf(fmaxf(mxp, S0[r]), S1[r - 1]); \
          mxp = fmaxf(fmaxf(mxp, S0[r + 1]), S1[r]); \
        } \
        mxp = fmaxf(mxp, S1[15]); \
        mxp = fmaxf(mxp, __shfl_xor(mxp, 32));            \
        const bool mv = (m_run == NINF) ? (mxp > 0.f) : (mxp > 256.0f); \
        const float alpha = mv ? __builtin_amdgcn_rcpf(mxp) : 1.0f; \
        m_run = mv ? (m_use + __builtin_amdgcn_logf(mxp)) : m_run; \
        l_run = (l_run + ps0 + ps1) * alpha; \
        oscale = alpha; \
      } \
      if ((MASKED) && mode == 1 && need_sel) {               \
        const int tt = base >> 6; \
        _Pragma("unroll") for (int kr = 0; kr < 2; ++kr) \
          _Pragma("unroll") for (int rg = 0; rg < 4; ++rg) { \
            float pv[4]; \
            _Pragma("unroll") for (int e = 0; e < 4; ++e) { \
              float v = (kr ? S1[rg * 4 + e] : S0[rg * 4 + e]) * inv_l; \
              v += __shfl_xor(v, 1); v += __shfl_xor(v, 2); \
              pv[e] = v; \
            } \
            if (hd == 0) { \
              const int nblk = tt * 16 + 8 * kr + 2 * rg + h; \
              impa[tl * 65 + nblk] = pv[0] + pv[1] + pv[2] + 0.5f * pv[3]; \
              impb[tl * 65 + nblk] = 0.5f * pv[3]; \
            } \
          } \
      } } while (0)
      if (full) ATT_BODY(false); else ATT_BODY(true);
#undef ATT_BODY
      if (n == ntc - 1) {
        const float lt = l_run + __shfl_xor(l_run, 32);
        inv_l = lt > 0.f ? 1.0f / lt : 0.f;
        oscale = 0.f;
      } else if (n == 2 * ntc - 1) {
        if (need_sel) {
          __syncthreads();
          const int tk = tid >> 3, nb0 = (tid & 7) * 8;
          float myv[8];
#pragma unroll
          for (int e = 0; e < 8; ++e) {
            const int nn = nb0 + e;
            const bool forced = (nn == 0) || (nn == i) || (nn == i - 1);
            float v = -1.0f;
            if (nn <= i) v = impa[tk * 65 + nn] + (nn > 0 ? impb[tk * 65 + nn - 1] : 0.f);
            if (forced) v = 1e9f;
            myv[e] = v;
            vals[tk * 65 + nn] = v;
          }
          __syncthreads();
          int cnt[8];
#pragma unroll
          for (int e = 0; e < 8; ++e) cnt[e] = 0;
          for (int mm = 0; mm < 64; ++mm) {
            const float vm = vals[tk * 65 + mm];
#pragma unroll
            for (int e = 0; e < 8; ++e) cnt[e] += (vm > myv[e] || (vm == myv[e] && mm < nb0 + e)) ? 1 : 0;
          }
          unsigned bits = 0;
#pragma unroll
          for (int e = 0; e < 8; ++e) bits |= (cnt[e] < 16 ? 1u : 0u) << e;
          unsigned wlo = (tid & 7) < 4 ? bits << (8 * (tid & 7)) : 0u;
          unsigned whi = (tid & 7) >= 4 ? bits << (8 * ((tid & 7) - 4)) : 0u;
          wlo |= __shfl_xor(wlo, 1); wlo |= __shfl_xor(wlo, 2); wlo |= __shfl_xor(wlo, 4);
          whi |= __shfl_xor(whi, 1); whi |= __shfl_xor(whi, 2); whi |= __shfl_xor(whi, 4);
          if ((tid & 7) == 0) { selm[tk * 2] = wlo; selm[tk * 2 + 1] = whi; }
          __syncthreads();
          sel_lo = selm[tl * 2]; sel_hi = selm[tl * 2 + 1];
        }
        {
          const float wgt = g0 * inv_l * oscale;
#pragma unroll
          for (int r = 0; r < 16; ++r) { fl[r * 64] = wgt * O0[r]; fl[(16 + r) * 64] = wgt * O1[r]; }
          m_run = NINF; l_run = 0.f; oscale = 0.f;
        }
      } else if (n == 2 * ntc + nsl - 1) {
        const float lt = l_run + __shfl_xor(l_run, 32);
        const float wgt = g1 * (lt > 0.f ? 1.0f / lt : 0.f) * oscale;
#pragma unroll
        for (int r = 0; r < 16; ++r) { fl[r * 64] += wgt * O0[r]; fl[(16 + r) * 64] += wgt * O1[r]; }
        m_run = NINF; l_run = 0.f; oscale = 0.f;
      }
    }
#undef TILE_PTRS
#undef TISSUE
    {
      const float lt = l_run + __shfl_xor(l_run, 32);
      const float wgt = g2 * (lt > 0.f ? 1.0f / lt : 0.f) * oscale;
      const size_t rowo = (size_t)(b * 4096 + t);
      const u16* zp = ws_zs(p) + rowo * 512 + (g * 4 + hd) * 64;
      u16* mp = ws_mix(p) + rowo * LDK + (g * 4 + hd) * 64;
#pragma unroll
      for (int dr = 0; dr < 2; ++dr)
#pragma unroll
        for (int rg = 0; rg < 4; ++rg) {
          const int d = 32 * dr + 8 * rg + 4 * h;
          const u32x2 zv = *(const u32x2*)(zp + d);
          const float f0 = fl[(dr * 16 + rg * 4 + 0) * 64] + wgt * (dr ? O1[rg * 4 + 0] : O0[rg * 4 + 0]);
          const float f1 = fl[(dr * 16 + rg * 4 + 1) * 64] + wgt * (dr ? O1[rg * 4 + 1] : O0[rg * 4 + 1]);
          const float f2 = fl[(dr * 16 + rg * 4 + 2) * 64] + wgt * (dr ? O1[rg * 4 + 2] : O0[rg * 4 + 2]);
          const float f3 = fl[(dr * 16 + rg * 4 + 3) * 64] + wgt * (dr ? O1[rg * 4 + 3] : O0[rg * 4 + 3]);
          u32x2 o;
          o[0] = cvtpk(f0 * bflo(zv[0]), f1 * bfhi(zv[0]));
          o[1] = cvtpk(f2 * bflo(zv[1]), f3 * bfhi(zv[1]));
          *(u32x2*)(mp + d) = o;
        }
    }
  }
}

#if FUSED
extern "C" __global__ void __launch_bounds__(NTHREADS) hybrid_fwd(Params p) {
  extern __shared__ __attribute__((aligned(16))) char smem[];
  cg::grid_group grid = cg::this_grid();
  const int bid = blockIdx.x, nb = gridDim.x;
  for (int r = 0; r < REP0; ++r) { phase_prep(p, smem, bid, nb); grid.sync(); }
  for (int r = 0; r < REP1; ++r) { gemm_phase<0>(p, smem, bid, nb); grid.sync(); }
  for (int r = 0; r < REP2; ++r) { phase_cmp_conv(p, smem, bid, nb); grid.sync(); }
  for (int r = 0; r < REP3; ++r) { phase_attn(p, smem, bid, nb, r); grid.sync(); }
  for (int r = 0; r < REP4; ++r) { gemm_phase<1>(p, smem, bid, nb); }
}
#else
template <int PH>
__global__ void __launch_bounds__(NTHREADS) phase_kernel(Params p) {
  extern __shared__ __attribute__((aligned(16))) char smem[];
  const int bid = blockIdx.x, nb = gridDim.x;
  if constexpr (PH == 0) phase_prep(p, smem, bid, nb);
  if constexpr (PH == 1) gemm_phase<0>(p, smem, bid, nb);
  if constexpr (PH == 2) phase_cmp_conv(p, smem, bid, nb);
  if constexpr (PH == 3) phase_attn(p, smem, bid, nb, 0);
  if constexpr (PH == 4) gemm_phase<1>(p, smem, bid, nb);
}
#endif

extern "C" void kernel_launch(void* const* d_in, const int* in_sizes, int n_in, void* d_out, int out_size, void* d_ws, size_t ws_size, hipStream_t stream) {
  Params p{};
  p.x = (const float*)d_in[0]; p.norm_w = (const float*)d_in[1]; p.w_in = (const float*)d_in[2]; p.q_norm_w = (const float*)d_in[3];
  p.k_norm_w = (const float*)d_in[4]; p.ck_pos = (const float*)d_in[5]; p.ck_w1 = (const float*)d_in[6]; p.ck_b1 = (const float*)d_in[7];
  p.ck_w2 = (const float*)d_in[8]; p.cv_pos = (const float*)d_in[9]; p.cv_w1 = (const float*)d_in[10]; p.cv_b1 = (const float*)d_in[11];
  p.cv_w2 = (const float*)d_in[12]; p.conv_w = (const float*)d_in[13]; p.conv_b = (const float*)d_in[14]; p.w_out = (const float*)d_in[15];
  p.out = (float*)d_out;
  p.ws = (char*)d_ws;
  const size_t off = WS_TOTAL;
  if (off > ws_size) { fprintf(stderr, "kernel_launch: workspace too small (%zu > %zu)\n", off, ws_size); return; }

#if FUSED
  static int grid_blocks = 0;
  if (!grid_blocks) {
    int dev = 0, cus = 0, per_cu = 0;
    hipGetDevice(&dev);
    hipDeviceGetAttribute(&cus, hipDeviceAttributeMultiprocessorCount, dev);
    hipFuncSetAttribute((const void*)hybrid_fwd, hipFuncAttributeMaxDynamicSharedMemorySize, SMEM_BYTES);
    hipOccupancyMaxActiveBlocksPerMultiprocessor(&per_cu, (const void*)hybrid_fwd, NTHREADS, SMEM_BYTES);
    if (per_cu < 1) per_cu = 1;
    grid_blocks = cus * per_cu;
  }
  void* args[] = {&p};
  hipError_t e = hipLaunchCooperativeKernel((const void*)hybrid_fwd, dim3(grid_blocks), dim3(NTHREADS), args, SMEM_BYTES, stream);
  if (e != hipSuccess) fprintf(stderr, "cooperative launch failed: %s (grid %d)\n", hipGetErrorString(e), grid_blocks);
#else
  static int attr_set = 0;
  if (!attr_set) {
    (void)hipFuncSetAttribute((const void*)phase_kernel<0>, hipFuncAttributeMaxDynamicSharedMemorySize, SMEM_BYTES);
    (void)hipFuncSetAttribute((const void*)phase_kernel<1>, hipFuncAttributeMaxDynamicSharedMemorySize, SMEM_BYTES);
    (void)hipFuncSetAttribute((const void*)phase_kernel<2>, hipFuncAttributeMaxDynamicSharedMemorySize, SMEM_BYTES);
    (void)hipFuncSetAttribute((const void*)phase_kernel<3>, hipFuncAttributeMaxDynamicSharedMemorySize, SMEM_BYTES);
    (void)hipFuncSetAttribute((const void*)phase_kernel<4>, hipFuncAttributeMaxDynamicSharedMemorySize, SMEM_BYTES);
    attr_set = 1;
  }
  const int G = 256;
  phase_kernel<0><<<G, NTHREADS, SMEM_BYTES, stream>>>(p);
  phase_kernel<1><<<G, NTHREADS, SMEM_BYTES, stream>>>(p);
  phase_kernel<2><<<G, NTHREADS, SMEM_BYTES, stream>>>(p);
  phase_kernel<3><<<G, NTHREADS, SMEM_BYTES, stream>>>(p);
  phase_kernel<4><<<G, NTHREADS, SMEM_BYTES, stream>>>(p);
#endif
}
```

```cpp
#include <hip/hip_runtime.h>
#include <hip/hip_cooperative_groups.h>
#include <cstdio>
#include <cstdint>
namespace cg = cooperative_groups;

#ifndef FUSED
#define FUSED 1
#endif
#define REP0 1
#define REP1 1
#define REP2 1
#define REP3 1
#define REP4 1

#define DI __device__ __forceinline__
typedef unsigned short u16;
using bf16x8 = __attribute__((ext_vector_type(8))) short;
using s16x4 = __attribute__((ext_vector_type(4))) short;
using f32x4 = __attribute__((ext_vector_type(4))) float;
using f32x16 = __attribute__((ext_vector_type(16))) float;
using u32x4 = __attribute__((ext_vector_type(4))) unsigned;
using u32x2 = __attribute__((ext_vector_type(2))) unsigned;
typedef __bf16 bf2_t __attribute__((ext_vector_type(2)));
typedef float fl2_t __attribute__((ext_vector_type(2)));

constexpr int NTHREADS = 512;
constexpr int SEQ = 4096, DM = 1024, DIN = 3864, NROWS = 32768;
constexpr int LDK = 1088;
constexpr float EPS = 1e-6f;
constexpr float QSCALE = 0.125f * 1.4426950408889634f;
constexpr int SMEM_BYTES = 148480;

__constant__ float c_invf[8] = {1.0f, 0.1939227432012558f, 0.03760603070259094f, 0.007292664609849453f,
                                0.0014142135623842478f, 0.00027424818836152554f, 5.3182957344688475e-05f, 1.0313385246263351e-05f};

DI unsigned cvtpk(float lo, float hi) {
  fl2_t f = {lo, hi};
  bf2_t b = __builtin_convertvector(f, bf2_t);
  return __builtin_bit_cast(unsigned, b);
}
DI u16 f2bf(float x) { return (u16)(cvtpk(x, 0.f) & 0xffffu); }
DI float bf2f(u16 v) { return __uint_as_float(((unsigned)v) << 16); }
DI float bflo(unsigned v) { return __uint_as_float(v << 16); }
DI float bfhi(unsigned v) { return __uint_as_float(v & 0xffff0000u); }
DI float sigmoidf_(float v) { return __builtin_amdgcn_rcpf(1.0f + __builtin_amdgcn_exp2f(-1.4426950408889634f * v)); }
DI float siluf_(float v) { return v * __builtin_amdgcn_rcpf(1.0f + __builtin_amdgcn_exp2f(-1.4426950408889634f * v)); }
DI void glds16(const void* g, unsigned lds_base) {
  unsigned sv;
  asm volatile("s_mov_b32 %0, m0\n\ts_mov_b32 m0, %2\n\ts_nop 0\n\tglobal_load_lds_dwordx4 %1, off\n\ts_mov_b32 m0, %0" : "=&s"(sv) : "v"(g), "s"(lds_base) : "memory");
}
#define MFMA16(a, b, c) __builtin_amdgcn_mfma_f32_16x16x32_bf16((a), (b), (c), 0, 0, 0)
#define MFMA32(a, b, c) __builtin_amdgcn_mfma_f32_32x32x16_bf16((a), (b), (c), 0, 0, 0)

struct Params {
  const float *x, *norm_w, *w_in, *q_norm_w, *k_norm_w, *ck_pos, *ck_w1, *ck_b1, *ck_w2, *cv_pos, *cv_w1, *cv_b1, *cv_w2, *conv_w, *conv_b, *w_out;
  float* out;
  char* ws;
};
constexpr size_t al256(size_t v) { return (v + 255) & ~(size_t)255; }
constexpr size_t OFF_xb = 0;
DI u16* ws_xb(const Params& p) { return (u16*)(p.ws + OFF_xb); }
constexpr size_t OFF_winT = OFF_xb + al256((size_t)NROWS * LDK * 2);
DI u16* ws_winT(const Params& p) { return (u16*)(p.ws + OFF_winT); }
constexpr size_t OFF_woutT = OFF_winT + al256((size_t)4096 * LDK * 2);
DI u16* ws_woutT(const Params& p) { return (u16*)(p.ws + OFF_woutT); }
constexpr size_t OFF_w1kT = OFF_woutT + al256((size_t)1024 * LDK * 2);
DI u16* ws_w1kT(const Params& p) { return (u16*)(p.ws + OFF_w1kT); }
constexpr size_t OFF_w1vT = OFF_w1kT + al256((size_t)128 * 2048 * 2);
DI u16* ws_w1vT(const Params& p) { return (u16*)(p.ws + OFF_w1vT); }
constexpr size_t OFF_w2kT = OFF_w1vT + al256((size_t)128 * 2048 * 2);
DI u16* ws_w2kT(const Params& p) { return (u16*)(p.ws + OFF_w2kT); }
constexpr size_t OFF_w2vT = OFF_w2kT + al256((size_t)64 * 128 * 2);
DI u16* ws_w2vT(const Params& p) { return (u16*)(p.ws + OFF_w2vT); }
constexpr size_t OFF_Q = OFF_w2vT + al256((size_t)64 * 128 * 2);
DI u16* ws_Q(const Params& p) { return (u16*)(p.ws + OFF_Q); }
constexpr size_t OFF_Ks = OFF_Q + al256((size_t)NROWS * 512 * 2);
DI u16* ws_Ks(const Params& p) { return (u16*)(p.ws + OFF_Ks); }
constexpr size_t OFF_Kw = OFF_Ks + al256((size_t)16 * 4096 * 64 * 2);
DI u16* ws_Kw(const Params& p) { return (u16*)(p.ws + OFF_Kw); }
constexpr size_t OFF_Vst = OFF_Kw + al256((size_t)16 * 4096 * 64 * 2);
DI u16* ws_Vst(const Params& p) { return (u16*)(p.ws + OFF_Vst); }
constexpr size_t OFF_Vwt = OFF_Vst + al256((size_t)16 * 4096 * 64 * 2);
DI u16* ws_Vwt(const Params& p) { return (u16*)(p.ws + OFF_Vwt); }
constexpr size_t OFF_kcraw = OFF_Vwt + al256((size_t)16 * 4096 * 64 * 2);
DI u16* ws_kcraw(const Params& p) { return (u16*)(p.ws + OFF_kcraw); }
constexpr size_t OFF_vcraw = OFF_kcraw + al256((size_t)16 * 4096 * 64 * 2 + 4096);
DI u16* ws_vcraw(const Params& p) { return (u16*)(p.ws + OFF_vcraw); }
constexpr size_t OFF_Kc = OFF_vcraw + al256((size_t)16 * 4096 * 64 * 2 + 4096);
DI u16* ws_Kc(const Params& p) { return (u16*)(p.ws + OFF_Kc); }
constexpr size_t OFF_Vct = OFF_Kc + al256((size_t)16 * 256 * 64 * 2);
DI u16* ws_Vct(const Params& p) { return (u16*)(p.ws + OFF_Vct); }
constexpr size_t OFF_zs = OFF_Vct + al256((size_t)16 * 256 * 64 * 2);
DI u16* ws_zs(const Params& p) { return (u16*)(p.ws + OFF_zs); }
constexpr size_t OFF_cvb = OFF_zs + al256((size_t)NROWS * 512 * 2);
DI u16* ws_cvb(const Params& p) { return (u16*)(p.ws + OFF_cvb); }
constexpr size_t OFF_mix = OFF_cvb + al256((size_t)NROWS * 2048 * 2);
DI u16* ws_mix(const Params& p) { return (u16*)(p.ws + OFF_mix); }
constexpr size_t OFF_rs = OFF_mix + al256((size_t)NROWS * LDK * 2);
DI float* ws_rs(const Params& p) { return (float*)(p.ws + OFF_rs); }
constexpr size_t OFF_ckpart = OFF_rs + al256((size_t)NROWS * 4);
DI float* ws_ckpart(const Params& p) { return (float*)(p.ws + OFF_ckpart); }
constexpr size_t OFF_rope = OFF_ckpart + al256((size_t)16 * 128 * 4);
DI float* ws_rope(const Params& p) { return (float*)(p.ws + OFF_rope); }
constexpr size_t OFF_gates = OFF_rope + al256((size_t)4096 * 8 * 2 * 4);
DI float* ws_gates(const Params& p) { return (float*)(p.ws + OFF_gates); }
constexpr size_t OFF_counter = OFF_gates + al256((size_t)NROWS * 24 * 4);
DI unsigned* ws_counter(const Params& p) { return (unsigned*)(p.ws + OFF_counter); }
constexpr size_t WS_TOTAL = OFF_counter + al256((size_t)256);


DI void transpose_tile(const float* __restrict__ src, u16* __restrict__ dst, int K, int N, const float* __restrict__ scale, int kt, int nt, char* smem, int ldd) {
  float* tile = (float*)smem;
  const int tid = threadIdx.x;
#pragma unroll
  for (int i = 0; i < 8; ++i) {
    const int kk = i * 8 + (tid >> 6), nn = tid & 63, n = nt * 64 + nn, k = kt * 64 + kk;
    float v = (n < N) ? src[(size_t)k * N + n] : 0.f;
    if (scale) v *= scale[k];
    tile[kk * 65 + nn] = v;
  }
  __syncthreads();
#pragma unroll
  for (int i = 0; i < 8; ++i) {
    const int nn = i * 8 + (tid >> 6), kk = tid & 63;
    dst[(size_t)(nt * 64 + nn) * ldd + kt * 64 + kk] = f2bf(tile[kk * 65 + nn]);
  }
  __syncthreads();
}

__device__ void phase_prep(const Params& p, char* smem, int bid, int nb) {
  int tid_ = threadIdx.x; asm volatile("" : "+v"(tid_));
  const int tid = tid_, lane = tid & 63, wid = __builtin_amdgcn_readfirstlane(tid >> 6);
  constexpr int J_X = 1024, J_TW = 1024, J_TO = 256, J_T1 = 64, J_T2 = 2, J_CK = 16, J_ROPE = 64;
  constexpr int TOTAL = J_X + J_TW + J_TO + 2 * J_T1 + 2 * J_T2 + J_CK + J_ROPE;
  if (bid == 0 && tid < 8) ws_counter(p)[tid] = 0u;
  for (int j = bid; j < TOTAL; j += nb) {
    int jj = j;
    if (jj < J_X) {
      const int row0 = jj * 32 + wid * 4;
      float4 v[4][4]; float ss[4];
#pragma unroll
      for (int r = 0; r < 4; ++r) {
        const float4* xr = (const float4*)(p.x + (size_t)(row0 + r) * DM);
#pragma unroll
        for (int i = 0; i < 4; ++i) v[r][i] = xr[i * 64 + lane];
      }
#pragma unroll
      for (int r = 0; r < 4; ++r) {
        float a = 0.f;
#pragma unroll
        for (int i = 0; i < 4; ++i) a += v[r][i].x * v[r][i].x + v[r][i].y * v[r][i].y + v[r][i].z * v[r][i].z + v[r][i].w * v[r][i].w;
#pragma unroll
        for (int o = 32; o >= 1; o >>= 1) a += __shfl_xor(a, o);
        ss[r] = a;
      }
#pragma unroll
      for (int r = 0; r < 4; ++r) {
        if (lane == 0) ws_rs(p)[row0 + r] = rsqrtf(ss[r] * (1.0f / DM) + EPS);
#pragma unroll
        for (int i = 0; i < 4; ++i) {
          u32x2 o; o[0] = cvtpk(v[r][i].x, v[r][i].y); o[1] = cvtpk(v[r][i].z, v[r][i].w);
          const int rr_ = row0 + r;
          *(u32x2*)(ws_xb(p) + ((size_t)((rr_ >> 8) * 16 + i * 4 + (lane >> 4)) * 256 + (rr_ & 255)) * 64 + (lane & 15) * 4) = o;
        }
      }
      continue;
    }
    jj -= J_X;
    if (jj < J_TW) { transpose_tile(p.w_in, ws_winT(p), 1024, DIN, p.norm_w, jj & 15, jj >> 4, smem, LDK); continue; }
    jj -= J_TW;
    if (jj < J_TO) { transpose_tile(p.w_out, ws_woutT(p), 1024, 1024, nullptr, jj & 15, jj >> 4, smem, LDK); continue; }
    jj -= J_TO;
    if (jj < J_T1) { transpose_tile(p.ck_w1, ws_w1kT(p), 2048, 128, nullptr, jj & 31, jj >> 5, smem, 2048); continue; }
    jj -= J_T1;
    if (jj < J_T1) { transpose_tile(p.cv_w1, ws_w1vT(p), 2048, 128, nullptr, jj & 31, jj >> 5, smem, 2048); continue; }
    jj -= J_T1;
    if (jj < J_T2) { transpose_tile(p.ck_w2, ws_w2kT(p), 128, 64, nullptr, jj, 0, smem, 128); continue; }
    jj -= J_T2;
    if (jj < J_T2) { transpose_tile(p.cv_w2, ws_w2vT(p), 128, 64, nullptr, jj, 0, smem, 128); continue; }
    jj -= J_T2;
    if (jj < J_CK) {
      const int which = jj >> 3, chunk = jj & 7, hh = tid & 127, sub = tid >> 7;
      const float* pos = which ? p.cv_pos : p.ck_pos;
      const float* w1 = which ? p.cv_w1 : p.ck_w1;
      float acc = 0.f;
      const int f0 = chunk * 256 + sub * 64;
#pragma unroll 8
      for (int f = 0; f < 64; ++f) acc += pos[f0 + f] * w1[(size_t)(f0 + f) * 128 + hh];
      float* red = (float*)smem;
      red[sub * 128 + hh] = acc;
      __syncthreads();
      if (tid < 128) ws_ckpart(p)[(which * 8 + chunk) * 128 + tid] = red[tid] + red[128 + tid] + red[256 + tid] + red[384 + tid];
      __syncthreads();
      continue;
    }
    jj -= J_CK;
    {
      const int idx = jj * 512 + tid, pos = idx >> 3, fi = idx & 7;
      const float ang = (float)pos * c_invf[fi];
      float s, c; sincosf(ang, &s, &c);
      ws_rope(p)[idx * 2] = c; ws_rope(p)[idx * 2 + 1] = s;
    }
  }
}

DI int kimg_off(int row, int d) { return row * 64 + (((d >> 3) ^ ((row >> 1) & 7)) * 8) + (d & 7); }
DI int vimg_off(int d, int key) {
  const int kp = (key & ~12) | ((key & 4) << 1) | ((key & 8) >> 1);
  return d * 64 + (((kp >> 3) ^ ((d >> 1) & 7)) * 8) + (kp & 7);
}

constexpr int G_ASZ = 256 * 128, G_BSZ = 256 * 128, G_STAGE = G_ASZ + G_BSZ;
constexpr int G_ROPE = 2 * G_STAGE, G_RS = G_ROPE + 256 * 64;
static_assert(G_RS + 1024 <= SMEM_BYTES, "GEMM LDS layout exceeds the dynamic LDS size");
#define WAIT_VM(n) asm volatile("s_waitcnt vmcnt(" #n ")" ::: "memory")

template <int EPI>
__device__ void gemm_phase(const Params& p, char* smem, int bid, int nb) {
  constexpr int NT = EPI == 0 ? 16 : 4;
  constexpr int MT = 128;
  const u16* __restrict__ A = EPI == 0 ? ws_xb(p) : ws_mix(p);
  const u16* __restrict__ Bt = EPI == 0 ? ws_winT(p) : ws_woutT(p);
  int tid_ = threadIdx.x; asm volatile("" : "+v"(tid_));
  const int tid = tid_, lane = tid & 63, wid = __builtin_amdgcn_readfirstlane(tid >> 6), fr = lane & 15, fq = lane >> 4;
  const int wr = wid >> 2, wc = wid & 3;
  const bool xmap = (nb == 256);
  const int xcd = bid & 7, li = bid >> 3;
  const int ntiles = xmap ? (EPI == 0 ? 8 : 2) : (MT * NT - bid + nb - 1) / nb;
  auto tile_of = [&](int ti, int& m0, int& n0) {
    if (xmap) {
      const int sg = ti * 8 + xcd;
      if (EPI == 0) { m0 = ((sg >> 1) * 4 + (li >> 3)) * 256; n0 = ((sg & 1) * 8 + (li & 7)) * 256; }
      else { m0 = (sg * 8 + (li >> 2)) * 256; n0 = (li & 3) * 256; }
    } else { const int tile = bid + ti * nb; const int mt = tile / NT; m0 = mt * 256; n0 = (tile - mt * NT) * 256; }
  };
  const int nsteps = ntiles * 16;
  const unsigned lds0 = (unsigned)(uintptr_t)smem;
  const int gsw = (lane & 7) ^ ((wid & 1) * 4 + (lane >> 4));
  const int grow = wid * 8 + (lane >> 3);
  auto issue = [&](int step, int stage) {
    int m0, n0; tile_of(step >> 4, m0, n0);
    const int kt = step & 15;
    const u16* ag = EPI == 0 ? A + ((size_t)((m0 >> 8) * 16 + kt) * 256 + grow) * 64 + gsw * 8 : A + (size_t)(m0 + grow) * LDK + kt * 64 + gsw * 8;
    const size_t astep = EPI == 0 ? (size_t)64 * 64 : (size_t)64 * LDK;
    const int brow = EPI == 0 ? ((grow & ~31) | ((grow & 0x0C) << 1) | ((grow & 0x10) >> 2) | (grow & 3)) : grow;
    const u16* bg_ = Bt + (size_t)(n0 + brow) * LDK + kt * 64 + gsw * 8;
    const unsigned dst = (unsigned)__builtin_amdgcn_readfirstlane((int)(lds0 + stage * G_STAGE + wid * 1024));
#pragma unroll
    for (int i = 0; i < 4; ++i) glds16(ag + i * astep, dst + i * 8192);
#pragma unroll
    for (int i = 0; i < 4; ++i) glds16(bg_ + (size_t)i * 64 * LDK, dst + G_ASZ + i * 8192);
    if (EPI == 0 && kt == 8) {
      const int t0 = m0 & 4095;
      const unsigned sd = (unsigned)__builtin_amdgcn_readfirstlane((int)(lds0 + G_ROPE + wid * 1024));
      glds16(ws_rope(p) + (size_t)t0 * 16 + tid * 4, sd);
      glds16(ws_rope(p) + (size_t)t0 * 16 + (512 + tid) * 4, sd + 8192);
      if (wid == 0) glds16(ws_rs(p) + m0 + lane * 4, lds0 + G_RS);
    }
  };
  const int ca0 = ((fq ^ (fr >> 1)) * 16), ca1 = (((4 + fq) ^ (fr >> 1)) * 16);
  f32x4 acc[8][4];
#pragma unroll
  for (int m = 0; m < 8; ++m)
#pragma unroll
    for (int n = 0; n < 4; ++n) acc[m][n] = f32x4{0.f, 0.f, 0.f, 0.f};
  __syncthreads();
  if (nsteps > 0) issue(0, 0);
  for (int s = 0; s < nsteps; ++s) {
    WAIT_VM(0);
    __builtin_amdgcn_s_waitcnt(0x0F70);
    __builtin_amdgcn_s_barrier();
    if (s + 1 < nsteps) issue(s + 1, (s + 1) & 1);
    {
      const char* ab = smem + (s & 1) * G_STAGE + (wr * 128 + fr) * 128;
      const char* bb = smem + (s & 1) * G_STAGE + G_ASZ + (wc * 64 + fr) * 128;
#pragma unroll
      for (int ks = 0; ks < 2; ++ks) {
        bf16x8 af[8], bf[4];
        const int co = ks ? ca1 : ca0;
#pragma unroll
        for (int n = 0; n < 4; ++n) bf[n] = *(const bf16x8*)(bb + n * 16 * 128 + co);
#pragma unroll
        for (int m = 0; m < 8; ++m) af[m] = *(const bf16x8*)(ab + m * 16 * 128 + co);
#pragma unroll
        for (int m = 0; m < 8; ++m)
#pragma unroll
          for (int n = 0; n < 4; ++n) acc[m][n] = MFMA16(bf[n], af[m], acc[m][n]);
      }
    }
    if ((s & 15) != 15) continue;
    int m0, n0; tile_of(s >> 4, m0, n0);
    const int rbase = m0 + wr * 128;
    const int cb = n0 + wc * 64;
    if constexpr (EPI == 1) {
#pragma unroll
      for (int hm = 0; hm < 2; ++hm) {
        float4 xv[4][4];
#pragma unroll
        for (int mm = 0; mm < 4; ++mm) {
          const size_t ro = (size_t)(rbase + (hm * 4 + mm) * 16 + fr) * DM + cb + fq * 4;
#pragma unroll
          for (int n = 0; n < 4; ++n) xv[mm][n] = *(const float4*)(p.x + ro + n * 16);
        }
#pragma unroll
        for (int mm = 0; mm < 4; ++mm) {
          const int m = hm * 4 + mm;
          const size_t ro = (size_t)(rbase + m * 16 + fr) * DM + cb + fq * 4;
#pragma unroll
          for (int n = 0; n < 4; ++n) {
            float4 o; o.x = xv[mm][n].x + acc[m][n][0]; o.y = xv[mm][n].y + acc[m][n][1]; o.z = xv[mm][n].z + acc[m][n][2]; o.w = xv[mm][n].w + acc[m][n][3];
            *(float4*)(p.out + ro + n * 16) = o;
          }
        }
        __builtin_amdgcn_sched_barrier(0);
      }
    } else {
      const int b = m0 >> 12;
      const int tb = rbase & 4095;
      if (cb < 1280) {
        const int seg = cb >> 6;
        const int which = seg < 8 ? -1 : ((seg - 8) >> 1);
        const int g = seg < 8 ? (seg >> 2) : ((seg - 8) & 1);
        const bool need_norm = (seg < 8) || which == 2 || which == 4;
        const float* nw = seg < 8 ? p.q_norm_w : (p.k_norm_w + (which == 2 ? 64 : 128));
        float w[16];
#pragma unroll
        for (int k = 0; k < 16; ++k) w[k] = need_norm ? nw[(k >> 3) * 32 + fq * 8 + (k & 7)] : 1.0f;
        const float qs = seg < 8 ? QSCALE : 1.0f;
#pragma unroll
        for (int m = 0; m < 8; ++m) {
          const int t = tb + m * 16 + fr;
          const int lrow = wr * 128 + m * 16 + fr;
          const float r = *(const float*)(smem + G_RS + lrow * 4);
          float v[16];
#pragma unroll
          for (int k = 0; k < 16; ++k) v[k] = acc[m][(k >> 3) * 2 + ((k & 7) >> 2)][k & 3] * r;
          if (need_norm) {
            float ss = 0.f;
#pragma unroll
            for (int k = 0; k < 16; ++k) ss += v[k] * v[k];
            ss += __shfl_xor(ss, 16); ss += __shfl_xor(ss, 32);
            const float rr = rsqrtf(ss * (1.0f / 64.f) + EPS);
#pragma unroll
            for (int k = 0; k < 16; ++k) v[k] = v[k] * rr * w[k];
            const float4* rp = (const float4*)(smem + G_ROPE + lrow * 64);
            const float4 c01 = rp[0], c23 = rp[1], c45 = rp[2], c67 = rp[3];
            const float cc[8] = {c01.x, c01.z, c23.x, c23.z, c45.x, c45.z, c67.x, c67.z};
            const float sn[8] = {c01.y, c01.w, c23.y, c23.w, c45.y, c45.w, c67.y, c67.w};
#pragma unroll
            for (int e = 0; e < 8; ++e) {
              const float pr = __shfl_xor(v[e], 16);
              const float rot = (fq == 0) ? (v[e] * cc[e] - pr * sn[e]) : (v[e] * cc[e] + pr * sn[e]);
              v[e] = (fq < 2) ? rot : v[e];
            }
#pragma unroll
            for (int k = 0; k < 16; ++k) v[k] *= qs;
          }
          if (which == 3 || which == 5) {
            int lz = 0; asm volatile("" : "+v"(lz));
            u16* vt = (which == 3 ? ws_Vst(p) : ws_Vwt(p)) + (size_t)((b * 2 + g) * 64 + (t >> 6)) * 4096 + lz;
            const int fqx = fq + lz, key = (t & 63) + lz;
#pragma unroll
            for (int k = 0; k < 16; ++k) vt[vimg_off((k >> 3) * 32 + fqx * 8 + (k & 7), key)] = f2bf(v[k]);
          } else {
            u16* dst;
            if (seg < 8) dst = ws_Q(p) + ((size_t)((b * 2 + g) * 4096 + t) * 4 + (seg & 3)) * 64;
            else { u16* buf = which == 0 ? ws_kcraw(p) : which == 1 ? ws_vcraw(p) : which == 2 ? ws_Ks(p) : ws_Kw(p); dst = buf + ((size_t)(b * 2 + g) * 4096 + t) * 64; }
            const bool img = which >= 2;
#pragma unroll
            for (int n2 = 0; n2 < 2; ++n2) {
              u32x4 o;
#pragma unroll
              for (int e = 0; e < 4; ++e) o[e] = cvtpk(v[n2 * 8 + 2 * e], v[n2 * 8 + 2 * e + 1]);
              const int d0 = n2 * 32 + fq * 8;
              const int off = img ? (((d0 >> 3) ^ (((t & 63) >> 1) & 7)) * 8) : d0;
              *(u32x4*)(dst + off) = o;
            }
          }
          __builtin_amdgcn_sched_barrier(0);
        }
      } else {
#pragma unroll
        for (int m = 0; m < 8; ++m) {
          const size_t row = rbase + m * 16 + fr;
          const float r = *(const float*)(smem + G_RS + (wr * 128 + m * 16 + fr) * 4);
#pragma unroll
          for (int n2 = 0; n2 < 2; ++n2) {
            const int c8 = cb + n2 * 32 + fq * 8;
            if (c8 >= DIN) continue;
            float v[8];
#pragma unroll
            for (int e = 0; e < 8; ++e) v[e] = acc[m][n2 * 2 + (e >> 2)][e & 3] * r;
            if (c8 < 1304) {
              float4 o0, o1;
              o0.x = sigmoidf_(v[0]); o0.y = sigmoidf_(v[1]); o0.z = sigmoidf_(v[2]); o0.w = sigmoidf_(v[3]);
              o1.x = sigmoidf_(v[4]); o1.y = sigmoidf_(v[5]); o1.z = sigmoidf_(v[6]); o1.w = sigmoidf_(v[7]);
              float* gp = ws_gates(p) + row * 24 + (c8 - 1280);
              *(float4*)gp = o0; *(float4*)(gp + 4) = o1;
            } else if (c8 < 1816) {
              u32x4 o;
#pragma unroll
              for (int e = 0; e < 4; ++e) o[e] = cvtpk(siluf_(v[2 * e]), siluf_(v[2 * e + 1]));
              *(u32x4*)(ws_zs(p) + row * 512 + (c8 - 1304)) = o;
            } else {
              u32x4 o;
#pragma unroll
              for (int e = 0; e < 4; ++e) o[e] = cvtpk(v[2 * e], v[2 * e + 1]);
              *(u32x4*)(ws_cvb(p) + row * 2048 + (c8 - 1816)) = o;
            }
          }
          __builtin_amdgcn_sched_barrier(0);
        }
      }
    }
#pragma unroll
    for (int m = 0; m < 8; ++m)
#pragma unroll
      for (int n = 0; n < 4; ++n) acc[m][n] = f32x4{0.f, 0.f, 0.f, 0.f};
  }
}

__device__ void phase_cmp_conv(const Params& p, char* smem, int bid, int nb) {
  int tid_ = threadIdx.x; asm volatile("" : "+v"(tid_));
  const int tid = tid_, lane = tid & 63, wid = __builtin_amdgcn_readfirstlane(tid >> 6), fr = lane & 15, fq = lane >> 4;
  float* part = (float*)smem;
  char* hl = smem + 8 * 16 * 132 * 4;
  float* outl = (float*)(hl + 2 * 4352);
  for (int job = bid; job < 256; job += nb) {
    const int which = wid >> 2, w4 = wid & 3, bg = job >> 4, ct = job & 15;
    const u16* raw = (which ? ws_vcraw(p) : ws_kcraw(p)) + (size_t)bg * 4096 * 64;
    const u16* w1T = which ? ws_w1vT(p) : ws_w1kT(p);
    const u16* w2T = which ? ws_w2vT(p) : ws_w2kT(p);
    const float* b1 = which ? p.cv_b1 : p.ck_b1;
    f32x4 acc[8];
#pragma unroll
    for (int n = 0; n < 8; ++n) acc[n] = f32x4{0.f, 0.f, 0.f, 0.f};
    const int c = ct * 16 + fr;
    const int ht = tid & 255, rrow = ht >> 4, c8 = (ht & 15) * 8;
    float bias[8];
#pragma unroll
    for (int e = 0; e < 8; ++e) {
      float bsum = b1[c8 + e];
#pragma unroll
      for (int ch = 0; ch < 8; ++ch) bsum += ws_ckpart(p)[(which * 8 + ch) * 128 + c8 + e];
      bias[e] = bsum;
    }
    bf16x8 w2f[4];
#pragma unroll
    for (int ks = 0; ks < 4; ++ks) w2f[ks] = *(const bf16x8*)(w2T + (size_t)(w4 * 16 + fr) * 128 + ks * 32 + fq * 8);
    const int orow = ht >> 4, d4 = (ht & 15) * 4;
    const int cc = ct * 16 + orow;
    float nwv[4], nwp[4]; float2 csv[4];
    {
      int pos = cc * 16 + 31; pos = pos > 4095 ? 4095 : pos;
#pragma unroll
      for (int e = 0; e < 4; ++e) {
        const int d = d4 + e;
        nwv[e] = p.k_norm_w[d]; nwp[e] = p.k_norm_w[d ^ 8];
        csv[e] = *(const float2*)(ws_rope(p) + ((size_t)pos * 8 + (d & 7)) * 2);
      }
    }
#pragma unroll 4
    for (int k16 = 0; k16 < 16; ++k16) {
      const int ks = w4 * 16 + k16;
      const int l = ks >> 1, d0 = (ks & 1) * 32 + fq * 8;
      int tt = c * 16 + l; tt = tt > 4095 ? 4095 : tt;
      const bf16x8 a = *(const bf16x8*)(raw + (size_t)tt * 64 + d0);
#pragma unroll
      for (int n = 0; n < 8; ++n) {
        const bf16x8 bb = *(const bf16x8*)(w1T + (size_t)(n * 16 + fr) * 2048 + ks * 32 + fq * 8);
        acc[n] = MFMA16(a, bb, acc[n]);
      }
    }
#pragma unroll
    for (int n = 0; n < 8; ++n)
#pragma unroll
      for (int j = 0; j < 4; ++j) part[(wid * 16 + fq * 4 + j) * 132 + n * 16 + fr] = acc[n][j];
    __syncthreads();
    {
      float sum[8];
#pragma unroll
      for (int e = 0; e < 8; ++e) sum[e] = bias[e];
#pragma unroll
      for (int w = 0; w < 4; ++w) {
        const float4 v0 = *(const float4*)(part + ((which * 4 + w) * 16 + rrow) * 132 + c8), v1 = *(const float4*)(part + ((which * 4 + w) * 16 + rrow) * 132 + c8 + 4);
        sum[0] += v0.x; sum[1] += v0.y; sum[2] += v0.z; sum[3] += v0.w; sum[4] += v1.x; sum[5] += v1.y; sum[6] += v1.z; sum[7] += v1.w;
      }
      u32x4 o;
#pragma unroll
      for (int e = 0; e < 4; ++e) o[e] = cvtpk(siluf_(sum[2 * e]), siluf_(sum[2 * e + 1]));
      *(u32x4*)(hl + which * 4352 + rrow * 272 + c8 * 2) = o;
    }
    __syncthreads();
    {
      f32x4 o2 = f32x4{0.f, 0.f, 0.f, 0.f};
#pragma unroll
      for (int ks = 0; ks < 4; ++ks) {
        const bf16x8 a = *(const bf16x8*)(hl + which * 4352 + fr * 272 + (ks * 32 + fq * 8) * 2);
        o2 = MFMA16(a, w2f[ks], o2);
      }
#pragma unroll
      for (int j = 0; j < 4; ++j) outl[which * 1088 + (fq * 4 + j) * 68 + w4 * 16 + fr] = o2[j];
    }
    __syncthreads();
    {
      const float* ol = outl + which * 1088;
      const float4 v = *(const float4*)(ol + orow * 68 + d4);
      if (which == 0) {
        float ss = v.x * v.x + v.y * v.y + v.z * v.z + v.w * v.w;
        ss += __shfl_xor(ss, 1); ss += __shfl_xor(ss, 2); ss += __shfl_xor(ss, 4); ss += __shfl_xor(ss, 8);
        const float rr = rsqrtf(ss * (1.0f / 64.f) + EPS);
        float o[4] = {v.x * rr * nwv[0], v.y * rr * nwv[1], v.z * rr * nwv[2], v.w * rr * nwv[3]};
        if (d4 < 16) {
#pragma unroll
          for (int e = 0; e < 4; ++e) {
            const int d = d4 + e, dp = d ^ 8;
            const float pr = ol[orow * 68 + dp] * rr * nwp[e];
            o[e] = (d < 8) ? (o[e] * csv[e].x - pr * csv[e].y) : (o[e] * csv[e].x + pr * csv[e].y);
          }
        }
        u32x2 ov; ov[0] = cvtpk(o[0], o[1]); ov[1] = cvtpk(o[2], o[3]);
        if (cc >= 255) { ov[0] = 0u; ov[1] = 0u; }
        *(u32x2*)(ws_Kc(p) + (size_t)(bg * 4 + (cc >> 6)) * 4096 + kimg_off(cc & 63, d4)) = ov;
      } else {
        const float z = (cc >= 255) ? 0.f : 1.f;
        u16* vt = ws_Vct(p) + (size_t)(bg * 4 + (cc >> 6)) * 4096;
        vt[vimg_off(d4 + 0, cc & 63)] = f2bf(v.x * z); vt[vimg_off(d4 + 1, cc & 63)] = f2bf(v.y * z);
        vt[vimg_off(d4 + 2, cc & 63)] = f2bf(v.z * z); vt[vimg_off(d4 + 3, cc & 63)] = f2bf(v.w * z);
      }
    }
    __syncthreads();
  }
  const int gw = bid * 8 + wid, nw = nb * 8;
  for (int chunk = gw; chunk < 2048; chunk += nw) {
    const int r0 = chunk * 16, t0 = r0 & 4095;
    const int ch = lane * 8;
    float cw0[8], cw1[8], cw2[8], cbv[8], u1[8], u2[8];
#pragma unroll
    for (int e = 0; e < 8; ++e) { cw0[e] = p.conv_w[ch + e]; cw1[e] = p.conv_w[512 + ch + e]; cw2[e] = p.conv_w[1024 + ch + e]; cbv[e] = p.conv_b[ch + e]; u1[e] = 0.f; u2[e] = 0.f; }
    if (t0 > 0) {
#pragma unroll
      for (int q = 0; q < 2; ++q) {
        const u16* rp = ws_cvb(p) + (size_t)(r0 - 2 + q) * 2048 + ch;
        const u32x4 hv = *(const u32x4*)(rp), cv = *(const u32x4*)(rp + 1024);
#pragma unroll
        for (int e = 0; e < 4; ++e) {
          const float ua = bflo(hv[e]) * bflo(cv[e]), ub = bfhi(hv[e]) * bfhi(cv[e]);
          if (q == 0) { u2[2 * e] = ua; u2[2 * e + 1] = ub; } else { u1[2 * e] = ua; u1[2 * e + 1] = ub; }
        }
      }
    }
#pragma unroll 4
    for (int rr = 0; rr < 16; ++rr) {
      const u16* rp = ws_cvb(p) + (size_t)(r0 + rr) * 2048 + ch;
      const u32x4 hv = *(const u32x4*)(rp), bv = *(const u32x4*)(rp + 512), cv = *(const u32x4*)(rp + 1024), zv = *(const u32x4*)(rp + 1536);
      u32x4 ov;
#pragma unroll
      for (int e = 0; e < 4; ++e) {
        const float ua = bflo(hv[e]) * bflo(cv[e]), ub = bfhi(hv[e]) * bfhi(cv[e]);
        const float ca = cw0[2 * e] * u2[2 * e] + cw1[2 * e] * u1[2 * e] + cw2[2 * e] * ua + cbv[2 * e];
        const float cbb = cw0[2 * e + 1] * u2[2 * e + 1] + cw1[2 * e + 1] * u1[2 * e + 1] + cw2[2 * e + 1] * ub + cbv[2 * e + 1];
        const float oa = bflo(bv[e]) * ca * siluf_(bflo(zv[e]));
        const float ob = bfhi(bv[e]) * cbb * siluf_(bfhi(zv[e]));
        ov[e] = cvtpk(oa, ob);
        u2[2 * e] = u1[2 * e]; u2[2 * e + 1] = u1[2 * e + 1]; u1[2 * e] = ua; u1[2 * e + 1] = ub;
      }
      *(u32x4*)(ws_mix(p) + (size_t)(r0 + rr) * LDK + 512 + ch) = ov;
    }
  }
}

constexpr int AT_NST = 5, AT_KB = 8192, AT_BUF = 16384;
constexpr int AT_F = AT_NST * AT_BUF, AT_IMPA = AT_F, AT_IMPB = AT_IMPA + 64 * 65 * 4, AT_VAL = AT_IMPA;
constexpr int AT_SELM = AT_F + 8 * 8192, AT_UNIT = AT_SELM + 512, AT_END = AT_UNIT + 16;
static_assert(AT_END <= SMEM_BYTES, "attention LDS layout exceeds the dynamic LDS size");

__device__ void phase_attn(const Params& p, char* smem, int bid, int nb, int rep) {
  int tid_ = threadIdx.x; asm volatile("" : "+v"(tid_));
  const int tid = tid_, lane = tid & 63, wid = __builtin_amdgcn_readfirstlane(tid >> 6), c32 = lane & 31, h = lane >> 5;
  const float NINF = -__builtin_inff();
  float* impa = (float*)(smem + AT_IMPA);
  float* impb = (float*)(smem + AT_IMPB);
  float* vals = (float*)(smem + AT_VAL);
  unsigned* selm = (unsigned*)(smem + AT_SELM);
  volatile int* s_unit = (volatile int*)(smem + AT_UNIT);
  const unsigned lds0 = (unsigned)(uintptr_t)smem;
  while (true) {
    if (tid == 0) *s_unit = (int)atomicAdd(ws_counter(p) + rep, 1u);
    __syncthreads();
    const int u = __builtin_amdgcn_readfirstlane(*s_unit);
    __syncthreads();
    if (u >= 1024) break;
    const int i = 63 - (u >> 4), bg = u & 15, b = bg >> 1, g = bg & 1;
    const int tl = wid * 8 + (c32 >> 2), hd = c32 & 3;
    const int t = i * 64 + tl;
    const u16* qrow = ws_Q(p) + ((size_t)(bg * 4096 + i * 64) * 4 + wid * 32 + c32) * 64;
    bf16x8 qf[4];
#pragma unroll
    for (int ks = 0; ks < 4; ++ks) qf[ks] = *(const bf16x8*)(qrow + ks * 16 + h * 8);
    const float* gp = ws_gates(p) + (size_t)(b * 4096 + t) * 24 + (g * 4 + hd) * 3;
    const float g0 = gp[0], g1 = gp[1], g2 = gp[2];
    asm volatile("" :: "v"(qf[0]), "v"(qf[1]), "v"(qf[2]), "v"(qf[3]), "v"(g0), "v"(g1), "v"(g2));
    const int ntc = (4 * i + 2) / 64 + 1, nsl = i + 1, nwin = (i < 8 ? i : 8) + 1;
    const int NT = 2 * ntc + nsl + nwin;
    const bool need_sel = i >= 16;

    f32x16 O0, O1;
#pragma unroll
    for (int r = 0; r < 16; ++r) { O0[r] = 0.f; O1[r] = 0.f; }
    float* fl = (float*)(smem + AT_F + wid * 8192) + lane;
    float m_run = NINF, l_run = 0.f, inv_l = 0.f;
    u32x4 kxw; kxw[0] = (h == 0) ? 0x3F80u : 0u; kxw[1] = 0u; kxw[2] = 0u; kxw[3] = 0u;
    const bf16x8 kx = __builtin_bit_cast(bf16x8, kxw);
    float oscale = 1.0f;
    unsigned sel_lo = 0xffffffffu, sel_hi = 0xffffffffu;
#define TILE_PTRS(n, kp, vp) do { \
      if ((n) < 2 * ntc) { const int tt_ = (n) < ntc ? (n) : (n) - ntc; kp = ws_Kc(p) + (size_t)(bg * 4 + tt_) * 4096; vp = ws_Vct(p) + (size_t)(bg * 4 + tt_) * 4096; } \
      else if ((n) < 2 * ntc + nsl) { const int j_ = (n) - 2 * ntc; kp = ws_Ks(p) + ((size_t)bg * 4096 + j_ * 64) * 64; vp = ws_Vst(p) + (size_t)(bg * 64 + j_) * 4096; } \
      else { const int j_ = i - nwin + 1 + ((n) - 2 * ntc - nsl); kp = ws_Kw(p) + ((size_t)bg * 4096 + j_ * 64) * 64; vp = ws_Vwt(p) + (size_t)(bg * 64 + j_) * 4096; } } while (0)
#define TISSUE(n, st_) do { const u16 *kp_, *vp_; TILE_PTRS(n, kp_, vp_); \
      const unsigned d_ = (unsigned)__builtin_amdgcn_readfirstlane((int)(lds0 + (st_) * AT_BUF + wid * 1024)); \
      glds16(kp_ + tid * 8, d_); glds16(vp_ + tid * 8, d_ + AT_KB); } while (0)
    {
      const int npre = NT < AT_NST - 1 ? NT : AT_NST - 1;
      for (int n = 0; n < npre; ++n) TISSUE(n, n);
    }
    int st_cur = 0, st_iss = AT_NST - 1;
    const int ksw = (c32 >> 1) & 7;
    for (int n = 0; n < NT; ++n) {
      {
        const int rem = NT - 1 - n;
        if (rem >= 3) WAIT_VM(6); else if (rem == 2) WAIT_VM(4); else if (rem == 1) WAIT_VM(2); else WAIT_VM(0);
        __builtin_amdgcn_s_barrier();
        if (n + AT_NST - 1 < NT) TISSUE(n + AT_NST - 1, st_iss);
      }
      int mode, base, lo, hi;
      bool full = false, lane_on = true;
      if (n < 2 * ntc) { mode = n < ntc ? 0 : 1; base = (n < ntc ? n : n - ntc) * 64; lo = -1; hi = (t - 31) >> 4; }
      else if (n < 2 * ntc + nsl) { const int j = n - 2 * ntc; mode = 2; base = j * 64; const unsigned bit = j < 32 ? (sel_lo >> j) & 1u : (sel_hi >> (j - 32)) & 1u; lo = -1; hi = bit ? t : -1; full = j < i; lane_on = bit != 0u; }
      else { const int j = i - nwin + 1 + (n - 2 * ntc - nsl); mode = 3; base = j * 64; lo = t - 512; hi = t; full = (j < i) && (j > i - 8); }
      const int lo_rel = lo - (base + 4 * h), hi_rel = hi - (base + 4 * h);
      const bool chk = ((n & 3) == 3) || mode == 0;
#pragma unroll
      for (int r = 0; r < 16; ++r) { O0[r] *= oscale; O1[r] *= oscale; }
      const char* kb = smem + st_cur * AT_BUF;
      const char* vb = kb + AT_KB;
      st_cur = st_cur == AT_NST - 1 ? 0 : st_cur + 1; st_iss = st_iss == AT_NST - 1 ? 0 : st_iss + 1;
      f32x16 S0, S1;
#define ATT_BODY(MASKED) do { \
      _Pragma("unroll") for (int r = 0; r < 16; ++r) { S0[r] = 0.f; S1[r] = 0.f; } \
      const float m_use = (m_run == NINF) ? 0.f : m_run;        \
      { \
          \
        const float negm = (!(MASKED) && !lane_on) ? NINF : -m_use; \
        u32x4 qxw; qxw[0] = (h == 0) ? (cvtpk(negm, 0.f) & 0xffffu) : 0u; qxw[1] = 0u; qxw[2] = 0u; qxw[3] = 0u; \
        const bf16x8 qx = __builtin_bit_cast(bf16x8, qxw); \
        S0 = MFMA32(kx, qx, S0); S1 = MFMA32(kx, qx, S1); \
      } \
      { \
        bf16x8 kf0[4], kf1[4]; \
        _Pragma("unroll") for (int ks = 0; ks < 4; ++ks) { \
          kf0[ks] = *(const bf16x8*)(kb + c32 * 128 + (((ks * 2 + h) ^ ksw) * 16)); \
          kf1[ks] = *(const bf16x8*)(kb + (32 + c32) * 128 + (((ks * 2 + h) ^ ksw) * 16)); \
        } \
        _Pragma("unroll") for (int ks = 0; ks < 4; ++ks) S0 = MFMA32(kf0[ks], qf[ks], S0);     \
        _Pragma("unroll") for (int ks = 0; ks < 4; ++ks) S1 = MFMA32(kf1[ks], qf[ks], S1); \
      } \
        \
      if (MASKED) { \
        _Pragma("unroll") for (int r = 0; r < 16; ++r) { \
          const int off = (r & 3) + 8 * (r >> 2); \
          S0[r] = (off > lo_rel && off <= hi_rel) ? S0[r] : NINF; \
          S1[r] = (off + 32 > lo_rel && off + 32 <= hi_rel) ? S1[r] : NINF; \
        } \
      } \
      float ps0 = 0.f, ps1 = 0.f; \
      bf16x8 vfa[4]; \
      _Pragma("unroll") for (int kk = 0; kk < 2; ++kk) \
        _Pragma("unroll") for (int dr = 0; dr < 2; ++dr) vfa[kk * 2 + dr] = *(const bf16x8*)(vb + (32 * dr + c32) * 128 + (((2 * kk + h) ^ ksw) * 16)); \
      _Pragma("unroll") for (int r = 0; r < 16; ++r) { S0[r] = __builtin_amdgcn_exp2f(S0[r]); ps0 += S0[r]; } \
      _Pragma("unroll") for (int kk = 0; kk < 2; ++kk) { \
        u32x4 pw; \
        _Pragma("unroll") for (int e = 0; e < 4; ++e) pw[e] = cvtpk(S0[8 * kk + 2 * e], S0[8 * kk + 2 * e + 1]); \
        const bf16x8 pf = __builtin_bit_cast(bf16x8, pw); \
        O0 = MFMA32(vfa[kk * 2], pf, O0); O1 = MFMA32(vfa[kk * 2 + 1], pf, O1); \
      } \
      __builtin_amdgcn_sched_group_barrier(0x100, 12, 0);     \
      __builtin_amdgcn_sched_group_barrier(0x008, 4, 0);      \
      _Pragma("unroll") for (int q_ = 0; q_ < 4; ++q_) { __builtin_amdgcn_sched_group_barrier(0x008, 1, 0); __builtin_amdgcn_sched_group_barrier(0x002, 9, 0); }     \
      __builtin_amdgcn_sched_barrier(0); \
      _Pragma("unroll") for (int r = 0; r < 16; ++r) { S1[r] = __builtin_amdgcn_exp2f(S1[r]); ps1 += S1[r]; } \
      _Pragma("unroll") for (int kk = 0; kk < 2; ++kk) { \
        u32x4 pw; \
        _Pragma("unroll") for (int e = 0; e < 4; ++e) pw[e] = cvtpk(S1[8 * kk + 2 * e], S1[8 * kk + 2 * e + 1]); \
        const bf16x8 pf = __builtin_bit_cast(bf16x8, pw); \
        const bf16x8 va0 = *(const bf16x8*)(vb + c32 * 128 + (((2 * (kk + 2) + h) ^ ksw) * 16)), va1 = *(const bf16x8*)(vb + (32 + c32) * 128 + (((2 * (kk + 2) + h) ^ ksw) * 16)); \
        O0 = MFMA32(va0, pf, O0); O1 = MFMA32(va1, pf, O1); \
      } \
      __builtin_amdgcn_sched_barrier(0); \
      oscale = 1.0f; \
      if (mode != 1) l_run += ps0 + ps1; \
      if (mode != 1 && chk) {                    \
        float mxp = fmaxf(fmaxf(S0[0], S0[1]), S1[0]); \
        mxp = fmaxf(fmaxf(mxp, S1[1]), S0[2]); \
        _Pragma("unroll") for (int r = 2; r < 16; r += 2) { \
          if (r > 2) mxp = fmaxf(fmaxf(mxp, S0[r]), S1[r - 1]); \
          mxp = fmaxf(fmaxf(mxp, S0[r + 1]), S1[r]); \
        } \
        mxp = fmaxf(mxp, S1[15]); \
        mxp = fmaxf(mxp, __shfl_xor(mxp, 32));            \
        const bool mv = (m_run == NINF) ? (mxp > 0.f) : (mxp > 256.0f); \
        const float m_new = bflo(cvtpk(m_use + __builtin_amdgcn_logf(mxp), 0.f));       \
        const float alpha = mv ? __builtin_amdgcn_exp2f(m_use - m_new) : 1.0f; \
        m_run = mv ? m_new : m_run; \
        l_run *= alpha; \
        oscale = alpha; \
      } \
      if ((MASKED) && mode == 1 && need_sel) {               \
        const int tt = base >> 6; \
        _Pragma("unroll") for (int kr = 0; kr < 2; ++kr) \
          _Pragma("unroll") for (int rg = 0; rg < 4; ++rg) { \
            float pv[4]; \
            _Pragma("unroll") for (int e = 0; e < 4; ++e) { \
              float v = (kr ? S1[rg * 4 + e] : S0[rg * 4 + e]) * inv_l; \
              v += __shfl_xor(v, 1); v += __shfl_xor(v, 2); \
              pv[e] = v; \
            } \
            if (hd == 0) { \
              const int nblk = tt * 16 + 8 * kr + 2 * rg + h; \
              impa[tl * 65 + nblk] = pv[0] + pv[1] + pv[2] + 0.5f * pv[3]; \
              impb[tl * 65 + nblk] = 0.5f * pv[3]; \
            } \
          } \
      } } while (0)
      if (full) ATT_BODY(false); else ATT_BODY(true);
#undef ATT_BODY
      if (n == ntc - 1) {
        const float lt = l_run + __shfl_xor(l_run, 32);
        inv_l = lt > 0.f ? 1.0f / lt : 0.f;
        oscale = 0.f;
      } else if (n == 2 * ntc - 1) {
        if (need_sel) {
          __syncthreads();
          const int tk = tid >> 3, nb0 = (tid & 7) * 8;
          float myv[8];
#pragma unroll
          for (int e = 0; e < 8; ++e) {
            const int nn = nb0 + e;
            const bool forced = (nn == 0) || (nn == i) || (nn == i - 1);
            float v = -1.0f;
            if (nn <= i) v = impa[tk * 65 + nn] + (nn > 0 ? impb[tk * 65 + nn - 1] : 0.f);
            if (forced) v = 1e9f;
            myv[e] = v;
            vals[tk * 65 + nn] = v;
          }
          __syncthreads();
          int cnt[8];
#pragma unroll
          for (int e = 0; e < 8; ++e) cnt[e] = 0;
          for (int mm = 0; mm < 64; ++mm) {
            const float vm = vals[tk * 65 + mm];
#pragma unroll
            for (int e = 0; e < 8; ++e) cnt[e] += (vm > myv[e] || (vm == myv[e] && mm < nb0 + e)) ? 1 : 0;
          }
          unsigned bits = 0;
#pragma unroll
          for (int e = 0; e < 8; ++e) bits |= (cnt[e] < 16 ? 1u : 0u) << e;
          unsigned wlo = (tid & 7) < 4 ? bits << (8 * (tid & 7)) : 0u;
          unsigned whi = (tid & 7) >= 4 ? bits << (8 * ((tid & 7) - 4)) : 0u;
          wlo |= __shfl_xor(wlo, 1); wlo |= __shfl_xor(wlo, 2); wlo |= __shfl_xor(wlo, 4);
          whi |= __shfl_xor(whi, 1); whi |= __shfl_xor(whi, 2); whi |= __shfl_xor(whi, 4);
          if ((tid & 7) == 0) { selm[tk * 2] = wlo; selm[tk * 2 + 1] = whi; }
          __syncthreads();
          sel_lo = selm[tl * 2]; sel_hi = selm[tl * 2 + 1];
        }
        {
          const float wgt = g0 * inv_l * oscale;
#pragma unroll
          for (int r = 0; r < 16; ++r) { fl[r * 64] = wgt * O0[r]; fl[(16 + r) * 64] = wgt * O1[r]; }
          m_run = NINF; l_run = 0.f; oscale = 0.f;
        }
      } else if (n == 2 * ntc + nsl - 1) {
        const float lt = l_run + __shfl_xor(l_run, 32);
        const float wgt = g1 * (lt > 0.f ? 1.0f / lt : 0.f) * oscale;
#pragma unroll
        for (int r = 0; r < 16; ++r) { fl[r * 64] += wgt * O0[r]; fl[(16 + r) * 64] += wgt * O1[r]; }
        m_run = NINF; l_run = 0.f; oscale = 0.f;
      }
    }
#undef TILE_PTRS
#undef TISSUE
    {
      const float lt = l_run + __shfl_xor(l_run, 32);
      const float wgt = g2 * (lt > 0.f ? 1.0f / lt : 0.f) * oscale;
      const size_t rowo = (size_t)(b * 4096 + t);
      const u16* zp = ws_zs(p) + rowo * 512 + (g * 4 + hd) * 64;
      u16* mp = ws_mix(p) + rowo * LDK + (g * 4 + hd) * 64;
#pragma unroll
      for (int dr = 0; dr < 2; ++dr)
#pragma unroll
        for (int rg = 0; rg < 4; ++rg) {
          const int d = 32 * dr + 8 * rg + 4 * h;
          const u32x2 zv = *(const u32x2*)(zp + d);
          const float f0 = fl[(dr * 16 + rg * 4 + 0) * 64] + wgt * (dr ? O1[rg * 4 + 0] : O0[rg * 4 + 0]);
          const float f1 = fl[(dr * 16 + rg * 4 + 1) * 64] + wgt * (dr ? O1[rg * 4 + 1] : O0[rg * 4 + 1]);
          const float f2 = fl[(dr * 16 + rg * 4 + 2) * 64] + wgt * (dr ? O1[rg * 4 + 2] : O0[rg * 4 + 2]);
          const float f3 = fl[(dr * 16 + rg * 4 + 3) * 64] + wgt * (dr ? O1[rg * 4 + 3] : O0[rg * 4 + 3]);
          u32x2 o;
          o[0] = cvtpk(f0 * bflo(zv[0]), f1 * bfhi(zv[0]));
          o[1] = cvtpk(f2 * bflo(zv[1]), f3 * bfhi(zv[1]));
          *(u32x2*)(mp + d) = o;
        }
    }
  }
}

#if FUSED
extern "C" __global__ void __launch_bounds__(NTHREADS) hybrid_fwd(Params p) {
  extern __shared__ __attribute__((aligned(16))) char smem[];
  cg::grid_group grid = cg::this_grid();
  const int bid = blockIdx.x, nb = gridDim.x;
  for (int r = 0; r < REP0; ++r) { phase_prep(p, smem, bid, nb); grid.sync(); }
  for (int r = 0; r < REP1; ++r) { gemm_phase<0>(p, smem, bid, nb); grid.sync(); }
  for (int r = 0; r < REP2; ++r) { phase_cmp_conv(p, smem, bid, nb); grid.sync(); }
  for (int r = 0; r < REP3; ++r) { phase_attn(p, smem, bid, nb, r); grid.sync(); }
  for (int r = 0; r < REP4; ++r) { gemm_phase<1>(p, smem, bid, nb); }
}
#else
template <int PH>
__global__ void __launch_bounds__(NTHREADS) phase_kernel(Params p) {
  extern __shared__ __attribute__((aligned(16))) char smem[];
  const int bid = blockIdx.x, nb = gridDim.x;
  if constexpr (PH == 0) phase_prep(p, smem, bid, nb);
  if constexpr (PH == 1) gemm_phase<0>(p, smem, bid, nb);
  if constexpr (PH == 2) phase_cmp_conv(p, smem, bid, nb);
  if constexpr (PH == 3) phase_attn(p, smem, bid, nb, 0);
  if constexpr (PH == 4) gemm_phase<1>(p, smem, bid, nb);
}
#endif

extern "C" void kernel_launch(void* const* d_in, const int* in_sizes, int n_in, void* d_out, int out_size, void* d_ws, size_t ws_size, hipStream_t stream) {
  Params p{};
  p.x = (const float*)d_in[0]; p.norm_w = (const float*)d_in[1]; p.w_in = (const float*)d_in[2]; p.q_norm_w = (const float*)d_in[3];
  p.k_norm_w = (const float*)d_in[4]; p.ck_pos = (const float*)d_in[5]; p.ck_w1 = (const float*)d_in[6]; p.ck_b1 = (const float*)d_in[7];
  p.ck_w2 = (const float*)d_in[8]; p.cv_pos = (const float*)d_in[9]; p.cv_w1 = (const float*)d_in[10]; p.cv_b1 = (const float*)d_in[11];
  p.cv_w2 = (const float*)d_in[12]; p.conv_w = (const float*)d_in[13]; p.conv_b = (const float*)d_in[14]; p.w_out = (const float*)d_in[15];
  p.out = (float*)d_out;
  p.ws = (char*)d_ws;
  const size_t off = WS_TOTAL;
  if (off > ws_size) { fprintf(stderr, "kernel_launch: workspace too small (%zu > %zu)\n", off, ws_size); return; }

#if FUSED
  static int grid_blocks = 0;
  if (!grid_blocks) {
    int dev = 0, cus = 0, per_cu = 0;
    hipGetDevice(&dev);
    hipDeviceGetAttribute(&cus, hipDeviceAttributeMultiprocessorCount, dev);
    hipFuncSetAttribute((const void*)hybrid_fwd, hipFuncAttributeMaxDynamicSharedMemorySize, SMEM_BYTES);
    hipOccupancyMaxActiveBlocksPerMultiprocessor(&per_cu, (const void*)hybrid_fwd, NTHREADS, SMEM_BYTES);
    if (per_cu < 1) per_cu = 1;
    grid_blocks = cus * per_cu;
  }
  void* args[] = {&p};
  hipError_t e = hipLaunchCooperativeKernel((const void*)hybrid_fwd, dim3(grid_blocks), dim3(NTHREADS), args, SMEM_BYTES, stream);
  if (e != hipSuccess) fprintf(stderr, "cooperative launch failed: %s (grid %d)\n", hipGetErrorString(e), grid_blocks);
#else
  static int attr_set = 0;
  if (!attr_set) {
    (void)hipFuncSetAttribute((const void*)phase_kernel<0>, hipFuncAttributeMaxDynamicSharedMemorySize, SMEM_BYTES);
    (void)hipFuncSetAttribute((const void*)phase_kernel<1>, hipFuncAttributeMaxDynamicSharedMemorySize, SMEM_BYTES);
    (void)hipFuncSetAttribute((const void*)phase_kernel<2>, hipFuncAttributeMaxDynamicSharedMemorySize, SMEM_BYTES);
    (void)hipFuncSetAttribute((const void*)phase_kernel<3>, hipFuncAttributeMaxDynamicSharedMemorySize, SMEM_BYTES);
    (void)hipFuncSetAttribute((const void*)phase_kernel<4>, hipFuncAttributeMaxDynamicSharedMemorySize, SMEM_BYTES);
    attr_set = 1;
  }
  const int G = 256;
  phase_kernel<0><<<G, NTHREADS, SMEM_BYTES, stream>>>(p);
  phase_kernel<1><<<G, NTHREADS, SMEM_BYTES, stream>>>(p);
  phase_kernel<2><<<G, NTHREADS, SMEM_BYTES, stream>>>(p);
  phase_kernel<3><<<G, NTHREADS, SMEM_BYTES, stream>>>(p);
  phase_kernel<4><<<G, NTHREADS, SMEM_BYTES, stream>>>(p);
#endif
}
```

```cpp
#include <hip/hip_runtime.h>
#include <hip/hip_cooperative_groups.h>
#include <cstdio>
#include <cstdint>
namespace cg = cooperative_groups;

#ifndef FUSED
#define FUSED 1
#endif
#define REP0 1
#define REP1 1
#define REP2 1
#define REP3 1
#define REP4 1

#define DI __device__ __forceinline__
typedef unsigned short u16;
using bf16x8 = __attribute__((ext_vector_type(8))) short;
using s16x4 = __attribute__((ext_vector_type(4))) short;
using f32x4 = __attribute__((ext_vector_type(4))) float;
using f32x16 = __attribute__((ext_vector_type(16))) float;
using u32x4 = __attribute__((ext_vector_type(4))) unsigned;
using u32x2 = __attribute__((ext_vector_type(2))) unsigned;
typedef __bf16 bf2_t __attribute__((ext_vector_type(2)));
typedef float fl2_t __attribute__((ext_vector_type(2)));

constexpr int NTHREADS = 512;
constexpr int SEQ = 4096, DM = 1024, DIN = 3864, NROWS = 32768;
constexpr int LDK = 1088;
constexpr float EPS = 1e-6f;
constexpr float QSCALE = 0.125f * 1.4426950408889634f;
constexpr int SMEM_BYTES = 148480;

__constant__ float c_invf[8] = {1.0f, 0.1939227432012558f, 0.03760603070259094f, 0.007292664609849453f,
                                0.0014142135623842478f, 0.00027424818836152554f, 5.3182957344688475e-05f, 1.0313385246263351e-05f};

DI unsigned cvtpk(float lo, float hi) {
  fl2_t f = {lo, hi};
  bf2_t b = __builtin_convertvector(f, bf2_t);
  return __builtin_bit_cast(unsigned, b);
}
DI u16 f2bf(float x) { return (u16)(cvtpk(x, 0.f) & 0xffffu); }
DI float bf2f(u16 v) { return __uint_as_float(((unsigned)v) << 16); }
DI float bflo(unsigned v) { return __uint_as_float(v << 16); }
DI float bfhi(unsigned v) { return __uint_as_float(v & 0xffff0000u); }
DI float sigmoidf_(float v) { return __builtin_amdgcn_rcpf(1.0f + __builtin_amdgcn_exp2f(-1.4426950408889634f * v)); }
DI float siluf_(float v) { return v * __builtin_amdgcn_rcpf(1.0f + __builtin_amdgcn_exp2f(-1.4426950408889634f * v)); }
DI void glds16(const void* g, unsigned lds_base) {
  unsigned sv;
  asm volatile("s_mov_b32 %0, m0\n\ts_mov_b32 m0, %2\n\ts_nop 0\n\tglobal_load_lds_dwordx4 %1, off\n\ts_mov_b32 m0, %0" : "=&s"(sv) : "v"(g), "s"(lds_base) : "memory");
}
#define MFMA16(a, b, c) __builtin_amdgcn_mfma_f32_16x16x32_bf16((a), (b), (c), 0, 0, 0)
#define MFMA32(a, b, c) __builtin_amdgcn_mfma_f32_32x32x16_bf16((a), (b), (c), 0, 0, 0)

struct Params {
  const float *x, *norm_w, *w_in, *q_norm_w, *k_norm_w, *ck_pos, *ck_w1, *ck_b1, *ck_w2, *cv_pos, *cv_w1, *cv_b1, *cv_w2, *conv_w, *conv_b, *w_out;
  float* out;
  char* ws;
};
constexpr size_t al256(size_t v) { return (v + 255) & ~(size_t)255; }
constexpr size_t OFF_xb = 0;
DI u16* ws_xb(const Params& p) { return (u16*)(p.ws + OFF_xb); }
constexpr size_t OFF_winT = OFF_xb + al256((size_t)NROWS * LDK * 2);
DI u16* ws_winT(const Params& p) { return (u16*)(p.ws + OFF_winT); }
constexpr size_t OFF_woutT = OFF_winT + al256((size_t)4096 * LDK * 2);
DI u16* ws_woutT(const Params& p) { return (u16*)(p.ws + OFF_woutT); }
constexpr size_t OFF_w1kT = OFF_woutT + al256((size_t)1024 * LDK * 2);
DI u16* ws_w1kT(const Params& p) { return (u16*)(p.ws + OFF_w1kT); }
constexpr size_t OFF_w1vT = OFF_w1kT + al256((size_t)128 * 2048 * 2);
DI u16* ws_w1vT(const Params& p) { return (u16*)(p.ws + OFF_w1vT); }
constexpr size_t OFF_w2kT = OFF_w1vT + al256((size_t)128 * 2048 * 2);
DI u16* ws_w2kT(const Params& p) { return (u16*)(p.ws + OFF_w2kT); }
constexpr size_t OFF_w2vT = OFF_w2kT + al256((size_t)64 * 128 * 2);
DI u16* ws_w2vT(const Params& p) { return (u16*)(p.ws + OFF_w2vT); }
constexpr size_t OFF_Q = OFF_w2vT + al256((size_t)64 * 128 * 2);
DI u16* ws_Q(const Params& p) { return (u16*)(p.ws + OFF_Q); }
constexpr size_t OFF_Ks = OFF_Q + al256((size_t)NROWS * 512 * 2);
DI u16* ws_Ks(const Params& p) { return (u16*)(p.ws + OFF_Ks); }
constexpr size_t OFF_Kw = OFF_Ks + al256((size_t)16 * 4096 * 64 * 2);
DI u16* ws_Kw(const Params& p) { return (u16*)(p.ws + OFF_Kw); }
constexpr size_t OFF_Vst = OFF_Kw + al256((size_t)16 * 4096 * 64 * 2);
DI u16* ws_Vst(const Params& p) { return (u16*)(p.ws + OFF_Vst); }
constexpr size_t OFF_Vwt = OFF_Vst + al256((size_t)16 * 4096 * 64 * 2);
DI u16* ws_Vwt(const Params& p) { return (u16*)(p.ws + OFF_Vwt); }
constexpr size_t OFF_kcraw = OFF_Vwt + al256((size_t)16 * 4096 * 64 * 2);
DI u16* ws_kcraw(const Params& p) { return (u16*)(p.ws + OFF_kcraw); }
constexpr size_t OFF_vcraw = OFF_kcraw + al256((size_t)16 * 4096 * 64 * 2 + 4096);
DI u16* ws_vcraw(const Params& p) { return (u16*)(p.ws + OFF_vcraw); }
constexpr size_t OFF_Kc = OFF_vcraw + al256((size_t)16 * 4096 * 64 * 2 + 4096);
DI u16* ws_Kc(const Params& p) { return (u16*)(p.ws + OFF_Kc); }
constexpr size_t OFF_Vct = OFF_Kc + al256((size_t)16 * 256 * 64 * 2);
DI u16* ws_Vct(const Params& p) { return (u16*)(p.ws + OFF_Vct); }
constexpr size_t OFF_zs = OFF_Vct + al256((size_t)16 * 256 * 64 * 2);
DI u16* ws_zs(const Params& p) { return (u16*)(p.ws + OFF_zs); }
constexpr size_t OFF_cvb = OFF_zs + al256((size_t)NROWS * 512 * 2);
DI u16* ws_cvb(const Params& p) { return (u16*)(p.ws + OFF_cvb); }
constexpr size_t OFF_mix = OFF_cvb + al256((size_t)NROWS * 2048 * 2);
DI u16* ws_mix(const Params& p) { return (u16*)(p.ws + OFF_mix); }
constexpr size_t OFF_rs = OFF_mix + al256((size_t)NROWS * LDK * 2);
DI float* ws_rs(const Params& p) { return (float*)(p.ws + OFF_rs); }
constexpr size_t OFF_ckpart = OFF_rs + al256((size_t)NROWS * 4);
DI float* ws_ckpart(const Params& p) { return (float*)(p.ws + OFF_ckpart); }
constexpr size_t OFF_rope = OFF_ckpart + al256((size_t)16 * 128 * 4);
DI float* ws_rope(const Params& p) { return (float*)(p.ws + OFF_rope); }
constexpr size_t OFF_gates = OFF_rope + al256((size_t)4096 * 8 * 2 * 4);
DI float* ws_gates(const Params& p) { return (float*)(p.ws + OFF_gates); }
constexpr size_t OFF_counter = OFF_gates + al256((size_t)NROWS * 24 * 4);
DI unsigned* ws_counter(const Params& p) { return (unsigned*)(p.ws + OFF_counter); }
constexpr size_t WS_TOTAL = OFF_counter + al256((size_t)256);


DI void transpose_tile(const float* __restrict__ src, u16* __restrict__ dst, int K, int N, const float* __restrict__ scale, int kt, int nt, char* smem, int ldd) {
  float* tile = (float*)smem;
  const int tid = threadIdx.x;
#pragma unroll
  for (int i = 0; i < 8; ++i) {
    const int kk = i * 8 + (tid >> 6), nn = tid & 63, n = nt * 64 + nn, k = kt * 64 + kk;
    float v = (n < N) ? src[(size_t)k * N + n] : 0.f;
    if (scale) v *= scale[k];
    tile[kk * 65 + nn] = v;
  }
  __syncthreads();
#pragma unroll
  for (int i = 0; i < 8; ++i) {
    const int nn = i * 8 + (tid >> 6), kk = tid & 63;
    dst[(size_t)(nt * 64 + nn) * ldd + kt * 64 + kk] = f2bf(tile[kk * 65 + nn]);
  }
  __syncthreads();
}

__device__ void phase_prep(const Params& p, char* smem, int bid, int nb) {
  int tid_ = threadIdx.x; asm volatile("" : "+v"(tid_));
  const int tid = tid_, lane = tid & 63, wid = __builtin_amdgcn_readfirstlane(tid >> 6);
  constexpr int J_X = 1024, J_TW = 1024, J_TO = 256, J_T1 = 64, J_T2 = 2, J_CK = 16, J_ROPE = 64;
  constexpr int TOTAL = J_X + J_TW + J_TO + 2 * J_T1 + 2 * J_T2 + J_CK + J_ROPE;
  if (bid == 0 && tid < 8) ws_counter(p)[tid] = 0u;
  for (int j = bid; j < TOTAL; j += nb) {
    int jj = j;
    if (jj < J_X) {
      const int row0 = jj * 32 + wid * 4;
      float4 v[4][4]; float ss[4];
#pragma unroll
      for (int r = 0; r < 4; ++r) {
        const float4* xr = (const float4*)(p.x + (size_t)(row0 + r) * DM);
#pragma unroll
        for (int i = 0; i < 4; ++i) v[r][i] = xr[i * 64 + lane];
      }
#pragma unroll
      for (int r = 0; r < 4; ++r) {
        float a = 0.f;
#pragma unroll
        for (int i = 0; i < 4; ++i) a += v[r][i].x * v[r][i].x + v[r][i].y * v[r][i].y + v[r][i].z * v[r][i].z + v[r][i].w * v[r][i].w;
#pragma unroll
        for (int o = 32; o >= 1; o >>= 1) a += __shfl_xor(a, o);
        ss[r] = a;
      }
#pragma unroll
      for (int r = 0; r < 4; ++r) {
        if (lane == 0) ws_rs(p)[row0 + r] = rsqrtf(ss[r] * (1.0f / DM) + EPS);
#pragma unroll
        for (int i = 0; i < 4; ++i) {
          u32x2 o; o[0] = cvtpk(v[r][i].x, v[r][i].y); o[1] = cvtpk(v[r][i].z, v[r][i].w);
          const int rr_ = row0 + r;
          *(u32x2*)(ws_xb(p) + ((size_t)((rr_ >> 8) * 16 + i * 4 + (lane >> 4)) * 256 + (rr_ & 255)) * 64 + (lane & 15) * 4) = o;
        }
      }
      continue;
    }
    jj -= J_X;
    if (jj < J_TW) { transpose_tile(p.w_in, ws_winT(p), 1024, DIN, p.norm_w, jj & 15, jj >> 4, smem, LDK); continue; }
    jj -= J_TW;
    if (jj < J_TO) { transpose_tile(p.w_out, ws_woutT(p), 1024, 1024, nullptr, jj & 15, jj >> 4, smem, LDK); continue; }
    jj -= J_TO;
    if (jj < J_T1) { transpose_tile(p.ck_w1, ws_w1kT(p), 2048, 128, nullptr, jj & 31, jj >> 5, smem, 2048); continue; }
    jj -= J_T1;
    if (jj < J_T1) { transpose_tile(p.cv_w1, ws_w1vT(p), 2048, 128, nullptr, jj & 31, jj >> 5, smem, 2048); continue; }
    jj -= J_T1;
    if (jj < J_T2) { transpose_tile(p.ck_w2, ws_w2kT(p), 128, 64, nullptr, jj, 0, smem, 128); continue; }
    jj -= J_T2;
    if (jj < J_T2) { transpose_tile(p.cv_w2, ws_w2vT(p), 128, 64, nullptr, jj, 0, smem, 128); continue; }
    jj -= J_T2;
    if (jj < J_CK) {
      const int which = jj >> 3, chunk = jj & 7, hh = tid & 127, sub = tid >> 7;
      const float* pos = which ? p.cv_pos : p.ck_pos;
      const float* w1 = which ? p.cv_w1 : p.ck_w1;
      float acc = 0.f;
      const int f0 = chunk * 256 + sub * 64;
      float pv_[64], wv_[64];
#pragma unroll
      for (int f = 0; f < 64; ++f) { pv_[f] = pos[f0 + f]; wv_[f] = w1[(size_t)(f0 + f) * 128 + hh]; }
#pragma unroll
      for (int f = 0; f < 64; ++f) acc += pv_[f] * wv_[f];
      float* red = (float*)smem;
      red[sub * 128 + hh] = acc;
      __syncthreads();
      if (tid < 128) ws_ckpart(p)[(which * 8 + chunk) * 128 + tid] = red[tid] + red[128 + tid] + red[256 + tid] + red[384 + tid];
      __syncthreads();
      continue;
    }
    jj -= J_CK;
    {
      const int idx = jj * 512 + tid, pos = idx >> 3, fi = idx & 7;
      const float ang = (float)pos * c_invf[fi];
      float s, c; sincosf(ang, &s, &c);
      ws_rope(p)[idx * 2] = c; ws_rope(p)[idx * 2 + 1] = s;
    }
  }
}

DI int kimg_off(int row, int d) { return row * 64 + (((d >> 3) ^ ((row >> 1) & 7)) * 8) + (d & 7); }
DI int vimg_off(int d, int key) {
  const int kp = (key & ~12) | ((key & 4) << 1) | ((key & 8) >> 1);
  return d * 64 + (((kp >> 3) ^ ((d >> 1) & 7)) * 8) + (kp & 7);
}

constexpr int G_ASZ = 256 * 128, G_BSZ = 256 * 128, G_STAGE = G_ASZ + G_BSZ;
constexpr int G_ROPE = 2 * G_STAGE, G_RS = G_ROPE + 256 * 64;
static_assert(G_RS + 1024 <= SMEM_BYTES, "GEMM LDS layout exceeds the dynamic LDS size");
#define WAIT_VM(n) asm volatile("s_waitcnt vmcnt(" #n ")" ::: "memory")

template <int EPI>
__device__ void gemm_phase(const Params& p, char* smem, int bid, int nb) {
  constexpr int NT = EPI == 0 ? 16 : 4;
  constexpr int MT = 128;
  const u16* __restrict__ A = EPI == 0 ? ws_xb(p) : ws_mix(p);
  const u16* __restrict__ Bt = EPI == 0 ? ws_winT(p) : ws_woutT(p);
  int tid_ = threadIdx.x; asm volatile("" : "+v"(tid_));
  const int tid = tid_, lane = tid & 63, wid = __builtin_amdgcn_readfirstlane(tid >> 6), fr = lane & 15, fq = lane >> 4;
  const int wr = wid >> 2, wc = wid & 3;
  const bool xmap = (nb == 256);
  const int xcd = bid & 7, li = bid >> 3;
  const int ntiles = xmap ? (EPI == 0 ? 8 : 2) : (MT * NT - bid + nb - 1) / nb;
  auto tile_of = [&](int ti, int& m0, int& n0) {
    if (xmap) {
      const int sg = ti * 8 + xcd;
      if (EPI == 0) { m0 = ((sg >> 1) * 4 + (li >> 3)) * 256; n0 = ((sg & 1) * 8 + (li & 7)) * 256; }
      else { m0 = (sg * 8 + (li >> 2)) * 256; n0 = (li & 3) * 256; }
    } else { const int tile = bid + ti * nb; const int mt = tile / NT; m0 = mt * 256; n0 = (tile - mt * NT) * 256; }
  };
  const int nsteps = ntiles * 16;
  const unsigned lds0 = (unsigned)(uintptr_t)smem;
  const int gsw = (lane & 7) ^ ((wid & 1) * 4 + (lane >> 4));
  const int grow = wid * 8 + (lane >> 3);
  auto issue = [&](int step, int stage) {
    int m0, n0; tile_of(step >> 4, m0, n0);
    const int kt = step & 15;
    const u16* ag = EPI == 0 ? A + ((size_t)((m0 >> 8) * 16 + kt) * 256 + grow) * 64 + gsw * 8 : A + (size_t)(m0 + grow) * LDK + kt * 64 + gsw * 8;
    const size_t astep = EPI == 0 ? (size_t)64 * 64 : (size_t)64 * LDK;
    const int brow = EPI == 0 ? ((grow & ~31) | ((grow & 0x0C) << 1) | ((grow & 0x10) >> 2) | (grow & 3)) : grow;
    const u16* bg_ = Bt + (size_t)(n0 + brow) * LDK + kt * 64 + gsw * 8;
    const unsigned dst = (unsigned)__builtin_amdgcn_readfirstlane((int)(lds0 + stage * G_STAGE + wid * 1024));
#pragma unroll
    for (int i = 0; i < 4; ++i) glds16(ag + i * astep, dst + i * 8192);
#pragma unroll
    for (int i = 0; i < 4; ++i) glds16(bg_ + (size_t)i * 64 * LDK, dst + G_ASZ + i * 8192);
    if (EPI == 0 && kt == 8) {
      const int t0 = m0 & 4095;
      const unsigned sd = (unsigned)__builtin_amdgcn_readfirstlane((int)(lds0 + G_ROPE + wid * 1024));
      glds16(ws_rope(p) + (size_t)t0 * 16 + tid * 4, sd);
      glds16(ws_rope(p) + (size_t)t0 * 16 + (512 + tid) * 4, sd + 8192);
      if (wid == 0) glds16(ws_rs(p) + m0 + lane * 4, lds0 + G_RS);
    }
  };
  const int ca0 = ((fq ^ (fr >> 1)) * 16), ca1 = (((4 + fq) ^ (fr >> 1)) * 16);
  f32x4 acc[8][4];
#pragma unroll
  for (int m = 0; m < 8; ++m)
#pragma unroll
    for (int n = 0; n < 4; ++n) acc[m][n] = f32x4{0.f, 0.f, 0.f, 0.f};
  __syncthreads();
  if (nsteps > 0) issue(0, 0);
  for (int s = 0; s < nsteps; ++s) {
    WAIT_VM(0);
    __builtin_amdgcn_s_waitcnt(0x0F70);
    __builtin_amdgcn_s_barrier();
    if (s + 1 < nsteps) issue(s + 1, (s + 1) & 1);
    {
      const char* ab = smem + (s & 1) * G_STAGE + (wr * 128 + fr) * 128;
      const char* bb = smem + (s & 1) * G_STAGE + G_ASZ + (wc * 64 + fr) * 128;
#pragma unroll
      for (int ks = 0; ks < 2; ++ks) {
        bf16x8 af[8], bf[4];
        const int co = ks ? ca1 : ca0;
#pragma unroll
        for (int n = 0; n < 4; ++n) bf[n] = *(const bf16x8*)(bb + n * 16 * 128 + co);
#pragma unroll
        for (int m = 0; m < 8; ++m) af[m] = *(const bf16x8*)(ab + m * 16 * 128 + co);
#pragma unroll
        for (int m = 0; m < 8; ++m)
#pragma unroll
          for (int n = 0; n < 4; ++n) acc[m][n] = MFMA16(bf[n], af[m], acc[m][n]);
      }
    }
    if ((s & 15) != 15) continue;
    int m0, n0; tile_of(s >> 4, m0, n0);
    const int rbase = m0 + wr * 128;
    const int cb = n0 + wc * 64;
    if constexpr (EPI == 1) {
#pragma unroll
      for (int hm = 0; hm < 2; ++hm) {
        float4 xv[4][4];
#pragma unroll
        for (int mm = 0; mm < 4; ++mm) {
          const size_t ro = (size_t)(rbase + (hm * 4 + mm) * 16 + fr) * DM + cb + fq * 4;
#pragma unroll
          for (int n = 0; n < 4; ++n) xv[mm][n] = *(const float4*)(p.x + ro + n * 16);
        }
#pragma unroll
        for (int mm = 0; mm < 4; ++mm) {
          const int m = hm * 4 + mm;
          const size_t ro = (size_t)(rbase + m * 16 + fr) * DM + cb + fq * 4;
#pragma unroll
          for (int n = 0; n < 4; ++n) {
            float4 o; o.x = xv[mm][n].x + acc[m][n][0]; o.y = xv[mm][n].y + acc[m][n][1]; o.z = xv[mm][n].z + acc[m][n][2]; o.w = xv[mm][n].w + acc[m][n][3];
            *(float4*)(p.out + ro + n * 16) = o;
          }
        }
        __builtin_amdgcn_sched_barrier(0);
      }
    } else {
      const int b = m0 >> 12;
      const int tb = rbase & 4095;
      if (cb < 1280) {
        const int seg = cb >> 6;
        const int which = seg < 8 ? -1 : ((seg - 8) >> 1);
        const int g = seg < 8 ? (seg >> 2) : ((seg - 8) & 1);
        const bool need_norm = (seg < 8) || which == 2 || which == 4;
        const float* nw = seg < 8 ? p.q_norm_w : (p.k_norm_w + (which == 2 ? 64 : 128));
        float w[16];
#pragma unroll
        for (int k = 0; k < 16; ++k) w[k] = need_norm ? nw[(k >> 3) * 32 + fq * 8 + (k & 7)] : 1.0f;
        const float qs = seg < 8 ? QSCALE : 1.0f;
#pragma unroll
        for (int m = 0; m < 8; ++m) {
          const int t = tb + m * 16 + fr;
          const int lrow = wr * 128 + m * 16 + fr;
          const float r = *(const float*)(smem + G_RS + lrow * 4);
          float v[16];
#pragma unroll
          for (int k = 0; k < 16; ++k) v[k] = acc[m][(k >> 3) * 2 + ((k & 7) >> 2)][k & 3] * r;
          if (need_norm) {
            float ss = 0.f;
#pragma unroll
            for (int k = 0; k < 16; ++k) ss += v[k] * v[k];
            ss += __shfl_xor(ss, 16); ss += __shfl_xor(ss, 32);
            const float rr = rsqrtf(ss * (1.0f / 64.f) + EPS);
#pragma unroll
            for (int k = 0; k < 16; ++k) v[k] = v[k] * rr * w[k];
            const float4* rp = (const float4*)(smem + G_ROPE + lrow * 64);
            const float4 c01 = rp[0], c23 = rp[1], c45 = rp[2], c67 = rp[3];
            const float cc[8] = {c01.x, c01.z, c23.x, c23.z, c45.x, c45.z, c67.x, c67.z};
            const float sn[8] = {c01.y, c01.w, c23.y, c23.w, c45.y, c45.w, c67.y, c67.w};
#pragma unroll
            for (int e = 0; e < 8; ++e) {
              const float pr = __shfl_xor(v[e], 16);
              const float rot = (fq == 0) ? (v[e] * cc[e] - pr * sn[e]) : (v[e] * cc[e] + pr * sn[e]);
              v[e] = (fq < 2) ? rot : v[e];
            }
#pragma unroll
            for (int k = 0; k < 16; ++k) v[k] *= qs;
          }
          if (which == 3 || which == 5) {
            int lz = 0; asm volatile("" : "+v"(lz));
            u16* vt = (which == 3 ? ws_Vst(p) : ws_Vwt(p)) + (size_t)((b * 2 + g) * 64 + (t >> 6)) * 4096 + lz;
            const int fqx = fq + lz, key = (t & 63) + lz;
#pragma unroll
            for (int k = 0; k < 16; ++k) vt[vimg_off((k >> 3) * 32 + fqx * 8 + (k & 7), key)] = f2bf(v[k]);
          } else {
            u16* dst;
            if (seg < 8) dst = ws_Q(p) + ((size_t)((b * 2 + g) * 4096 + t) * 4 + (seg & 3)) * 64;
            else { u16* buf = which == 0 ? ws_kcraw(p) : which == 1 ? ws_vcraw(p) : which == 2 ? ws_Ks(p) : ws_Kw(p); dst = buf + ((size_t)(b * 2 + g) * 4096 + t) * 64; }
            const bool img = which >= 2;
#pragma unroll
            for (int n2 = 0; n2 < 2; ++n2) {
              u32x4 o;
#pragma unroll
              for (int e = 0; e < 4; ++e) o[e] = cvtpk(v[n2 * 8 + 2 * e], v[n2 * 8 + 2 * e + 1]);
              const int d0 = n2 * 32 + fq * 8;
              const int off = img ? (((d0 >> 3) ^ (((t & 63) >> 1) & 7)) * 8) : d0;
              *(u32x4*)(dst + off) = o;
            }
          }
          __builtin_amdgcn_sched_barrier(0);
        }
      } else {
#pragma unroll
        for (int m = 0; m < 8; ++m) {
          const size_t row = rbase + m * 16 + fr;
          const float r = *(const float*)(smem + G_RS + (wr * 128 + m * 16 + fr) * 4);
#pragma unroll
          for (int n2 = 0; n2 < 2; ++n2) {
            const int c8 = cb + n2 * 32 + fq * 8;
            if (c8 >= DIN) continue;
            float v[8];
#pragma unroll
            for (int e = 0; e < 8; ++e) v[e] = acc[m][n2 * 2 + (e >> 2)][e & 3] * r;
            if (c8 < 1304) {
              float4 o0, o1;
              o0.x = sigmoidf_(v[0]); o0.y = sigmoidf_(v[1]); o0.z = sigmoidf_(v[2]); o0.w = sigmoidf_(v[3]);
              o1.x = sigmoidf_(v[4]); o1.y = sigmoidf_(v[5]); o1.z = sigmoidf_(v[6]); o1.w = sigmoidf_(v[7]);
              float* gp = ws_gates(p) + row * 24 + (c8 - 1280);
              *(float4*)gp = o0; *(float4*)(gp + 4) = o1;
            } else if (c8 < 1816) {
              u32x4 o;
#pragma unroll
              for (int e = 0; e < 4; ++e) o[e] = cvtpk(siluf_(v[2 * e]), siluf_(v[2 * e + 1]));
              *(u32x4*)(ws_zs(p) + row * 512 + (c8 - 1304)) = o;
            } else {
              u32x4 o;
#pragma unroll
              for (int e = 0; e < 4; ++e) o[e] = cvtpk(v[2 * e], v[2 * e + 1]);
              *(u32x4*)(ws_cvb(p) + row * 2048 + (c8 - 1816)) = o;
            }
          }
          __builtin_amdgcn_sched_barrier(0);
        }
      }
    }
#pragma unroll
    for (int m = 0; m < 8; ++m)
#pragma unroll
      for (int n = 0; n < 4; ++n) acc[m][n] = f32x4{0.f, 0.f, 0.f, 0.f};
  }
}

__device__ void phase_cmp_conv(const Params& p, char* smem, int bid, int nb) {
  int tid_ = threadIdx.x; asm volatile("" : "+v"(tid_));
  const int tid = tid_, lane = tid & 63, wid = __builtin_amdgcn_readfirstlane(tid >> 6), fr = lane & 15, fq = lane >> 4;
  float* part = (float*)smem;
  char* hl = smem + 8 * 16 * 132 * 4;
  float* outl = (float*)(hl + 2 * 4352);
  for (int job = bid; job < 256; job += nb) {
    const int which = wid >> 2, w4 = wid & 3, bg = job >> 4, ct = job & 15;
    const u16* raw = (which ? ws_vcraw(p) : ws_kcraw(p)) + (size_t)bg * 4096 * 64;
    const u16* w1T = which ? ws_w1vT(p) : ws_w1kT(p);
    const u16* w2T = which ? ws_w2vT(p) : ws_w2kT(p);
    const float* b1 = which ? p.cv_b1 : p.ck_b1;
    f32x4 acc[8];
#pragma unroll
    for (int n = 0; n < 8; ++n) acc[n] = f32x4{0.f, 0.f, 0.f, 0.f};
    const int c = ct * 16 + fr;
    const int ht = tid & 255, rrow = ht >> 4, c8 = (ht & 15) * 8;
    float bias[8];
#pragma unroll
    for (int e = 0; e < 8; ++e) {
      float bsum = b1[c8 + e];
#pragma unroll
      for (int ch = 0; ch < 8; ++ch) bsum += ws_ckpart(p)[(which * 8 + ch) * 128 + c8 + e];
      bias[e] = bsum;
    }
    bf16x8 w2f[4];
#pragma unroll
    for (int ks = 0; ks < 4; ++ks) w2f[ks] = *(const bf16x8*)(w2T + (size_t)(w4 * 16 + fr) * 128 + ks * 32 + fq * 8);
    const int orow = ht >> 4, d4 = (ht & 15) * 4;
    const int cc = ct * 16 + orow;
    float nwv[4], nwp[4]; float2 csv[4];
    {
      int pos = cc * 16 + 31; pos = pos > 4095 ? 4095 : pos;
#pragma unroll
      for (int e = 0; e < 4; ++e) {
        const int d = d4 + e;
        nwv[e] = p.k_norm_w[d]; nwp[e] = p.k_norm_w[d ^ 8];
        csv[e] = *(const float2*)(ws_rope(p) + ((size_t)pos * 8 + (d & 7)) * 2);
      }
    }
#pragma unroll 4
    for (int k16 = 0; k16 < 16; ++k16) {
      const int ks = w4 * 16 + k16;
      const int l = ks >> 1, d0 = (ks & 1) * 32 + fq * 8;
      int tt = c * 16 + l; tt = tt > 4095 ? 4095 : tt;
      const bf16x8 a = *(const bf16x8*)(raw + (size_t)tt * 64 + d0);
#pragma unroll
      for (int n = 0; n < 8; ++n) {
        const bf16x8 bb = *(const bf16x8*)(w1T + (size_t)(n * 16 + fr) * 2048 + ks * 32 + fq * 8);
        acc[n] = MFMA16(a, bb, acc[n]);
      }
    }
#pragma unroll
    for (int n = 0; n < 8; ++n)
#pragma unroll
      for (int j = 0; j < 4; ++j) part[(wid * 16 + fq * 4 + j) * 132 + n * 16 + fr] = acc[n][j];
    __syncthreads();
    {
      float sum[8];
#pragma unroll
      for (int e = 0; e < 8; ++e) sum[e] = bias[e];
#pragma unroll
      for (int w = 0; w < 4; ++w) {
        const float4 v0 = *(const float4*)(part + ((which * 4 + w) * 16 + rrow) * 132 + c8), v1 = *(const float4*)(part + ((which * 4 + w) * 16 + rrow) * 132 + c8 + 4);
        sum[0] += v0.x; sum[1] += v0.y; sum[2] += v0.z; sum[3] += v0.w; sum[4] += v1.x; sum[5] += v1.y; sum[6] += v1.z; sum[7] += v1.w;
      }
      u32x4 o;
#pragma unroll
      for (int e = 0; e < 4; ++e) o[e] = cvtpk(siluf_(sum[2 * e]), siluf_(sum[2 * e + 1]));
      *(u32x4*)(hl + which * 4352 + rrow * 272 + c8 * 2) = o;
    }
    __syncthreads();
    {
      f32x4 o2 = f32x4{0.f, 0.f, 0.f, 0.f};
#pragma unroll
      for (int ks = 0; ks < 4; ++ks) {
        const bf16x8 a = *(const bf16x8*)(hl + which * 4352 + fr * 272 + (ks * 32 + fq * 8) * 2);
        o2 = MFMA16(a, w2f[ks], o2);
      }
#pragma unroll
      for (int j = 0; j < 4; ++j) outl[which * 1088 + (fq * 4 + j) * 68 + w4 * 16 + fr] = o2[j];
    }
    __syncthreads();
    {
      const float* ol = outl + which * 1088;
      const float4 v = *(const float4*)(ol + orow * 68 + d4);
      if (which == 0) {
        float ss = v.x * v.x + v.y * v.y + v.z * v.z + v.w * v.w;
        ss += __shfl_xor(ss, 1); ss += __shfl_xor(ss, 2); ss += __shfl_xor(ss, 4); ss += __shfl_xor(ss, 8);
        const float rr = rsqrtf(ss * (1.0f / 64.f) + EPS);
        float o[4] = {v.x * rr * nwv[0], v.y * rr * nwv[1], v.z * rr * nwv[2], v.w * rr * nwv[3]};
        if (d4 < 16) {
#pragma unroll
          for (int e = 0; e < 4; ++e) {
            const int d = d4 + e, dp = d ^ 8;
            const float pr = ol[orow * 68 + dp] * rr * nwp[e];
            o[e] = (d < 8) ? (o[e] * csv[e].x - pr * csv[e].y) : (o[e] * csv[e].x + pr * csv[e].y);
          }
        }
        u32x2 ov; ov[0] = cvtpk(o[0], o[1]); ov[1] = cvtpk(o[2], o[3]);
        if (cc >= 255) { ov[0] = 0u; ov[1] = 0u; }
        *(u32x2*)(ws_Kc(p) + (size_t)(bg * 4 + (cc >> 6)) * 4096 + kimg_off(cc & 63, d4)) = ov;
      } else {
        const float z = (cc >= 255) ? 0.f : 1.f;
        u16* vt = ws_Vct(p) + (size_t)(bg * 4 + (cc >> 6)) * 4096;
        vt[vimg_off(d4 + 0, cc & 63)] = f2bf(v.x * z); vt[vimg_off(d4 + 1, cc & 63)] = f2bf(v.y * z);
        vt[vimg_off(d4 + 2, cc & 63)] = f2bf(v.z * z); vt[vimg_off(d4 + 3, cc & 63)] = f2bf(v.w * z);
      }
    }
    __syncthreads();
  }
  const int gw = bid * 8 + wid, nw = nb * 8;
  for (int chunk = gw; chunk < 2048; chunk += nw) {
    const int r0 = chunk * 16, t0 = r0 & 4095;
    const int ch = lane * 8;
    float cw0[8], cw1[8], cw2[8], cbv[8], u1[8], u2[8];
#pragma unroll
    for (int e = 0; e < 8; ++e) { cw0[e] = p.conv_w[ch + e]; cw1[e] = p.conv_w[512 + ch + e]; cw2[e] = p.conv_w[1024 + ch + e]; cbv[e] = p.conv_b[ch + e]; u1[e] = 0.f; u2[e] = 0.f; }
    if (t0 > 0) {
#pragma unroll
      for (int q = 0; q < 2; ++q) {
        const u16* rp = ws_cvb(p) + (size_t)(r0 - 2 + q) * 2048 + ch;
        const u32x4 hv = *(const u32x4*)(rp), cv = *(const u32x4*)(rp + 1024);
#pragma unroll
        for (int e = 0; e < 4; ++e) {
          const float ua = bflo(hv[e]) * bflo(cv[e]), ub = bfhi(hv[e]) * bfhi(cv[e]);
          if (q == 0) { u2[2 * e] = ua; u2[2 * e + 1] = ub; } else { u1[2 * e] = ua; u1[2 * e + 1] = ub; }
        }
      }
    }
#pragma unroll 4
    for (int rr = 0; rr < 16; ++rr) {
      const u16* rp = ws_cvb(p) + (size_t)(r0 + rr) * 2048 + ch;
      const u32x4 hv = *(const u32x4*)(rp), bv = *(const u32x4*)(rp + 512), cv = *(const u32x4*)(rp + 1024), zv = *(const u32x4*)(rp + 1536);
      u32x4 ov;
#pragma unroll
      for (int e = 0; e < 4; ++e) {
        const float ua = bflo(hv[e]) * bflo(cv[e]), ub = bfhi(hv[e]) * bfhi(cv[e]);
        const float ca = cw0[2 * e] * u2[2 * e] + cw1[2 * e] * u1[2 * e] + cw2[2 * e] * ua + cbv[2 * e];
        const float cbb = cw0[2 * e + 1] * u2[2 * e + 1] + cw1[2 * e + 1] * u1[2 * e + 1] + cw2[2 * e + 1] * ub + cbv[2 * e + 1];
        const float oa = bflo(bv[e]) * ca * siluf_(bflo(zv[e]));
        const float ob = bfhi(bv[e]) * cbb * siluf_(bfhi(zv[e]));
        ov[e] = cvtpk(oa, ob);
        u2[2 * e] = u1[2 * e]; u2[2 * e + 1] = u1[2 * e + 1]; u1[2 * e] = ua; u1[2 * e + 1] = ub;
      }
      *(u32x4*)(ws_mix(p) + (size_t)(r0 + rr) * LDK + 512 + ch) = ov;
    }
  }
}

constexpr int AT_NST = 5, AT_KB = 8192, AT_BUF = 16384;
constexpr int AT_F = AT_NST * AT_BUF, AT_IMPA = AT_F, AT_IMPB = AT_IMPA + 64 * 65 * 4, AT_VAL = AT_IMPA;
constexpr int AT_SELM = AT_F + 8 * 8192, AT_UNIT = AT_SELM + 512, AT_END = AT_UNIT + 16;
static_assert(AT_END <= SMEM_BYTES, "attention LDS layout exceeds the dynamic LDS size");

__device__ void phase_attn(const Params& p, char* smem, int bid, int nb, int rep) {
  int tid_ = threadIdx.x; asm volatile("" : "+v"(tid_));
  const int tid = tid_, lane = tid & 63, wid = __builtin_amdgcn_readfirstlane(tid >> 6), c32 = lane & 31, h = lane >> 5;
  const float NINF = -__builtin_inff();
  float* impa = (float*)(smem + AT_IMPA);
  float* impb = (float*)(smem + AT_IMPB);
  float* vals = (float*)(smem + AT_VAL);
  unsigned* selm = (unsigned*)(smem + AT_SELM);
  volatile int* s_unit = (volatile int*)(smem + AT_UNIT);
  const unsigned lds0 = (unsigned)(uintptr_t)smem;
  while (true) {
    if (tid == 0) *s_unit = (int)atomicAdd(ws_counter(p) + rep, 1u);
    __syncthreads();
    const int u = __builtin_amdgcn_readfirstlane(*s_unit);
    __syncthreads();
    if (u >= 1024) break;
    const int i = 63 - (u >> 4), bg = u & 15, b = bg >> 1, g = bg & 1;
    const int tl = wid * 8 + (c32 >> 2), hd = c32 & 3;
    const int t = i * 64 + tl;
    const u16* qrow = ws_Q(p) + ((size_t)(bg * 4096 + i * 64) * 4 + wid * 32 + c32) * 64;
    bf16x8 qf[4];
#pragma unroll
    for (int ks = 0; ks < 4; ++ks) qf[ks] = *(const bf16x8*)(qrow + ks * 16 + h * 8);
    const float* gp = ws_gates(p) + (size_t)(b * 4096 + t) * 24 + (g * 4 + hd) * 3;
    const float g0 = gp[0], g1 = gp[1], g2 = gp[2];
    asm volatile("" :: "v"(qf[0]), "v"(qf[1]), "v"(qf[2]), "v"(qf[3]), "v"(g0), "v"(g1), "v"(g2));
    const int ntc = (4 * i + 2) / 64 + 1, nsl = i + 1, nwin = (i < 8 ? i : 8) + 1;
    const int NT = 2 * ntc + nsl + nwin;
    const bool need_sel = i >= 16;

    f32x16 O0, O1;
#pragma unroll
    for (int r = 0; r < 16; ++r) { O0[r] = 0.f; O1[r] = 0.f; }
    float* fl = (float*)(smem + AT_F + wid * 8192) + lane;
    float m_run = NINF, l_run = 0.f, inv_l = 0.f;
    u32x4 kxw; kxw[0] = (h == 0) ? 0x3F80u : 0u; kxw[1] = 0u; kxw[2] = 0u; kxw[3] = 0u;
    const bf16x8 kx = __builtin_bit_cast(bf16x8, kxw);
    float oscale = 1.0f;
    unsigned sel_lo = 0xffffffffu, sel_hi = 0xffffffffu;
#define TILE_PTRS(n, kp, vp) do { \
      if ((n) < 2 * ntc) { const int tt_ = (n) < ntc ? (n) : (n) - ntc; kp = ws_Kc(p) + (size_t)(bg * 4 + tt_) * 4096; vp = ws_Vct(p) + (size_t)(bg * 4 + tt_) * 4096; } \
      else if ((n) < 2 * ntc + nsl) { const int j_ = (n) - 2 * ntc; kp = ws_Ks(p) + ((size_t)bg * 4096 + j_ * 64) * 64; vp = ws_Vst(p) + (size_t)(bg * 64 + j_) * 4096; } \
      else { const int j_ = i - nwin + 1 + ((n) - 2 * ntc - nsl); kp = ws_Kw(p) + ((size_t)bg * 4096 + j_ * 64) * 64; vp = ws_Vwt(p) + (size_t)(bg * 64 + j_) * 4096; } } while (0)
#define TISSUE(n, st_) do { const u16 *kp_, *vp_; TILE_PTRS(n, kp_, vp_); \
      const unsigned d_ = (unsigned)__builtin_amdgcn_readfirstlane((int)(lds0 + (st_) * AT_BUF + wid * 1024)); \
      glds16(kp_ + tid * 8, d_); glds16(vp_ + tid * 8, d_ + AT_KB); } while (0)
    {
      const int npre = NT < AT_NST - 1 ? NT : AT_NST - 1;
      for (int n = 0; n < npre; ++n) TISSUE(n, n);
    }
    int st_cur = 0, st_iss = AT_NST - 1;
    const int ksw = (c32 >> 1) & 7;
    for (int n = 0; n < NT; ++n) {
      {
        const int rem = NT - 1 - n;
        if (rem >= 3) WAIT_VM(6); else if (rem == 2) WAIT_VM(4); else if (rem == 1) WAIT_VM(2); else WAIT_VM(0);
        __builtin_amdgcn_s_barrier();
        if (n + AT_NST - 1 < NT) TISSUE(n + AT_NST - 1, st_iss);
      }
      int mode, base, lo, hi;
      bool full = false, lane_on = true;
      if (n < 2 * ntc) { mode = n < ntc ? 0 : 1; base = (n < ntc ? n : n - ntc) * 64; lo = -1; hi = (t - 31) >> 4; }
      else if (n < 2 * ntc + nsl) { const int j = n - 2 * ntc; mode = 2; base = j * 64; const unsigned bit = j < 32 ? (sel_lo >> j) & 1u : (sel_hi >> (j - 32)) & 1u; lo = -1; hi = bit ? t : -1; full = j < i; lane_on = bit != 0u; }
      else { const int j = i - nwin + 1 + (n - 2 * ntc - nsl); mode = 3; base = j * 64; lo = t - 512; hi = t; full = (j < i) && (j > i - 8); }
      const int lo_rel = lo - (base + 4 * h), hi_rel = hi - (base + 4 * h);
      const bool chk = ((n & 3) == 3) || mode == 0;
#pragma unroll
      for (int r = 0; r < 16; ++r) { O0[r] *= oscale; O1[r] *= oscale; }
      const char* kb = smem + st_cur * AT_BUF;
      const char* vb = kb + AT_KB;
      st_cur = st_cur == AT_NST - 1 ? 0 : st_cur + 1; st_iss = st_iss == AT_NST - 1 ? 0 : st_iss + 1;
      f32x16 S0, S1;
#define ATT_BODY(MASKED) do { \
      _Pragma("unroll") for (int r = 0; r < 16; ++r) { S0[r] = 0.f; S1[r] = 0.f; } \
      const float m_use = (m_run == NINF) ? 0.f : m_run;        \
      { \
          \
        const float negm = (!(MASKED) && !lane_on) ? NINF : -m_use; \
        u32x4 qxw; qxw[0] = (h == 0) ? (cvtpk(negm, 0.f) & 0xffffu) : 0u; qxw[1] = 0u; qxw[2] = 0u; qxw[3] = 0u; \
        const bf16x8 qx = __builtin_bit_cast(bf16x8, qxw); \
        S0 = MFMA32(kx, qx, S0); S1 = MFMA32(kx, qx, S1); \
      } \
      { \
        bf16x8 kf0[4], kf1[4]; \
        _Pragma("unroll") for (int ks = 0; ks < 4; ++ks) { \
          kf0[ks] = *(const bf16x8*)(kb + c32 * 128 + (((ks * 2 + h) ^ ksw) * 16)); \
          kf1[ks] = *(const bf16x8*)(kb + (32 + c32) * 128 + (((ks * 2 + h) ^ ksw) * 16)); \
        } \
        _Pragma("unroll") for (int ks = 0; ks < 4; ++ks) S0 = MFMA32(kf0[ks], qf[ks], S0);     \
        _Pragma("unroll") for (int ks = 0; ks < 4; ++ks) S1 = MFMA32(kf1[ks], qf[ks], S1); \
      } \
        \
      if (MASKED) { \
        _Pragma("unroll") for (int r = 0; r < 16; ++r) { \
          const int off = (r & 3) + 8 * (r >> 2); \
          S0[r] = (off > lo_rel && off <= hi_rel) ? S0[r] : NINF; \
          S1[r] = (off + 32 > lo_rel && off + 32 <= hi_rel) ? S1[r] : NINF; \
        } \
      } \
      float ps0 = 0.f, ps1 = 0.f; \
      bf16x8 vfa[4]; \
      _Pragma("unroll") for (int kk = 0; kk < 2; ++kk) \
        _Pragma("unroll") for (int dr = 0; dr < 2; ++dr) vfa[kk * 2 + dr] = *(const bf16x8*)(vb + (32 * dr + c32) * 128 + (((2 * kk + h) ^ ksw) * 16)); \
      _Pragma("unroll") for (int r = 0; r < 16; ++r) { S0[r] = __builtin_amdgcn_exp2f(S0[r]); ps0 += S0[r]; } \
      _Pragma("unroll") for (int kk = 0; kk < 2; ++kk) { \
        u32x4 pw; \
        _Pragma("unroll") for (int e = 0; e < 4; ++e) pw[e] = cvtpk(S0[8 * kk + 2 * e], S0[8 * kk + 2 * e + 1]); \
        const bf16x8 pf = __builtin_bit_cast(bf16x8, pw); \
        O0 = MFMA32(vfa[kk * 2], pf, O0); O1 = MFMA32(vfa[kk * 2 + 1], pf, O1); \
      } \
      __builtin_amdgcn_sched_group_barrier(0x100, 12, 0);     \
      __builtin_amdgcn_sched_group_barrier(0x008, 4, 0);      \
      _Pragma("unroll") for (int q_ = 0; q_ < 4; ++q_) { __builtin_amdgcn_sched_group_barrier(0x008, 1, 0); __builtin_amdgcn_sched_group_barrier(0x002, 9, 0); }     \
      __builtin_amdgcn_sched_barrier(0); \
      _Pragma("unroll") for (int r = 0; r < 16; ++r) { S1[r] = __builtin_amdgcn_exp2f(S1[r]); ps1 += S1[r]; } \
      _Pragma("unroll") for (int kk = 0; kk < 2; ++kk) { \
        u32x4 pw; \
        _Pragma("unroll") for (int e = 0; e < 4; ++e) pw[e] = cvtpk(S1[8 * kk + 2 * e], S1[8 * kk + 2 * e + 1]); \
        const bf16x8 pf = __builtin_bit_cast(bf16x8, pw); \
        const bf16x8 va0 = *(const bf16x8*)(vb + c32 * 128 + (((2 * (kk + 2) + h) ^ ksw) * 16)), va1 = *(const bf16x8*)(vb + (32 + c32) * 128 + (((2 * (kk + 2) + h) ^ ksw) * 16)); \
        O0 = MFMA32(va0, pf, O0); O1 = MFMA32(va1, pf, O1); \
      } \
      __builtin_amdgcn_sched_barrier(0); \
      oscale = 1.0f; \
      if (mode != 1) l_run += ps0 + ps1; \
      if (mode != 1 && chk) {                    \
        float mxp = fmaxf(fmaxf(S0[0], S0[1]), S1[0]); \
        mxp = fmaxf(fmaxf(mxp, S1[1]), S0[2]); \
        _Pragma("unroll") for (int r = 2; r < 16; r += 2) { \
          if (r > 2) mxp = fmaxf(fmaxf(mxp, S0[r]), S1[r - 1]); \
          mxp = fmaxf(fmaxf(mxp, S0[r + 1]), S1[r]); \
        } \
        mxp = fmaxf(mxp, S1[15]); \
        mxp = fmaxf(mxp, __shfl_xor(mxp, 32));            \
        const bool mv = (m_run == NINF) ? (mxp > 0.f) : (mxp > 256.0f); \
        const float m_new = bflo(cvtpk(m_use + __builtin_amdgcn_logf(mxp), 0.f));       \
        const float alpha = mv ? __builtin_amdgcn_exp2f(m_use - m_new) : 1.0f; \
        m_run = mv ? m_new : m_run; \
        l_run *= alpha; \
        oscale = alpha; \
      } \
      if ((MASKED) && mode == 1 && need_sel) {               \
        const int tt = base >> 6; \
        _Pragma("unroll") for (int kr = 0; kr < 2; ++kr) \
          _Pragma("unroll") for (int rg = 0; rg < 4; ++rg) { \
            float pv[4]; \
            _Pragma("unroll") for (int e = 0; e < 4; ++e) { \
              float v = (kr ? S1[rg * 4 + e] : S0[rg * 4 + e]) * inv_l; \
              v += __shfl_xor(v, 1); v += __shfl_xor(v, 2); \
              pv[e] = v; \
            } \
            if (hd == 0) { \
              const int nblk = tt * 16 + 8 * kr + 2 * rg + h; \
              impa[tl * 65 + nblk] = pv[0] + pv[1] + pv[2] + 0.5f * pv[3]; \
              impb[tl * 65 + nblk] = 0.5f * pv[3]; \
            } \
          } \
      } } while (0)
      if (full) ATT_BODY(false); else ATT_BODY(true);
#undef ATT_BODY
      if (n == ntc - 1) {
        const float lt = l_run + __shfl_xor(l_run, 32);
        inv_l = lt > 0.f ? 1.0f / lt : 0.f;
        oscale = 0.f;
      } else if (n == 2 * ntc - 1) {
        if (need_sel) {
          __syncthreads();
          const int tk = tid >> 3, nb0 = (tid & 7) * 8;
          float myv[8];
#pragma unroll
          for (int e = 0; e < 8; ++e) {
            const int nn = nb0 + e;
            const bool forced = (nn == 0) || (nn == i) || (nn == i - 1);
            float v = -1.0f;
            if (nn <= i) v = impa[tk * 65 + nn] + (nn > 0 ? impb[tk * 65 + nn - 1] : 0.f);
            if (forced) v = 1e9f;
            myv[e] = v;
            vals[tk * 65 + nn] = v;
          }
          __syncthreads();
          int cnt[8];
#pragma unroll
          for (int e = 0; e < 8; ++e) cnt[e] = 0;
          for (int mm = 0; mm < 64; ++mm) {
            const float vm = vals[tk * 65 + mm];
#pragma unroll
            for (int e = 0; e < 8; ++e) cnt[e] += (vm > myv[e] || (vm == myv[e] && mm < nb0 + e)) ? 1 : 0;
          }
          unsigned bits = 0;
#pragma unroll
          for (int e = 0; e < 8; ++e) bits |= (cnt[e] < 16 ? 1u : 0u) << e;
          unsigned wlo = (tid & 7) < 4 ? bits << (8 * (tid & 7)) : 0u;
          unsigned whi = (tid & 7) >= 4 ? bits << (8 * ((tid & 7) - 4)) : 0u;
          wlo |= __shfl_xor(wlo, 1); wlo |= __shfl_xor(wlo, 2); wlo |= __shfl_xor(wlo, 4);
          whi |= __shfl_xor(whi, 1); whi |= __shfl_xor(whi, 2); whi |= __shfl_xor(whi, 4);
          if ((tid & 7) == 0) { selm[tk * 2] = wlo; selm[tk * 2 + 1] = whi; }
          __syncthreads();
          sel_lo = selm[tl * 2]; sel_hi = selm[tl * 2 + 1];
        }
        {
          const float wgt = g0 * inv_l * oscale;
#pragma unroll
          for (int r = 0; r < 16; ++r) { fl[r * 64] = wgt * O0[r]; fl[(16 + r) * 64] = wgt * O1[r]; }
          m_run = NINF; l_run = 0.f; oscale = 0.f;
        }
      } else if (n == 2 * ntc + nsl - 1) {
        const float lt = l_run + __shfl_xor(l_run, 32);
        const float wgt = g1 * (lt > 0.f ? 1.0f / lt : 0.f) * oscale;
#pragma unroll
        for (int r = 0; r < 16; ++r) { fl[r * 64] += wgt * O0[r]; fl[(16 + r) * 64] += wgt * O1[r]; }
        m_run = NINF; l_run = 0.f; oscale = 0.f;
      }
    }
#undef TILE_PTRS
#undef TISSUE
    {
      const float lt = l_run + __shfl_xor(l_run, 32);
      const float wgt = g2 * (lt > 0.f ? 1.0f / lt : 0.f) * oscale;
      const size_t rowo = (size_t)(b * 4096 + t);
      const u16* zp = ws_zs(p) + rowo * 512 + (g * 4 + hd) * 64;
      u16* mp = ws_mix(p) + rowo * LDK + (g * 4 + hd) * 64;
#pragma unroll
      for (int dr = 0; dr < 2; ++dr)
#pragma unroll
        for (int rg = 0; rg < 4; ++rg) {
          const int d = 32 * dr + 8 * rg + 4 * h;
          const u32x2 zv = *(const u32x2*)(zp + d);
          const float f0 = fl[(dr * 16 + rg * 4 + 0) * 64] + wgt * (dr ? O1[rg * 4 + 0] : O0[rg * 4 + 0]);
          const float f1 = fl[(dr * 16 + rg * 4 + 1) * 64] + wgt * (dr ? O1[rg * 4 + 1] : O0[rg * 4 + 1]);
          const float f2 = fl[(dr * 16 + rg * 4 + 2) * 64] + wgt * (dr ? O1[rg * 4 + 2] : O0[rg * 4 + 2]);
          const float f3 = fl[(dr * 16 + rg * 4 + 3) * 64] + wgt * (dr ? O1[rg * 4 + 3] : O0[rg * 4 + 3]);
          u32x2 o;
          o[0] = cvtpk(f0 * bflo(zv[0]), f1 * bfhi(zv[0]));
          o[1] = cvtpk(f2 * bflo(zv[1]), f3 * bfhi(zv[1]));
          *(u32x2*)(mp + d) = o;
        }
    }
  }
}

#if FUSED
extern "C" __global__ void __launch_bounds__(NTHREADS) hybrid_fwd(Params p) {
  extern __shared__ __attribute__((aligned(16))) char smem[];
  cg::grid_group grid = cg::this_grid();
  const int bid = blockIdx.x, nb = gridDim.x;
  for (int r = 0; r < REP0; ++r) { phase_prep(p, smem, bid, nb); grid.sync(); }
  for (int r = 0; r < REP1; ++r) { gemm_phase<0>(p, smem, bid, nb); grid.sync(); }
  for (int r = 0; r < REP2; ++r) { phase_cmp_conv(p, smem, bid, nb); grid.sync(); }
  for (int r = 0; r < REP3; ++r) { phase_attn(p, smem, bid, nb, r); grid.sync(); }
  for (int r = 0; r < REP4; ++r) { gemm_phase<1>(p, smem, bid, nb); }
}
#else
template <int PH>
__global__ void __launch_bounds__(NTHREADS) phase_kernel(Params p) {
  extern __shared__ __attribute__((aligned(16))) char smem[];
  const int bid = blockIdx.x, nb = gridDim.x;
  if constexpr (PH == 0) phase_prep(p, smem, bid, nb);
  if constexpr (PH == 1) gemm_phase<0>(p, smem, bid, nb);
  if constexpr (PH == 2) phase_cmp_conv(p, smem, bid, nb);
  if constexpr (PH == 3) phase_attn(p, smem, bid, nb, 0);
  if constexpr (PH == 4) gemm_phase<1>(p, smem, bid, nb);
}
#endif

extern "C" void kernel_launch(void* const* d_in, const int* in_sizes, int n_in, void* d_out, int out_size, void* d_ws, size_t ws_size, hipStream_t stream) {
  Params p{};
  p.x = (const float*)d_in[0]; p.norm_w = (const float*)d_in[1]; p.w_in = (const float*)d_in[2]; p.q_norm_w = (const float*)d_in[3];
  p.k_norm_w = (const float*)d_in[4]; p.ck_pos = (const float*)d_in[5]; p.ck_w1 = (const float*)d_in[6]; p.ck_b1 = (const float*)d_in[7];
  p.ck_w2 = (const float*)d_in[8]; p.cv_pos = (const float*)d_in[9]; p.cv_w1 = (const float*)d_in[10]; p.cv_b1 = (const float*)d_in[11];
  p.cv_w2 = (const float*)d_in[12]; p.conv_w = (const float*)d_in[13]; p.conv_b = (const float*)d_in[14]; p.w_out = (const float*)d_in[15];
  p.out = (float*)d_out;
  p.ws = (char*)d_ws;
  const size_t off = WS_TOTAL;
  if (off > ws_size) { fprintf(stderr, "kernel_launch: workspace too small (%zu > %zu)\n", off, ws_size); return; }

#if FUSED
  static int grid_blocks = 0;
  if (!grid_blocks) {
    int dev = 0, cus = 0, per_cu = 0;
    hipGetDevice(&dev);
    hipDeviceGetAttribute(&cus, hipDeviceAttributeMultiprocessorCount, dev);
    hipFuncSetAttribute((const void*)hybrid_fwd, hipFuncAttributeMaxDynamicSharedMemorySize, SMEM_BYTES);
    hipOccupancyMaxActiveBlocksPerMultiprocessor(&per_cu, (const void*)hybrid_fwd, NTHREADS, SMEM_BYTES);
    if (per_cu < 1) per_cu = 1;
    grid_blocks = cus * per_cu;
  }
  void* args[] = {&p};
  hipError_t e = hipLaunchCooperativeKernel((const void*)hybrid_fwd, dim3(grid_blocks), dim3(NTHREADS), args, SMEM_BYTES, stream);
  if (e != hipSuccess) fprintf(stderr, "cooperative launch failed: %s (grid %d)\n", hipGetErrorString(e), grid_blocks);
#else
  static int attr_set = 0;
  if (!attr_set) {
    (void)hipFuncSetAttribute((const void*)phase_kernel<0>, hipFuncAttributeMaxDynamicSharedMemorySize, SMEM_BYTES);
    (void)hipFuncSetAttribute((const void*)phase_kernel<1>, hipFuncAttributeMaxDynamicSharedMemorySize, SMEM_BYTES);
    (void)hipFuncSetAttribute((const void*)phase_kernel<2>, hipFuncAttributeMaxDynamicSharedMemorySize, SMEM_BYTES);
    (void)hipFuncSetAttribute((const void*)phase_kernel<3>, hipFuncAttributeMaxDynamicSharedMemorySize, SMEM_BYTES);
    (void)hipFuncSetAttribute((const void*)phase_kernel<4>, hipFuncAttributeMaxDynamicSharedMemorySize, SMEM_BYTES);
    attr_set = 1;
  }
  const int G = 256;
  phase_kernel<0><<<G, NTHREADS, SMEM_BYTES, stream>>>(p);
  phase_kernel<1><<<G, NTHREADS, SMEM_BYTES, stream>>>(p);
  phase_kernel<2><<<G, NTHREADS, SMEM_BYTES, stream>>>(p);
  phase_kernel<3><<<G, NTHREADS, SMEM_BYTES, stream>>>(p);
  phase_kernel<4><<<G, NTHREADS, SMEM_BYTES, stream>>>(p);
#endif
}
```

```cpp
#include <hip/hip_runtime.h>
#include <hip/hip_cooperative_groups.h>
#include <cstdio>
#include <cstdint>
namespace cg = cooperative_groups;

#ifndef FUSED
#define FUSED 1
#endif
#define REP0 1
#define REP1 1
#define REP2 1
#define REP3 1
#define REP4 1

#define DI __device__ __forceinline__
typedef unsigned short u16;
using bf16x8 = __attribute__((ext_vector_type(8))) short;
using s16x4 = __attribute__((ext_vector_type(4))) short;
using f32x4 = __attribute__((ext_vector_type(4))) float;
using f32x16 = __attribute__((ext_vector_type(16))) float;
using u32x4 = __attribute__((ext_vector_type(4))) unsigned;
using u32x2 = __attribute__((ext_vector_type(2))) unsigned;
typedef __bf16 bf2_t __attribute__((ext_vector_type(2)));
typedef float fl2_t __attribute__((ext_vector_type(2)));

constexpr int NTHREADS = 512;
constexpr int SEQ = 4096, DM = 1024, DIN = 3864, NROWS = 32768;
constexpr int LDK = 1088;
constexpr float EPS = 1e-6f;
constexpr float QSCALE = 0.125f * 1.4426950408889634f;
constexpr int SMEM_BYTES = 148480;

__constant__ float c_invf[8] = {1.0f, 0.1939227432012558f, 0.03760603070259094f, 0.007292664609849453f,
                                0.0014142135623842478f, 0.00027424818836152554f, 5.3182957344688475e-05f, 1.0313385246263351e-05f};

DI unsigned cvtpk(float lo, float hi) {
  fl2_t f = {lo, hi};
  bf2_t b = __builtin_convertvector(f, bf2_t);
  return __builtin_bit_cast(unsigned, b);
}
DI u16 f2bf(float x) { return (u16)(cvtpk(x, 0.f) & 0xffffu); }
DI float bf2f(u16 v) { return __uint_as_float(((unsigned)v) << 16); }
DI float bflo(unsigned v) { return __uint_as_float(v << 16); }
DI float bfhi(unsigned v) { return __uint_as_float(v & 0xffff0000u); }
DI float sigmoidf_(float v) { return __builtin_amdgcn_rcpf(1.0f + __builtin_amdgcn_exp2f(-1.4426950408889634f * v)); }
DI float siluf_(float v) { return v * __builtin_amdgcn_rcpf(1.0f + __builtin_amdgcn_exp2f(-1.4426950408889634f * v)); }
DI void glds16(const void* g, unsigned lds_base) {
  unsigned sv;
  asm volatile("s_mov_b32 %0, m0\n\ts_mov_b32 m0, %2\n\ts_nop 0\n\tglobal_load_lds_dwordx4 %1, off\n\ts_mov_b32 m0, %0" : "=&s"(sv) : "v"(g), "s"(lds_base) : "memory");
}
#define MFMA16(a, b, c) __builtin_amdgcn_mfma_f32_16x16x32_bf16((a), (b), (c), 0, 0, 0)
#define MFMA32(a, b, c) __builtin_amdgcn_mfma_f32_32x32x16_bf16((a), (b), (c), 0, 0, 0)

struct Params {
  const float *x, *norm_w, *w_in, *q_norm_w, *k_norm_w, *ck_pos, *ck_w1, *ck_b1, *ck_w2, *cv_pos, *cv_w1, *cv_b1, *cv_w2, *conv_w, *conv_b, *w_out;
  float* out;
  char* ws;
};
constexpr size_t al256(size_t v) { return (v + 255) & ~(size_t)255; }
constexpr size_t OFF_xb = 0;
DI u16* ws_xb(const Params& p) { return (u16*)(p.ws + OFF_xb); }
constexpr size_t OFF_winT = OFF_xb + al256((size_t)NROWS * LDK * 2);
DI u16* ws_winT(const Params& p) { return (u16*)(p.ws + OFF_winT); }
constexpr size_t OFF_woutT = OFF_winT + al256((size_t)4096 * LDK * 2);
DI u16* ws_woutT(const Params& p) { return (u16*)(p.ws + OFF_woutT); }
constexpr size_t OFF_w1kT = OFF_woutT + al256((size_t)1024 * LDK * 2);
DI u16* ws_w1kT(const Params& p) { return (u16*)(p.ws + OFF_w1kT); }
constexpr size_t OFF_w1vT = OFF_w1kT + al256((size_t)128 * 2048 * 2);
DI u16* ws_w1vT(const Params& p) { return (u16*)(p.ws + OFF_w1vT); }
constexpr size_t OFF_w2kT = OFF_w1vT + al256((size_t)128 * 2048 * 2);
DI u16* ws_w2kT(const Params& p) { return (u16*)(p.ws + OFF_w2kT); }
constexpr size_t OFF_w2vT = OFF_w2kT + al256((size_t)64 * 128 * 2);
DI u16* ws_w2vT(const Params& p) { return (u16*)(p.ws + OFF_w2vT); }
constexpr size_t OFF_Q = OFF_w2vT + al256((size_t)64 * 128 * 2);
DI u16* ws_Q(const Params& p) { return (u16*)(p.ws + OFF_Q); }
constexpr size_t OFF_Ks = OFF_Q + al256((size_t)NROWS * 512 * 2);
DI u16* ws_Ks(const Params& p) { return (u16*)(p.ws + OFF_Ks); }
constexpr size_t OFF_Kw = OFF_Ks + al256((size_t)16 * 4096 * 64 * 2);
DI u16* ws_Kw(const Params& p) { return (u16*)(p.ws + OFF_Kw); }
constexpr size_t OFF_Vst = OFF_Kw + al256((size_t)16 * 4096 * 64 * 2);
DI u16* ws_Vst(const Params& p) { return (u16*)(p.ws + OFF_Vst); }
constexpr size_t OFF_Vwt = OFF_Vst + al256((size_t)16 * 4096 * 64 * 2);
DI u16* ws_Vwt(const Params& p) { return (u16*)(p.ws + OFF_Vwt); }
constexpr size_t OFF_kcraw = OFF_Vwt + al256((size_t)16 * 4096 * 64 * 2);
DI u16* ws_kcraw(const Params& p) { return (u16*)(p.ws + OFF_kcraw); }
constexpr size_t OFF_vcraw = OFF_kcraw + al256((size_t)16 * 4096 * 64 * 2 + 4096);
DI u16* ws_vcraw(const Params& p) { return (u16*)(p.ws + OFF_vcraw); }
constexpr size_t OFF_Kc = OFF_vcraw + al256((size_t)16 * 4096 * 64 * 2 + 4096);
DI u16* ws_Kc(const Params& p) { return (u16*)(p.ws + OFF_Kc); }
constexpr size_t OFF_Vct = OFF_Kc + al256((size_t)16 * 256 * 64 * 2);
DI u16* ws_Vct(const Params& p) { return (u16*)(p.ws + OFF_Vct); }
constexpr size_t OFF_zs = OFF_Vct + al256((size_t)16 * 256 * 64 * 2);
DI u16* ws_zs(const Params& p) { return (u16*)(p.ws + OFF_zs); }
constexpr size_t OFF_cvb = OFF_zs + al256((size_t)NROWS * 512 * 2);
DI u16* ws_cvb(const Params& p) { return (u16*)(p.ws + OFF_cvb); }
constexpr size_t OFF_mix = OFF_cvb + al256((size_t)NROWS * 2048 * 2);
DI u16* ws_mix(const Params& p) { return (u16*)(p.ws + OFF_mix); }
constexpr size_t OFF_rs = OFF_mix + al256((size_t)NROWS * LDK * 2);
DI float* ws_rs(const Params& p) { return (float*)(p.ws + OFF_rs); }
constexpr size_t OFF_ckpart = OFF_rs + al256((size_t)NROWS * 4);
DI float* ws_ckpart(const Params& p) { return (float*)(p.ws + OFF_ckpart); }
constexpr size_t OFF_rope = OFF_ckpart + al256((size_t)16 * 128 * 4);
DI float* ws_rope(const Params& p) { return (float*)(p.ws + OFF_rope); }
constexpr size_t OFF_gates = OFF_rope + al256((size_t)4096 * 8 * 2 * 4);
DI float* ws_gates(const Params& p) { return (float*)(p.ws + OFF_gates); }
constexpr size_t OFF_counter = OFF_gates + al256((size_t)NROWS * 24 * 4);
DI unsigned* ws_counter(const Params& p) { return (unsigned*)(p.ws + OFF_counter); }
constexpr size_t OFF_bar = OFF_counter + al256((size_t)256);
DI unsigned* ws_bar(const Params& p) { return (unsigned*)(p.ws + OFF_bar); }
constexpr size_t WS_TOTAL = OFF_bar + al256((size_t)3456 * 4);


DI void transpose_tile(const float* __restrict__ src, u16* __restrict__ dst, int K, int N, const float* __restrict__ scale, int kt, int nt, char* smem, int ldd) {
  float* tile = (float*)smem;
  const int tid = threadIdx.x;
#pragma unroll
  for (int i = 0; i < 8; ++i) {
    const int kk = i * 8 + (tid >> 6), nn = tid & 63, n = nt * 64 + nn, k = kt * 64 + kk;
    float v = (n < N) ? src[(size_t)k * N + n] : 0.f;
    if (scale) v *= scale[k];
    tile[kk * 65 + nn] = v;
  }
  __syncthreads();
#pragma unroll
  for (int i = 0; i < 8; ++i) {
    const int nn = i * 8 + (tid >> 6), kk = tid & 63;
    dst[(size_t)(nt * 64 + nn) * ldd + kt * 64 + kk] = f2bf(tile[kk * 65 + nn]);
  }
  __syncthreads();
}

__device__ void phase_prep(const Params& p, char* smem, int bid, int nb) {
  int tid_ = threadIdx.x; asm volatile("" : "+v"(tid_));
  const int tid = tid_, lane = tid & 63, wid = __builtin_amdgcn_readfirstlane(tid >> 6);
  constexpr int J_X = 1024, J_TW = 1024, J_TO = 256, J_T1 = 64, J_T2 = 2, J_CK = 16, J_ROPE = 64;
  constexpr int TOTAL = J_X + J_TW + J_TO + 2 * J_T1 + 2 * J_T2 + J_CK + J_ROPE;
  if (bid == 0 && tid < 8) ws_counter(p)[tid] = 0u;
  for (int j = bid; j < TOTAL; j += nb) {
    int jj = j;
    if (jj < J_X) {
      const int row0 = jj * 32 + wid * 4;
      float4 v[4][4]; float ss[4];
#pragma unroll
      for (int r = 0; r < 4; ++r) {
        const float4* xr = (const float4*)(p.x + (size_t)(row0 + r) * DM);
#pragma unroll
        for (int i = 0; i < 4; ++i) v[r][i] = xr[i * 64 + lane];
      }
#pragma unroll
      for (int r = 0; r < 4; ++r) {
        float a = 0.f;
#pragma unroll
        for (int i = 0; i < 4; ++i) a += v[r][i].x * v[r][i].x + v[r][i].y * v[r][i].y + v[r][i].z * v[r][i].z + v[r][i].w * v[r][i].w;
#pragma unroll
        for (int o = 32; o >= 1; o >>= 1) a += __shfl_xor(a, o);
        ss[r] = a;
      }
#pragma unroll
      for (int r = 0; r < 4; ++r) {
        if (lane == 0) ws_rs(p)[row0 + r] = rsqrtf(ss[r] * (1.0f / DM) + EPS);
#pragma unroll
        for (int i = 0; i < 4; ++i) {
          u32x2 o; o[0] = cvtpk(v[r][i].x, v[r][i].y); o[1] = cvtpk(v[r][i].z, v[r][i].w);
          const int rr_ = row0 + r;
          *(u32x2*)(ws_xb(p) + ((size_t)((rr_ >> 8) * 16 + i * 4 + (lane >> 4)) * 256 + (rr_ & 255)) * 64 + (lane & 15) * 4) = o;
        }
      }
      continue;
    }
    jj -= J_X;
    if (jj < J_TW) { transpose_tile(p.w_in, ws_winT(p), 1024, DIN, p.norm_w, jj & 15, jj >> 4, smem, LDK); continue; }
    jj -= J_TW;
    if (jj < J_TO) { transpose_tile(p.w_out, ws_woutT(p), 1024, 1024, nullptr, jj & 15, jj >> 4, smem, LDK); continue; }
    jj -= J_TO;
    if (jj < J_T1) { transpose_tile(p.ck_w1, ws_w1kT(p), 2048, 128, nullptr, jj & 31, jj >> 5, smem, 2048); continue; }
    jj -= J_T1;
    if (jj < J_T1) { transpose_tile(p.cv_w1, ws_w1vT(p), 2048, 128, nullptr, jj & 31, jj >> 5, smem, 2048); continue; }
    jj -= J_T1;
    if (jj < J_T2) { transpose_tile(p.ck_w2, ws_w2kT(p), 128, 64, nullptr, jj, 0, smem, 128); continue; }
    jj -= J_T2;
    if (jj < J_T2) { transpose_tile(p.cv_w2, ws_w2vT(p), 128, 64, nullptr, jj, 0, smem, 128); continue; }
    jj -= J_T2;
    if (jj < J_CK) {
      const int which = jj >> 3, chunk = jj & 7, hh = tid & 127, sub = tid >> 7;
      const float* pos = which ? p.cv_pos : p.ck_pos;
      const float* w1 = which ? p.cv_w1 : p.ck_w1;
      float acc = 0.f;
      const int f0 = chunk * 256 + sub * 64;
      float pv_[64], wv_[64];
#pragma unroll
      for (int f = 0; f < 64; ++f) { pv_[f] = pos[f0 + f]; wv_[f] = w1[(size_t)(f0 + f) * 128 + hh]; }
#pragma unroll
      for (int f = 0; f < 64; ++f) acc += pv_[f] * wv_[f];
      float* red = (float*)smem;
      red[sub * 128 + hh] = acc;
      __syncthreads();
      if (tid < 128) ws_ckpart(p)[(which * 8 + chunk) * 128 + tid] = red[tid] + red[128 + tid] + red[256 + tid] + red[384 + tid];
      __syncthreads();
      continue;
    }
    jj -= J_CK;
    {
      const int idx = jj * 512 + tid, pos = idx >> 3, fi = idx & 7;
      const float ang = (float)pos * c_invf[fi];
      float s, c; sincosf(ang, &s, &c);
      ws_rope(p)[idx * 2] = c; ws_rope(p)[idx * 2 + 1] = s;
    }
  }
}

DI int kimg_off(int row, int d) { return row * 64 + (((d >> 3) ^ ((row >> 1) & 7)) * 8) + (d & 7); }
DI int vimg_off(int d, int key) {
  const int kp = (key & ~12) | ((key & 4) << 1) | ((key & 8) >> 1);
  return d * 64 + (((kp >> 3) ^ ((d >> 1) & 7)) * 8) + (kp & 7);
}

constexpr int G_ASZ = 256 * 128, G_BSZ = 256 * 128, G_STAGE = G_ASZ + G_BSZ;
constexpr int G_ROPE = 2 * G_STAGE, G_RS = G_ROPE + 256 * 64;
static_assert(G_RS + 1024 <= SMEM_BYTES, "GEMM LDS layout exceeds the dynamic LDS size");
#define WAIT_VM(n) asm volatile("s_waitcnt vmcnt(" #n ")" ::: "memory")

template <int EPI>
__device__ void gemm_phase(const Params& p, char* smem, int bid, int nb) {
  constexpr int NT = EPI == 0 ? 16 : 4;
  constexpr int MT = 128;
  const u16* __restrict__ A = EPI == 0 ? ws_xb(p) : ws_mix(p);
  const u16* __restrict__ Bt = EPI == 0 ? ws_winT(p) : ws_woutT(p);
  int tid_ = threadIdx.x; asm volatile("" : "+v"(tid_));
  const int tid = tid_, lane = tid & 63, wid = __builtin_amdgcn_readfirstlane(tid >> 6), fr = lane & 15, fq = lane >> 4;
  const int wr = wid >> 2, wc = wid & 3;
  const bool xmap = (nb == 256);
  const int xcd = bid & 7, li = bid >> 3;
  const int ntiles = xmap ? (EPI == 0 ? 8 : 2) : (MT * NT - bid + nb - 1) / nb;
  auto tile_of = [&](int ti, int& m0, int& n0) {
    if (xmap) {
      const int sg = ti * 8 + xcd;
      if (EPI == 0) { m0 = ((sg >> 1) * 4 + (li >> 3)) * 256; n0 = ((sg & 1) * 8 + (li & 7)) * 256; }
      else { m0 = (sg * 8 + (li >> 2)) * 256; n0 = (li & 3) * 256; }
    } else { const int tile = bid + ti * nb; const int mt = tile / NT; m0 = mt * 256; n0 = (tile - mt * NT) * 256; }
  };
  const int nsteps = ntiles * 16;
  const unsigned lds0 = (unsigned)(uintptr_t)smem;
  const int gsw = (lane & 7) ^ ((wid & 1) * 4 + (lane >> 4));
  const int grow = wid * 8 + (lane >> 3);
  auto issue = [&](int step, int stage) {
    int m0, n0; tile_of(step >> 4, m0, n0);
    const int kt = step & 15;
    const u16* ag = EPI == 0 ? A + ((size_t)((m0 >> 8) * 16 + kt) * 256 + grow) * 64 + gsw * 8 : A + (size_t)(m0 + grow) * LDK + kt * 64 + gsw * 8;
    const size_t astep = EPI == 0 ? (size_t)64 * 64 : (size_t)64 * LDK;
    const int brow = EPI == 0 ? ((grow & ~31) | ((grow & 0x0C) << 1) | ((grow & 0x10) >> 2) | (grow & 3)) : grow;
    const u16* bg_ = Bt + (size_t)(n0 + brow) * LDK + kt * 64 + gsw * 8;
    const unsigned dst = (unsigned)__builtin_amdgcn_readfirstlane((int)(lds0 + stage * G_STAGE + wid * 1024));
#pragma unroll
    for (int i = 0; i < 4; ++i) glds16(ag + i * astep, dst + i * 8192);
#pragma unroll
    for (int i = 0; i < 4; ++i) glds16(bg_ + (size_t)i * 64 * LDK, dst + G_ASZ + i * 8192);
    if (EPI == 0 && kt == 8) {
      const int t0 = m0 & 4095;
      const unsigned sd = (unsigned)__builtin_amdgcn_readfirstlane((int)(lds0 + G_ROPE + wid * 1024));
      glds16(ws_rope(p) + (size_t)t0 * 16 + tid * 4, sd);
      glds16(ws_rope(p) + (size_t)t0 * 16 + (512 + tid) * 4, sd + 8192);
      if (wid == 0) glds16(ws_rs(p) + m0 + lane * 4, lds0 + G_RS);
    }
  };
  const int ca0 = ((fq ^ (fr >> 1)) * 16), ca1 = (((4 + fq) ^ (fr >> 1)) * 16);
  f32x4 acc[8][4];
#pragma unroll
  for (int m = 0; m < 8; ++m)
#pragma unroll
    for (int n = 0; n < 4; ++n) acc[m][n] = f32x4{0.f, 0.f, 0.f, 0.f};
  __syncthreads();
  if (nsteps > 0) issue(0, 0);
  for (int s = 0; s < nsteps; ++s) {
    WAIT_VM(0);
    __builtin_amdgcn_s_waitcnt(0x0F70);
    __builtin_amdgcn_s_barrier();
    if (s + 1 < nsteps) issue(s + 1, (s + 1) & 1);
    {
      const char* ab = smem + (s & 1) * G_STAGE + (wr * 128 + fr) * 128;
      const char* bb = smem + (s & 1) * G_STAGE + G_ASZ + (wc * 64 + fr) * 128;
#pragma unroll
      for (int ks = 0; ks < 2; ++ks) {
        bf16x8 af[8], bf[4];
        const int co = ks ? ca1 : ca0;
#pragma unroll
        for (int n = 0; n < 4; ++n) bf[n] = *(const bf16x8*)(bb + n * 16 * 128 + co);
#pragma unroll
        for (int m = 0; m < 8; ++m) af[m] = *(const bf16x8*)(ab + m * 16 * 128 + co);
#pragma unroll
        for (int m = 0; m < 8; ++m)
#pragma unroll
          for (int n = 0; n < 4; ++n) acc[m][n] = MFMA16(bf[n], af[m], acc[m][n]);
      }
    }
    if ((s & 15) != 15) continue;
    int m0, n0; tile_of(s >> 4, m0, n0);
    const int rbase = m0 + wr * 128;
    const int cb = n0 + wc * 64;
    if constexpr (EPI == 1) {
#pragma unroll
      for (int hm = 0; hm < 2; ++hm) {
        float4 xv[4][4];
#pragma unroll
        for (int mm = 0; mm < 4; ++mm) {
          const size_t ro = (size_t)(rbase + (hm * 4 + mm) * 16 + fr) * DM + cb + fq * 4;
#pragma unroll
          for (int n = 0; n < 4; ++n) xv[mm][n] = *(const float4*)(p.x + ro + n * 16);
        }
#pragma unroll
        for (int mm = 0; mm < 4; ++mm) {
          const int m = hm * 4 + mm;
          const size_t ro = (size_t)(rbase + m * 16 + fr) * DM + cb + fq * 4;
#pragma unroll
          for (int n = 0; n < 4; ++n) {
            float4 o; o.x = xv[mm][n].x + acc[m][n][0]; o.y = xv[mm][n].y + acc[m][n][1]; o.z = xv[mm][n].z + acc[m][n][2]; o.w = xv[mm][n].w + acc[m][n][3];
            *(float4*)(p.out + ro + n * 16) = o;
          }
        }
        __builtin_amdgcn_sched_barrier(0);
      }
    } else {
      const int b = m0 >> 12;
      const int tb = rbase & 4095;
      if (cb < 1280) {
        const int seg = cb >> 6;
        const int which = seg < 8 ? -1 : ((seg - 8) >> 1);
        const int g = seg < 8 ? (seg >> 2) : ((seg - 8) & 1);
        const bool need_norm = (seg < 8) || which == 2 || which == 4;
        const float* nw = seg < 8 ? p.q_norm_w : (p.k_norm_w + (which == 2 ? 64 : 128));
        float w[16];
#pragma unroll
        for (int k = 0; k < 16; ++k) w[k] = need_norm ? nw[(k >> 3) * 32 + fq * 8 + (k & 7)] : 1.0f;
        const float qs = seg < 8 ? QSCALE : 1.0f;
#pragma unroll
        for (int m = 0; m < 8; ++m) {
          const int t = tb + m * 16 + fr;
          const int lrow = wr * 128 + m * 16 + fr;
          const float r = *(const float*)(smem + G_RS + lrow * 4);
          float v[16];
#pragma unroll
          for (int k = 0; k < 16; ++k) v[k] = acc[m][(k >> 3) * 2 + ((k & 7) >> 2)][k & 3] * r;
          if (need_norm) {
            float ss = 0.f;
#pragma unroll
            for (int k = 0; k < 16; ++k) ss += v[k] * v[k];
            ss += __shfl_xor(ss, 16); ss += __shfl_xor(ss, 32);
            const float rr = rsqrtf(ss * (1.0f / 64.f) + EPS);
#pragma unroll
            for (int k = 0; k < 16; ++k) v[k] = v[k] * rr * w[k];
            const float4* rp = (const float4*)(smem + G_ROPE + lrow * 64);
            const float4 c01 = rp[0], c23 = rp[1], c45 = rp[2], c67 = rp[3];
            const float cc[8] = {c01.x, c01.z, c23.x, c23.z, c45.x, c45.z, c67.x, c67.z};
            const float sn[8] = {c01.y, c01.w, c23.y, c23.w, c45.y, c45.w, c67.y, c67.w};
#pragma unroll
            for (int e = 0; e < 8; ++e) {
              const float pr = __shfl_xor(v[e], 16);
              const float rot = (fq == 0) ? (v[e] * cc[e] - pr * sn[e]) : (v[e] * cc[e] + pr * sn[e]);
              v[e] = (fq < 2) ? rot : v[e];
            }
#pragma unroll
            for (int k = 0; k < 16; ++k) v[k] *= qs;
          }
          if (which == 3 || which == 5) {
            int lz = 0; asm volatile("" : "+v"(lz));
            u16* vt = (which == 3 ? ws_Vst(p) : ws_Vwt(p)) + (size_t)((b * 2 + g) * 64 + (t >> 6)) * 4096 + lz;
            const int fqx = fq + lz, key = (t & 63) + lz;
#pragma unroll
            for (int k = 0; k < 16; ++k) vt[vimg_off((k >> 3) * 32 + fqx * 8 + (k & 7), key)] = f2bf(v[k]);
          } else {
            u16* dst;
            if (seg < 8) dst = ws_Q(p) + ((size_t)((b * 2 + g) * 4096 + t) * 4 + (seg & 3)) * 64;
            else { u16* buf = which == 0 ? ws_kcraw(p) : which == 1 ? ws_vcraw(p) : which == 2 ? ws_Ks(p) : ws_Kw(p); dst = buf + ((size_t)(b * 2 + g) * 4096 + t) * 64; }
            const bool img = which >= 2;
#pragma unroll
            for (int n2 = 0; n2 < 2; ++n2) {
              u32x4 o;
#pragma unroll
              for (int e = 0; e < 4; ++e) o[e] = cvtpk(v[n2 * 8 + 2 * e], v[n2 * 8 + 2 * e + 1]);
              const int d0 = n2 * 32 + fq * 8;
              const int off = img ? (((d0 >> 3) ^ (((t & 63) >> 1) & 7)) * 8) : d0;
              *(u32x4*)(dst + off) = o;
            }
          }
          __builtin_amdgcn_sched_barrier(0);
        }
      } else {
#pragma unroll
        for (int m = 0; m < 8; ++m) {
          const size_t row = rbase + m * 16 + fr;
          const float r = *(const float*)(smem + G_RS + (wr * 128 + m * 16 + fr) * 4);
#pragma unroll
          for (int n2 = 0; n2 < 2; ++n2) {
            const int c8 = cb + n2 * 32 + fq * 8;
            if (c8 >= DIN) continue;
            float v[8];
#pragma unroll
            for (int e = 0; e < 8; ++e) v[e] = acc[m][n2 * 2 + (e >> 2)][e & 3] * r;
            if (c8 < 1304) {
              float4 o0, o1;
              o0.x = sigmoidf_(v[0]); o0.y = sigmoidf_(v[1]); o0.z = sigmoidf_(v[2]); o0.w = sigmoidf_(v[3]);
              o1.x = sigmoidf_(v[4]); o1.y = sigmoidf_(v[5]); o1.z = sigmoidf_(v[6]); o1.w = sigmoidf_(v[7]);
              float* gp = ws_gates(p) + row * 24 + (c8 - 1280);
              *(float4*)gp = o0; *(float4*)(gp + 4) = o1;
            } else if (c8 < 1816) {
              u32x4 o;
#pragma unroll
              for (int e = 0; e < 4; ++e) o[e] = cvtpk(siluf_(v[2 * e]), siluf_(v[2 * e + 1]));
              *(u32x4*)(ws_zs(p) + row * 512 + (c8 - 1304)) = o;
            } else {
              u32x4 o;
#pragma unroll
              for (int e = 0; e < 4; ++e) o[e] = cvtpk(v[2 * e], v[2 * e + 1]);
              *(u32x4*)(ws_cvb(p) + row * 2048 + (c8 - 1816)) = o;
            }
          }
          __builtin_amdgcn_sched_barrier(0);
        }
      }
    }
#pragma unroll
    for (int m = 0; m < 8; ++m)
#pragma unroll
      for (int n = 0; n < 4; ++n) acc[m][n] = f32x4{0.f, 0.f, 0.f, 0.f};
  }
}

__device__ void phase_cmp_conv(const Params& p, char* smem, int bid, int nb) {
  int tid_ = threadIdx.x; asm volatile("" : "+v"(tid_));
  const int tid = tid_, lane = tid & 63, wid = __builtin_amdgcn_readfirstlane(tid >> 6), fr = lane & 15, fq = lane >> 4;
  float* part = (float*)smem;
  char* hl = smem + 8 * 16 * 132 * 4;
  float* outl = (float*)(hl + 2 * 4352);
  for (int job = bid; job < 256; job += nb) {
    const int which = wid >> 2, w4 = wid & 3, bg = job >> 4, ct = job & 15;
    const u16* raw = (which ? ws_vcraw(p) : ws_kcraw(p)) + (size_t)bg * 4096 * 64;
    const u16* w1T = which ? ws_w1vT(p) : ws_w1kT(p);
    const u16* w2T = which ? ws_w2vT(p) : ws_w2kT(p);
    const float* b1 = which ? p.cv_b1 : p.ck_b1;
    f32x4 acc[8];
#pragma unroll
    for (int n = 0; n < 8; ++n) acc[n] = f32x4{0.f, 0.f, 0.f, 0.f};
    const int c = ct * 16 + fr;
    const int ht = tid & 255, rrow = ht >> 4, c8 = (ht & 15) * 8;
    float bias[8];
#pragma unroll
    for (int e = 0; e < 8; ++e) {
      float bsum = b1[c8 + e];
#pragma unroll
      for (int ch = 0; ch < 8; ++ch) bsum += ws_ckpart(p)[(which * 8 + ch) * 128 + c8 + e];
      bias[e] = bsum;
    }
    bf16x8 w2f[4];
#pragma unroll
    for (int ks = 0; ks < 4; ++ks) w2f[ks] = *(const bf16x8*)(w2T + (size_t)(w4 * 16 + fr) * 128 + ks * 32 + fq * 8);
    const int orow = ht >> 4, d4 = (ht & 15) * 4;
    const int cc = ct * 16 + orow;
    float nwv[4], nwp[4]; float2 csv[4];
    {
      int pos = cc * 16 + 31; pos = pos > 4095 ? 4095 : pos;
#pragma unroll
      for (int e = 0; e < 4; ++e) {
        const int d = d4 + e;
        nwv[e] = p.k_norm_w[d]; nwp[e] = p.k_norm_w[d ^ 8];
        csv[e] = *(const float2*)(ws_rope(p) + ((size_t)pos * 8 + (d & 7)) * 2);
      }
    }
#pragma unroll 4
    for (int k16 = 0; k16 < 16; ++k16) {
      const int ks = w4 * 16 + k16;
      const int l = ks >> 1, d0 = (ks & 1) * 32 + fq * 8;
      int tt = c * 16 + l; tt = tt > 4095 ? 4095 : tt;
      const bf16x8 a = *(const bf16x8*)(raw + (size_t)tt * 64 + d0);
#pragma unroll
      for (int n = 0; n < 8; ++n) {
        const bf16x8 bb = *(const bf16x8*)(w1T + (size_t)(n * 16 + fr) * 2048 + ks * 32 + fq * 8);
        acc[n] = MFMA16(a, bb, acc[n]);
      }
    }
#pragma unroll
    for (int n = 0; n < 8; ++n)
#pragma unroll
      for (int j = 0; j < 4; ++j) part[(wid * 16 + fq * 4 + j) * 132 + n * 16 + fr] = acc[n][j];
    __syncthreads();
    {
      float sum[8];
#pragma unroll
      for (int e = 0; e < 8; ++e) sum[e] = bias[e];
#pragma unroll
      for (int w = 0; w < 4; ++w) {
        const float4 v0 = *(const float4*)(part + ((which * 4 + w) * 16 + rrow) * 132 + c8), v1 = *(const float4*)(part + ((which * 4 + w) * 16 + rrow) * 132 + c8 + 4);
        sum[0] += v0.x; sum[1] += v0.y; sum[2] += v0.z; sum[3] += v0.w; sum[4] += v1.x; sum[5] += v1.y; sum[6] += v1.z; sum[7] += v1.w;
      }
      u32x4 o;
#pragma unroll
      for (int e = 0; e < 4; ++e) o[e] = cvtpk(siluf_(sum[2 * e]), siluf_(sum[2 * e + 1]));
      *(u32x4*)(hl + which * 4352 + rrow * 272 + c8 * 2) = o;
    }
    __syncthreads();
    {
      f32x4 o2 = f32x4{0.f, 0.f, 0.f, 0.f};
#pragma unroll
      for (int ks = 0; ks < 4; ++ks) {
        const bf16x8 a = *(const bf16x8*)(hl + which * 4352 + fr * 272 + (ks * 32 + fq * 8) * 2);
        o2 = MFMA16(a, w2f[ks], o2);
      }
#pragma unroll
      for (int j = 0; j < 4; ++j) outl[which * 1088 + (fq * 4 + j) * 68 + w4 * 16 + fr] = o2[j];
    }
    __syncthreads();
    {
      const float* ol = outl + which * 1088;
      const float4 v = *(const float4*)(ol + orow * 68 + d4);
      if (which == 0) {
        float ss = v.x * v.x + v.y * v.y + v.z * v.z + v.w * v.w;
        ss += __shfl_xor(ss, 1); ss += __shfl_xor(ss, 2); ss += __shfl_xor(ss, 4); ss += __shfl_xor(ss, 8);
        const float rr = rsqrtf(ss * (1.0f / 64.f) + EPS);
        float o[4] = {v.x * rr * nwv[0], v.y * rr * nwv[1], v.z * rr * nwv[2], v.w * rr * nwv[3]};
        if (d4 < 16) {
#pragma unroll
          for (int e = 0; e < 4; ++e) {
            const int d = d4 + e, dp = d ^ 8;
            const float pr = ol[orow * 68 + dp] * rr * nwp[e];
            o[e] = (d < 8) ? (o[e] * csv[e].x - pr * csv[e].y) : (o[e] * csv[e].x + pr * csv[e].y);
          }
        }
        u32x2 ov; ov[0] = cvtpk(o[0], o[1]); ov[1] = cvtpk(o[2], o[3]);
        if (cc >= 255) { ov[0] = 0u; ov[1] = 0u; }
        *(u32x2*)(ws_Kc(p) + (size_t)(bg * 4 + (cc >> 6)) * 4096 + kimg_off(cc & 63, d4)) = ov;
      } else {
        const float z = (cc >= 255) ? 0.f : 1.f;
        u16* vt = ws_Vct(p) + (size_t)(bg * 4 + (cc >> 6)) * 4096;
        vt[vimg_off(d4 + 0, cc & 63)] = f2bf(v.x * z); vt[vimg_off(d4 + 1, cc & 63)] = f2bf(v.y * z);
        vt[vimg_off(d4 + 2, cc & 63)] = f2bf(v.z * z); vt[vimg_off(d4 + 3, cc & 63)] = f2bf(v.w * z);
      }
    }
    __syncthreads();
  }
  const int gw = bid * 8 + wid, nw = nb * 8;
  for (int chunk = gw; chunk < 2048; chunk += nw) {
    const int r0 = chunk * 16, t0 = r0 & 4095;
    const int ch = lane * 8;
    float cw0[8], cw1[8], cw2[8], cbv[8], u1[8], u2[8];
#pragma unroll
    for (int e = 0; e < 8; ++e) { cw0[e] = p.conv_w[ch + e]; cw1[e] = p.conv_w[512 + ch + e]; cw2[e] = p.conv_w[1024 + ch + e]; cbv[e] = p.conv_b[ch + e]; u1[e] = 0.f; u2[e] = 0.f; }
    if (t0 > 0) {
#pragma unroll
      for (int q = 0; q < 2; ++q) {
        const u16* rp = ws_cvb(p) + (size_t)(r0 - 2 + q) * 2048 + ch;
        const u32x4 hv = *(const u32x4*)(rp), cv = *(const u32x4*)(rp + 1024);
#pragma unroll
        for (int e = 0; e < 4; ++e) {
          const float ua = bflo(hv[e]) * bflo(cv[e]), ub = bfhi(hv[e]) * bfhi(cv[e]);
          if (q == 0) { u2[2 * e] = ua; u2[2 * e + 1] = ub; } else { u1[2 * e] = ua; u1[2 * e + 1] = ub; }
        }
      }
    }
#pragma unroll 4
    for (int rr = 0; rr < 16; ++rr) {
      const u16* rp = ws_cvb(p) + (size_t)(r0 + rr) * 2048 + ch;
      const u32x4 hv = *(const u32x4*)(rp), bv = *(const u32x4*)(rp + 512), cv = *(const u32x4*)(rp + 1024), zv = *(const u32x4*)(rp + 1536);
      u32x4 ov;
#pragma unroll
      for (int e = 0; e < 4; ++e) {
        const float ua = bflo(hv[e]) * bflo(cv[e]), ub = bfhi(hv[e]) * bfhi(cv[e]);
        const float ca = cw0[2 * e] * u2[2 * e] + cw1[2 * e] * u1[2 * e] + cw2[2 * e] * ua + cbv[2 * e];
        const float cbb = cw0[2 * e + 1] * u2[2 * e + 1] + cw1[2 * e + 1] * u1[2 * e + 1] + cw2[2 * e + 1] * ub + cbv[2 * e + 1];
        const float oa = bflo(bv[e]) * ca * siluf_(bflo(zv[e]));
        const float ob = bfhi(bv[e]) * cbb * siluf_(bfhi(zv[e]));
        ov[e] = cvtpk(oa, ob);
        u2[2 * e] = u1[2 * e]; u2[2 * e + 1] = u1[2 * e + 1]; u1[2 * e] = ua; u1[2 * e + 1] = ub;
      }
      *(u32x4*)(ws_mix(p) + (size_t)(r0 + rr) * LDK + 512 + ch) = ov;
    }
  }
}

constexpr int AT_NST = 5, AT_KB = 8192, AT_BUF = 16384;
constexpr int AT_F = AT_NST * AT_BUF, AT_IMPA = AT_F, AT_IMPB = AT_IMPA + 64 * 65 * 4, AT_VAL = AT_IMPA;
constexpr int AT_SELM = AT_F + 8 * 8192, AT_UNIT = AT_SELM + 512, AT_END = AT_UNIT + 16;
static_assert(AT_END <= SMEM_BYTES, "attention LDS layout exceeds the dynamic LDS size");

__device__ void phase_attn(const Params& p, char* smem, int bid, int nb, int rep) {
  int tid_ = threadIdx.x; asm volatile("" : "+v"(tid_));
  const int tid = tid_, lane = tid & 63, wid = __builtin_amdgcn_readfirstlane(tid >> 6), c32 = lane & 31, h = lane >> 5;
  const float NINF = -__builtin_inff();
  float* impa = (float*)(smem + AT_IMPA);
  float* impb = (float*)(smem + AT_IMPB);
  float* vals = (float*)(smem + AT_VAL);
  unsigned* selm = (unsigned*)(smem + AT_SELM);
  volatile int* s_unit = (volatile int*)(smem + AT_UNIT);
  const unsigned lds0 = (unsigned)(uintptr_t)smem;
  while (true) {
    if (tid == 0) *s_unit = (int)atomicAdd(ws_counter(p) + rep, 1u);
    __syncthreads();
    const int u = __builtin_amdgcn_readfirstlane(*s_unit);
    __syncthreads();
    if (u >= 1024) break;
    const int i = 63 - (u >> 4), bg = u & 15, b = bg >> 1, g = bg & 1;
    const int tl = wid * 8 + (c32 >> 2), hd = c32 & 3;
    const int t = i * 64 + tl;
    const u16* qrow = ws_Q(p) + ((size_t)(bg * 4096 + i * 64) * 4 + wid * 32 + c32) * 64;
    bf16x8 qf[4];
#pragma unroll
    for (int ks = 0; ks < 4; ++ks) qf[ks] = *(const bf16x8*)(qrow + ks * 16 + h * 8);
    const float* gp = ws_gates(p) + (size_t)(b * 4096 + t) * 24 + (g * 4 + hd) * 3;
    const float g0 = gp[0], g1 = gp[1], g2 = gp[2];
    asm volatile("" :: "v"(qf[0]), "v"(qf[1]), "v"(qf[2]), "v"(qf[3]), "v"(g0), "v"(g1), "v"(g2));
    const int ntc = (4 * i + 2) / 64 + 1, nsl = i + 1, nwin = (i < 8 ? i : 8) + 1;
    const int NT = 2 * ntc + nsl + nwin;
    const bool need_sel = i >= 16;

    f32x16 O0, O1;
#pragma unroll
    for (int r = 0; r < 16; ++r) { O0[r] = 0.f; O1[r] = 0.f; }
    float* fl = (float*)(smem + AT_F + wid * 8192) + lane;
    float m_run = NINF, l_run = 0.f, inv_l = 0.f;
    u32x4 kxw; kxw[0] = (h == 0) ? 0x3F80u : 0u; kxw[1] = 0u; kxw[2] = 0u; kxw[3] = 0u;
    const bf16x8 kx = __builtin_bit_cast(bf16x8, kxw);
    float oscale = 1.0f;
    unsigned sel_lo = 0xffffffffu, sel_hi = 0xffffffffu;
#define TILE_PTRS(n, kp, vp) do { \
      if ((n) < 2 * ntc) { const int tt_ = (n) < ntc ? (n) : (n) - ntc; kp = ws_Kc(p) + (size_t)(bg * 4 + tt_) * 4096; vp = ws_Vct(p) + (size_t)(bg * 4 + tt_) * 4096; } \
      else if ((n) < 2 * ntc + nsl) { const int j_ = (n) - 2 * ntc; kp = ws_Ks(p) + ((size_t)bg * 4096 + j_ * 64) * 64; vp = ws_Vst(p) + (size_t)(bg * 64 + j_) * 4096; } \
      else { const int j_ = i - nwin + 1 + ((n) - 2 * ntc - nsl); kp = ws_Kw(p) + ((size_t)bg * 4096 + j_ * 64) * 64; vp = ws_Vwt(p) + (size_t)(bg * 64 + j_) * 4096; } } while (0)
#define TISSUE(n, st_) do { const u16 *kp_, *vp_; TILE_PTRS(n, kp_, vp_); \
      const unsigned d_ = (unsigned)__builtin_amdgcn_readfirstlane((int)(lds0 + (st_) * AT_BUF + wid * 1024)); \
      glds16(kp_ + tid * 8, d_); glds16(vp_ + tid * 8, d_ + AT_KB); } while (0)
    {
      const int npre = NT < AT_NST - 1 ? NT : AT_NST - 1;
      for (int n = 0; n < npre; ++n) TISSUE(n, n);
    }
    int st_cur = 0, st_iss = AT_NST - 1;
    const int ksw = (c32 >> 1) & 7;
    for (int n = 0; n < NT; ++n) {
      {
        const int rem = NT - 1 - n;
        if (rem >= 3) WAIT_VM(6); else if (rem == 2) WAIT_VM(4); else if (rem == 1) WAIT_VM(2); else WAIT_VM(0);
        __builtin_amdgcn_s_barrier();
        if (n + AT_NST - 1 < NT) TISSUE(n + AT_NST - 1, st_iss);
      }
      int mode, base, lo, hi;
      bool full = false, lane_on = true;
      if (n < 2 * ntc) { mode = n < ntc ? 0 : 1; base = (n < ntc ? n : n - ntc) * 64; lo = -1; hi = (t - 31) >> 4; }
      else if (n < 2 * ntc + nsl) { const int j = n - 2 * ntc; mode = 2; base = j * 64; const unsigned bit = j < 32 ? (sel_lo >> j) & 1u : (sel_hi >> (j - 32)) & 1u; lo = -1; hi = bit ? t : -1; full = j < i; lane_on = bit != 0u; }
      else { const int j = i - nwin + 1 + (n - 2 * ntc - nsl); mode = 3; base = j * 64; lo = t - 512; hi = t; full = (j < i) && (j > i - 8); }
      const int lo_rel = lo - (base + 4 * h), hi_rel = hi - (base + 4 * h);
      const bool chk = ((n & 3) == 3) || mode == 0;
#pragma unroll
      for (int r = 0; r < 16; ++r) { O0[r] *= oscale; O1[r] *= oscale; }
      const char* kb = smem + st_cur * AT_BUF;
      const char* vb = kb + AT_KB;
      st_cur = st_cur == AT_NST - 1 ? 0 : st_cur + 1; st_iss = st_iss == AT_NST - 1 ? 0 : st_iss + 1;
      f32x16 S0, S1;
#define ATT_BODY(MASKED) do { \
      _Pragma("unroll") for (int r = 0; r < 16; ++r) { S0[r] = 0.f; S1[r] = 0.f; } \
      const float m_use = (m_run == NINF) ? 0.f : m_run;        \
      { \
          \
        const float negm = (!(MASKED) && !lane_on) ? NINF : -m_use; \
        u32x4 qxw; qxw[0] = (h == 0) ? (cvtpk(negm, 0.f) & 0xffffu) : 0u; qxw[1] = 0u; qxw[2] = 0u; qxw[3] = 0u; \
        const bf16x8 qx = __builtin_bit_cast(bf16x8, qxw); \
        S0 = MFMA32(kx, qx, S0); S1 = MFMA32(kx, qx, S1); \
      } \
      { \
        bf16x8 kf0[4], kf1[4]; \
        _Pragma("unroll") for (int ks = 0; ks < 4; ++ks) { \
          kf0[ks] = *(const bf16x8*)(kb + c32 * 128 + (((ks * 2 + h) ^ ksw) * 16)); \
          kf1[ks] = *(const bf16x8*)(kb + (32 + c32) * 128 + (((ks * 2 + h) ^ ksw) * 16)); \
        } \
        _Pragma("unroll") for (int ks = 0; ks < 4; ++ks) S0 = MFMA32(kf0[ks], qf[ks], S0);     \
        _Pragma("unroll") for (int ks = 0; ks < 4; ++ks) S1 = MFMA32(kf1[ks], qf[ks], S1); \
      } \
        \
      if (MASKED) { \
        _Pragma("unroll") for (int r = 0; r < 16; ++r) { \
          const int off = (r & 3) + 8 * (r >> 2); \
          S0[r] = (off > lo_rel && off <= hi_rel) ? S0[r] : NINF; \
          S1[r] = (off + 32 > lo_rel && off + 32 <= hi_rel) ? S1[r] : NINF; \
        } \
      } \
      float ps0 = 0.f, ps1 = 0.f; \
      bf16x8 vfa[4]; \
      _Pragma("unroll") for (int kk = 0; kk < 2; ++kk) \
        _Pragma("unroll") for (int dr = 0; dr < 2; ++dr) vfa[kk * 2 + dr] = *(const bf16x8*)(vb + (32 * dr + c32) * 128 + (((2 * kk + h) ^ ksw) * 16)); \
      _Pragma("unroll") for (int r = 0; r < 16; ++r) { S0[r] = __builtin_amdgcn_exp2f(S0[r]); ps0 += S0[r]; } \
      _Pragma("unroll") for (int kk = 0; kk < 2; ++kk) { \
        u32x4 pw; \
        _Pragma("unroll") for (int e = 0; e < 4; ++e) pw[e] = cvtpk(S0[8 * kk + 2 * e], S0[8 * kk + 2 * e + 1]); \
        const bf16x8 pf = __builtin_bit_cast(bf16x8, pw); \
        O0 = MFMA32(vfa[kk * 2], pf, O0); O1 = MFMA32(vfa[kk * 2 + 1], pf, O1); \
      } \
      __builtin_amdgcn_sched_group_barrier(0x100, 12, 0);     \
      __builtin_amdgcn_sched_group_barrier(0x008, 4, 0);      \
      _Pragma("unroll") for (int q_ = 0; q_ < 4; ++q_) { __builtin_amdgcn_sched_group_barrier(0x008, 1, 0); __builtin_amdgcn_sched_group_barrier(0x002, 9, 0); }     \
      __builtin_amdgcn_sched_barrier(0); \
      _Pragma("unroll") for (int r = 0; r < 16; ++r) { S1[r] = __builtin_amdgcn_exp2f(S1[r]); ps1 += S1[r]; } \
      _Pragma("unroll") for (int kk = 0; kk < 2; ++kk) { \
        u32x4 pw; \
        _Pragma("unroll") for (int e = 0; e < 4; ++e) pw[e] = cvtpk(S1[8 * kk + 2 * e], S1[8 * kk + 2 * e + 1]); \
        const bf16x8 pf = __builtin_bit_cast(bf16x8, pw); \
        const bf16x8 va0 = *(const bf16x8*)(vb + c32 * 128 + (((2 * (kk + 2) + h) ^ ksw) * 16)), va1 = *(const bf16x8*)(vb + (32 + c32) * 128 + (((2 * (kk + 2) + h) ^ ksw) * 16)); \
        O0 = MFMA32(va0, pf, O0); O1 = MFMA32(va1, pf, O1); \
      } \
      __builtin_amdgcn_sched_barrier(0); \
      oscale = 1.0f; \
      if (mode != 1) l_run += ps0 + ps1; \
      if (mode != 1 && chk) {                    \
        float mxp = fmaxf(fmaxf(S0[0], S0[1]), S1[0]); \
        mxp = fmaxf(fmaxf(mxp, S1[1]), S0[2]); \
        _Pragma("unroll") for (int r = 2; r < 16; r += 2) { \
          if (r > 2) mxp = fmaxf(fmaxf(mxp, S0[r]), S1[r - 1]); \
          mxp = fmaxf(fmaxf(mxp, S0[r + 1]), S1[r]); \
        } \
        mxp = fmaxf(mxp, S1[15]); \
        mxp = fmaxf(mxp, __shfl_xor(mxp, 32));            \
        const bool mv = (m_run == NINF) ? (mxp > 0.f) : (mxp > 256.0f); \
        const float m_new = bflo(cvtpk(m_use + __builtin_amdgcn_logf(mxp), 0.f));       \
        const float alpha = mv ? __builtin_amdgcn_exp2f(m_use - m_new) : 1.0f; \
        m_run = mv ? m_new : m_run; \
        l_run *= alpha; \
        oscale = alpha; \
      } \
      if ((MASKED) && mode == 1 && need_sel) {               \
        const int tt = base >> 6; \
        _Pragma("unroll") for (int kr = 0; kr < 2; ++kr) \
          _Pragma("unroll") for (int rg = 0; rg < 4; ++rg) { \
            float pv[4]; \
            _Pragma("unroll") for (int e = 0; e < 4; ++e) { \
              float v = (kr ? S1[rg * 4 + e] : S0[rg * 4 + e]) * inv_l; \
              v += __shfl_xor(v, 1); v += __shfl_xor(v, 2); \
              pv[e] = v; \
            } \
            if (hd == 0) { \
              const int nblk = tt * 16 + 8 * kr + 2 * rg + h; \
              impa[tl * 65 + nblk] = pv[0] + pv[1] + pv[2] + 0.5f * pv[3]; \
              impb[tl * 65 + nblk] = 0.5f * pv[3]; \
            } \
          } \
      } } while (0)
      if (full) ATT_BODY(false); else ATT_BODY(true);
#undef ATT_BODY
      if (n == ntc - 1) {
        const float lt = l_run + __shfl_xor(l_run, 32);
        inv_l = lt > 0.f ? 1.0f / lt : 0.f;
        oscale = 0.f;
      } else if (n == 2 * ntc - 1) {
        if (need_sel) {
          __syncthreads();
          const int tk = tid >> 3, nb0 = (tid & 7) * 8;
          float myv[8];
#pragma unroll
          for (int e = 0; e < 8; ++e) {
            const int nn = nb0 + e;
            const bool forced = (nn == 0) || (nn == i) || (nn == i - 1);
            float v = -1.0f;
            if (nn <= i) v = impa[tk * 65 + nn] + (nn > 0 ? impb[tk * 65 + nn - 1] : 0.f);
            if (forced) v = 1e9f;
            myv[e] = v;
            vals[tk * 65 + nn] = v;
          }
          __syncthreads();
          int cnt[8];
#pragma unroll
          for (int e = 0; e < 8; ++e) cnt[e] = 0;
          for (int mm = 0; mm < 64; ++mm) {
            const float vm = vals[tk * 65 + mm];
#pragma unroll
            for (int e = 0; e < 8; ++e) cnt[e] += (vm > myv[e] || (vm == myv[e] && mm < nb0 + e)) ? 1 : 0;
          }
          unsigned bits = 0;
#pragma unroll
          for (int e = 0; e < 8; ++e) bits |= (cnt[e] < 16 ? 1u : 0u) << e;
          unsigned wlo = (tid & 7) < 4 ? bits << (8 * (tid & 7)) : 0u;
          unsigned whi = (tid & 7) >= 4 ? bits << (8 * ((tid & 7) - 4)) : 0u;
          wlo |= __shfl_xor(wlo, 1); wlo |= __shfl_xor(wlo, 2); wlo |= __shfl_xor(wlo, 4);
          whi |= __shfl_xor(whi, 1); whi |= __shfl_xor(whi, 2); whi |= __shfl_xor(whi, 4);
          if ((tid & 7) == 0) { selm[tk * 2] = wlo; selm[tk * 2 + 1] = whi; }
          __syncthreads();
          sel_lo = selm[tl * 2]; sel_hi = selm[tl * 2 + 1];
        }
        {
          const float wgt = g0 * inv_l * oscale;
#pragma unroll
          for (int r = 0; r < 16; ++r) { fl[r * 64] = wgt * O0[r]; fl[(16 + r) * 64] = wgt * O1[r]; }
          m_run = NINF; l_run = 0.f; oscale = 0.f;
        }
      } else if (n == 2 * ntc + nsl - 1) {
        const float lt = l_run + __shfl_xor(l_run, 32);
        const float wgt = g1 * (lt > 0.f ? 1.0f / lt : 0.f) * oscale;
#pragma unroll
        for (int r = 0; r < 16; ++r) { fl[r * 64] += wgt * O0[r]; fl[(16 + r) * 64] += wgt * O1[r]; }
        m_run = NINF; l_run = 0.f; oscale = 0.f;
      }
    }
#undef TILE_PTRS
#undef TISSUE
    {
      const float lt = l_run + __shfl_xor(l_run, 32);
      const float wgt = g2 * (lt > 0.f ? 1.0f / lt : 0.f) * oscale;
      const size_t rowo = (size_t)(b * 4096 + t);
      const u16* zp = ws_zs(p) + rowo * 512 + (g * 4 + hd) * 64;
      u16* mp = ws_mix(p) + rowo * LDK + (g * 4 + hd) * 64;
#pragma unroll
      for (int dr = 0; dr < 2; ++dr)
#pragma unroll
        for (int rg = 0; rg < 4; ++rg) {
          const int d = 32 * dr + 8 * rg + 4 * h;
          const u32x2 zv = *(const u32x2*)(zp + d);
          const float f0 = fl[(dr * 16 + rg * 4 + 0) * 64] + wgt * (dr ? O1[rg * 4 + 0] : O0[rg * 4 + 0]);
          const float f1 = fl[(dr * 16 + rg * 4 + 1) * 64] + wgt * (dr ? O1[rg * 4 + 1] : O0[rg * 4 + 1]);
          const float f2 = fl[(dr * 16 + rg * 4 + 2) * 64] + wgt * (dr ? O1[rg * 4 + 2] : O0[rg * 4 + 2]);
          const float f3 = fl[(dr * 16 + rg * 4 + 3) * 64] + wgt * (dr ? O1[rg * 4 + 3] : O0[rg * 4 + 3]);
          u32x2 o;
          o[0] = cvtpk(f0 * bflo(zv[0]), f1 * bfhi(zv[0]));
          o[1] = cvtpk(f2 * bflo(zv[1]), f3 * bfhi(zv[1]));
          *(u32x2*)(mp + d) = o;
        }
    }
  }
}

#define XB_TMO      128
#define XB_XCNT(j)  (256  + 64 * (j))
#define XB_XSUB(j)  (1280 + 64 * (j))
#define XB_XGEN(j)  (2304 + 64 * (j))
#define XB_TOP      3328
#define XB_TOPGEN   3392
#define XCD_BAR_WORDS 3456
#define XB_SPIN_CAP (1u << 18)
#define LAS __attribute__((address_space(3)))

__device__ __forceinline__ unsigned xb_ld(unsigned* p)              { return __hip_atomic_load(p, __ATOMIC_RELAXED, __HIP_MEMORY_SCOPE_AGENT); }
__device__ __forceinline__ unsigned xb_add(unsigned* p, unsigned v) { return __hip_atomic_fetch_add(p, v, __ATOMIC_RELAXED, __HIP_MEMORY_SCOPE_AGENT); }
__device__ __forceinline__ unsigned xb_xcc_id() { return (unsigned)__builtin_amdgcn_s_getreg((3 << 11) | 20) & 0xFu; }
#define XB_SPIN(cond, bar) do { unsigned _sp = 0; while (cond) { __builtin_amdgcn_s_sleep(1); \
    if ((++_sp & 255u) == 0u) { if (xb_ld(&(bar)[XB_TMO])) break; if (_sp > XB_SPIN_CAP) { atomicAdd(&(bar)[XB_TMO], 1u); break; } } } } while (0)

struct XcdBarrier {
    unsigned* bar; unsigned x;
    volatile LAS unsigned* st;
};

__device__ __forceinline__ XcdBarrier xcd_barrier_post(unsigned* bar, volatile LAS unsigned* st) {
    XcdBarrier b; b.bar = bar; b.x = xb_xcc_id(); b.st = st;
    if (threadIdx.x == 0) (void)xb_add(&bar[XB_XCNT(b.x)], 1u);
    return b;
}
__device__ __forceinline__ void xcd_barrier_complete(unsigned* bar, unsigned x, unsigned& nloc, unsigned& nx) {
    const unsigned G = gridDim.x * gridDim.y * gridDim.z;
    unsigned sum, cnt, mine, sp = 0u;
    for (;;) {
        sum = 0u; cnt = 0u; mine = 0u;
#pragma unroll
        for (unsigned j = 0; j < 16; ++j) { const unsigned c = xb_ld(&bar[XB_XCNT(j)]); sum += c; cnt += (c > 0u) ? 1u : 0u; mine = (j == x) ? c : mine; }
        if (sum == G) break;
        __builtin_amdgcn_s_sleep(1);
        if ((++sp & 255u) == 0u) { if (xb_ld(&bar[XB_TMO])) break; if (sp > XB_SPIN_CAP) { atomicAdd(&bar[XB_TMO], 1u); break; } }
    }
    nloc = mine > 0u ? mine : 1u; nx = cnt > 0u ? cnt : 1u;
}

__device__ __forceinline__ void xcd_barrier(const XcdBarrier& b) {
    asm volatile("s_waitcnt vmcnt(0)" ::: "memory");
    __syncthreads();
    if (threadIdx.x == 0) {
        unsigned* bar = b.bar;
        __builtin_amdgcn_s_waitcnt(0);
        unsigned nloc = b.st[0], nx = b.st[1];
        if (nloc == 0u) { xcd_barrier_complete(bar, b.x, nloc, nx); b.st[0] = nloc; b.st[1] = nx; }
        const unsigned old = xb_add(&bar[XB_XSUB(b.x)], 1u);
        const unsigned gen = old / nloc;
        if (old + 1u == (gen + 1u) * nloc) {
            __builtin_amdgcn_fence(__ATOMIC_RELEASE, "agent");
            asm volatile("s_waitcnt vmcnt(0)" ::: "memory");
            const unsigned og = xb_add(&bar[XB_TOP], 1u);
            const unsigned tg = og / nx;
            if (og + 1u == (tg + 1u) * nx) xb_add(&bar[XB_TOPGEN], 1u);
            else XB_SPIN(xb_ld(&bar[XB_TOPGEN]) == tg, bar);
            __builtin_amdgcn_fence(__ATOMIC_ACQUIRE, "agent");
            xb_add(&bar[XB_XGEN(b.x)], 1u);
            asm volatile("s_waitcnt vmcnt(0)" ::: "memory");
        } else {
            XB_SPIN(xb_ld(&bar[XB_XGEN(b.x)]) == gen, bar);
            __builtin_amdgcn_fence(__ATOMIC_ACQUIRE, "agent");
            asm volatile("s_waitcnt vmcnt(0)" ::: "memory");
        }
    }
    __syncthreads();
}


#if FUSED
extern "C" __global__ void __launch_bounds__(NTHREADS) hybrid_fwd(Params p) {
  extern __shared__ __attribute__((aligned(16))) char smem[];
  cg::grid_group grid = cg::this_grid();
  const int bid = blockIdx.x, nb = gridDim.x;
  if (threadIdx.x < 4) ((volatile unsigned*)(smem + SMEM_BYTES))[threadIdx.x] = 0u;
  __syncthreads();
  XcdBarrier xb = xcd_barrier_post(ws_bar(p), (volatile LAS unsigned*)(smem + SMEM_BYTES));
  for (int r = 0; r < REP0; ++r) { phase_prep(p, smem, bid, nb); grid.sync(); }
  for (int r = 0; r < REP1; ++r) { gemm_phase<0>(p, smem, bid, nb); xcd_barrier(xb); }
  for (int r = 0; r < REP2; ++r) { phase_cmp_conv(p, smem, bid, nb); xcd_barrier(xb); }
  for (int r = 0; r < REP3; ++r) { phase_attn(p, smem, bid, nb, r); xcd_barrier(xb); }
  for (int r = 0; r < REP4; ++r) { gemm_phase<1>(p, smem, bid, nb); }
}
#else
template <int PH>
__global__ void __launch_bounds__(NTHREADS) phase_kernel(Params p) {
  extern __shared__ __attribute__((aligned(16))) char smem[];
  const int bid = blockIdx.x, nb = gridDim.x;
  if constexpr (PH == 0) phase_prep(p, smem, bid, nb);
  if constexpr (PH == 1) gemm_phase<0>(p, smem, bid, nb);
  if constexpr (PH == 2) phase_cmp_conv(p, smem, bid, nb);
  if constexpr (PH == 3) phase_attn(p, smem, bid, nb, 0);
  if constexpr (PH == 4) gemm_phase<1>(p, smem, bid, nb);
}
#endif

extern "C" void kernel_launch(void* const* d_in, const int* in_sizes, int n_in, void* d_out, int out_size, void* d_ws, size_t ws_size, hipStream_t stream) {
  Params p{};
  p.x = (const float*)d_in[0]; p.norm_w = (const float*)d_in[1]; p.w_in = (const float*)d_in[2]; p.q_norm_w = (const float*)d_in[3];
  p.k_norm_w = (const float*)d_in[4]; p.ck_pos = (const float*)d_in[5]; p.ck_w1 = (const float*)d_in[6]; p.ck_b1 = (const float*)d_in[7];
  p.ck_w2 = (const float*)d_in[8]; p.cv_pos = (const float*)d_in[9]; p.cv_w1 = (const float*)d_in[10]; p.cv_b1 = (const float*)d_in[11];
  p.cv_w2 = (const float*)d_in[12]; p.conv_w = (const float*)d_in[13]; p.conv_b = (const float*)d_in[14]; p.w_out = (const float*)d_in[15];
  p.out = (float*)d_out;
  p.ws = (char*)d_ws;
  const size_t off = WS_TOTAL;
  if (off > ws_size) { fprintf(stderr, "kernel_launch: workspace too small (%zu > %zu)\n", off, ws_size); return; }

#if FUSED
  static int grid_blocks = 0;
  if (!grid_blocks) {
    int dev = 0, cus = 0, per_cu = 0;
    hipGetDevice(&dev);
    hipDeviceGetAttribute(&cus, hipDeviceAttributeMultiprocessorCount, dev);
    hipFuncSetAttribute((const void*)hybrid_fwd, hipFuncAttributeMaxDynamicSharedMemorySize, SMEM_BYTES + 16);
    hipOccupancyMaxActiveBlocksPerMultiprocessor(&per_cu, (const void*)hybrid_fwd, NTHREADS, SMEM_BYTES + 16);
    if (per_cu < 1) per_cu = 1;
    grid_blocks = cus * per_cu;
  }
  (void)hipMemsetAsync((char*)d_ws + OFF_bar, 0, (size_t)3456 * 4, stream);
  void* args[] = {&p};
  hipError_t e = hipLaunchCooperativeKernel((const void*)hybrid_fwd, dim3(grid_blocks), dim3(NTHREADS), args, SMEM_BYTES + 16, stream);
  if (e != hipSuccess) fprintf(stderr, "cooperative launch failed: %s (grid %d)\n", hipGetErrorString(e), grid_blocks);
#else
  static int attr_set = 0;
  if (!attr_set) {
    (void)hipFuncSetAttribute((const void*)phase_kernel<0>, hipFuncAttributeMaxDynamicSharedMemorySize, SMEM_BYTES);
    (void)hipFuncSetAttribute((const void*)phase_kernel<1>, hipFuncAttributeMaxDynamicSharedMemorySize, SMEM_BYTES);
    (void)hipFuncSetAttribute((const void*)phase_kernel<2>, hipFuncAttributeMaxDynamicSharedMemorySize, SMEM_BYTES);
    (void)hipFuncSetAttribute((const void*)phase_kernel<3>, hipFuncAttributeMaxDynamicSharedMemorySize, SMEM_BYTES);
    (void)hipFuncSetAttribute((const void*)phase_kernel<4>, hipFuncAttributeMaxDynamicSharedMemorySize, SMEM_BYTES);
    attr_set = 1;
  }
  const int G = 256;
  phase_kernel<0><<<G, NTHREADS, SMEM_BYTES, stream>>>(p);
  phase_kernel<1><<<G, NTHREADS, SMEM_BYTES, stream>>>(p);
  phase_kernel<2><<<G, NTHREADS, SMEM_BYTES, stream>>>(p);
  phase_kernel<3><<<G, NTHREADS, SMEM_BYTES, stream>>>(p);
  phase_kernel<4><<<G, NTHREADS, SMEM_BYTES, stream>>>(p);
#endif
}
```

```cpp
#include <hip/hip_runtime.h>
#include <hip/hip_cooperative_groups.h>
#include <cstdio>
#include <cstdint>
namespace cg = cooperative_groups;

#ifndef FUSED
#define FUSED 1
#endif
#define REP0 1
#define REP1 1
#define REP2 1
#define REP3 1
#define REP4 1

#define DI __device__ __forceinline__
typedef unsigned short u16;
using bf16x8 = __attribute__((ext_vector_type(8))) short;
using s16x4 = __attribute__((ext_vector_type(4))) short;
using f32x4 = __attribute__((ext_vector_type(4))) float;
using f32x16 = __attribute__((ext_vector_type(16))) float;
using u32x4 = __attribute__((ext_vector_type(4))) unsigned;
using u32x2 = __attribute__((ext_vector_type(2))) unsigned;
typedef __bf16 bf2_t __attribute__((ext_vector_type(2)));
typedef float fl2_t __attribute__((ext_vector_type(2)));

constexpr int NTHREADS = 512;
constexpr int SEQ = 4096, DM = 1024, DIN = 3864, NROWS = 32768;
constexpr int LDK = 1088;
constexpr float EPS = 1e-6f;
constexpr float QSCALE = 0.125f * 1.4426950408889634f;
constexpr int SMEM_BYTES = 148480;

__constant__ float c_invf[8] = {1.0f, 0.1939227432012558f, 0.03760603070259094f, 0.007292664609849453f,
                                0.0014142135623842478f, 0.00027424818836152554f, 5.3182957344688475e-05f, 1.0313385246263351e-05f};

DI unsigned cvtpk(float lo, float hi) {
  fl2_t f = {lo, hi};
  bf2_t b = __builtin_convertvector(f, bf2_t);
  return __builtin_bit_cast(unsigned, b);
}
DI u16 f2bf(float x) { return (u16)(cvtpk(x, 0.f) & 0xffffu); }
DI float bf2f(u16 v) { return __uint_as_float(((unsigned)v) << 16); }
DI float bflo(unsigned v) { return __uint_as_float(v << 16); }
DI float bfhi(unsigned v) { return __uint_as_float(v & 0xffff0000u); }
DI float sigmoidf_(float v) { return __builtin_amdgcn_rcpf(1.0f + __builtin_amdgcn_exp2f(-1.4426950408889634f * v)); }
DI float siluf_(float v) { return v * __builtin_amdgcn_rcpf(1.0f + __builtin_amdgcn_exp2f(-1.4426950408889634f * v)); }
DI void glds16(const void* g, unsigned lds_base) {
  unsigned sv;
  asm volatile("s_mov_b32 %0, m0\n\ts_mov_b32 m0, %2\n\ts_nop 0\n\tglobal_load_lds_dwordx4 %1, off\n\ts_mov_b32 m0, %0" : "=&s"(sv) : "v"(g), "s"(lds_base) : "memory");
}
template <int CTRL> DI float qperm(float v) { return __int_as_float(__builtin_amdgcn_update_dpp(0, __float_as_int(v), CTRL, 0xF, 0xF, true)); }
#define MFMA16(a, b, c) __builtin_amdgcn_mfma_f32_16x16x32_bf16((a), (b), (c), 0, 0, 0)
#define MFMA32(a, b, c) __builtin_amdgcn_mfma_f32_32x32x16_bf16((a), (b), (c), 0, 0, 0)

struct Params {
  const float *x, *norm_w, *w_in, *q_norm_w, *k_norm_w, *ck_pos, *ck_w1, *ck_b1, *ck_w2, *cv_pos, *cv_w1, *cv_b1, *cv_w2, *conv_w, *conv_b, *w_out;
  float* out;
  char* ws;
};
constexpr size_t al256(size_t v) { return (v + 255) & ~(size_t)255; }
constexpr size_t OFF_xb = 0;
DI u16* ws_xb(const Params& p) { return (u16*)(p.ws + OFF_xb); }
constexpr size_t OFF_winT = OFF_xb + al256((size_t)NROWS * LDK * 2);
DI u16* ws_winT(const Params& p) { return (u16*)(p.ws + OFF_winT); }
constexpr size_t OFF_woutT = OFF_winT + al256((size_t)4096 * LDK * 2);
DI u16* ws_woutT(const Params& p) { return (u16*)(p.ws + OFF_woutT); }
constexpr size_t OFF_w1kT = OFF_woutT + al256((size_t)1024 * LDK * 2);
DI u16* ws_w1kT(const Params& p) { return (u16*)(p.ws + OFF_w1kT); }
constexpr size_t OFF_w1vT = OFF_w1kT + al256((size_t)128 * 2048 * 2);
DI u16* ws_w1vT(const Params& p) { return (u16*)(p.ws + OFF_w1vT); }
constexpr size_t OFF_w2kT = OFF_w1vT + al256((size_t)128 * 2048 * 2);
DI u16* ws_w2kT(const Params& p) { return (u16*)(p.ws + OFF_w2kT); }
constexpr size_t OFF_w2vT = OFF_w2kT + al256((size_t)64 * 128 * 2);
DI u16* ws_w2vT(const Params& p) { return (u16*)(p.ws + OFF_w2vT); }
constexpr size_t OFF_Q = OFF_w2vT + al256((size_t)64 * 128 * 2);
DI u16* ws_Q(const Params& p) { return (u16*)(p.ws + OFF_Q); }
constexpr size_t OFF_Ks = OFF_Q + al256((size_t)NROWS * 512 * 2);
DI u16* ws_Ks(const Params& p) { return (u16*)(p.ws + OFF_Ks); }
constexpr size_t OFF_Kw = OFF_Ks + al256((size_t)16 * 4096 * 64 * 2);
DI u16* ws_Kw(const Params& p) { return (u16*)(p.ws + OFF_Kw); }
constexpr size_t OFF_Vst = OFF_Kw + al256((size_t)16 * 4096 * 64 * 2);
DI u16* ws_Vst(const Params& p) { return (u16*)(p.ws + OFF_Vst); }
constexpr size_t OFF_Vwt = OFF_Vst + al256((size_t)16 * 4096 * 64 * 2);
DI u16* ws_Vwt(const Params& p) { return (u16*)(p.ws + OFF_Vwt); }
constexpr size_t OFF_kcraw = OFF_Vwt + al256((size_t)16 * 4096 * 64 * 2);
DI u16* ws_kcraw(const Params& p) { return (u16*)(p.ws + OFF_kcraw); }
constexpr size_t OFF_vcraw = OFF_kcraw + al256((size_t)16 * 4096 * 64 * 2 + 4096);
DI u16* ws_vcraw(const Params& p) { return (u16*)(p.ws + OFF_vcraw); }
constexpr size_t OFF_Kc = OFF_vcraw + al256((size_t)16 * 4096 * 64 * 2 + 4096);
DI u16* ws_Kc(const Params& p) { return (u16*)(p.ws + OFF_Kc); }
constexpr size_t OFF_Vct = OFF_Kc + al256((size_t)16 * 256 * 64 * 2);
DI u16* ws_Vct(const Params& p) { return (u16*)(p.ws + OFF_Vct); }
constexpr size_t OFF_zs = OFF_Vct + al256((size_t)16 * 256 * 64 * 2);
DI u16* ws_zs(const Params& p) { return (u16*)(p.ws + OFF_zs); }
constexpr size_t OFF_cvb = OFF_zs + al256((size_t)NROWS * 512 * 2);
DI u16* ws_cvb(const Params& p) { return (u16*)(p.ws + OFF_cvb); }
constexpr size_t OFF_mix = OFF_cvb + al256((size_t)NROWS * 2048 * 2);
DI u16* ws_mix(const Params& p) { return (u16*)(p.ws + OFF_mix); }
constexpr size_t OFF_rs = OFF_mix + al256((size_t)NROWS * LDK * 2);
DI float* ws_rs(const Params& p) { return (float*)(p.ws + OFF_rs); }
constexpr size_t OFF_ckpart = OFF_rs + al256((size_t)NROWS * 4);
DI float* ws_ckpart(const Params& p) { return (float*)(p.ws + OFF_ckpart); }
constexpr size_t OFF_rope = OFF_ckpart + al256((size_t)16 * 128 * 4);
DI float* ws_rope(const Params& p) { return (float*)(p.ws + OFF_rope); }
constexpr size_t OFF_gates = OFF_rope + al256((size_t)4096 * 8 * 2 * 4);
DI float* ws_gates(const Params& p) { return (float*)(p.ws + OFF_gates); }
constexpr size_t OFF_counter = OFF_gates + al256((size_t)NROWS * 24 * 4);
DI unsigned* ws_counter(const Params& p) { return (unsigned*)(p.ws + OFF_counter); }
constexpr size_t OFF_bar = OFF_counter + al256((size_t)256);
DI unsigned* ws_bar(const Params& p) { return (unsigned*)(p.ws + OFF_bar); }
constexpr size_t WS_TOTAL = OFF_bar + al256((size_t)3456 * 4);


DI void transpose_tile(const float* __restrict__ src, u16* __restrict__ dst, int K, int N, const float* __restrict__ scale, int kt, int nt, char* smem, int ldd) {
  float* tile = (float*)smem;
  const int tid = threadIdx.x;
#pragma unroll
  for (int i = 0; i < 8; ++i) {
    const int kk = i * 8 + (tid >> 6), nn = tid & 63, n = nt * 64 + nn, k = kt * 64 + kk;
    float v = (n < N) ? src[(size_t)k * N + n] : 0.f;
    if (scale) v *= scale[k];
    tile[kk * 65 + nn] = v;
  }
  __syncthreads();
#pragma unroll
  for (int i = 0; i < 8; ++i) {
    const int nn = i * 8 + (tid >> 6), kk = tid & 63;
    dst[(size_t)(nt * 64 + nn) * ldd + kt * 64 + kk] = f2bf(tile[kk * 65 + nn]);
  }
  __syncthreads();
}

__device__ void phase_prep(const Params& p, char* smem, int bid, int nb) {
  int tid_ = threadIdx.x; asm volatile("" : "+v"(tid_));
  const int tid = tid_, lane = tid & 63, wid = __builtin_amdgcn_readfirstlane(tid >> 6);
  constexpr int J_X = 1024, J_TW = 1024, J_TO = 256, J_T1 = 64, J_T2 = 2, J_CK = 16, J_ROPE = 64;
  constexpr int TOTAL = J_X + J_TW + J_TO + 2 * J_T1 + 2 * J_T2 + J_CK + J_ROPE;
  if (bid == 0 && tid < 8) ws_counter(p)[tid] = 0u;
  for (int j = bid; j < TOTAL; j += nb) {
    int jj = j;
    if (jj < J_X) {
      const int row0 = jj * 32 + wid * 4;
      float4 v[4][4]; float ss[4];
#pragma unroll
      for (int r = 0; r < 4; ++r) {
        const float4* xr = (const float4*)(p.x + (size_t)(row0 + r) * DM);
#pragma unroll
        for (int i = 0; i < 4; ++i) v[r][i] = xr[i * 64 + lane];
      }
#pragma unroll
      for (int r = 0; r < 4; ++r) {
        float a = 0.f;
#pragma unroll
        for (int i = 0; i < 4; ++i) a += v[r][i].x * v[r][i].x + v[r][i].y * v[r][i].y + v[r][i].z * v[r][i].z + v[r][i].w * v[r][i].w;
#pragma unroll
        for (int o = 32; o >= 1; o >>= 1) a += __shfl_xor(a, o);
        ss[r] = a;
      }
#pragma unroll
      for (int r = 0; r < 4; ++r) {
        if (lane == 0) ws_rs(p)[row0 + r] = rsqrtf(ss[r] * (1.0f / DM) + EPS);
#pragma unroll
        for (int i = 0; i < 4; ++i) {
          u32x2 o; o[0] = cvtpk(v[r][i].x, v[r][i].y); o[1] = cvtpk(v[r][i].z, v[r][i].w);
          const int rr_ = row0 + r;
          *(u32x2*)(ws_xb(p) + ((size_t)((rr_ >> 8) * 16 + i * 4 + (lane >> 4)) * 256 + (rr_ & 255)) * 64 + (lane & 15) * 4) = o;
        }
      }
      continue;
    }
    jj -= J_X;
    if (jj < J_TW) { transpose_tile(p.w_in, ws_winT(p), 1024, DIN, p.norm_w, jj & 15, jj >> 4, smem, LDK); continue; }
    jj -= J_TW;
    if (jj < J_TO) { transpose_tile(p.w_out, ws_woutT(p), 1024, 1024, nullptr, jj & 15, jj >> 4, smem, LDK); continue; }
    jj -= J_TO;
    if (jj < J_T1) { transpose_tile(p.ck_w1, ws_w1kT(p), 2048, 128, nullptr, jj & 31, jj >> 5, smem, 2048); continue; }
    jj -= J_T1;
    if (jj < J_T1) { transpose_tile(p.cv_w1, ws_w1vT(p), 2048, 128, nullptr, jj & 31, jj >> 5, smem, 2048); continue; }
    jj -= J_T1;
    if (jj < J_T2) { transpose_tile(p.ck_w2, ws_w2kT(p), 128, 64, nullptr, jj, 0, smem, 128); continue; }
    jj -= J_T2;
    if (jj < J_T2) { transpose_tile(p.cv_w2, ws_w2vT(p), 128, 64, nullptr, jj, 0, smem, 128); continue; }
    jj -= J_T2;
    if (jj < J_CK) {
      const int which = jj >> 3, chunk = jj & 7, hh = tid & 127, sub = tid >> 7;
      const float* pos = which ? p.cv_pos : p.ck_pos;
      const float* w1 = which ? p.cv_w1 : p.ck_w1;
      float acc = 0.f;
      const int f0 = chunk * 256 + sub * 64;
      float pv_[64], wv_[64];
#pragma unroll
      for (int f = 0; f < 64; ++f) { pv_[f] = pos[f0 + f]; wv_[f] = w1[(size_t)(f0 + f) * 128 + hh]; }
#pragma unroll
      for (int f = 0; f < 64; ++f) acc += pv_[f] * wv_[f];
      float* red = (float*)smem;
      red[sub * 128 + hh] = acc;
      __syncthreads();
      if (tid < 128) ws_ckpart(p)[(which * 8 + chunk) * 128 + tid] = red[tid] + red[128 + tid] + red[256 + tid] + red[384 + tid];
      __syncthreads();
      continue;
    }
    jj -= J_CK;
    {
      const int idx = jj * 512 + tid, pos = idx >> 3, fi = idx & 7;
      const float ang = (float)pos * c_invf[fi];
      float s, c; sincosf(ang, &s, &c);
      ws_rope(p)[idx * 2] = c; ws_rope(p)[idx * 2 + 1] = s;
    }
  }
}

DI int kimg_off(int row, int d) { return row * 64 + (((d >> 3) ^ ((row >> 1) & 7)) * 8) + (d & 7); }
DI int vimg_off(int d, int key) {
  const int kp = (key & ~12) | ((key & 4) << 1) | ((key & 8) >> 1);
  return d * 64 + (((kp >> 3) ^ ((d >> 1) & 7)) * 8) + (kp & 7);
}

constexpr int G_ASZ = 256 * 128, G_BSZ = 256 * 128, G_STAGE = G_ASZ + G_BSZ;
constexpr int G_ROPE = 2 * G_STAGE, G_RS = G_ROPE + 256 * 64;
static_assert(G_RS + 1024 <= SMEM_BYTES, "GEMM LDS layout exceeds the dynamic LDS size");
#define WAIT_VM(n) asm volatile("s_waitcnt vmcnt(" #n ")" ::: "memory")

template <int EPI>
__device__ void gemm_phase(const Params& p, char* smem, int bid, int nb) {
  constexpr int NT = EPI == 0 ? 16 : 4;
  constexpr int MT = 128;
  const u16* __restrict__ A = EPI == 0 ? ws_xb(p) : ws_mix(p);
  const u16* __restrict__ Bt = EPI == 0 ? ws_winT(p) : ws_woutT(p);
  int tid_ = threadIdx.x; asm volatile("" : "+v"(tid_));
  const int tid = tid_, lane = tid & 63, wid = __builtin_amdgcn_readfirstlane(tid >> 6), fr = lane & 15, fq = lane >> 4;
  const int wr = wid >> 2, wc = wid & 3;
  const bool xmap = (nb == 256);
  const int xcd = bid & 7, li = bid >> 3;
  const int ntiles = xmap ? (EPI == 0 ? 8 : 2) : (MT * NT - bid + nb - 1) / nb;
  auto tile_of = [&](int ti, int& m0, int& n0) {
    if (xmap) {
      const int sg = ti * 8 + xcd;
      if (EPI == 0) { m0 = ((sg >> 1) * 4 + (li >> 3)) * 256; n0 = ((sg & 1) * 8 + (li & 7)) * 256; }
      else { m0 = (sg * 8 + (li >> 2)) * 256; n0 = (li & 3) * 256; }
    } else { const int tile = bid + ti * nb; const int mt = tile / NT; m0 = mt * 256; n0 = (tile - mt * NT) * 256; }
  };
  const int nsteps = ntiles * 16;
  const unsigned lds0 = (unsigned)(uintptr_t)smem;
  const int gsw = (lane & 7) ^ ((wid & 1) * 4 + (lane >> 4));
  const int grow = wid * 8 + (lane >> 3);
  auto issue = [&](int step, int stage) {
    int m0, n0; tile_of(step >> 4, m0, n0);
    const int kt = step & 15;
    const u16* ag = EPI == 0 ? A + ((size_t)((m0 >> 8) * 16 + kt) * 256 + grow) * 64 + gsw * 8 : A + (size_t)(m0 + grow) * LDK + kt * 64 + gsw * 8;
    const size_t astep = EPI == 0 ? (size_t)64 * 64 : (size_t)64 * LDK;
    const int brow = EPI == 0 ? ((grow & ~31) | ((grow & 0x0C) << 1) | ((grow & 0x10) >> 2) | (grow & 3)) : grow;
    const u16* bg_ = Bt + (size_t)(n0 + brow) * LDK + kt * 64 + gsw * 8;
    const unsigned dst = (unsigned)__builtin_amdgcn_readfirstlane((int)(lds0 + stage * G_STAGE + wid * 1024));
#pragma unroll
    for (int i = 0; i < 4; ++i) glds16(ag + i * astep, dst + i * 8192);
#pragma unroll
    for (int i = 0; i < 4; ++i) glds16(bg_ + (size_t)i * 64 * LDK, dst + G_ASZ + i * 8192);
    if (EPI == 0 && kt == 8) {
      const int t0 = m0 & 4095;
      const unsigned sd = (unsigned)__builtin_amdgcn_readfirstlane((int)(lds0 + G_ROPE + wid * 1024));
      glds16(ws_rope(p) + (size_t)t0 * 16 + tid * 4, sd);
      glds16(ws_rope(p) + (size_t)t0 * 16 + (512 + tid) * 4, sd + 8192);
      if (wid == 0) glds16(ws_rs(p) + m0 + lane * 4, lds0 + G_RS);
    }
  };
  const int ca0 = ((fq ^ (fr >> 1)) * 16), ca1 = (((4 + fq) ^ (fr >> 1)) * 16);
  f32x4 acc[8][4];
#pragma unroll
  for (int m = 0; m < 8; ++m)
#pragma unroll
    for (int n = 0; n < 4; ++n) acc[m][n] = f32x4{0.f, 0.f, 0.f, 0.f};
  __syncthreads();
  if (nsteps > 0) issue(0, 0);
  for (int s = 0; s < nsteps; ++s) {
    WAIT_VM(0);
    __builtin_amdgcn_s_waitcnt(0x0F70);
    __builtin_amdgcn_s_barrier();
    if (s + 1 < nsteps) issue(s + 1, (s + 1) & 1);
    {
      const char* ab = smem + (s & 1) * G_STAGE + (wr * 128 + fr) * 128;
      const char* bb = smem + (s & 1) * G_STAGE + G_ASZ + (wc * 64 + fr) * 128;
#pragma unroll
      for (int ks = 0; ks < 2; ++ks) {
        bf16x8 af[8], bf[4];
        const int co = ks ? ca1 : ca0;
#pragma unroll
        for (int n = 0; n < 4; ++n) bf[n] = *(const bf16x8*)(bb + n * 16 * 128 + co);
#pragma unroll
        for (int m = 0; m < 8; ++m) af[m] = *(const bf16x8*)(ab + m * 16 * 128 + co);
#pragma unroll
        for (int m = 0; m < 8; ++m)
#pragma unroll
          for (int n = 0; n < 4; ++n) acc[m][n] = MFMA16(bf[n], af[m], acc[m][n]);
      }
    }
    if ((s & 15) != 15) continue;
    int m0, n0; tile_of(s >> 4, m0, n0);
    const int rbase = m0 + wr * 128;
    const int cb = n0 + wc * 64;
    if constexpr (EPI == 1) {
#pragma unroll
      for (int hm = 0; hm < 2; ++hm) {
        float4 xv[4][4];
#pragma unroll
        for (int mm = 0; mm < 4; ++mm) {
          const size_t ro = (size_t)(rbase + (hm * 4 + mm) * 16 + fr) * DM + cb + fq * 4;
#pragma unroll
          for (int n = 0; n < 4; ++n) xv[mm][n] = *(const float4*)(p.x + ro + n * 16);
        }
#pragma unroll
        for (int mm = 0; mm < 4; ++mm) {
          const int m = hm * 4 + mm;
          const size_t ro = (size_t)(rbase + m * 16 + fr) * DM + cb + fq * 4;
#pragma unroll
          for (int n = 0; n < 4; ++n) {
            float4 o; o.x = xv[mm][n].x + acc[m][n][0]; o.y = xv[mm][n].y + acc[m][n][1]; o.z = xv[mm][n].z + acc[m][n][2]; o.w = xv[mm][n].w + acc[m][n][3];
            *(float4*)(p.out + ro + n * 16) = o;
          }
        }
        __builtin_amdgcn_sched_barrier(0);
      }
    } else {
      const int b = m0 >> 12;
      const int tb = rbase & 4095;
      if (cb < 1280) {
        const int seg = cb >> 6;
        const int which = seg < 8 ? -1 : ((seg - 8) >> 1);
        const int g = seg < 8 ? (seg >> 2) : ((seg - 8) & 1);
        const bool need_norm = (seg < 8) || which == 2 || which == 4;
        const float* nw = seg < 8 ? p.q_norm_w : (p.k_norm_w + (which == 2 ? 64 : 128));
        float w[16];
#pragma unroll
        for (int k = 0; k < 16; ++k) w[k] = need_norm ? nw[(k >> 3) * 32 + fq * 8 + (k & 7)] : 1.0f;
        const float qs = seg < 8 ? QSCALE : 1.0f;
#pragma unroll
        for (int m = 0; m < 8; ++m) {
          const int t = tb + m * 16 + fr;
          const int lrow = wr * 128 + m * 16 + fr;
          const float r = *(const float*)(smem + G_RS + lrow * 4);
          float v[16];
#pragma unroll
          for (int k = 0; k < 16; ++k) v[k] = acc[m][(k >> 3) * 2 + ((k & 7) >> 2)][k & 3] * r;
          if (need_norm) {
            float ss = 0.f;
#pragma unroll
            for (int k = 0; k < 16; ++k) ss += v[k] * v[k];
            ss += __shfl_xor(ss, 16); ss += __shfl_xor(ss, 32);
            const float rr = rsqrtf(ss * (1.0f / 64.f) + EPS);
#pragma unroll
            for (int k = 0; k < 16; ++k) v[k] = v[k] * rr * w[k];
            const float4* rp = (const float4*)(smem + G_ROPE + lrow * 64);
            const float4 c01 = rp[0], c23 = rp[1], c45 = rp[2], c67 = rp[3];
            const float cc[8] = {c01.x, c01.z, c23.x, c23.z, c45.x, c45.z, c67.x, c67.z};
            const float sn[8] = {c01.y, c01.w, c23.y, c23.w, c45.y, c45.w, c67.y, c67.w};
#pragma unroll
            for (int e = 0; e < 8; ++e) {
              const float pr = __shfl_xor(v[e], 16);
              const float rot = (fq == 0) ? (v[e] * cc[e] - pr * sn[e]) : (v[e] * cc[e] + pr * sn[e]);
              v[e] = (fq < 2) ? rot : v[e];
            }
#pragma unroll
            for (int k = 0; k < 16; ++k) v[k] *= qs;
          }
          if (which == 3 || which == 5) {
            int lz = 0; asm volatile("" : "+v"(lz));
            u16* vt = (which == 3 ? ws_Vst(p) : ws_Vwt(p)) + (size_t)((b * 2 + g) * 64 + (t >> 6)) * 4096 + lz;
            const int fqx = fq + lz, key = (t & 63) + lz;
#pragma unroll
            for (int k = 0; k < 16; ++k) vt[vimg_off((k >> 3) * 32 + fqx * 8 + (k & 7), key)] = f2bf(v[k]);
          } else {
            u16* dst;
            if (seg < 8) dst = ws_Q(p) + ((size_t)((b * 2 + g) * 4096 + t) * 4 + (seg & 3)) * 64;
            else { u16* buf = which == 0 ? ws_kcraw(p) : which == 1 ? ws_vcraw(p) : which == 2 ? ws_Ks(p) : ws_Kw(p); dst = buf + ((size_t)(b * 2 + g) * 4096 + t) * 64; }
            const bool img = which >= 2;
#pragma unroll
            for (int n2 = 0; n2 < 2; ++n2) {
              u32x4 o;
#pragma unroll
              for (int e = 0; e < 4; ++e) o[e] = cvtpk(v[n2 * 8 + 2 * e], v[n2 * 8 + 2 * e + 1]);
              const int d0 = n2 * 32 + fq * 8;
              const int off = img ? (((d0 >> 3) ^ (((t & 63) >> 1) & 7)) * 8) : d0;
              *(u32x4*)(dst + off) = o;
            }
          }
          __builtin_amdgcn_sched_barrier(0);
        }
      } else {
#pragma unroll
        for (int m = 0; m < 8; ++m) {
          const size_t row = rbase + m * 16 + fr;
          const float r = *(const float*)(smem + G_RS + (wr * 128 + m * 16 + fr) * 4);
#pragma unroll
          for (int n2 = 0; n2 < 2; ++n2) {
            const int c8 = cb + n2 * 32 + fq * 8;
            if (c8 >= DIN) continue;
            float v[8];
#pragma unroll
            for (int e = 0; e < 8; ++e) v[e] = acc[m][n2 * 2 + (e >> 2)][e & 3] * r;
            if (c8 < 1304) {
              float4 o0, o1;
              o0.x = sigmoidf_(v[0]); o0.y = sigmoidf_(v[1]); o0.z = sigmoidf_(v[2]); o0.w = sigmoidf_(v[3]);
              o1.x = sigmoidf_(v[4]); o1.y = sigmoidf_(v[5]); o1.z = sigmoidf_(v[6]); o1.w = sigmoidf_(v[7]);
              float* gp = ws_gates(p) + row * 24 + (c8 - 1280);
              *(float4*)gp = o0; *(float4*)(gp + 4) = o1;
            } else if (c8 < 1816) {
              u32x4 o;
#pragma unroll
              for (int e = 0; e < 4; ++e) o[e] = cvtpk(siluf_(v[2 * e]), siluf_(v[2 * e + 1]));
              *(u32x4*)(ws_zs(p) + row * 512 + (c8 - 1304)) = o;
            } else {
              u32x4 o;
#pragma unroll
              for (int e = 0; e < 4; ++e) o[e] = cvtpk(v[2 * e], v[2 * e + 1]);
              *(u32x4*)(ws_cvb(p) + row * 2048 + (c8 - 1816)) = o;
            }
          }
          __builtin_amdgcn_sched_barrier(0);
        }
      }
    }
#pragma unroll
    for (int m = 0; m < 8; ++m)
#pragma unroll
      for (int n = 0; n < 4; ++n) acc[m][n] = f32x4{0.f, 0.f, 0.f, 0.f};
  }
}

__device__ void phase_cmp_conv(const Params& p, char* smem, int bid, int nb) {
  int tid_ = threadIdx.x; asm volatile("" : "+v"(tid_));
  const int tid = tid_, lane = tid & 63, wid = __builtin_amdgcn_readfirstlane(tid >> 6), fr = lane & 15, fq = lane >> 4;
  float* part = (float*)smem;
  char* hl = smem + 8 * 16 * 132 * 4;
  float* outl = (float*)(hl + 2 * 4352);
  for (int job = bid; job < 256; job += nb) {
    const int which = wid >> 2, w4 = wid & 3, bg = job >> 4, ct = job & 15;
    const u16* raw = (which ? ws_vcraw(p) : ws_kcraw(p)) + (size_t)bg * 4096 * 64;
    const u16* w1T = which ? ws_w1vT(p) : ws_w1kT(p);
    const u16* w2T = which ? ws_w2vT(p) : ws_w2kT(p);
    const float* b1 = which ? p.cv_b1 : p.ck_b1;
    f32x4 acc[8];
#pragma unroll
    for (int n = 0; n < 8; ++n) acc[n] = f32x4{0.f, 0.f, 0.f, 0.f};
    const int c = ct * 16 + fr;
    const int ht = tid & 255, rrow = ht >> 4, c8 = (ht & 15) * 8;
    float bias[8];
#pragma unroll
    for (int e = 0; e < 8; ++e) {
      float bsum = b1[c8 + e];
#pragma unroll
      for (int ch = 0; ch < 8; ++ch) bsum += ws_ckpart(p)[(which * 8 + ch) * 128 + c8 + e];
      bias[e] = bsum;
    }
    bf16x8 w2f[4];
#pragma unroll
    for (int ks = 0; ks < 4; ++ks) w2f[ks] = *(const bf16x8*)(w2T + (size_t)(w4 * 16 + fr) * 128 + ks * 32 + fq * 8);
    const int orow = ht >> 4, d4 = (ht & 15) * 4;
    const int cc = ct * 16 + orow;
    float nwv[4], nwp[4]; float2 csv[4];
    {
      int pos = cc * 16 + 31; pos = pos > 4095 ? 4095 : pos;
#pragma unroll
      for (int e = 0; e < 4; ++e) {
        const int d = d4 + e;
        nwv[e] = p.k_norm_w[d]; nwp[e] = p.k_norm_w[d ^ 8];
        csv[e] = *(const float2*)(ws_rope(p) + ((size_t)pos * 8 + (d & 7)) * 2);
      }
    }
#pragma unroll 4
    for (int k16 = 0; k16 < 16; ++k16) {
      const int ks = w4 * 16 + k16;
      const int l = ks >> 1, d0 = (ks & 1) * 32 + fq * 8;
      int tt = c * 16 + l; tt = tt > 4095 ? 4095 : tt;
      const bf16x8 a = *(const bf16x8*)(raw + (size_t)tt * 64 + d0);
#pragma unroll
      for (int n = 0; n < 8; ++n) {
        const bf16x8 bb = *(const bf16x8*)(w1T + (size_t)(n * 16 + fr) * 2048 + ks * 32 + fq * 8);
        acc[n] = MFMA16(a, bb, acc[n]);
      }
    }
#pragma unroll
    for (int n = 0; n < 8; ++n)
#pragma unroll
      for (int j = 0; j < 4; ++j) part[(wid * 16 + fq * 4 + j) * 132 + n * 16 + fr] = acc[n][j];
    __syncthreads();
    {
      float sum[8];
#pragma unroll
      for (int e = 0; e < 8; ++e) sum[e] = bias[e];
#pragma unroll
      for (int w = 0; w < 4; ++w) {
        const float4 v0 = *(const float4*)(part + ((which * 4 + w) * 16 + rrow) * 132 + c8), v1 = *(const float4*)(part + ((which * 4 + w) * 16 + rrow) * 132 + c8 + 4);
        sum[0] += v0.x; sum[1] += v0.y; sum[2] += v0.z; sum[3] += v0.w; sum[4] += v1.x; sum[5] += v1.y; sum[6] += v1.z; sum[7] += v1.w;
      }
      u32x4 o;
#pragma unroll
      for (int e = 0; e < 4; ++e) o[e] = cvtpk(siluf_(sum[2 * e]), siluf_(sum[2 * e + 1]));
      *(u32x4*)(hl + which * 4352 + rrow * 272 + c8 * 2) = o;
    }
    __syncthreads();
    {
      f32x4 o2 = f32x4{0.f, 0.f, 0.f, 0.f};
#pragma unroll
      for (int ks = 0; ks < 4; ++ks) {
        const bf16x8 a = *(const bf16x8*)(hl + which * 4352 + fr * 272 + (ks * 32 + fq * 8) * 2);
        o2 = MFMA16(a, w2f[ks], o2);
      }
#pragma unroll
      for (int j = 0; j < 4; ++j) outl[which * 1088 + (fq * 4 + j) * 68 + w4 * 16 + fr] = o2[j];
    }
    __syncthreads();
    {
      const float* ol = outl + which * 1088;
      const float4 v = *(const float4*)(ol + orow * 68 + d4);
      if (which == 0) {
        float ss = v.x * v.x + v.y * v.y + v.z * v.z + v.w * v.w;
        ss += __shfl_xor(ss, 1); ss += __shfl_xor(ss, 2); ss += __shfl_xor(ss, 4); ss += __shfl_xor(ss, 8);
        const float rr = rsqrtf(ss * (1.0f / 64.f) + EPS);
        float o[4] = {v.x * rr * nwv[0], v.y * rr * nwv[1], v.z * rr * nwv[2], v.w * rr * nwv[3]};
        if (d4 < 16) {
#pragma unroll
          for (int e = 0; e < 4; ++e) {
            const int d = d4 + e, dp = d ^ 8;
            const float pr = ol[orow * 68 + dp] * rr * nwp[e];
            o[e] = (d < 8) ? (o[e] * csv[e].x - pr * csv[e].y) : (o[e] * csv[e].x + pr * csv[e].y);
          }
        }
        u32x2 ov; ov[0] = cvtpk(o[0], o[1]); ov[1] = cvtpk(o[2], o[3]);
        if (cc >= 255) { ov[0] = 0u; ov[1] = 0u; }
        *(u32x2*)(ws_Kc(p) + (size_t)(bg * 4 + (cc >> 6)) * 4096 + kimg_off(cc & 63, d4)) = ov;
      } else {
        const float z = (cc >= 255) ? 0.f : 1.f;
        u16* vt = ws_Vct(p) + (size_t)(bg * 4 + (cc >> 6)) * 4096;
        vt[vimg_off(d4 + 0, cc & 63)] = f2bf(v.x * z); vt[vimg_off(d4 + 1, cc & 63)] = f2bf(v.y * z);
        vt[vimg_off(d4 + 2, cc & 63)] = f2bf(v.z * z); vt[vimg_off(d4 + 3, cc & 63)] = f2bf(v.w * z);
      }
    }
    __syncthreads();
  }
  const int gw = bid * 8 + wid, nw = nb * 8;
  for (int chunk = gw; chunk < 2048; chunk += nw) {
    const int r0 = chunk * 16, t0 = r0 & 4095;
    const int ch = lane * 8;
    float cw0[8], cw1[8], cw2[8], cbv[8], u1[8], u2[8];
#pragma unroll
    for (int e = 0; e < 8; ++e) { cw0[e] = p.conv_w[ch + e]; cw1[e] = p.conv_w[512 + ch + e]; cw2[e] = p.conv_w[1024 + ch + e]; cbv[e] = p.conv_b[ch + e]; u1[e] = 0.f; u2[e] = 0.f; }
    if (t0 > 0) {
#pragma unroll
      for (int q = 0; q < 2; ++q) {
        const u16* rp = ws_cvb(p) + (size_t)(r0 - 2 + q) * 2048 + ch;
        const u32x4 hv = *(const u32x4*)(rp), cv = *(const u32x4*)(rp + 1024);
#pragma unroll
        for (int e = 0; e < 4; ++e) {
          const float ua = bflo(hv[e]) * bflo(cv[e]), ub = bfhi(hv[e]) * bfhi(cv[e]);
          if (q == 0) { u2[2 * e] = ua; u2[2 * e + 1] = ub; } else { u1[2 * e] = ua; u1[2 * e + 1] = ub; }
        }
      }
    }
#pragma unroll 4
    for (int rr = 0; rr < 16; ++rr) {
      const u16* rp = ws_cvb(p) + (size_t)(r0 + rr) * 2048 + ch;
      const u32x4 hv = *(const u32x4*)(rp), bv = *(const u32x4*)(rp + 512), cv = *(const u32x4*)(rp + 1024), zv = *(const u32x4*)(rp + 1536);
      u32x4 ov;
#pragma unroll
      for (int e = 0; e < 4; ++e) {
        const float ua = bflo(hv[e]) * bflo(cv[e]), ub = bfhi(hv[e]) * bfhi(cv[e]);
        const float ca = cw0[2 * e] * u2[2 * e] + cw1[2 * e] * u1[2 * e] + cw2[2 * e] * ua + cbv[2 * e];
        const float cbb = cw0[2 * e + 1] * u2[2 * e + 1] + cw1[2 * e + 1] * u1[2 * e + 1] + cw2[2 * e + 1] * ub + cbv[2 * e + 1];
        const float oa = bflo(bv[e]) * ca * siluf_(bflo(zv[e]));
        const float ob = bfhi(bv[e]) * cbb * siluf_(bfhi(zv[e]));
        ov[e] = cvtpk(oa, ob);
        u2[2 * e] = u1[2 * e]; u2[2 * e + 1] = u1[2 * e + 1]; u1[2 * e] = ua; u1[2 * e + 1] = ub;
      }
      *(u32x4*)(ws_mix(p) + (size_t)(r0 + rr) * LDK + 512 + ch) = ov;
    }
  }
}

constexpr int AT_NST = 5, AT_KB = 8192, AT_BUF = 16384;
constexpr int AT_F = AT_NST * AT_BUF, AT_IMPA = AT_F, AT_IMPB = AT_IMPA + 64 * 65 * 4, AT_VAL = AT_IMPA;
constexpr int AT_SELM = AT_F + 8 * 8192, AT_UNIT = AT_SELM + 512, AT_END = AT_UNIT + 16;
static_assert(AT_END <= SMEM_BYTES, "attention LDS layout exceeds the dynamic LDS size");

__device__ void phase_attn(const Params& p, char* smem, int bid, int nb, int rep) {
  int tid_ = threadIdx.x; asm volatile("" : "+v"(tid_));
  const int tid = tid_, lane = tid & 63, wid = __builtin_amdgcn_readfirstlane(tid >> 6), c32 = lane & 31, h = lane >> 5;
  const float NINF = -__builtin_inff();
  float* impa = (float*)(smem + AT_IMPA);
  float* impb = (float*)(smem + AT_IMPB);
  float* vals = (float*)(smem + AT_VAL);
  unsigned* selm = (unsigned*)(smem + AT_SELM);
  volatile int* s_unit = (volatile int*)(smem + AT_UNIT);
  const unsigned lds0 = (unsigned)(uintptr_t)smem;
  while (true) {
    if (tid == 0) *s_unit = (int)atomicAdd(ws_counter(p) + rep, 1u);
    __syncthreads();
    const int u = __builtin_amdgcn_readfirstlane(*s_unit);
    __syncthreads();
    if (u >= 1024) break;
    const int i = 63 - (u >> 4), bg = u & 15, b = bg >> 1, g = bg & 1;
    const int tl = wid * 8 + (c32 >> 2), hd = c32 & 3;
    const int t = i * 64 + tl;
    const u16* qrow = ws_Q(p) + ((size_t)(bg * 4096 + i * 64) * 4 + wid * 32 + c32) * 64;
    bf16x8 qf[4];
#pragma unroll
    for (int ks = 0; ks < 4; ++ks) qf[ks] = *(const bf16x8*)(qrow + ks * 16 + h * 8);
    const float* gp = ws_gates(p) + (size_t)(b * 4096 + t) * 24 + (g * 4 + hd) * 3;
    const float g0 = gp[0], g1 = gp[1], g2 = gp[2];
    asm volatile("" :: "v"(qf[0]), "v"(qf[1]), "v"(qf[2]), "v"(qf[3]), "v"(g0), "v"(g1), "v"(g2));
    const int ntc = (4 * i + 2) / 64 + 1, nsl = i + 1, nwin = (i < 8 ? i : 8) + 1;
    const int NT = 2 * ntc + nsl + nwin;
    const bool need_sel = i >= 16;

    f32x16 O0, O1;
#pragma unroll
    for (int r = 0; r < 16; ++r) { O0[r] = 0.f; O1[r] = 0.f; }
    float* fl = (float*)(smem + AT_F + wid * 8192) + lane;
    float m_run = NINF, l_run = 0.f, inv_l = 0.f;
    u32x4 kxw; kxw[0] = (h == 0) ? 0x3F80u : 0u; kxw[1] = 0u; kxw[2] = 0u; kxw[3] = 0u;
    const bf16x8 kx = __builtin_bit_cast(bf16x8, kxw);
    float oscale = 1.0f;
    unsigned sel_lo = 0xffffffffu, sel_hi = 0xffffffffu;
#define TILE_PTRS(n, kp, vp) do { \
      if ((n) < 2 * ntc) { const int tt_ = (n) < ntc ? (n) : (n) - ntc; kp = ws_Kc(p) + (size_t)(bg * 4 + tt_) * 4096; vp = ws_Vct(p) + (size_t)(bg * 4 + tt_) * 4096; } \
      else if ((n) < 2 * ntc + nsl) { const int j_ = (n) - 2 * ntc; kp = ws_Ks(p) + ((size_t)bg * 4096 + j_ * 64) * 64; vp = ws_Vst(p) + (size_t)(bg * 64 + j_) * 4096; } \
      else { const int j_ = i - nwin + 1 + ((n) - 2 * ntc - nsl); kp = ws_Kw(p) + ((size_t)bg * 4096 + j_ * 64) * 64; vp = ws_Vwt(p) + (size_t)(bg * 64 + j_) * 4096; } } while (0)
#define TISSUE(n, st_) do { const u16 *kp_, *vp_; TILE_PTRS(n, kp_, vp_); \
      const unsigned d_ = (unsigned)__builtin_amdgcn_readfirstlane((int)(lds0 + (st_) * AT_BUF + wid * 1024)); \
      glds16(kp_ + tid * 8, d_); glds16(vp_ + tid * 8, d_ + AT_KB); } while (0)
    {
      const int npre = NT < AT_NST - 1 ? NT : AT_NST - 1;
      for (int n = 0; n < npre; ++n) TISSUE(n, n);
    }
    int st_cur = 0, st_iss = AT_NST - 1;
    const int ksw = (c32 >> 1) & 7;
    for (int n = 0; n < NT; ++n) {
      {
        const int rem = NT - 1 - n;
        if (rem >= 3) WAIT_VM(6); else if (rem == 2) WAIT_VM(4); else if (rem == 1) WAIT_VM(2); else WAIT_VM(0);
        __builtin_amdgcn_s_barrier();
        if (n + AT_NST - 1 < NT) TISSUE(n + AT_NST - 1, st_iss);
      }
      int mode, base, lo, hi;
      bool full = false, lane_on = true;
      if (n < 2 * ntc) { mode = n < ntc ? 0 : 1; base = (n < ntc ? n : n - ntc) * 64; lo = -1; hi = (t - 31) >> 4; }
      else if (n < 2 * ntc + nsl) { const int j = n - 2 * ntc; mode = 2; base = j * 64; const unsigned bit = j < 32 ? (sel_lo >> j) & 1u : (sel_hi >> (j - 32)) & 1u; lo = -1; hi = bit ? t : -1; full = j < i; lane_on = bit != 0u; }
      else { const int j = i - nwin + 1 + (n - 2 * ntc - nsl); mode = 3; base = j * 64; lo = t - 512; hi = t; full = (j < i) && (j > i - 8); }
      const int lo_rel = lo - (base + 4 * h), hi_rel = hi - (base + 4 * h);
      const bool chk = ((n & 7) == 7) || mode == 0;
#pragma unroll
      for (int r = 0; r < 16; ++r) { O0[r] *= oscale; O1[r] *= oscale; }
      const char* kb = smem + st_cur * AT_BUF;
      const char* vb = kb + AT_KB;
      st_cur = st_cur == AT_NST - 1 ? 0 : st_cur + 1; st_iss = st_iss == AT_NST - 1 ? 0 : st_iss + 1;
      f32x16 S0, S1;
#define ATT_BODY(MASKED) do { \
      _Pragma("unroll") for (int r = 0; r < 16; ++r) { S0[r] = 0.f; S1[r] = 0.f; } \
      const float m_use = (m_run == NINF) ? 0.f : m_run;        \
      { \
          \
        const float negm = (!(MASKED) && !lane_on) ? NINF : -m_use; \
        u32x4 qxw; qxw[0] = (h == 0) ? (cvtpk(negm, 0.f) & 0xffffu) : 0u; qxw[1] = 0u; qxw[2] = 0u; qxw[3] = 0u; \
        const bf16x8 qx = __builtin_bit_cast(bf16x8, qxw); \
        S0 = MFMA32(kx, qx, S0); S1 = MFMA32(kx, qx, S1); \
      } \
      { \
        bf16x8 kf0[4], kf1[4]; \
        _Pragma("unroll") for (int ks = 0; ks < 4; ++ks) { \
          kf0[ks] = *(const bf16x8*)(kb + c32 * 128 + (((ks * 2 + h) ^ ksw) * 16)); \
          kf1[ks] = *(const bf16x8*)(kb + (32 + c32) * 128 + (((ks * 2 + h) ^ ksw) * 16)); \
        } \
        _Pragma("unroll") for (int ks = 0; ks < 4; ++ks) S0 = MFMA32(kf0[ks], qf[ks], S0);     \
        _Pragma("unroll") for (int ks = 0; ks < 4; ++ks) S1 = MFMA32(kf1[ks], qf[ks], S1); \
      } \
        \
      if (MASKED) { \
        _Pragma("unroll") for (int r = 0; r < 16; ++r) { \
          const int off = (r & 3) + 8 * (r >> 2); \
          S0[r] = (off > lo_rel && off <= hi_rel) ? S0[r] : NINF; \
          S1[r] = (off + 32 > lo_rel && off + 32 <= hi_rel) ? S1[r] : NINF; \
        } \
      } \
      float ps0 = 0.f, ps1 = 0.f; \
      bf16x8 vfa[4]; \
      _Pragma("unroll") for (int kk = 0; kk < 2; ++kk) \
        _Pragma("unroll") for (int dr = 0; dr < 2; ++dr) vfa[kk * 2 + dr] = *(const bf16x8*)(vb + (32 * dr + c32) * 128 + (((2 * kk + h) ^ ksw) * 16)); \
      _Pragma("unroll") for (int r = 0; r < 16; ++r) { S0[r] = __builtin_amdgcn_exp2f(S0[r]); ps0 += S0[r]; } \
      _Pragma("unroll") for (int kk = 0; kk < 2; ++kk) { \
        u32x4 pw; \
        _Pragma("unroll") for (int e = 0; e < 4; ++e) pw[e] = cvtpk(S0[8 * kk + 2 * e], S0[8 * kk + 2 * e + 1]); \
        const bf16x8 pf = __builtin_bit_cast(bf16x8, pw); \
        O0 = MFMA32(vfa[kk * 2], pf, O0); O1 = MFMA32(vfa[kk * 2 + 1], pf, O1); \
      } \
      __builtin_amdgcn_sched_group_barrier(0x100, 12, 0);     \
      __builtin_amdgcn_sched_group_barrier(0x008, 4, 0);      \
      _Pragma("unroll") for (int q_ = 0; q_ < 4; ++q_) { __builtin_amdgcn_sched_group_barrier(0x008, 1, 0); __builtin_amdgcn_sched_group_barrier(0x002, 9, 0); }     \
      __builtin_amdgcn_sched_barrier(0); \
      _Pragma("unroll") for (int r = 0; r < 16; ++r) { S1[r] = __builtin_amdgcn_exp2f(S1[r]); ps1 += S1[r]; } \
      _Pragma("unroll") for (int kk = 0; kk < 2; ++kk) { \
        u32x4 pw; \
        _Pragma("unroll") for (int e = 0; e < 4; ++e) pw[e] = cvtpk(S1[8 * kk + 2 * e], S1[8 * kk + 2 * e + 1]); \
        const bf16x8 pf = __builtin_bit_cast(bf16x8, pw); \
        const bf16x8 va0 = *(const bf16x8*)(vb + c32 * 128 + (((2 * (kk + 2) + h) ^ ksw) * 16)), va1 = *(const bf16x8*)(vb + (32 + c32) * 128 + (((2 * (kk + 2) + h) ^ ksw) * 16)); \
        O0 = MFMA32(va0, pf, O0); O1 = MFMA32(va1, pf, O1); \
      } \
      __builtin_amdgcn_sched_barrier(0); \
      oscale = 1.0f; \
      if (mode != 1) l_run += ps0 + ps1; \
      if (mode != 1 && chk) {                    \
        float mxp = fmaxf(fmaxf(S0[0], S0[1]), S1[0]); \
        mxp = fmaxf(fmaxf(mxp, S1[1]), S0[2]); \
        _Pragma("unroll") for (int r = 2; r < 16; r += 2) { \
          if (r > 2) mxp = fmaxf(fmaxf(mxp, S0[r]), S1[r - 1]); \
          mxp = fmaxf(fmaxf(mxp, S0[r + 1]), S1[r]); \
        } \
        mxp = fmaxf(mxp, S1[15]); \
        mxp = fmaxf(mxp, __shfl_xor(mxp, 32));            \
        const bool mv = (m_run == NINF) ? (mxp > 0.f) : (mxp > 256.0f); \
        const float m_new = bflo(cvtpk(m_use + __builtin_amdgcn_logf(mxp), 0.f));       \
        const float alpha = mv ? __builtin_amdgcn_exp2f(m_use - m_new) : 1.0f; \
        m_run = mv ? m_new : m_run; \
        l_run *= alpha; \
        oscale = alpha; \
      } \
      if ((MASKED) && mode == 1 && need_sel) {               \
        const int tt = base >> 6; \
        _Pragma("unroll") for (int kr = 0; kr < 2; ++kr) \
          _Pragma("unroll") for (int rg = 0; rg < 4; ++rg) { \
            float pv[4]; \
            _Pragma("unroll") for (int e = 0; e < 4; ++e) { \
              float v = (kr ? S1[rg * 4 + e] : S0[rg * 4 + e]) * inv_l; \
              v += qperm<0xB1>(v); v += qperm<0x4E>(v);            \
              pv[e] = v; \
            } \
            if (hd == 0) { \
              const int nblk = tt * 16 + 8 * kr + 2 * rg + h; \
              impa[tl * 65 + nblk] = pv[0] + pv[1] + pv[2] + 0.5f * pv[3]; \
              impb[tl * 65 + nblk] = 0.5f * pv[3]; \
            } \
          } \
      } } while (0)
      if (full) ATT_BODY(false); else ATT_BODY(true);
#undef ATT_BODY
      if (n == ntc - 1) {
        const float lt = l_run + __shfl_xor(l_run, 32);
        inv_l = lt > 0.f ? 1.0f / lt : 0.f;
        oscale = 0.f;
      } else if (n == 2 * ntc - 1) {
        if (need_sel) {
          __syncthreads();
          for (int q = 0; q < 8; ++q) {
            const int tk = wid * 8 + q, nn = lane;
            const bool forced = (nn == 0) || (nn == i) || (nn == i - 1);
            const bool vis = nn <= i;
            float v = 0.f;
            if (vis) v = impa[tk * 65 + nn] + (nn > 0 ? impb[tk * 65 + nn - 1] : 0.f);
            const unsigned bse = forced ? 0x4E6E6B28u : __float_as_uint(v);
            const unsigned key = (bse & ~127u) | (vis ? 64u : 0u) | (unsigned)(63 - nn);
            unsigned T = 0u;
#pragma unroll 1
            for (int bbit = 31; bbit >= 0; --bbit) {
              const unsigned Tc = T | (1u << bbit);
              const unsigned long long mk = __builtin_amdgcn_ballot_w64(key >= Tc);
              if (__builtin_popcountll(mk) >= 16) T = Tc;
            }
            const unsigned long long sel = __builtin_amdgcn_ballot_w64(key >= T);
            if (lane == 0) { selm[tk * 2] = (unsigned)sel; selm[tk * 2 + 1] = (unsigned)(sel >> 32); }
          }
          __syncthreads();
          sel_lo = selm[tl * 2]; sel_hi = selm[tl * 2 + 1];
        }
        {
          const float wgt = g0 * inv_l * oscale;
#pragma unroll
          for (int r = 0; r < 16; ++r) { fl[r * 64] = wgt * O0[r]; fl[(16 + r) * 64] = wgt * O1[r]; }
          m_run = NINF; l_run = 0.f; oscale = 0.f;
        }
      } else if (n == 2 * ntc + nsl - 1) {
        const float lt = l_run + __shfl_xor(l_run, 32);
        const float wgt = g1 * (lt > 0.f ? 1.0f / lt : 0.f) * oscale;
#pragma unroll
        for (int r = 0; r < 16; ++r) { fl[r * 64] += wgt * O0[r]; fl[(16 + r) * 64] += wgt * O1[r]; }
        m_run = NINF; l_run = 0.f; oscale = 0.f;
      }
    }
#undef TILE_PTRS
#undef TISSUE
    {
      const float lt = l_run + __shfl_xor(l_run, 32);
      const float wgt = g2 * (lt > 0.f ? 1.0f / lt : 0.f) * oscale;
      const size_t rowo = (size_t)(b * 4096 + t);
      const u16* zp = ws_zs(p) + rowo * 512 + (g * 4 + hd) * 64;
      u16* mp = ws_mix(p) + rowo * LDK + (g * 4 + hd) * 64;
#pragma unroll
      for (int dr = 0; dr < 2; ++dr)
#pragma unroll
        for (int rg = 0; rg < 4; ++rg) {
          const int d = 32 * dr + 8 * rg + 4 * h;
          const u32x2 zv = *(const u32x2*)(zp + d);
          const float f0 = fl[(dr * 16 + rg * 4 + 0) * 64] + wgt * (dr ? O1[rg * 4 + 0] : O0[rg * 4 + 0]);
          const float f1 = fl[(dr * 16 + rg * 4 + 1) * 64] + wgt * (dr ? O1[rg * 4 + 1] : O0[rg * 4 + 1]);
          const float f2 = fl[(dr * 16 + rg * 4 + 2) * 64] + wgt * (dr ? O1[rg * 4 + 2] : O0[rg * 4 + 2]);
          const float f3 = fl[(dr * 16 + rg * 4 + 3) * 64] + wgt * (dr ? O1[rg * 4 + 3] : O0[rg * 4 + 3]);
          u32x2 o;
          o[0] = cvtpk(f0 * bflo(zv[0]), f1 * bfhi(zv[0]));
          o[1] = cvtpk(f2 * bflo(zv[1]), f3 * bfhi(zv[1]));
          *(u32x2*)(mp + d) = o;
        }
    }
  }
}

#define XB_TMO      128
#define XB_XCNT(j)  (256  + 64 * (j))
#define XB_XSUB(j)  (1280 + 64 * (j))
#define XB_XGEN(j)  (2304 + 64 * (j))
#define XB_TOP      3328
#define XB_TOPGEN   3392
#define XCD_BAR_WORDS 3456
#define XB_SPIN_CAP (1u << 18)
#define LAS __attribute__((address_space(3)))

__device__ __forceinline__ unsigned xb_ld(unsigned* p)              { return __hip_atomic_load(p, __ATOMIC_RELAXED, __HIP_MEMORY_SCOPE_AGENT); }
__device__ __forceinline__ unsigned xb_add(unsigned* p, unsigned v) { return __hip_atomic_fetch_add(p, v, __ATOMIC_RELAXED, __HIP_MEMORY_SCOPE_AGENT); }
__device__ __forceinline__ unsigned xb_xcc_id() { return (unsigned)__builtin_amdgcn_s_getreg((3 << 11) | 20) & 0xFu; }
#define XB_SPIN(cond, bar) do { unsigned _sp = 0; while (cond) { __builtin_amdgcn_s_sleep(1); \
    if ((++_sp & 255u) == 0u) { if (xb_ld(&(bar)[XB_TMO])) break; if (_sp > XB_SPIN_CAP) { atomicAdd(&(bar)[XB_TMO], 1u); break; } } } } while (0)

struct XcdBarrier {
    unsigned* bar; unsigned x;
    volatile LAS unsigned* st;
};

__device__ __forceinline__ XcdBarrier xcd_barrier_post(unsigned* bar, volatile LAS unsigned* st) {
    XcdBarrier b; b.bar = bar; b.x = xb_xcc_id(); b.st = st;
    if (threadIdx.x == 0) (void)xb_add(&bar[XB_XCNT(b.x)], 1u);
    return b;
}
__device__ __forceinline__ void xcd_barrier_complete(unsigned* bar, unsigned x, unsigned& nloc, unsigned& nx) {
    const unsigned G = gridDim.x * gridDim.y * gridDim.z;
    unsigned sum, cnt, mine, sp = 0u;
    for (;;) {
        sum = 0u; cnt = 0u; mine = 0u;
#pragma unroll
        for (unsigned j = 0; j < 16; ++j) { const unsigned c = xb_ld(&bar[XB_XCNT(j)]); sum += c; cnt += (c > 0u) ? 1u : 0u; mine = (j == x) ? c : mine; }
        if (sum == G) break;
        __builtin_amdgcn_s_sleep(1);
        if ((++sp & 255u) == 0u) { if (xb_ld(&bar[XB_TMO])) break; if (sp > XB_SPIN_CAP) { atomicAdd(&bar[XB_TMO], 1u); break; } }
    }
    nloc = mine > 0u ? mine : 1u; nx = cnt > 0u ? cnt : 1u;
}

__device__ __forceinline__ void xcd_barrier(const XcdBarrier& b) {
    asm volatile("s_waitcnt vmcnt(0)" ::: "memory");
    __syncthreads();
    if (threadIdx.x == 0) {
        unsigned* bar = b.bar;
        __builtin_amdgcn_s_waitcnt(0);
        unsigned nloc = b.st[0], nx = b.st[1];
        if (nloc == 0u) { xcd_barrier_complete(bar, b.x, nloc, nx); b.st[0] = nloc; b.st[1] = nx; }
        const unsigned old = xb_add(&bar[XB_XSUB(b.x)], 1u);
        const unsigned gen = old / nloc;
        if (old + 1u == (gen + 1u) * nloc) {
            __builtin_amdgcn_fence(__ATOMIC_RELEASE, "agent");
            asm volatile("s_waitcnt vmcnt(0)" ::: "memory");
            const unsigned og = xb_add(&bar[XB_TOP], 1u);
            const unsigned tg = og / nx;
            if (og + 1u == (tg + 1u) * nx) xb_add(&bar[XB_TOPGEN], 1u);
            else XB_SPIN(xb_ld(&bar[XB_TOPGEN]) == tg, bar);
            __builtin_amdgcn_fence(__ATOMIC_ACQUIRE, "agent");
            xb_add(&bar[XB_XGEN(b.x)], 1u);
            asm volatile("s_waitcnt vmcnt(0)" ::: "memory");
        } else {
            XB_SPIN(xb_ld(&bar[XB_XGEN(b.x)]) == gen, bar);
            __builtin_amdgcn_fence(__ATOMIC_ACQUIRE, "agent");
            asm volatile("s_waitcnt vmcnt(0)" ::: "memory");
        }
    }
    __syncthreads();
}


#if FUSED
extern "C" __global__ void __launch_bounds__(NTHREADS) hybrid_fwd(Params p) {
  extern __shared__ __attribute__((aligned(16))) char smem[];
  cg::grid_group grid = cg::this_grid();
  const int bid = blockIdx.x, nb = gridDim.x;
  if (threadIdx.x < 4) ((volatile unsigned*)(smem + SMEM_BYTES))[threadIdx.x] = 0u;
  __syncthreads();
  XcdBarrier xb = xcd_barrier_post(ws_bar(p), (volatile LAS unsigned*)(smem + SMEM_BYTES));
  for (int r = 0; r < REP0; ++r) { phase_prep(p, smem, bid, nb); grid.sync(); }
  for (int r = 0; r < REP1; ++r) { gemm_phase<0>(p, smem, bid, nb); xcd_barrier(xb); }
  for (int r = 0; r < REP2; ++r) { phase_cmp_conv(p, smem, bid, nb); xcd_barrier(xb); }
  for (int r = 0; r < REP3; ++r) { phase_attn(p, smem, bid, nb, r); xcd_barrier(xb); }
  for (int r = 0; r < REP4; ++r) { gemm_phase<1>(p, smem, bid, nb); }
}
#else
template <int PH>
__global__ void __launch_bounds__(NTHREADS) phase_kernel(Params p) {
  extern __shared__ __attribute__((aligned(16))) char smem[];
  const int bid = blockIdx.x, nb = gridDim.x;
  if constexpr (PH == 0) phase_prep(p, smem, bid, nb);
  if constexpr (PH == 1) gemm_phase<0>(p, smem, bid, nb);
  if constexpr (PH == 2) phase_cmp_conv(p, smem, bid, nb);
  if constexpr (PH == 3) phase_attn(p, smem, bid, nb, 0);
  if constexpr (PH == 4) gemm_phase<1>(p, smem, bid, nb);
}
#endif

extern "C" void kernel_launch(void* const* d_in, const int* in_sizes, int n_in, void* d_out, int out_size, void* d_ws, size_t ws_size, hipStream_t stream) {
  Params p{};
  p.x = (const float*)d_in[0]; p.norm_w = (const float*)d_in[1]; p.w_in = (const float*)d_in[2]; p.q_norm_w = (const float*)d_in[3];
  p.k_norm_w = (const float*)d_in[4]; p.ck_pos = (const float*)d_in[5]; p.ck_w1 = (const float*)d_in[6]; p.ck_b1 = (const float*)d_in[7];
  p.ck_w2 = (const float*)d_in[8]; p.cv_pos = (const float*)d_in[9]; p.cv_w1 = (const float*)d_in[10]; p.cv_b1 = (const float*)d_in[11];
  p.cv_w2 = (const float*)d_in[12]; p.conv_w = (const float*)d_in[13]; p.conv_b = (const float*)d_in[14]; p.w_out = (const float*)d_in[15];
  p.out = (float*)d_out;
  p.ws = (char*)d_ws;
  const size_t off = WS_TOTAL;
  if (off > ws_size) { fprintf(stderr, "kernel_launch: workspace too small (%zu > %zu)\n", off, ws_size); return; }

#if FUSED
  static int grid_blocks = 0;
  if (!grid_blocks) {
    int dev = 0, cus = 0, per_cu = 0;
    hipGetDevice(&dev);
    hipDeviceGetAttribute(&cus, hipDeviceAttributeMultiprocessorCount, dev);
    hipFuncSetAttribute((const void*)hybrid_fwd, hipFuncAttributeMaxDynamicSharedMemorySize, SMEM_BYTES + 16);
    hipOccupancyMaxActiveBlocksPerMultiprocessor(&per_cu, (const void*)hybrid_fwd, NTHREADS, SMEM_BYTES + 16);
    if (per_cu < 1) per_cu = 1;
    grid_blocks = cus * per_cu;
  }
  (void)hipMemsetAsync((char*)d_ws + OFF_bar, 0, (size_t)3456 * 4, stream);
  void* args[] = {&p};
  hipError_t e = hipLaunchCooperativeKernel((const void*)hybrid_fwd, dim3(grid_blocks), dim3(NTHREADS), args, SMEM_BYTES + 16, stream);
  if (e != hipSuccess) fprintf(stderr, "cooperative launch failed: %s (grid %d)\n", hipGetErrorString(e), grid_blocks);
#else
  static int attr_set = 0;
  if (!attr_set) {
    (void)hipFuncSetAttribute((const void*)phase_kernel<0>, hipFuncAttributeMaxDynamicSharedMemorySize, SMEM_BYTES);
    (void)hipFuncSetAttribute((const void*)phase_kernel<1>, hipFuncAttributeMaxDynamicSharedMemorySize, SMEM_BYTES);
    (void)hipFuncSetAttribute((const void*)phase_kernel<2>, hipFuncAttributeMaxDynamicSharedMemorySize, SMEM_BYTES);
    (void)hipFuncSetAttribute((const void*)phase_kernel<3>, hipFuncAttributeMaxDynamicSharedMemorySize, SMEM_BYTES);
    (void)hipFuncSetAttribute((const void*)phase_kernel<4>, hipFuncAttributeMaxDynamicSharedMemorySize, SMEM_BYTES);
    attr_set = 1;
  }
  const int G = 256;
  phase_kernel<0><<<G, NTHREADS, SMEM_BYTES, stream>>>(p);
  phase_kernel<1><<<G, NTHREADS, SMEM_BYTES, stream>>>(p);
  phase_kernel<2><<<G, NTHREADS, SMEM_BYTES, stream>>>(p);
  phase_kernel<3><<<G, NTHREADS, SMEM_BYTES, stream>>>(p);
  phase_kernel<4><<<G, NTHREADS, SMEM_BYTES, stream>>>(p);
#endif
}
```

```cpp
#include <hip/hip_runtime.h>
#include <hip/hip_cooperative_groups.h>
#include <cstdio>
#include <cstdint>
namespace cg = cooperative_groups;

#ifndef FUSED
#define FUSED 1
#endif
#define REP0 1
#define REP1 1
#define REP2 1
#define REP3 1
#define REP4 1

#define DI __device__ __forceinline__
typedef unsigned short u16;
using bf16x8 = __attribute__((ext_vector_type(8))) short;
using s16x4 = __attribute__((ext_vector_type(4))) short;
using f32x4 = __attribute__((ext_vector_type(4))) float;
using f32x16 = __attribute__((ext_vector_type(16))) float;
using u32x4 = __attribute__((ext_vector_type(4))) unsigned;
using u32x2 = __attribute__((ext_vector_type(2))) unsigned;
typedef __bf16 bf2_t __attribute__((ext_vector_type(2)));
typedef float fl2_t __attribute__((ext_vector_type(2)));

constexpr int NTHREADS = 512;
constexpr int SEQ = 4096, DM = 1024, DIN = 3864, NROWS = 32768;
constexpr int LDK = 1088;
constexpr float EPS = 1e-6f;
constexpr float QSCALE = 0.125f * 1.4426950408889634f;
constexpr int SMEM_BYTES = 148480;

__constant__ float c_invf[8] = {1.0f, 0.1939227432012558f, 0.03760603070259094f, 0.007292664609849453f,
                                0.0014142135623842478f, 0.00027424818836152554f, 5.3182957344688475e-05f, 1.0313385246263351e-05f};

DI unsigned cvtpk(float lo, float hi) {
  fl2_t f = {lo, hi};
  bf2_t b = __builtin_convertvector(f, bf2_t);
  return __builtin_bit_cast(unsigned, b);
}
DI u16 f2bf(float x) { return (u16)(cvtpk(x, 0.f) & 0xffffu); }
DI float bf2f(u16 v) { return __uint_as_float(((unsigned)v) << 16); }
DI float bflo(unsigned v) { return __uint_as_float(v << 16); }
DI float bfhi(unsigned v) { return __uint_as_float(v & 0xffff0000u); }
DI float sigmoidf_(float v) { return __builtin_amdgcn_rcpf(1.0f + __builtin_amdgcn_exp2f(-1.4426950408889634f * v)); }
DI float siluf_(float v) { return v * __builtin_amdgcn_rcpf(1.0f + __builtin_amdgcn_exp2f(-1.4426950408889634f * v)); }
DI void glds16(const void* g, unsigned lds_base) {
  unsigned sv;
  asm volatile("s_mov_b32 %0, m0\n\ts_mov_b32 m0, %2\n\ts_nop 0\n\tglobal_load_lds_dwordx4 %1, off\n\ts_mov_b32 m0, %0" : "=&s"(sv) : "v"(g), "s"(lds_base) : "memory");
}
template <int CTRL> DI float qperm(float v) { return __int_as_float(__builtin_amdgcn_update_dpp(0, __float_as_int(v), CTRL, 0xF, 0xF, true)); }
#define MFMA16(a, b, c) __builtin_amdgcn_mfma_f32_16x16x32_bf16((a), (b), (c), 0, 0, 0)
#define MFMA32(a, b, c) __builtin_amdgcn_mfma_f32_32x32x16_bf16((a), (b), (c), 0, 0, 0)

struct Params {
  const float *x, *norm_w, *w_in, *q_norm_w, *k_norm_w, *ck_pos, *ck_w1, *ck_b1, *ck_w2, *cv_pos, *cv_w1, *cv_b1, *cv_w2, *conv_w, *conv_b, *w_out;
  float* out;
  char* ws;
};
constexpr size_t al256(size_t v) { return (v + 255) & ~(size_t)255; }
constexpr size_t OFF_xb = 0;
DI u16* ws_xb(const Params& p) { return (u16*)(p.ws + OFF_xb); }
constexpr size_t OFF_winT = OFF_xb + al256((size_t)NROWS * LDK * 2);
DI u16* ws_winT(const Params& p) { return (u16*)(p.ws + OFF_winT); }
constexpr size_t OFF_woutT = OFF_winT + al256((size_t)4096 * LDK * 2);
DI u16* ws_woutT(const Params& p) { return (u16*)(p.ws + OFF_woutT); }
constexpr size_t OFF_w1kT = OFF_woutT + al256((size_t)1024 * LDK * 2);
DI u16* ws_w1kT(const Params& p) { return (u16*)(p.ws + OFF_w1kT); }
constexpr size_t OFF_w1vT = OFF_w1kT + al256((size_t)128 * 2048 * 2);
DI u16* ws_w1vT(const Params& p) { return (u16*)(p.ws + OFF_w1vT); }
constexpr size_t OFF_w2kT = OFF_w1vT + al256((size_t)128 * 2048 * 2);
DI u16* ws_w2kT(const Params& p) { return (u16*)(p.ws + OFF_w2kT); }
constexpr size_t OFF_w2vT = OFF_w2kT + al256((size_t)64 * 128 * 2);
DI u16* ws_w2vT(const Params& p) { return (u16*)(p.ws + OFF_w2vT); }
constexpr size_t OFF_Q = OFF_w2vT + al256((size_t)64 * 128 * 2);
DI u16* ws_Q(const Params& p) { return (u16*)(p.ws + OFF_Q); }
constexpr size_t OFF_Ks = OFF_Q + al256((size_t)NROWS * 512 * 2);
DI u16* ws_Ks(const Params& p) { return (u16*)(p.ws + OFF_Ks); }
constexpr size_t OFF_Kw = OFF_Ks + al256((size_t)16 * 4096 * 64 * 2);
DI u16* ws_Kw(const Params& p) { return (u16*)(p.ws + OFF_Kw); }
constexpr size_t OFF_Vst = OFF_Kw + al256((size_t)16 * 4096 * 64 * 2);
DI u16* ws_Vst(const Params& p) { return (u16*)(p.ws + OFF_Vst); }
constexpr size_t OFF_Vwt = OFF_Vst + al256((size_t)16 * 4096 * 64 * 2);
DI u16* ws_Vwt(const Params& p) { return (u16*)(p.ws + OFF_Vwt); }
constexpr size_t OFF_kcraw = OFF_Vwt + al256((size_t)16 * 4096 * 64 * 2);
DI u16* ws_kcraw(const Params& p) { return (u16*)(p.ws + OFF_kcraw); }
constexpr size_t OFF_vcraw = OFF_kcraw + al256((size_t)16 * 4096 * 64 * 2 + 4096);
DI u16* ws_vcraw(const Params& p) { return (u16*)(p.ws + OFF_vcraw); }
constexpr size_t OFF_Kc = OFF_vcraw + al256((size_t)16 * 4096 * 64 * 2 + 4096);
DI u16* ws_Kc(const Params& p) { return (u16*)(p.ws + OFF_Kc); }
constexpr size_t OFF_Vct = OFF_Kc + al256((size_t)16 * 256 * 64 * 2);
DI u16* ws_Vct(const Params& p) { return (u16*)(p.ws + OFF_Vct); }
constexpr size_t OFF_zs = OFF_Vct + al256((size_t)16 * 256 * 64 * 2);
DI u16* ws_zs(const Params& p) { return (u16*)(p.ws + OFF_zs); }
constexpr size_t OFF_cvb = OFF_zs + al256((size_t)NROWS * 512 * 2);
DI u16* ws_cvb(const Params& p) { return (u16*)(p.ws + OFF_cvb); }
constexpr size_t OFF_mix = OFF_cvb + al256((size_t)NROWS * 2048 * 2);
DI u16* ws_mix(const Params& p) { return (u16*)(p.ws + OFF_mix); }
constexpr size_t OFF_rs = OFF_mix + al256((size_t)NROWS * LDK * 2);
DI float* ws_rs(const Params& p) { return (float*)(p.ws + OFF_rs); }
constexpr size_t OFF_ckpart = OFF_rs + al256((size_t)NROWS * 4);
DI float* ws_ckpart(const Params& p) { return (float*)(p.ws + OFF_ckpart); }
constexpr size_t OFF_rope = OFF_ckpart + al256((size_t)16 * 128 * 4);
DI float* ws_rope(const Params& p) { return (float*)(p.ws + OFF_rope); }
constexpr size_t OFF_gates = OFF_rope + al256((size_t)4096 * 8 * 2 * 4);
DI float* ws_gates(const Params& p) { return (float*)(p.ws + OFF_gates); }
constexpr size_t OFF_counter = OFF_gates + al256((size_t)NROWS * 24 * 4);
DI unsigned* ws_counter(const Params& p) { return (unsigned*)(p.ws + OFF_counter); }
constexpr size_t OFF_bar = OFF_counter + al256((size_t)256);
DI unsigned* ws_bar(const Params& p) { return (unsigned*)(p.ws + OFF_bar); }
constexpr size_t WS_TOTAL = OFF_bar + al256((size_t)3456 * 4);


DI void transpose_tile(const float* __restrict__ src, u16* __restrict__ dst, int K, int N, const float* __restrict__ scale, int kt, int nt, char* smem, int ldd) {
  float* tile = (float*)smem;
  const int tid = threadIdx.x;
#pragma unroll
  for (int i = 0; i < 8; ++i) {
    const int kk = i * 8 + (tid >> 6), nn = tid & 63, n = nt * 64 + nn, k = kt * 64 + kk;
    float v = (n < N) ? src[(size_t)k * N + n] : 0.f;
    if (scale) v *= scale[k];
    tile[kk * 65 + nn] = v;
  }
  __syncthreads();
#pragma unroll
  for (int i = 0; i < 8; ++i) {
    const int nn = i * 8 + (tid >> 6), kk = tid & 63;
    dst[(size_t)(nt * 64 + nn) * ldd + kt * 64 + kk] = f2bf(tile[kk * 65 + nn]);
  }
  __syncthreads();
}

__device__ void phase_prep(const Params& p, char* smem, int bid, int nb) {
  int tid_ = threadIdx.x; asm volatile("" : "+v"(tid_));
  const int tid = tid_, lane = tid & 63, wid = __builtin_amdgcn_readfirstlane(tid >> 6);
  constexpr int J_X = 1024, J_TW = 1024, J_TO = 256, J_T1 = 64, J_T2 = 2, J_CK = 16, J_ROPE = 64;
  constexpr int TOTAL = J_X + J_TW + J_TO + 2 * J_T1 + 2 * J_T2 + J_CK + J_ROPE;
  if (bid == 0 && tid < 8) ws_counter(p)[tid] = 0u;
  for (int j = bid; j < TOTAL; j += nb) {
    int jj = j;
    if (jj < J_X) {
      const int row0 = jj * 32 + wid * 4;
      float4 v[4][4]; float ss[4];
#pragma unroll
      for (int r = 0; r < 4; ++r) {
        const float4* xr = (const float4*)(p.x + (size_t)(row0 + r) * DM);
#pragma unroll
        for (int i = 0; i < 4; ++i) v[r][i] = xr[i * 64 + lane];
      }
#pragma unroll
      for (int r = 0; r < 4; ++r) {
        float a = 0.f;
#pragma unroll
        for (int i = 0; i < 4; ++i) a += v[r][i].x * v[r][i].x + v[r][i].y * v[r][i].y + v[r][i].z * v[r][i].z + v[r][i].w * v[r][i].w;
#pragma unroll
        for (int o = 32; o >= 1; o >>= 1) a += __shfl_xor(a, o);
        ss[r] = a;
      }
#pragma unroll
      for (int r = 0; r < 4; ++r) {
        if (lane == 0) ws_rs(p)[row0 + r] = rsqrtf(ss[r] * (1.0f / DM) + EPS);
#pragma unroll
        for (int i = 0; i < 4; ++i) {
          u32x2 o; o[0] = cvtpk(v[r][i].x, v[r][i].y); o[1] = cvtpk(v[r][i].z, v[r][i].w);
          const int rr_ = row0 + r;
          *(u32x2*)(ws_xb(p) + ((size_t)((rr_ >> 8) * 16 + i * 4 + (lane >> 4)) * 256 + (rr_ & 255)) * 64 + (lane & 15) * 4) = o;
        }
      }
      continue;
    }
    jj -= J_X;
    if (jj < J_TW) { transpose_tile(p.w_in, ws_winT(p), 1024, DIN, p.norm_w, jj & 15, jj >> 4, smem, LDK); continue; }
    jj -= J_TW;
    if (jj < J_TO) { transpose_tile(p.w_out, ws_woutT(p), 1024, 1024, nullptr, jj & 15, jj >> 4, smem, LDK); continue; }
    jj -= J_TO;
    if (jj < J_T1) { transpose_tile(p.ck_w1, ws_w1kT(p), 2048, 128, nullptr, jj & 31, jj >> 5, smem, 2048); continue; }
    jj -= J_T1;
    if (jj < J_T1) { transpose_tile(p.cv_w1, ws_w1vT(p), 2048, 128, nullptr, jj & 31, jj >> 5, smem, 2048); continue; }
    jj -= J_T1;
    if (jj < J_T2) { transpose_tile(p.ck_w2, ws_w2kT(p), 128, 64, nullptr, jj, 0, smem, 128); continue; }
    jj -= J_T2;
    if (jj < J_T2) { transpose_tile(p.cv_w2, ws_w2vT(p), 128, 64, nullptr, jj, 0, smem, 128); continue; }
    jj -= J_T2;
    if (jj < J_CK) {
      const int which = jj >> 3, chunk = jj & 7, hh = tid & 127, sub = tid >> 7;
      const float* pos = which ? p.cv_pos : p.ck_pos;
      const float* w1 = which ? p.cv_w1 : p.ck_w1;
      float acc = 0.f;
      const int f0 = chunk * 256 + sub * 64;
      float pv_[64], wv_[64];
#pragma unroll
      for (int f = 0; f < 64; ++f) { pv_[f] = pos[f0 + f]; wv_[f] = w1[(size_t)(f0 + f) * 128 + hh]; }
#pragma unroll
      for (int f = 0; f < 64; ++f) acc += pv_[f] * wv_[f];
      float* red = (float*)smem;
      red[sub * 128 + hh] = acc;
      __syncthreads();
      if (tid < 128) ws_ckpart(p)[(which * 8 + chunk) * 128 + tid] = red[tid] + red[128 + tid] + red[256 + tid] + red[384 + tid];
      __syncthreads();
      continue;
    }
    jj -= J_CK;
    {
      const int idx = jj * 512 + tid, pos = idx >> 3, fi = idx & 7;
      const float ang = (float)pos * c_invf[fi];
      float s, c; sincosf(ang, &s, &c);
      ws_rope(p)[idx * 2] = c; ws_rope(p)[idx * 2 + 1] = s;
    }
  }
}

DI int kimg_off(int row, int d) { return row * 64 + (((d >> 3) ^ ((row >> 1) & 7)) * 8) + (d & 7); }
DI int vimg_off(int d, int key) {
  const int kp = (key & ~12) | ((key & 4) << 1) | ((key & 8) >> 1);
  return d * 64 + (((kp >> 3) ^ ((d >> 1) & 7)) * 8) + (kp & 7);
}

constexpr int G_ASZ = 256 * 128, G_BSZ = 256 * 128, G_STAGE = G_ASZ + G_BSZ;
constexpr int G_ROPE = 2 * G_STAGE, G_RS = G_ROPE + 256 * 64;
static_assert(G_RS + 1024 <= SMEM_BYTES, "GEMM LDS layout exceeds the dynamic LDS size");
#define WAIT_VM(n) asm volatile("s_waitcnt vmcnt(" #n ")" ::: "memory")

template <int EPI>
__device__ void gemm_phase(const Params& p, char* smem, int bid, int nb) {
  constexpr int NT = EPI == 0 ? 16 : 4;
  constexpr int MT = 128;
  const u16* __restrict__ A = EPI == 0 ? ws_xb(p) : ws_mix(p);
  const u16* __restrict__ Bt = EPI == 0 ? ws_winT(p) : ws_woutT(p);
  int tid_ = threadIdx.x; asm volatile("" : "+v"(tid_));
  const int tid = tid_, lane = tid & 63, wid = __builtin_amdgcn_readfirstlane(tid >> 6), fr = lane & 15, fq = lane >> 4;
  const int wr = wid >> 2, wc = wid & 3;
  const bool xmap = (nb == 256);
  const int xcd = bid & 7, li = bid >> 3;
  const int ntiles = xmap ? (EPI == 0 ? 8 : 2) : (MT * NT - bid + nb - 1) / nb;
  auto tile_of = [&](int ti, int& m0, int& n0) {
    if (xmap) {
      const int sg = ti * 8 + xcd;
      if (EPI == 0) { m0 = ((sg >> 1) * 4 + (li >> 3)) * 256; n0 = ((sg & 1) * 8 + (li & 7)) * 256; }
      else { m0 = (sg * 8 + (li >> 2)) * 256; n0 = (li & 3) * 256; }
    } else { const int tile = bid + ti * nb; const int mt = tile / NT; m0 = mt * 256; n0 = (tile - mt * NT) * 256; }
  };
  const int nsteps = ntiles * 16;
  const unsigned lds0 = (unsigned)(uintptr_t)smem;
  const int gsw = (lane & 7) ^ ((wid & 1) * 4 + (lane >> 4));
  const int grow = wid * 8 + (lane >> 3);
  auto issue = [&](int step, int stage) {
    int m0, n0; tile_of(step >> 4, m0, n0);
    const int kt = step & 15;
    const u16* ag = EPI == 0 ? A + ((size_t)((m0 >> 8) * 16 + kt) * 256 + grow) * 64 + gsw * 8 : A + (size_t)(m0 + grow) * LDK + kt * 64 + gsw * 8;
    const size_t astep = EPI == 0 ? (size_t)64 * 64 : (size_t)64 * LDK;
    const int brow = EPI == 0 ? ((grow & ~31) | ((grow & 0x0C) << 1) | ((grow & 0x10) >> 2) | (grow & 3)) : grow;
    const u16* bg_ = Bt + (size_t)(n0 + brow) * LDK + kt * 64 + gsw * 8;
    const unsigned dst = (unsigned)__builtin_amdgcn_readfirstlane((int)(lds0 + stage * G_STAGE + wid * 1024));
#pragma unroll
    for (int i = 0; i < 4; ++i) glds16(ag + i * astep, dst + i * 8192);
#pragma unroll
    for (int i = 0; i < 4; ++i) glds16(bg_ + (size_t)i * 64 * LDK, dst + G_ASZ + i * 8192);
    if (EPI == 0 && kt == 8) {
      const int t0 = m0 & 4095;
      const unsigned sd = (unsigned)__builtin_amdgcn_readfirstlane((int)(lds0 + G_ROPE + wid * 1024));
      glds16(ws_rope(p) + (size_t)t0 * 16 + tid * 4, sd);
      glds16(ws_rope(p) + (size_t)t0 * 16 + (512 + tid) * 4, sd + 8192);
      if (wid == 0) glds16(ws_rs(p) + m0 + lane * 4, lds0 + G_RS);
    }
  };
  const int ca0 = ((fq ^ (fr >> 1)) * 16), ca1 = (((4 + fq) ^ (fr >> 1)) * 16);
  f32x4 acc[8][4];
#pragma unroll
  for (int m = 0; m < 8; ++m)
#pragma unroll
    for (int n = 0; n < 4; ++n) acc[m][n] = f32x4{0.f, 0.f, 0.f, 0.f};
  __syncthreads();
  if (nsteps > 0) issue(0, 0);
  for (int s = 0; s < nsteps; ++s) {
    WAIT_VM(0);
    __builtin_amdgcn_s_waitcnt(0x0F70);
    __builtin_amdgcn_s_barrier();
    if (s + 1 < nsteps) issue(s + 1, (s + 1) & 1);
    {
      const char* ab = smem + (s & 1) * G_STAGE + (wr * 128 + fr) * 128;
      const char* bb = smem + (s & 1) * G_STAGE + G_ASZ + (wc * 64 + fr) * 128;
#pragma unroll
      for (int ks = 0; ks < 2; ++ks) {
        bf16x8 af[8], bf[4];
        const int co = ks ? ca1 : ca0;
#pragma unroll
        for (int n = 0; n < 4; ++n) bf[n] = *(const bf16x8*)(bb + n * 16 * 128 + co);
#pragma unroll
        for (int m = 0; m < 8; ++m) af[m] = *(const bf16x8*)(ab + m * 16 * 128 + co);
#pragma unroll
        for (int m = 0; m < 8; ++m)
#pragma unroll
          for (int n = 0; n < 4; ++n) acc[m][n] = MFMA16(bf[n], af[m], acc[m][n]);
      }
    }
    if ((s & 15) != 15) continue;
    int m0, n0; tile_of(s >> 4, m0, n0);
    const int rbase = m0 + wr * 128;
    const int cb = n0 + wc * 64;
    if constexpr (EPI == 1) {
#pragma unroll
      for (int hm = 0; hm < 2; ++hm) {
        float4 xv[4][4];
#pragma unroll
        for (int mm = 0; mm < 4; ++mm) {
          const size_t ro = (size_t)(rbase + (hm * 4 + mm) * 16 + fr) * DM + cb + fq * 4;
#pragma unroll
          for (int n = 0; n < 4; ++n) xv[mm][n] = *(const float4*)(p.x + ro + n * 16);
        }
#pragma unroll
        for (int mm = 0; mm < 4; ++mm) {
          const int m = hm * 4 + mm;
          const size_t ro = (size_t)(rbase + m * 16 + fr) * DM + cb + fq * 4;
#pragma unroll
          for (int n = 0; n < 4; ++n) {
            float4 o; o.x = xv[mm][n].x + acc[m][n][0]; o.y = xv[mm][n].y + acc[m][n][1]; o.z = xv[mm][n].z + acc[m][n][2]; o.w = xv[mm][n].w + acc[m][n][3];
            *(float4*)(p.out + ro + n * 16) = o;
          }
        }
        __builtin_amdgcn_sched_barrier(0);
      }
    } else {
      const int b = m0 >> 12;
      const int tb = rbase & 4095;
      if (cb < 1280) {
        const int seg = cb >> 6;
        const int which = seg < 8 ? -1 : ((seg - 8) >> 1);
        const int g = seg < 8 ? (seg >> 2) : ((seg - 8) & 1);
        const bool need_norm = (seg < 8) || which == 2 || which == 4;
        const float* nw = seg < 8 ? p.q_norm_w : (p.k_norm_w + (which == 2 ? 64 : 128));
        float w[16];
#pragma unroll
        for (int k = 0; k < 16; ++k) w[k] = need_norm ? nw[(k >> 3) * 32 + fq * 8 + (k & 7)] : 1.0f;
        const float qs = seg < 8 ? QSCALE : 1.0f;
#pragma unroll
        for (int m = 0; m < 8; ++m) {
          const int t = tb + m * 16 + fr;
          const int lrow = wr * 128 + m * 16 + fr;
          const float r = *(const float*)(smem + G_RS + lrow * 4);
          float v[16];
#pragma unroll
          for (int k = 0; k < 16; ++k) v[k] = acc[m][(k >> 3) * 2 + ((k & 7) >> 2)][k & 3] * r;
          if (need_norm) {
            float ss = 0.f;
#pragma unroll
            for (int k = 0; k < 16; ++k) ss += v[k] * v[k];
            ss += __shfl_xor(ss, 16); ss += __shfl_xor(ss, 32);
            const float rr = rsqrtf(ss * (1.0f / 64.f) + EPS);
#pragma unroll
            for (int k = 0; k < 16; ++k) v[k] = v[k] * rr * w[k];
            const float4* rp = (const float4*)(smem + G_ROPE + lrow * 64);
            const float4 c01 = rp[0], c23 = rp[1], c45 = rp[2], c67 = rp[3];
            const float cc[8] = {c01.x, c01.z, c23.x, c23.z, c45.x, c45.z, c67.x, c67.z};
            const float sn[8] = {c01.y, c01.w, c23.y, c23.w, c45.y, c45.w, c67.y, c67.w};
#pragma unroll
            for (int e = 0; e < 8; ++e) {
              const float pr = __shfl_xor(v[e], 16);
              const float rot = (fq == 0) ? (v[e] * cc[e] - pr * sn[e]) : (v[e] * cc[e] + pr * sn[e]);
              v[e] = (fq < 2) ? rot : v[e];
            }
#pragma unroll
            for (int k = 0; k < 16; ++k) v[k] *= qs;
          }
          if (which == 3 || which == 5) {
            int lz = 0; asm volatile("" : "+v"(lz));
            u16* vt = (which == 3 ? ws_Vst(p) : ws_Vwt(p)) + (size_t)((b * 2 + g) * 64 + (t >> 6)) * 4096 + lz;
            const int fqx = fq + lz, key = (t & 63) + lz;
#pragma unroll
            for (int k = 0; k < 16; ++k) vt[vimg_off((k >> 3) * 32 + fqx * 8 + (k & 7), key)] = f2bf(v[k]);
          } else {
            u16* dst;
            if (seg < 8) dst = ws_Q(p) + ((size_t)((b * 2 + g) * 4096 + t) * 4 + (seg & 3)) * 64;
            else { u16* buf = which == 0 ? ws_kcraw(p) : which == 1 ? ws_vcraw(p) : which == 2 ? ws_Ks(p) : ws_Kw(p); dst = buf + ((size_t)(b * 2 + g) * 4096 + t) * 64; }
            const bool img = which >= 2;
#pragma unroll
            for (int n2 = 0; n2 < 2; ++n2) {
              u32x4 o;
#pragma unroll
              for (int e = 0; e < 4; ++e) o[e] = cvtpk(v[n2 * 8 + 2 * e], v[n2 * 8 + 2 * e + 1]);
              const int d0 = n2 * 32 + fq * 8;
              const int off = img ? (((d0 >> 3) ^ (((t & 63) >> 1) & 7)) * 8) : d0;
              *(u32x4*)(dst + off) = o;
            }
          }
          __builtin_amdgcn_sched_barrier(0);
        }
      } else {
#pragma unroll
        for (int m = 0; m < 8; ++m) {
          const size_t row = rbase + m * 16 + fr;
          const float r = *(const float*)(smem + G_RS + (wr * 128 + m * 16 + fr) * 4);
#pragma unroll
          for (int n2 = 0; n2 < 2; ++n2) {
            const int c8 = cb + n2 * 32 + fq * 8;
            if (c8 >= DIN) continue;
            float v[8];
#pragma unroll
            for (int e = 0; e < 8; ++e) v[e] = acc[m][n2 * 2 + (e >> 2)][e & 3] * r;
            if (c8 < 1304) {
              float4 o0, o1;
              o0.x = sigmoidf_(v[0]); o0.y = sigmoidf_(v[1]); o0.z = sigmoidf_(v[2]); o0.w = sigmoidf_(v[3]);
              o1.x = sigmoidf_(v[4]); o1.y = sigmoidf_(v[5]); o1.z = sigmoidf_(v[6]); o1.w = sigmoidf_(v[7]);
              float* gp = ws_gates(p) + row * 24 + (c8 - 1280);
              *(float4*)gp = o0; *(float4*)(gp + 4) = o1;
            } else if (c8 < 1816) {
              u32x4 o;
#pragma unroll
              for (int e = 0; e < 4; ++e) o[e] = cvtpk(siluf_(v[2 * e]), siluf_(v[2 * e + 1]));
              *(u32x4*)(ws_zs(p) + row * 512 + (c8 - 1304)) = o;
            } else {
              u32x4 o;
#pragma unroll
              for (int e = 0; e < 4; ++e) o[e] = cvtpk(v[2 * e], v[2 * e + 1]);
              *(u32x4*)(ws_cvb(p) + row * 2048 + (c8 - 1816)) = o;
            }
          }
          __builtin_amdgcn_sched_barrier(0);
        }
      }
    }
#pragma unroll
    for (int m = 0; m < 8; ++m)
#pragma unroll
      for (int n = 0; n < 4; ++n) acc[m][n] = f32x4{0.f, 0.f, 0.f, 0.f};
  }
}

__device__ void phase_cmp_conv(const Params& p, char* smem, int bid, int nb) {
  int tid_ = threadIdx.x; asm volatile("" : "+v"(tid_));
  const int tid = tid_, lane = tid & 63, wid = __builtin_amdgcn_readfirstlane(tid >> 6), fr = lane & 15, fq = lane >> 4;
  float* part = (float*)smem;
  char* hl = smem + 8 * 16 * 132 * 4;
  float* outl = (float*)(hl + 2 * 4352);
  for (int job = bid; job < 256; job += nb) {
    const int which = wid >> 2, w4 = wid & 3, bg = job >> 4, ct = job & 15;
    const u16* raw = (which ? ws_vcraw(p) : ws_kcraw(p)) + (size_t)bg * 4096 * 64;
    const u16* w1T = which ? ws_w1vT(p) : ws_w1kT(p);
    const u16* w2T = which ? ws_w2vT(p) : ws_w2kT(p);
    const float* b1 = which ? p.cv_b1 : p.ck_b1;
    f32x4 acc[8];
#pragma unroll
    for (int n = 0; n < 8; ++n) acc[n] = f32x4{0.f, 0.f, 0.f, 0.f};
    const int c = ct * 16 + fr;
    const int ht = tid & 255, rrow = ht >> 4, c8 = (ht & 15) * 8;
    float bias[8];
#pragma unroll
    for (int e = 0; e < 8; ++e) {
      float bsum = b1[c8 + e];
#pragma unroll
      for (int ch = 0; ch < 8; ++ch) bsum += ws_ckpart(p)[(which * 8 + ch) * 128 + c8 + e];
      bias[e] = bsum;
    }
    bf16x8 w2f[4];
#pragma unroll
    for (int ks = 0; ks < 4; ++ks) w2f[ks] = *(const bf16x8*)(w2T + (size_t)(w4 * 16 + fr) * 128 + ks * 32 + fq * 8);
    const int orow = ht >> 4, d4 = (ht & 15) * 4;
    const int cc = ct * 16 + orow;
    float nwv[4], nwp[4]; float2 csv[4];
    {
      int pos = cc * 16 + 31; pos = pos > 4095 ? 4095 : pos;
#pragma unroll
      for (int e = 0; e < 4; ++e) {
        const int d = d4 + e;
        nwv[e] = p.k_norm_w[d]; nwp[e] = p.k_norm_w[d ^ 8];
        csv[e] = *(const float2*)(ws_rope(p) + ((size_t)pos * 8 + (d & 7)) * 2);
      }
    }
#pragma unroll 4
    for (int k16 = 0; k16 < 16; ++k16) {
      const int ks = w4 * 16 + k16;
      const int l = ks >> 1, d0 = (ks & 1) * 32 + fq * 8;
      int tt = c * 16 + l; tt = tt > 4095 ? 4095 : tt;
      const bf16x8 a = *(const bf16x8*)(raw + (size_t)tt * 64 + d0);
#pragma unroll
      for (int n = 0; n < 8; ++n) {
        const bf16x8 bb = *(const bf16x8*)(w1T + (size_t)(n * 16 + fr) * 2048 + ks * 32 + fq * 8);
        acc[n] = MFMA16(a, bb, acc[n]);
      }
    }
#pragma unroll
    for (int n = 0; n < 8; ++n)
#pragma unroll
      for (int j = 0; j < 4; ++j) part[(wid * 16 + fq * 4 + j) * 132 + n * 16 + fr] = acc[n][j];
    __syncthreads();
    {
      float sum[8];
#pragma unroll
      for (int e = 0; e < 8; ++e) sum[e] = bias[e];
#pragma unroll
      for (int w = 0; w < 4; ++w) {
        const float4 v0 = *(const float4*)(part + ((which * 4 + w) * 16 + rrow) * 132 + c8), v1 = *(const float4*)(part + ((which * 4 + w) * 16 + rrow) * 132 + c8 + 4);
        sum[0] += v0.x; sum[1] += v0.y; sum[2] += v0.z; sum[3] += v0.w; sum[4] += v1.x; sum[5] += v1.y; sum[6] += v1.z; sum[7] += v1.w;
      }
      u32x4 o;
#pragma unroll
      for (int e = 0; e < 4; ++e) o[e] = cvtpk(siluf_(sum[2 * e]), siluf_(sum[2 * e + 1]));
      *(u32x4*)(hl + which * 4352 + rrow * 272 + c8 * 2) = o;
    }
    __syncthreads();
    {
      f32x4 o2 = f32x4{0.f, 0.f, 0.f, 0.f};
#pragma unroll
      for (int ks = 0; ks < 4; ++ks) {
        const bf16x8 a = *(const bf16x8*)(hl + which * 4352 + fr * 272 + (ks * 32 + fq * 8) * 2);
        o2 = MFMA16(a, w2f[ks], o2);
      }
#pragma unroll
      for (int j = 0; j < 4; ++j) outl[which * 1088 + (fq * 4 + j) * 68 + w4 * 16 + fr] = o2[j];
    }
    __syncthreads();
    {
      const float* ol = outl + which * 1088;
      const float4 v = *(const float4*)(ol + orow * 68 + d4);
      if (which == 0) {
        float ss = v.x * v.x + v.y * v.y + v.z * v.z + v.w * v.w;
        ss += __shfl_xor(ss, 1); ss += __shfl_xor(ss, 2); ss += __shfl_xor(ss, 4); ss += __shfl_xor(ss, 8);
        const float rr = rsqrtf(ss * (1.0f / 64.f) + EPS);
        float o[4] = {v.x * rr * nwv[0], v.y * rr * nwv[1], v.z * rr * nwv[2], v.w * rr * nwv[3]};
        if (d4 < 16) {
#pragma unroll
          for (int e = 0; e < 4; ++e) {
            const int d = d4 + e, dp = d ^ 8;
            const float pr = ol[orow * 68 + dp] * rr * nwp[e];
            o[e] = (d < 8) ? (o[e] * csv[e].x - pr * csv[e].y) : (o[e] * csv[e].x + pr * csv[e].y);
          }
        }
        u32x2 ov; ov[0] = cvtpk(o[0], o[1]); ov[1] = cvtpk(o[2], o[3]);
        if (cc >= 255) { ov[0] = 0u; ov[1] = 0u; }
        *(u32x2*)(ws_Kc(p) + (size_t)(bg * 4 + (cc >> 6)) * 4096 + kimg_off(cc & 63, d4)) = ov;
      } else {
        const float z = (cc >= 255) ? 0.f : 1.f;
        u16* vt = ws_Vct(p) + (size_t)(bg * 4 + (cc >> 6)) * 4096;
        vt[vimg_off(d4 + 0, cc & 63)] = f2bf(v.x * z); vt[vimg_off(d4 + 1, cc & 63)] = f2bf(v.y * z);
        vt[vimg_off(d4 + 2, cc & 63)] = f2bf(v.z * z); vt[vimg_off(d4 + 3, cc & 63)] = f2bf(v.w * z);
      }
    }
    __syncthreads();
  }
  const int gw = bid * 8 + wid, nw = nb * 8;
  for (int chunk = gw; chunk < 2048; chunk += nw) {
    const int r0 = chunk * 16, t0 = r0 & 4095;
    const int ch = lane * 8;
    float cw0[8], cw1[8], cw2[8], cbv[8], u1[8], u2[8];
#pragma unroll
    for (int e = 0; e < 8; ++e) { cw0[e] = p.conv_w[ch + e]; cw1[e] = p.conv_w[512 + ch + e]; cw2[e] = p.conv_w[1024 + ch + e]; cbv[e] = p.conv_b[ch + e]; u1[e] = 0.f; u2[e] = 0.f; }
    if (t0 > 0) {
#pragma unroll
      for (int q = 0; q < 2; ++q) {
        const u16* rp = ws_cvb(p) + (size_t)(r0 - 2 + q) * 2048 + ch;
        const u32x4 hv = *(const u32x4*)(rp), cv = *(const u32x4*)(rp + 1024);
#pragma unroll
        for (int e = 0; e < 4; ++e) {
          const float ua = bflo(hv[e]) * bflo(cv[e]), ub = bfhi(hv[e]) * bfhi(cv[e]);
          if (q == 0) { u2[2 * e] = ua; u2[2 * e + 1] = ub; } else { u1[2 * e] = ua; u1[2 * e + 1] = ub; }
        }
      }
    }
#pragma unroll 4
    for (int rr = 0; rr < 16; ++rr) {
      const u16* rp = ws_cvb(p) + (size_t)(r0 + rr) * 2048 + ch;
      const u32x4 hv = *(const u32x4*)(rp), bv = *(const u32x4*)(rp + 512), cv = *(const u32x4*)(rp + 1024), zv = *(const u32x4*)(rp + 1536);
      u32x4 ov;
#pragma unroll
      for (int e = 0; e < 4; ++e) {
        const float ua = bflo(hv[e]) * bflo(cv[e]), ub = bfhi(hv[e]) * bfhi(cv[e]);
        const float ca = cw0[2 * e] * u2[2 * e] + cw1[2 * e] * u1[2 * e] + cw2[2 * e] * ua + cbv[2 * e];
        const float cbb = cw0[2 * e + 1] * u2[2 * e + 1] + cw1[2 * e + 1] * u1[2 * e + 1] + cw2[2 * e + 1] * ub + cbv[2 * e + 1];
        const float oa = bflo(bv[e]) * ca * siluf_(bflo(zv[e]));
        const float ob = bfhi(bv[e]) * cbb * siluf_(bfhi(zv[e]));
        ov[e] = cvtpk(oa, ob);
        u2[2 * e] = u1[2 * e]; u2[2 * e + 1] = u1[2 * e + 1]; u1[2 * e] = ua; u1[2 * e + 1] = ub;
      }
      *(u32x4*)(ws_mix(p) + (size_t)(r0 + rr) * LDK + 512 + ch) = ov;
    }
  }
}

constexpr int AT_NST = 5, AT_KB = 8192, AT_BUF = 16384;
constexpr int AT_F = AT_NST * AT_BUF, AT_IMPA = AT_F, AT_IMPB = AT_IMPA + 64 * 65 * 4, AT_VAL = AT_IMPA;
constexpr int AT_SELM = AT_F + 8 * 8192, AT_UNIT = AT_SELM + 512, AT_END = AT_UNIT + 16;
static_assert(AT_END <= SMEM_BYTES, "attention LDS layout exceeds the dynamic LDS size");

__device__ void phase_attn(const Params& p, char* smem, int bid, int nb, int rep) {
  int tid_ = threadIdx.x; asm volatile("" : "+v"(tid_));
  const int tid = tid_, lane = tid & 63, wid = __builtin_amdgcn_readfirstlane(tid >> 6), c32 = lane & 31, h = lane >> 5;
  const float NINF = -__builtin_inff();
  float* impa = (float*)(smem + AT_IMPA);
  float* impb = (float*)(smem + AT_IMPB);
  float* vals = (float*)(smem + AT_VAL);
  unsigned* selm = (unsigned*)(smem + AT_SELM);
  volatile int* s_unit = (volatile int*)(smem + AT_UNIT);
  const unsigned lds0 = (unsigned)(uintptr_t)smem;
  while (true) {
    if (tid == 0) *s_unit = (int)atomicAdd(ws_counter(p) + rep, 1u);
    __syncthreads();
    const int u = __builtin_amdgcn_readfirstlane(*s_unit);
    __syncthreads();
    if (u >= 1024) break;
    const int i = 63 - (u >> 4), bg = u & 15, b = bg >> 1, g = bg & 1;
    const int tl = wid * 8 + (c32 >> 2), hd = c32 & 3;
    const int t = i * 64 + tl;
    const u16* qrow = ws_Q(p) + ((size_t)(bg * 4096 + i * 64) * 4 + wid * 32 + c32) * 64;
    bf16x8 qf[4];
#pragma unroll
    for (int ks = 0; ks < 4; ++ks) qf[ks] = *(const bf16x8*)(qrow + ks * 16 + h * 8);
    const float* gp = ws_gates(p) + (size_t)(b * 4096 + t) * 24 + (g * 4 + hd) * 3;
    const float g0 = gp[0], g1 = gp[1], g2 = gp[2];
    asm volatile("" :: "v"(qf[0]), "v"(qf[1]), "v"(qf[2]), "v"(qf[3]), "v"(g0), "v"(g1), "v"(g2));
    const int ntc = (4 * i + 2) / 64 + 1, nsl = i + 1, nwin = (i < 8 ? i : 8) + 1;
    const int NT = 2 * ntc + nsl + nwin;
    const bool need_sel = i >= 16;

    f32x16 O0, O1;
#pragma unroll
    for (int r = 0; r < 16; ++r) { O0[r] = 0.f; O1[r] = 0.f; }
    float* fl = (float*)(smem + AT_F + wid * 8192) + lane;
    float m_run = NINF, l_run = 0.f, inv_l = 0.f;
    u32x4 kxw; kxw[0] = (h == 0) ? 0x3F80u : 0u; kxw[1] = 0u; kxw[2] = 0u; kxw[3] = 0u;
    const bf16x8 kx = __builtin_bit_cast(bf16x8, kxw);
    float oscale = 1.0f;
    unsigned sel_lo = 0xffffffffu, sel_hi = 0xffffffffu;
#define TILE_PTRS(n, kp, vp) do { \
      if ((n) < 2 * ntc) { const int tt_ = (n) < ntc ? (n) : (n) - ntc; kp = ws_Kc(p) + (size_t)(bg * 4 + tt_) * 4096; vp = ws_Vct(p) + (size_t)(bg * 4 + tt_) * 4096; } \
      else if ((n) < 2 * ntc + nsl) { const int j_ = (n) - 2 * ntc; kp = ws_Ks(p) + ((size_t)bg * 4096 + j_ * 64) * 64; vp = ws_Vst(p) + (size_t)(bg * 64 + j_) * 4096; } \
      else { const int j_ = i - nwin + 1 + ((n) - 2 * ntc - nsl); kp = ws_Kw(p) + ((size_t)bg * 4096 + j_ * 64) * 64; vp = ws_Vwt(p) + (size_t)(bg * 64 + j_) * 4096; } } while (0)
#define TISSUE(n, st_) do { const u16 *kp_, *vp_; TILE_PTRS(n, kp_, vp_); \
      const unsigned d_ = (unsigned)__builtin_amdgcn_readfirstlane((int)(lds0 + (st_) * AT_BUF + wid * 1024)); \
      glds16(kp_ + tid * 8, d_); glds16(vp_ + tid * 8, d_ + AT_KB); } while (0)
    {
      const int npre = NT < AT_NST - 1 ? NT : AT_NST - 1;
      for (int n = 0; n < npre; ++n) TISSUE(n, n);
    }
    int st_cur = 0, st_iss = AT_NST - 1;
    const int ksw = (c32 >> 1) & 7;
    for (int n = 0; n < NT; ++n) {
      {
        const int rem = NT - 1 - n;
        if (rem >= 3) WAIT_VM(6); else if (rem == 2) WAIT_VM(4); else if (rem == 1) WAIT_VM(2); else WAIT_VM(0);
        __builtin_amdgcn_s_barrier();
        if (n + AT_NST - 1 < NT) TISSUE(n + AT_NST - 1, st_iss);
      }
      int mode, base, lo, hi;
      bool full = false, lane_on = true;
      if (n < 2 * ntc) { mode = n < ntc ? 0 : 1; base = (n < ntc ? n : n - ntc) * 64; lo = -1; hi = (t - 31) >> 4; }
      else if (n < 2 * ntc + nsl) { const int j = n - 2 * ntc; mode = 2; base = j * 64; const unsigned bit = j < 32 ? (sel_lo >> j) & 1u : (sel_hi >> (j - 32)) & 1u; lo = -1; hi = bit ? t : -1; full = j < i; lane_on = bit != 0u; }
      else { const int j = i - nwin + 1 + (n - 2 * ntc - nsl); mode = 3; base = j * 64; lo = t - 512; hi = t; full = (j < i) && (j > i - 8); }
      const int lo_rel = lo - (base + 4 * h), hi_rel = hi - (base + 4 * h);
      const bool chk = ((n & 7) == 7) || mode == 0;
#pragma unroll
      for (int r = 0; r < 16; ++r) { O0[r] *= oscale; O1[r] *= oscale; }
      const char* kb = smem + st_cur * AT_BUF;
      const char* vb = kb + AT_KB;
      st_cur = st_cur == AT_NST - 1 ? 0 : st_cur + 1; st_iss = st_iss == AT_NST - 1 ? 0 : st_iss + 1;
      f32x16 S0, S1;
#define ATT_BODY(MASKED) do { \
      _Pragma("unroll") for (int r = 0; r < 16; ++r) { S0[r] = 0.f; S1[r] = 0.f; } \
      const float m_use = (m_run == NINF) ? 0.f : m_run;        \
      { \
          \
        const float negm = (!(MASKED) && !lane_on) ? NINF : -m_use; \
        u32x4 qxw; qxw[0] = (h == 0) ? (cvtpk(negm, 0.f) & 0xffffu) : 0u; qxw[1] = 0u; qxw[2] = 0u; qxw[3] = 0u; \
        const bf16x8 qx = __builtin_bit_cast(bf16x8, qxw); \
        S0 = MFMA32(kx, qx, S0); S1 = MFMA32(kx, qx, S1); \
      } \
      { \
        bf16x8 kf0[4], kf1[4]; \
        _Pragma("unroll") for (int ks = 0; ks < 4; ++ks) { \
          kf0[ks] = *(const bf16x8*)(kb + c32 * 128 + (((ks * 2 + h) ^ ksw) * 16)); \
          kf1[ks] = *(const bf16x8*)(kb + (32 + c32) * 128 + (((ks * 2 + h) ^ ksw) * 16)); \
        } \
        _Pragma("unroll") for (int ks = 0; ks < 4; ++ks) S0 = MFMA32(kf0[ks], qf[ks], S0);     \
        _Pragma("unroll") for (int ks = 0; ks < 4; ++ks) S1 = MFMA32(kf1[ks], qf[ks], S1); \
      } \
        \
      if (MASKED) { \
        _Pragma("unroll") for (int r = 0; r < 16; ++r) { \
          const int off = (r & 3) + 8 * (r >> 2); \
          S0[r] = (off > lo_rel && off <= hi_rel) ? S0[r] : NINF; \
          S1[r] = (off + 32 > lo_rel && off + 32 <= hi_rel) ? S1[r] : NINF; \
        } \
      } \
      float ps0 = 0.f, ps1 = 0.f; \
      bf16x8 vfa[4]; \
      _Pragma("unroll") for (int kk = 0; kk < 2; ++kk) \
        _Pragma("unroll") for (int dr = 0; dr < 2; ++dr) vfa[kk * 2 + dr] = *(const bf16x8*)(vb + (32 * dr + c32) * 128 + (((2 * kk + h) ^ ksw) * 16)); \
      _Pragma("unroll") for (int r = 0; r < 16; ++r) { S0[r] = __builtin_amdgcn_exp2f(S0[r]); ps0 += S0[r]; } \
      _Pragma("unroll") for (int kk = 0; kk < 2; ++kk) { \
        u32x4 pw; \
        _Pragma("unroll") for (int e = 0; e < 4; ++e) pw[e] = cvtpk(S0[8 * kk + 2 * e], S0[8 * kk + 2 * e + 1]); \
        const bf16x8 pf = __builtin_bit_cast(bf16x8, pw); \
        O0 = MFMA32(vfa[kk * 2], pf, O0); O1 = MFMA32(vfa[kk * 2 + 1], pf, O1); \
      } \
      __builtin_amdgcn_sched_group_barrier(0x100, 12, 0);     \
      __builtin_amdgcn_sched_group_barrier(0x008, 4, 0);      \
      _Pragma("unroll") for (int q_ = 0; q_ < 4; ++q_) { __builtin_amdgcn_sched_group_barrier(0x008, 1, 0); __builtin_amdgcn_sched_group_barrier(0x002, 9, 0); }     \
      __builtin_amdgcn_sched_barrier(0); \
      _Pragma("unroll") for (int r = 0; r < 16; ++r) { S1[r] = __builtin_amdgcn_exp2f(S1[r]); ps1 += S1[r]; } \
      _Pragma("unroll") for (int kk = 0; kk < 2; ++kk) { \
        u32x4 pw; \
        _Pragma("unroll") for (int e = 0; e < 4; ++e) pw[e] = cvtpk(S1[8 * kk + 2 * e], S1[8 * kk + 2 * e + 1]); \
        const bf16x8 pf = __builtin_bit_cast(bf16x8, pw); \
        const bf16x8 va0 = *(const bf16x8*)(vb + c32 * 128 + (((2 * (kk + 2) + h) ^ ksw) * 16)), va1 = *(const bf16x8*)(vb + (32 + c32) * 128 + (((2 * (kk + 2) + h) ^ ksw) * 16)); \
        O0 = MFMA32(va0, pf, O0); O1 = MFMA32(va1, pf, O1); \
      } \
      __builtin_amdgcn_sched_barrier(0); \
      oscale = 1.0f; \
      if (mode != 1) l_run += ps0 + ps1; \
      if (mode != 1 && chk) {                    \
        float mxp = fmaxf(fmaxf(S0[0], S0[1]), S1[0]); \
        mxp = fmaxf(fmaxf(mxp, S1[1]), S0[2]); \
        _Pragma("unroll") for (int r = 2; r < 16; r += 2) { \
          if (r > 2) mxp = fmaxf(fmaxf(mxp, S0[r]), S1[r - 1]); \
          mxp = fmaxf(fmaxf(mxp, S0[r + 1]), S1[r]); \
        } \
        mxp = fmaxf(mxp, S1[15]); \
        mxp = fmaxf(mxp, __shfl_xor(mxp, 32));            \
        const bool mv = (m_run == NINF) ? (mxp > 0.f) : (mxp > 256.0f); \
        const float m_new = bflo(cvtpk(m_use + __builtin_amdgcn_logf(mxp), 0.f));       \
        const float alpha = mv ? __builtin_amdgcn_exp2f(m_use - m_new) : 1.0f; \
        m_run = mv ? m_new : m_run; \
        l_run *= alpha; \
        oscale = alpha; \
      } \
      if ((MASKED) && mode == 1 && need_sel) {               \
        const int tt = base >> 6; \
        _Pragma("unroll") for (int kr = 0; kr < 2; ++kr) \
          _Pragma("unroll") for (int rg = 0; rg < 4; ++rg) { \
            float pv[4]; \
            _Pragma("unroll") for (int e = 0; e < 4; ++e) { \
              float v = (kr ? S1[rg * 4 + e] : S0[rg * 4 + e]) * inv_l; \
              v += qperm<0xB1>(v); v += qperm<0x4E>(v);            \
              pv[e] = v; \
            } \
            if (hd == 0) { \
              const int nblk = tt * 16 + 8 * kr + 2 * rg + h; \
              impa[tl * 65 + nblk] = pv[0] + pv[1] + pv[2] + 0.5f * pv[3]; \
              impb[tl * 65 + nblk] = 0.5f * pv[3]; \
            } \
          } \
      } } while (0)
      if (full) ATT_BODY(false); else ATT_BODY(true);
#undef ATT_BODY
      if (n == ntc - 1) {
        const float lt = l_run + __shfl_xor(l_run, 32);
        inv_l = lt > 0.f ? 1.0f / lt : 0.f;
        oscale = 0.f;
      } else if (n == 2 * ntc - 1) {
        if (need_sel) {
          __syncthreads();
          for (int q = 0; q < 8; ++q) {
            const int tk = wid * 8 + q, nn = lane;
            const bool forced = (nn == 0) || (nn == i) || (nn == i - 1);
            const bool vis = nn <= i;
            float v = 0.f;
            if (vis) v = impa[tk * 65 + nn] + (nn > 0 ? impb[tk * 65 + nn - 1] : 0.f);
            const unsigned bse = forced ? 0x4E6E6B28u : __float_as_uint(v);
            const unsigned key = (bse & ~127u) | (vis ? 64u : 0u) | (unsigned)(63 - nn);
            unsigned T = 0u;
#pragma unroll 1
            for (int bbit = 31; bbit >= 0; --bbit) {
              const unsigned Tc = T | (1u << bbit);
              const unsigned long long mk = __builtin_amdgcn_ballot_w64(key >= Tc);
              if (__builtin_popcountll(mk) >= 16) T = Tc;
            }
            const unsigned long long sel = __builtin_amdgcn_ballot_w64(key >= T);
            if (lane == 0) { selm[tk * 2] = (unsigned)sel; selm[tk * 2 + 1] = (unsigned)(sel >> 32); }
          }
          __syncthreads();
          sel_lo = selm[tl * 2]; sel_hi = selm[tl * 2 + 1];
        }
        {
          const float wgt = g0 * inv_l * oscale;
#pragma unroll
          for (int r = 0; r < 16; ++r) { fl[r * 64] = wgt * O0[r]; fl[(16 + r) * 64] = wgt * O1[r]; }
          m_run = NINF; l_run = 0.f; oscale = 0.f;
        }
      } else if (n == 2 * ntc + nsl - 1) {
        const float lt = l_run + __shfl_xor(l_run, 32);
        const float wgt = g1 * (lt > 0.f ? 1.0f / lt : 0.f) * oscale;
#pragma unroll
        for (int r = 0; r < 16; ++r) { fl[r * 64] += wgt * O0[r]; fl[(16 + r) * 64] += wgt * O1[r]; }
        m_run = NINF; l_run = 0.f; oscale = 0.f;
      }
    }
#undef TILE_PTRS
#undef TISSUE
    {
      const float lt = l_run + __shfl_xor(l_run, 32);
      const float wgt = g2 * (lt > 0.f ? 1.0f / lt : 0.f) * oscale;
      const size_t rowo = (size_t)(b * 4096 + t);
      const u16* zp = ws_zs(p) + rowo * 512 + (g * 4 + hd) * 64;
      u16* mp = ws_mix(p) + rowo * LDK + (g * 4 + hd) * 64;
#pragma unroll
      for (int dr = 0; dr < 2; ++dr)
#pragma unroll
        for (int rg = 0; rg < 4; ++rg) {
          const int d = 32 * dr + 8 * rg + 4 * h;
          const u32x2 zv = *(const u32x2*)(zp + d);
          const float f0 = fl[(dr * 16 + rg * 4 + 0) * 64] + wgt * (dr ? O1[rg * 4 + 0] : O0[rg * 4 + 0]);
          const float f1 = fl[(dr * 16 + rg * 4 + 1) * 64] + wgt * (dr ? O1[rg * 4 + 1] : O0[rg * 4 + 1]);
          const float f2 = fl[(dr * 16 + rg * 4 + 2) * 64] + wgt * (dr ? O1[rg * 4 + 2] : O0[rg * 4 + 2]);
          const float f3 = fl[(dr * 16 + rg * 4 + 3) * 64] + wgt * (dr ? O1[rg * 4 + 3] : O0[rg * 4 + 3]);
          u32x2 o;
          o[0] = cvtpk(f0 * bflo(zv[0]), f1 * bfhi(zv[0]));
          o[1] = cvtpk(f2 * bflo(zv[1]), f3 * bfhi(zv[1]));
          *(u32x2*)(mp + d) = o;
        }
    }
  }
}

#define XB_TMO      128
#define XB_XCNT(j)  (256  + 64 * (j))
#define XB_XSUB(j)  (1280 + 64 * (j))
#define XB_XGEN(j)  (2304 + 64 * (j))
#define XB_TOP      3328
#define XB_TOPGEN   3392
#define XCD_BAR_WORDS 3456
#define XB_SPIN_CAP (1u << 18)
#define LAS __attribute__((address_space(3)))

__device__ __forceinline__ unsigned xb_ld(unsigned* p)              { return __hip_atomic_load(p, __ATOMIC_RELAXED, __HIP_MEMORY_SCOPE_AGENT); }
__device__ __forceinline__ unsigned xb_add(unsigned* p, unsigned v) { return __hip_atomic_fetch_add(p, v, __ATOMIC_RELAXED, __HIP_MEMORY_SCOPE_AGENT); }
__device__ __forceinline__ unsigned xb_xcc_id() { return (unsigned)__builtin_amdgcn_s_getreg((3 << 11) | 20) & 0xFu; }
#define XB_SPIN(cond, bar) do { unsigned _sp = 0; while (cond) { __builtin_amdgcn_s_sleep(1); \
    if ((++_sp & 255u) == 0u) { if (xb_ld(&(bar)[XB_TMO])) break; if (_sp > XB_SPIN_CAP) { atomicAdd(&(bar)[XB_TMO], 1u); break; } } } } while (0)

struct XcdBarrier {
    unsigned* bar; unsigned x;
    volatile LAS unsigned* st;
};

__device__ __forceinline__ XcdBarrier xcd_barrier_post(unsigned* bar, volatile LAS unsigned* st) {
    XcdBarrier b; b.bar = bar; b.x = xb_xcc_id(); b.st = st;
    if (threadIdx.x == 0) (void)xb_add(&bar[XB_XCNT(b.x)], 1u);
    return b;
}
__device__ __forceinline__ void xcd_barrier_complete(unsigned* bar, unsigned x, unsigned& nloc, unsigned& nx) {
    const unsigned G = gridDim.x * gridDim.y * gridDim.z;
    unsigned sum, cnt, mine, sp = 0u;
    for (;;) {
        sum = 0u; cnt = 0u; mine = 0u;
#pragma unroll
        for (unsigned j = 0; j < 16; ++j) { const unsigned c = xb_ld(&bar[XB_XCNT(j)]); sum += c; cnt += (c > 0u) ? 1u : 0u; mine = (j == x) ? c : mine; }
        if (sum == G) break;
        __builtin_amdgcn_s_sleep(1);
        if ((++sp & 255u) == 0u) { if (xb_ld(&bar[XB_TMO])) break; if (sp > XB_SPIN_CAP) { atomicAdd(&bar[XB_TMO], 1u); break; } }
    }
    nloc = mine > 0u ? mine : 1u; nx = cnt > 0u ? cnt : 1u;
}

__device__ __forceinline__ void xcd_barrier(const XcdBarrier& b) {
    asm volatile("s_waitcnt vmcnt(0)" ::: "memory");
    __syncthreads();
    if (threadIdx.x == 0) {
        unsigned* bar = b.bar;
        __builtin_amdgcn_s_waitcnt(0);
        unsigned nloc = b.st[0], nx = b.st[1];
        if (nloc == 0u) { xcd_barrier_complete(bar, b.x, nloc, nx); b.st[0] = nloc; b.st[1] = nx; }
        const unsigned old = xb_add(&bar[XB_XSUB(b.x)], 1u);
        const unsigned gen = old / nloc;
        if (old + 1u == (gen + 1u) * nloc) {
            __builtin_amdgcn_fence(__ATOMIC_RELEASE, "agent");
            asm volatile("s_waitcnt vmcnt(0)" ::: "memory");
            const unsigned og = xb_add(&bar[XB_TOP], 1u);
            const unsigned tg = og / nx;
            if (og + 1u == (tg + 1u) * nx) xb_add(&bar[XB_TOPGEN], 1u);
            else XB_SPIN(xb_ld(&bar[XB_TOPGEN]) == tg, bar);
            __builtin_amdgcn_fence(__ATOMIC_ACQUIRE, "agent");
            xb_add(&bar[XB_XGEN(b.x)], 1u);
            asm volatile("s_waitcnt vmcnt(0)" ::: "memory");
        } else {
            XB_SPIN(xb_ld(&bar[XB_XGEN(b.x)]) == gen, bar);
            __builtin_amdgcn_fence(__ATOMIC_ACQUIRE, "agent");
            asm volatile("s_waitcnt vmcnt(0)" ::: "memory");
        }
    }
    __syncthreads();
}


#if FUSED
extern "C" __global__ void __launch_bounds__(NTHREADS) hybrid_fwd(Params p) {
  extern __shared__ __attribute__((aligned(16))) char smem[];
  cg::grid_group grid = cg::this_grid();
  const int bid = blockIdx.x, nb = gridDim.x;
  if (threadIdx.x < 4) ((volatile unsigned*)(smem + SMEM_BYTES))[threadIdx.x] = 0u;
  __syncthreads();
  if (bid == 0) { for (int w_ = threadIdx.x; w_ < XCD_BAR_WORDS; w_ += NTHREADS) ws_bar(p)[w_] = 0u; }
  for (int r = 0; r < REP0; ++r) { phase_prep(p, smem, bid, nb); grid.sync(); }
  XcdBarrier xb = xcd_barrier_post(ws_bar(p), (volatile LAS unsigned*)(smem + SMEM_BYTES));
  for (int r = 0; r < REP1; ++r) { gemm_phase<0>(p, smem, bid, nb); xcd_barrier(xb); }
  for (int r = 0; r < REP2; ++r) { phase_cmp_conv(p, smem, bid, nb); xcd_barrier(xb); }
  for (int r = 0; r < REP3; ++r) { phase_attn(p, smem, bid, nb, r); xcd_barrier(xb); }
  for (int r = 0; r < REP4; ++r) { gemm_phase<1>(p, smem, bid, nb); }
}
#else
template <int PH>
__global__ void __launch_bounds__(NTHREADS) phase_kernel(Params p) {
  extern __shared__ __attribute__((aligned(16))) char smem[];
  const int bid = blockIdx.x, nb = gridDim.x;
  if constexpr (PH == 0) phase_prep(p, smem, bid, nb);
  if constexpr (PH == 1) gemm_phase<0>(p, smem, bid, nb);
  if constexpr (PH == 2) phase_cmp_conv(p, smem, bid, nb);
  if constexpr (PH == 3) phase_attn(p, smem, bid, nb, 0);
  if constexpr (PH == 4) gemm_phase<1>(p, smem, bid, nb);
}
#endif

extern "C" void kernel_launch(void* const* d_in, const int* in_sizes, int n_in, void* d_out, int out_size, void* d_ws, size_t ws_size, hipStream_t stream) {
  Params p{};
  p.x = (const float*)d_in[0]; p.norm_w = (const float*)d_in[1]; p.w_in = (const float*)d_in[2]; p.q_norm_w = (const float*)d_in[3];
  p.k_norm_w = (const float*)d_in[4]; p.ck_pos = (const float*)d_in[5]; p.ck_w1 = (const float*)d_in[6]; p.ck_b1 = (const float*)d_in[7];
  p.ck_w2 = (const float*)d_in[8]; p.cv_pos = (const float*)d_in[9]; p.cv_w1 = (const float*)d_in[10]; p.cv_b1 = (const float*)d_in[11];
  p.cv_w2 = (const float*)d_in[12]; p.conv_w = (const float*)d_in[13]; p.conv_b = (const float*)d_in[14]; p.w_out = (const float*)d_in[15];
  p.out = (float*)d_out;
  p.ws = (char*)d_ws;
  const size_t off = WS_TOTAL;
  if (off > ws_size) { fprintf(stderr, "kernel_launch: workspace too small (%zu > %zu)\n", off, ws_size); return; }

#if FUSED
  static int grid_blocks = 0;
  if (!grid_blocks) {
    int dev = 0, cus = 0, per_cu = 0;
    hipGetDevice(&dev);
    hipDeviceGetAttribute(&cus, hipDeviceAttributeMultiprocessorCount, dev);
    hipFuncSetAttribute((const void*)hybrid_fwd, hipFuncAttributeMaxDynamicSharedMemorySize, SMEM_BYTES + 16);
    hipOccupancyMaxActiveBlocksPerMultiprocessor(&per_cu, (const void*)hybrid_fwd, NTHREADS, SMEM_BYTES + 16);
    if (per_cu < 1) per_cu = 1;
    grid_blocks = cus * per_cu;
  }
  void* args[] = {&p};
  hipError_t e = hipLaunchCooperativeKernel((const void*)hybrid_fwd, dim3(grid_blocks), dim3(NTHREADS), args, SMEM_BYTES + 16, stream);
  if (e != hipSuccess) fprintf(stderr, "cooperative launch failed: %s (grid %d)\n", hipGetErrorString(e), grid_blocks);
#else
  static int attr_set = 0;
  if (!attr_set) {
    (void)hipFuncSetAttribute((const void*)phase_kernel<0>, hipFuncAttributeMaxDynamicSharedMemorySize, SMEM_BYTES);
    (void)hipFuncSetAttribute((const void*)phase_kernel<1>, hipFuncAttributeMaxDynamicSharedMemorySize, SMEM_BYTES);
    (void)hipFuncSetAttribute((const void*)phase_kernel<2>, hipFuncAttributeMaxDynamicSharedMemorySize, SMEM_BYTES);
    (void)hipFuncSetAttribute((const void*)phase_kernel<3>, hipFuncAttributeMaxDynamicSharedMemorySize, SMEM_BYTES);
    (void)hipFuncSetAttribute((const void*)phase_kernel<4>, hipFuncAttributeMaxDynamicSharedMemorySize, SMEM_BYTES);
    attr_set = 1;
  }
  const int G = 256;
  phase_kernel<0><<<G, NTHREADS, SMEM_BYTES, stream>>>(p);
  phase_kernel<1><<<G, NTHREADS, SMEM_BYTES, stream>>>(p);
  phase_kernel<2><<<G, NTHREADS, SMEM_BYTES, stream>>>(p);
  phase_kernel<3><<<G, NTHREADS, SMEM_BYTES, stream>>>(p);
  phase_kernel<4><<<G, NTHREADS, SMEM_BYTES, stream>>>(p);
#endif
}
```

```cpp
#include <hip/hip_runtime.h>
#include <hip/hip_cooperative_groups.h>
#include <cstdio>
#include <cstdint>
namespace cg = cooperative_groups;

#ifndef FUSED
#define FUSED 1
#endif
#define REP0 1
#define REP1 1
#define REP2 1
#define REP3 1
#define REP4 1

#define DI __device__ __forceinline__
typedef unsigned short u16;
using bf16x8 = __attribute__((ext_vector_type(8))) short;
using s16x4 = __attribute__((ext_vector_type(4))) short;
using f32x4 = __attribute__((ext_vector_type(4))) float;
using f32x16 = __attribute__((ext_vector_type(16))) float;
using u32x4 = __attribute__((ext_vector_type(4))) unsigned;
using u32x2 = __attribute__((ext_vector_type(2))) unsigned;
typedef __bf16 bf2_t __attribute__((ext_vector_type(2)));
typedef float fl2_t __attribute__((ext_vector_type(2)));

constexpr int NTHREADS = 512;
constexpr int SEQ = 4096, DM = 1024, DIN = 3864, NROWS = 32768;
constexpr int LDK = 1088;
constexpr float EPS = 1e-6f;
constexpr float QSCALE = 0.125f * 1.4426950408889634f;
constexpr int SMEM_BYTES = 148480;

__constant__ float c_invf[8] = {1.0f, 0.1939227432012558f, 0.03760603070259094f, 0.007292664609849453f,
                                0.0014142135623842478f, 0.00027424818836152554f, 5.3182957344688475e-05f, 1.0313385246263351e-05f};

DI unsigned cvtpk(float lo, float hi) {
  fl2_t f = {lo, hi};
  bf2_t b = __builtin_convertvector(f, bf2_t);
  return __builtin_bit_cast(unsigned, b);
}
DI u16 f2bf(float x) { return (u16)(cvtpk(x, 0.f) & 0xffffu); }
DI float bf2f(u16 v) { return __uint_as_float(((unsigned)v) << 16); }
DI float bflo(unsigned v) { return __uint_as_float(v << 16); }
DI float bfhi(unsigned v) { return __uint_as_float(v & 0xffff0000u); }
DI float sigmoidf_(float v) { return __builtin_amdgcn_rcpf(1.0f + __builtin_amdgcn_exp2f(-1.4426950408889634f * v)); }
DI float siluf_(float v) { return v * __builtin_amdgcn_rcpf(1.0f + __builtin_amdgcn_exp2f(-1.4426950408889634f * v)); }
DI void glds16(const void* g, unsigned lds_base) {
  unsigned sv;
  asm volatile("s_mov_b32 %0, m0\n\ts_mov_b32 m0, %2\n\ts_nop 0\n\tglobal_load_lds_dwordx4 %1, off\n\ts_mov_b32 m0, %0" : "=&s"(sv) : "v"(g), "s"(lds_base) : "memory");
}
template <int CTRL> DI float qperm(float v) { return __int_as_float(__builtin_amdgcn_update_dpp(0, __float_as_int(v), CTRL, 0xF, 0xF, true)); }
#define MFMA16(a, b, c) __builtin_amdgcn_mfma_f32_16x16x32_bf16((a), (b), (c), 0, 0, 0)
#define MFMA32(a, b, c) __builtin_amdgcn_mfma_f32_32x32x16_bf16((a), (b), (c), 0, 0, 0)

struct Params {
  const float *x, *norm_w, *w_in, *q_norm_w, *k_norm_w, *ck_pos, *ck_w1, *ck_b1, *ck_w2, *cv_pos, *cv_w1, *cv_b1, *cv_w2, *conv_w, *conv_b, *w_out;
  float* out;
  char* ws;
};
constexpr size_t al256(size_t v) { return (v + 255) & ~(size_t)255; }
constexpr size_t OFF_xb = 0;
DI u16* ws_xb(const Params& p) { return (u16*)(p.ws + OFF_xb); }
constexpr size_t OFF_winT = OFF_xb + al256((size_t)NROWS * LDK * 2);
DI u16* ws_winT(const Params& p) { return (u16*)(p.ws + OFF_winT); }
constexpr size_t OFF_woutT = OFF_winT + al256((size_t)4096 * LDK * 2);
DI u16* ws_woutT(const Params& p) { return (u16*)(p.ws + OFF_woutT); }
constexpr size_t OFF_w1kT = OFF_woutT + al256((size_t)1024 * LDK * 2);
DI u16* ws_w1kT(const Params& p) { return (u16*)(p.ws + OFF_w1kT); }
constexpr size_t OFF_w1vT = OFF_w1kT + al256((size_t)128 * 2048 * 2);
DI u16* ws_w1vT(const Params& p) { return (u16*)(p.ws + OFF_w1vT); }
constexpr size_t OFF_w2kT = OFF_w1vT + al256((size_t)128 * 2048 * 2);
DI u16* ws_w2kT(const Params& p) { return (u16*)(p.ws + OFF_w2kT); }
constexpr size_t OFF_w2vT = OFF_w2kT + al256((size_t)64 * 128 * 2);
DI u16* ws_w2vT(const Params& p) { return (u16*)(p.ws + OFF_w2vT); }
constexpr size_t OFF_Q = OFF_w2vT + al256((size_t)64 * 128 * 2);
DI u16* ws_Q(const Params& p) { return (u16*)(p.ws + OFF_Q); }
constexpr size_t OFF_Ks = OFF_Q + al256((size_t)NROWS * 512 * 2);
DI u16* ws_Ks(const Params& p) { return (u16*)(p.ws + OFF_Ks); }
constexpr size_t OFF_Kw = OFF_Ks + al256((size_t)16 * 4096 * 64 * 2);
DI u16* ws_Kw(const Params& p) { return (u16*)(p.ws + OFF_Kw); }
constexpr size_t OFF_Vst = OFF_Kw + al256((size_t)16 * 4096 * 64 * 2);
DI u16* ws_Vst(const Params& p) { return (u16*)(p.ws + OFF_Vst); }
constexpr size_t OFF_Vwt = OFF_Vst + al256((size_t)16 * 4096 * 64 * 2);
DI u16* ws_Vwt(const Params& p) { return (u16*)(p.ws + OFF_Vwt); }
constexpr size_t OFF_kcraw = OFF_Vwt + al256((size_t)16 * 4096 * 64 * 2);
DI u16* ws_kcraw(const Params& p) { return (u16*)(p.ws + OFF_kcraw); }
constexpr size_t OFF_vcraw = OFF_kcraw + al256((size_t)16 * 4096 * 64 * 2 + 4096);
DI u16* ws_vcraw(const Params& p) { return (u16*)(p.ws + OFF_vcraw); }
constexpr size_t OFF_Kc = OFF_vcraw + al256((size_t)16 * 4096 * 64 * 2 + 4096);
DI u16* ws_Kc(const Params& p) { return (u16*)(p.ws + OFF_Kc); }
constexpr size_t OFF_Vct = OFF_Kc + al256((size_t)16 * 256 * 64 * 2);
DI u16* ws_Vct(const Params& p) { return (u16*)(p.ws + OFF_Vct); }
constexpr size_t OFF_zs = OFF_Vct + al256((size_t)16 * 256 * 64 * 2);
DI u16* ws_zs(const Params& p) { return (u16*)(p.ws + OFF_zs); }
constexpr size_t OFF_cvb = OFF_zs + al256((size_t)NROWS * 512 * 2);
DI u16* ws_cvb(const Params& p) { return (u16*)(p.ws + OFF_cvb); }
constexpr size_t OFF_mix = OFF_cvb + al256((size_t)NROWS * 2048 * 2);
DI u16* ws_mix(const Params& p) { return (u16*)(p.ws + OFF_mix); }
constexpr size_t OFF_rs = OFF_mix + al256((size_t)NROWS * LDK * 2);
DI float* ws_rs(const Params& p) { return (float*)(p.ws + OFF_rs); }
constexpr size_t OFF_ckpart = OFF_rs + al256((size_t)NROWS * 4);
DI float* ws_ckpart(const Params& p) { return (float*)(p.ws + OFF_ckpart); }
constexpr size_t OFF_rope = OFF_ckpart + al256((size_t)16 * 128 * 4);
DI float* ws_rope(const Params& p) { return (float*)(p.ws + OFF_rope); }
constexpr size_t OFF_gates = OFF_rope + al256((size_t)4096 * 8 * 2 * 4);
DI float* ws_gates(const Params& p) { return (float*)(p.ws + OFF_gates); }
constexpr size_t OFF_counter = OFF_gates + al256((size_t)NROWS * 24 * 4);
DI unsigned* ws_counter(const Params& p) { return (unsigned*)(p.ws + OFF_counter); }
constexpr size_t OFF_bar = OFF_counter + al256((size_t)256);
DI unsigned* ws_bar(const Params& p) { return (unsigned*)(p.ws + OFF_bar); }
constexpr size_t WS_TOTAL = OFF_bar + al256((size_t)3456 * 4);


DI void transpose_tile(const float* __restrict__ src, u16* __restrict__ dst, int K, int N, const float* __restrict__ scale, int kt, int nt, char* smem, int ldd) {
  float* tile = (float*)smem;
  const int tid = threadIdx.x;
#pragma unroll
  for (int i = 0; i < 8; ++i) {
    const int kk = i * 8 + (tid >> 6), nn = tid & 63, n = nt * 64 + nn, k = kt * 64 + kk;
    float v = (n < N) ? src[(size_t)k * N + n] : 0.f;
    if (scale) v *= scale[k];
    tile[kk * 65 + nn] = v;
  }
  __syncthreads();
#pragma unroll
  for (int i = 0; i < 8; ++i) {
    const int nn = i * 8 + (tid >> 6), kk = tid & 63;
    dst[(size_t)(nt * 64 + nn) * ldd + kt * 64 + kk] = f2bf(tile[kk * 65 + nn]);
  }
  __syncthreads();
}

__device__ void phase_prep(const Params& p, char* smem, int bid, int nb) {
  int tid_ = threadIdx.x; asm volatile("" : "+v"(tid_));
  const int tid = tid_, lane = tid & 63, wid = __builtin_amdgcn_readfirstlane(tid >> 6);
  constexpr int J_X = 1024, J_TW = 1024, J_TO = 256, J_T1 = 64, J_T2 = 2, J_CK = 16, J_ROPE = 64;
  constexpr int TOTAL = J_X + J_TW + J_TO + 2 * J_T1 + 2 * J_T2 + J_CK + J_ROPE;
  if (bid == 0 && tid < 8) ws_counter(p)[tid] = 0u;
  for (int j = bid; j < TOTAL; j += nb) {
    constexpr int HEAD = J_CK + J_ROPE;
    int jj = j < HEAD ? (TOTAL - HEAD) + j : j - HEAD;
    if (jj < J_X) {
      const int row0 = jj * 32 + wid * 4;
      float4 v[4][4]; float ss[4];
#pragma unroll
      for (int r = 0; r < 4; ++r) {
        const float4* xr = (const float4*)(p.x + (size_t)(row0 + r) * DM);
#pragma unroll
        for (int i = 0; i < 4; ++i) v[r][i] = xr[i * 64 + lane];
      }
#pragma unroll
      for (int r = 0; r < 4; ++r) {
        float a = 0.f;
#pragma unroll
        for (int i = 0; i < 4; ++i) a += v[r][i].x * v[r][i].x + v[r][i].y * v[r][i].y + v[r][i].z * v[r][i].z + v[r][i].w * v[r][i].w;
#pragma unroll
        for (int o = 32; o >= 1; o >>= 1) a += __shfl_xor(a, o);
        ss[r] = a;
      }
#pragma unroll
      for (int r = 0; r < 4; ++r) {
        if (lane == 0) ws_rs(p)[row0 + r] = rsqrtf(ss[r] * (1.0f / DM) + EPS);
#pragma unroll
        for (int i = 0; i < 4; ++i) {
          u32x2 o; o[0] = cvtpk(v[r][i].x, v[r][i].y); o[1] = cvtpk(v[r][i].z, v[r][i].w);
          const int rr_ = row0 + r;
          *(u32x2*)(ws_xb(p) + ((size_t)((rr_ >> 8) * 16 + i * 4 + (lane >> 4)) * 256 + (rr_ & 255)) * 64 + (lane & 15) * 4) = o;
        }
      }
      continue;
    }
    jj -= J_X;
    if (jj < J_TW) { transpose_tile(p.w_in, ws_winT(p), 1024, DIN, p.norm_w, jj & 15, jj >> 4, smem, LDK); continue; }
    jj -= J_TW;
    if (jj < J_TO) { transpose_tile(p.w_out, ws_woutT(p), 1024, 1024, nullptr, jj & 15, jj >> 4, smem, LDK); continue; }
    jj -= J_TO;
    if (jj < J_T1) { transpose_tile(p.ck_w1, ws_w1kT(p), 2048, 128, nullptr, jj & 31, jj >> 5, smem, 2048); continue; }
    jj -= J_T1;
    if (jj < J_T1) { transpose_tile(p.cv_w1, ws_w1vT(p), 2048, 128, nullptr, jj & 31, jj >> 5, smem, 2048); continue; }
    jj -= J_T1;
    if (jj < J_T2) { transpose_tile(p.ck_w2, ws_w2kT(p), 128, 64, nullptr, jj, 0, smem, 128); continue; }
    jj -= J_T2;
    if (jj < J_T2) { transpose_tile(p.cv_w2, ws_w2vT(p), 128, 64, nullptr, jj, 0, smem, 128); continue; }
    jj -= J_T2;
    if (jj < J_CK) {
      const int which = jj >> 3, chunk = jj & 7, hh = tid & 127, sub = tid >> 7;
      const float* pos = which ? p.cv_pos : p.ck_pos;
      const float* w1 = which ? p.cv_w1 : p.ck_w1;
      float acc = 0.f;
      const int f0 = chunk * 256 + sub * 64;
      float pv_[64], wv_[64];
#pragma unroll
      for (int f = 0; f < 64; ++f) { pv_[f] = pos[f0 + f]; wv_[f] = w1[(size_t)(f0 + f) * 128 + hh]; }
#pragma unroll
      for (int f = 0; f < 64; ++f) acc += pv_[f] * wv_[f];
      float* red = (float*)smem;
      red[sub * 128 + hh] = acc;
      __syncthreads();
      if (tid < 128) ws_ckpart(p)[(which * 8 + chunk) * 128 + tid] = red[tid] + red[128 + tid] + red[256 + tid] + red[384 + tid];
      __syncthreads();
      continue;
    }
    jj -= J_CK;
    {
      const int idx = jj * 512 + tid, pos = idx >> 3, fi = idx & 7;
      const float ang = (float)pos * c_invf[fi];
      float s, c; sincosf(ang, &s, &c);
      ws_rope(p)[idx * 2] = c; ws_rope(p)[idx * 2 + 1] = s;
    }
  }
}

DI int kimg_off(int row, int d) { return row * 64 + (((d >> 3) ^ ((row >> 1) & 7)) * 8) + (d & 7); }
DI int vimg_off(int d, int key) {
  const int kp = (key & ~12) | ((key & 4) << 1) | ((key & 8) >> 1);
  return d * 64 + (((kp >> 3) ^ ((d >> 1) & 7)) * 8) + (kp & 7);
}

constexpr int G_ASZ = 256 * 128, G_BSZ = 256 * 128, G_STAGE = G_ASZ + G_BSZ;
constexpr int G_ROPE = 2 * G_STAGE, G_RS = G_ROPE + 256 * 64;
static_assert(G_RS + 1024 <= SMEM_BYTES, "GEMM LDS layout exceeds the dynamic LDS size");
#define WAIT_VM(n) asm volatile("s_waitcnt vmcnt(" #n ")" ::: "memory")

template <int EPI>
__device__ void gemm_phase(const Params& p, char* smem, int bid, int nb) {
  constexpr int NT = EPI == 0 ? 16 : 4;
  constexpr int MT = 128;
  const u16* __restrict__ A = EPI == 0 ? ws_xb(p) : ws_mix(p);
  const u16* __restrict__ Bt = EPI == 0 ? ws_winT(p) : ws_woutT(p);
  int tid_ = threadIdx.x; asm volatile("" : "+v"(tid_));
  const int tid = tid_, lane = tid & 63, wid = __builtin_amdgcn_readfirstlane(tid >> 6), fr = lane & 15, fq = lane >> 4;
  const int wr = wid >> 2, wc = wid & 3;
  const bool xmap = (nb == 256);
  const int xcd = bid & 7, li = bid >> 3;
  const int ntiles = xmap ? (EPI == 0 ? 8 : 2) : (MT * NT - bid + nb - 1) / nb;
  auto tile_of = [&](int ti, int& m0, int& n0) {
    if (xmap) {
      const int sg = ti * 8 + xcd;
      if (EPI == 0) { m0 = ((sg >> 1) * 4 + (li >> 3)) * 256; n0 = ((sg & 1) * 8 + (li & 7)) * 256; }
      else { m0 = (sg * 8 + (li >> 2)) * 256; n0 = (li & 3) * 256; }
    } else { const int tile = bid + ti * nb; const int mt = tile / NT; m0 = mt * 256; n0 = (tile - mt * NT) * 256; }
  };
  const int nsteps = ntiles * 16;
  const unsigned lds0 = (unsigned)(uintptr_t)smem;
  const int gsw = (lane & 7) ^ ((wid & 1) * 4 + (lane >> 4));
  const int grow = wid * 8 + (lane >> 3);
  auto issue = [&](int step, int stage) {
    int m0, n0; tile_of(step >> 4, m0, n0);
    const int kt = step & 15;
    const u16* ag = EPI == 0 ? A + ((size_t)((m0 >> 8) * 16 + kt) * 256 + grow) * 64 + gsw * 8 : A + (size_t)(m0 + grow) * LDK + kt * 64 + gsw * 8;
    const size_t astep = EPI == 0 ? (size_t)64 * 64 : (size_t)64 * LDK;
    const int brow = EPI == 0 ? ((grow & ~31) | ((grow & 0x0C) << 1) | ((grow & 0x10) >> 2) | (grow & 3)) : grow;
    const u16* bg_ = Bt + (size_t)(n0 + brow) * LDK + kt * 64 + gsw * 8;
    const unsigned dst = (unsigned)__builtin_amdgcn_readfirstlane((int)(lds0 + stage * G_STAGE + wid * 1024));
#pragma unroll
    for (int i = 0; i < 4; ++i) glds16(ag + i * astep, dst + i * 8192);
#pragma unroll
    for (int i = 0; i < 4; ++i) glds16(bg_ + (size_t)i * 64 * LDK, dst + G_ASZ + i * 8192);
    if (EPI == 0 && kt == 8) {
      const int t0 = m0 & 4095;
      const unsigned sd = (unsigned)__builtin_amdgcn_readfirstlane((int)(lds0 + G_ROPE + wid * 1024));
      glds16(ws_rope(p) + (size_t)t0 * 16 + tid * 4, sd);
      glds16(ws_rope(p) + (size_t)t0 * 16 + (512 + tid) * 4, sd + 8192);
      if (wid == 0) glds16(ws_rs(p) + m0 + lane * 4, lds0 + G_RS);
    }
  };
  const int ca0 = ((fq ^ (fr >> 1)) * 16), ca1 = (((4 + fq) ^ (fr >> 1)) * 16);
  f32x4 acc[8][4];
#pragma unroll
  for (int m = 0; m < 8; ++m)
#pragma unroll
    for (int n = 0; n < 4; ++n) acc[m][n] = f32x4{0.f, 0.f, 0.f, 0.f};
  __syncthreads();
  if (nsteps > 0) issue(0, 0);
  for (int s = 0; s < nsteps; ++s) {
    WAIT_VM(0);
    __builtin_amdgcn_s_waitcnt(0x0F70);
    __builtin_amdgcn_s_barrier();
    if (s + 1 < nsteps) issue(s + 1, (s + 1) & 1);
    {
      const char* ab = smem + (s & 1) * G_STAGE + (wr * 128 + fr) * 128;
      const char* bb = smem + (s & 1) * G_STAGE + G_ASZ + (wc * 64 + fr) * 128;
#pragma unroll
      for (int ks = 0; ks < 2; ++ks) {
        bf16x8 af[8], bf[4];
        const int co = ks ? ca1 : ca0;
#pragma unroll
        for (int n = 0; n < 4; ++n) bf[n] = *(const bf16x8*)(bb + n * 16 * 128 + co);
#pragma unroll
        for (int m = 0; m < 8; ++m) af[m] = *(const bf16x8*)(ab + m * 16 * 128 + co);
#pragma unroll
        for (int m = 0; m < 8; ++m)
#pragma unroll
          for (int n = 0; n < 4; ++n) acc[m][n] = MFMA16(bf[n], af[m], acc[m][n]);
      }
    }
    if ((s & 15) != 15) continue;
    int m0, n0; tile_of(s >> 4, m0, n0);
    const int rbase = m0 + wr * 128;
    const int cb = n0 + wc * 64;
    if constexpr (EPI == 1) {
#pragma unroll
      for (int hm = 0; hm < 2; ++hm) {
        float4 xv[4][4];
#pragma unroll
        for (int mm = 0; mm < 4; ++mm) {
          const size_t ro = (size_t)(rbase + (hm * 4 + mm) * 16 + fr) * DM + cb + fq * 4;
#pragma unroll
          for (int n = 0; n < 4; ++n) xv[mm][n] = *(const float4*)(p.x + ro + n * 16);
        }
#pragma unroll
        for (int mm = 0; mm < 4; ++mm) {
          const int m = hm * 4 + mm;
          const size_t ro = (size_t)(rbase + m * 16 + fr) * DM + cb + fq * 4;
#pragma unroll
          for (int n = 0; n < 4; ++n) {
            float4 o; o.x = xv[mm][n].x + acc[m][n][0]; o.y = xv[mm][n].y + acc[m][n][1]; o.z = xv[mm][n].z + acc[m][n][2]; o.w = xv[mm][n].w + acc[m][n][3];
            *(float4*)(p.out + ro + n * 16) = o;
          }
        }
        __builtin_amdgcn_sched_barrier(0);
      }
    } else {
      const int b = m0 >> 12;
      const int tb = rbase & 4095;
      if (cb < 1280) {
        const int seg = cb >> 6;
        const int which = seg < 8 ? -1 : ((seg - 8) >> 1);
        const int g = seg < 8 ? (seg >> 2) : ((seg - 8) & 1);
        const bool need_norm = (seg < 8) || which == 2 || which == 4;
        const float* nw = seg < 8 ? p.q_norm_w : (p.k_norm_w + (which == 2 ? 64 : 128));
        float w[16];
#pragma unroll
        for (int k = 0; k < 16; ++k) w[k] = need_norm ? nw[(k >> 3) * 32 + fq * 8 + (k & 7)] : 1.0f;
        const float qs = seg < 8 ? QSCALE : 1.0f;
#pragma unroll
        for (int m = 0; m < 8; ++m) {
          const int t = tb + m * 16 + fr;
          const int lrow = wr * 128 + m * 16 + fr;
          const float r = *(const float*)(smem + G_RS + lrow * 4);
          float v[16];
#pragma unroll
          for (int k = 0; k < 16; ++k) v[k] = acc[m][(k >> 3) * 2 + ((k & 7) >> 2)][k & 3] * r;
          if (need_norm) {
            float ss = 0.f;
#pragma unroll
            for (int k = 0; k < 16; ++k) ss += v[k] * v[k];
            ss += __shfl_xor(ss, 16); ss += __shfl_xor(ss, 32);
            const float rr = rsqrtf(ss * (1.0f / 64.f) + EPS);
#pragma unroll
            for (int k = 0; k < 16; ++k) v[k] = v[k] * rr * w[k];
            const float4* rp = (const float4*)(smem + G_ROPE + lrow * 64);
            const float4 c01 = rp[0], c23 = rp[1], c45 = rp[2], c67 = rp[3];
            const float cc[8] = {c01.x, c01.z, c23.x, c23.z, c45.x, c45.z, c67.x, c67.z};
            const float sn[8] = {c01.y, c01.w, c23.y, c23.w, c45.y, c45.w, c67.y, c67.w};
#pragma unroll
            for (int e = 0; e < 8; ++e) {
              const float pr = __shfl_xor(v[e], 16);
              const float rot = (fq == 0) ? (v[e] * cc[e] - pr * sn[e]) : (v[e] * cc[e] + pr * sn[e]);
              v[e] = (fq < 2) ? rot : v[e];
            }
#pragma unroll
            for (int k = 0; k < 16; ++k) v[k] *= qs;
          }
          if (which == 3 || which == 5) {
            int lz = 0; asm volatile("" : "+v"(lz));
            u16* vt = (which == 3 ? ws_Vst(p) : ws_Vwt(p)) + (size_t)((b * 2 + g) * 64 + (t >> 6)) * 4096 + lz;
            const int fqx = fq + lz, key = (t & 63) + lz;
#pragma unroll
            for (int k = 0; k < 16; ++k) vt[vimg_off((k >> 3) * 32 + fqx * 8 + (k & 7), key)] = f2bf(v[k]);
          } else {
            u16* dst;
            if (seg < 8) dst = ws_Q(p) + ((size_t)((b * 2 + g) * 4096 + t) * 4 + (seg & 3)) * 64;
            else { u16* buf = which == 0 ? ws_kcraw(p) : which == 1 ? ws_vcraw(p) : which == 2 ? ws_Ks(p) : ws_Kw(p); dst = buf + ((size_t)(b * 2 + g) * 4096 + t) * 64; }
            const bool img = which >= 2;
#pragma unroll
            for (int n2 = 0; n2 < 2; ++n2) {
              u32x4 o;
#pragma unroll
              for (int e = 0; e < 4; ++e) o[e] = cvtpk(v[n2 * 8 + 2 * e], v[n2 * 8 + 2 * e + 1]);
              const int d0 = n2 * 32 + fq * 8;
              const int off = img ? (((d0 >> 3) ^ (((t & 63) >> 1) & 7)) * 8) : d0;
              *(u32x4*)(dst + off) = o;
            }
          }
          __builtin_amdgcn_sched_barrier(0);
        }
      } else {
#pragma unroll
        for (int m = 0; m < 8; ++m) {
          const size_t row = rbase + m * 16 + fr;
          const float r = *(const float*)(smem + G_RS + (wr * 128 + m * 16 + fr) * 4);
#pragma unroll
          for (int n2 = 0; n2 < 2; ++n2) {
            const int c8 = cb + n2 * 32 + fq * 8;
            if (c8 >= DIN) continue;
            float v[8];
#pragma unroll
            for (int e = 0; e < 8; ++e) v[e] = acc[m][n2 * 2 + (e >> 2)][e & 3] * r;
            if (c8 < 1304) {
              float4 o0, o1;
              o0.x = sigmoidf_(v[0]); o0.y = sigmoidf_(v[1]); o0.z = sigmoidf_(v[2]); o0.w = sigmoidf_(v[3]);
              o1.x = sigmoidf_(v[4]); o1.y = sigmoidf_(v[5]); o1.z = sigmoidf_(v[6]); o1.w = sigmoidf_(v[7]);
              float* gp = ws_gates(p) + row * 24 + (c8 - 1280);
              *(float4*)gp = o0; *(float4*)(gp + 4) = o1;
            } else if (c8 < 1816) {
              u32x4 o;
#pragma unroll
              for (int e = 0; e < 4; ++e) o[e] = cvtpk(siluf_(v[2 * e]), siluf_(v[2 * e + 1]));
              *(u32x4*)(ws_zs(p) + row * 512 + (c8 - 1304)) = o;
            } else {
              u32x4 o;
#pragma unroll
              for (int e = 0; e < 4; ++e) o[e] = cvtpk(v[2 * e], v[2 * e + 1]);
              *(u32x4*)(ws_cvb(p) + row * 2048 + (c8 - 1816)) = o;
            }
          }
          __builtin_amdgcn_sched_barrier(0);
        }
      }
    }
#pragma unroll
    for (int m = 0; m < 8; ++m)
#pragma unroll
      for (int n = 0; n < 4; ++n) acc[m][n] = f32x4{0.f, 0.f, 0.f, 0.f};
  }
}

__device__ void phase_cmp_conv(const Params& p, char* smem, int bid, int nb) {
  int tid_ = threadIdx.x; asm volatile("" : "+v"(tid_));
  const int tid = tid_, lane = tid & 63, wid = __builtin_amdgcn_readfirstlane(tid >> 6), fr = lane & 15, fq = lane >> 4;
  float* part = (float*)smem;
  char* hl = smem + 8 * 16 * 132 * 4;
  float* outl = (float*)(hl + 2 * 4352);
  for (int job = bid; job < 256; job += nb) {
    const int which = wid >> 2, w4 = wid & 3, bg = job >> 4, ct = job & 15;
    const u16* raw = (which ? ws_vcraw(p) : ws_kcraw(p)) + (size_t)bg * 4096 * 64;
    const u16* w1T = which ? ws_w1vT(p) : ws_w1kT(p);
    const u16* w2T = which ? ws_w2vT(p) : ws_w2kT(p);
    const float* b1 = which ? p.cv_b1 : p.ck_b1;
    f32x4 acc[8];
#pragma unroll
    for (int n = 0; n < 8; ++n) acc[n] = f32x4{0.f, 0.f, 0.f, 0.f};
    const int c = ct * 16 + fr;
    const int ht = tid & 255, rrow = ht >> 4, c8 = (ht & 15) * 8;
    float bias[8];
#pragma unroll
    for (int e = 0; e < 8; ++e) {
      float bsum = b1[c8 + e];
#pragma unroll
      for (int ch = 0; ch < 8; ++ch) bsum += ws_ckpart(p)[(which * 8 + ch) * 128 + c8 + e];
      bias[e] = bsum;
    }
    bf16x8 w2f[4];
#pragma unroll
    for (int ks = 0; ks < 4; ++ks) w2f[ks] = *(const bf16x8*)(w2T + (size_t)(w4 * 16 + fr) * 128 + ks * 32 + fq * 8);
    const int orow = ht >> 4, d4 = (ht & 15) * 4;
    const int cc = ct * 16 + orow;
    float nwv[4], nwp[4]; float2 csv[4];
    {
      int pos = cc * 16 + 31; pos = pos > 4095 ? 4095 : pos;
#pragma unroll
      for (int e = 0; e < 4; ++e) {
        const int d = d4 + e;
        nwv[e] = p.k_norm_w[d]; nwp[e] = p.k_norm_w[d ^ 8];
        csv[e] = *(const float2*)(ws_rope(p) + ((size_t)pos * 8 + (d & 7)) * 2);
      }
    }
#pragma unroll 4
    for (int k16 = 0; k16 < 16; ++k16) {
      const int ks = w4 * 16 + k16;
      const int l = ks >> 1, d0 = (ks & 1) * 32 + fq * 8;
      int tt = c * 16 + l; tt = tt > 4095 ? 4095 : tt;
      const bf16x8 a = *(const bf16x8*)(raw + (size_t)tt * 64 + d0);
#pragma unroll
      for (int n = 0; n < 8; ++n) {
        const bf16x8 bb = *(const bf16x8*)(w1T + (size_t)(n * 16 + fr) * 2048 + ks * 32 + fq * 8);
        acc[n] = MFMA16(a, bb, acc[n]);
      }
    }
#pragma unroll
    for (int n = 0; n < 8; ++n)
#pragma unroll
      for (int j = 0; j < 4; ++j) part[(wid * 16 + fq * 4 + j) * 132 + n * 16 + fr] = acc[n][j];
    __syncthreads();
    {
      float sum[8];
#pragma unroll
      for (int e = 0; e < 8; ++e) sum[e] = bias[e];
#pragma unroll
      for (int w = 0; w < 4; ++w) {
        const float4 v0 = *(const float4*)(part + ((which * 4 + w) * 16 + rrow) * 132 + c8), v1 = *(const float4*)(part + ((which * 4 + w) * 16 + rrow) * 132 + c8 + 4);
        sum[0] += v0.x; sum[1] += v0.y; sum[2] += v0.z; sum[3] += v0.w; sum[4] += v1.x; sum[5] += v1.y; sum[6] += v1.z; sum[7] += v1.w;
      }
      u32x4 o;
#pragma unroll
      for (int e = 0; e < 4; ++e) o[e] = cvtpk(siluf_(sum[2 * e]), siluf_(sum[2 * e + 1]));
      *(u32x4*)(hl + which * 4352 + rrow * 272 + c8 * 2) = o;
    }
    __syncthreads();
    {
      f32x4 o2 = f32x4{0.f, 0.f, 0.f, 0.f};
#pragma unroll
      for (int ks = 0; ks < 4; ++ks) {
        const bf16x8 a = *(const bf16x8*)(hl + which * 4352 + fr * 272 + (ks * 32 + fq * 8) * 2);
        o2 = MFMA16(a, w2f[ks], o2);
      }
#pragma unroll
      for (int j = 0; j < 4; ++j) outl[which * 1088 + (fq * 4 + j) * 68 + w4 * 16 + fr] = o2[j];
    }
    __syncthreads();
    {
      const float* ol = outl + which * 1088;
      const float4 v = *(const float4*)(ol + orow * 68 + d4);
      if (which == 0) {
        float ss = v.x * v.x + v.y * v.y + v.z * v.z + v.w * v.w;
        ss += __shfl_xor(ss, 1); ss += __shfl_xor(ss, 2); ss += __shfl_xor(ss, 4); ss += __shfl_xor(ss, 8);
        const float rr = rsqrtf(ss * (1.0f / 64.f) + EPS);
        float o[4] = {v.x * rr * nwv[0], v.y * rr * nwv[1], v.z * rr * nwv[2], v.w * rr * nwv[3]};
        if (d4 < 16) {
#pragma unroll
          for (int e = 0; e < 4; ++e) {
            const int d = d4 + e, dp = d ^ 8;
            const float pr = ol[orow * 68 + dp] * rr * nwp[e];
            o[e] = (d < 8) ? (o[e] * csv[e].x - pr * csv[e].y) : (o[e] * csv[e].x + pr * csv[e].y);
          }
        }
        u32x2 ov; ov[0] = cvtpk(o[0], o[1]); ov[1] = cvtpk(o[2], o[3]);
        if (cc >= 255) { ov[0] = 0u; ov[1] = 0u; }
        *(u32x2*)(ws_Kc(p) + (size_t)(bg * 4 + (cc >> 6)) * 4096 + kimg_off(cc & 63, d4)) = ov;
      } else {
        const float z = (cc >= 255) ? 0.f : 1.f;
        u16* vt = ws_Vct(p) + (size_t)(bg * 4 + (cc >> 6)) * 4096;
        vt[vimg_off(d4 + 0, cc & 63)] = f2bf(v.x * z); vt[vimg_off(d4 + 1, cc & 63)] = f2bf(v.y * z);
        vt[vimg_off(d4 + 2, cc & 63)] = f2bf(v.z * z); vt[vimg_off(d4 + 3, cc & 63)] = f2bf(v.w * z);
      }
    }
    __syncthreads();
  }
  const int gw = bid * 8 + wid, nw = nb * 8;
  for (int chunk = gw; chunk < 2048; chunk += nw) {
    const int r0 = chunk * 16, t0 = r0 & 4095;
    const int ch = lane * 8;
    float cw0[8], cw1[8], cw2[8], cbv[8], u1[8], u2[8];
#pragma unroll
    for (int e = 0; e < 8; ++e) { cw0[e] = p.conv_w[ch + e]; cw1[e] = p.conv_w[512 + ch + e]; cw2[e] = p.conv_w[1024 + ch + e]; cbv[e] = p.conv_b[ch + e]; u1[e] = 0.f; u2[e] = 0.f; }
    if (t0 > 0) {
#pragma unroll
      for (int q = 0; q < 2; ++q) {
        const u16* rp = ws_cvb(p) + (size_t)(r0 - 2 + q) * 2048 + ch;
        const u32x4 hv = *(const u32x4*)(rp), cv = *(const u32x4*)(rp + 1024);
#pragma unroll
        for (int e = 0; e < 4; ++e) {
          const float ua = bflo(hv[e]) * bflo(cv[e]), ub = bfhi(hv[e]) * bfhi(cv[e]);
          if (q == 0) { u2[2 * e] = ua; u2[2 * e + 1] = ub; } else { u1[2 * e] = ua; u1[2 * e + 1] = ub; }
        }
      }
    }
#pragma unroll 4
    for (int rr = 0; rr < 16; ++rr) {
      const u16* rp = ws_cvb(p) + (size_t)(r0 + rr) * 2048 + ch;
      const u32x4 hv = *(const u32x4*)(rp), bv = *(const u32x4*)(rp + 512), cv = *(const u32x4*)(rp + 1024), zv = *(const u32x4*)(rp + 1536);
      u32x4 ov;
#pragma unroll
      for (int e = 0; e < 4; ++e) {
        const float ua = bflo(hv[e]) * bflo(cv[e]), ub = bfhi(hv[e]) * bfhi(cv[e]);
        const float ca = cw0[2 * e] * u2[2 * e] + cw1[2 * e] * u1[2 * e] + cw2[2 * e] * ua + cbv[2 * e];
        const float cbb = cw0[2 * e + 1] * u2[2 * e + 1] + cw1[2 * e + 1] * u1[2 * e + 1] + cw2[2 * e + 1] * ub + cbv[2 * e + 1];
        const float oa = bflo(bv[e]) * ca * siluf_(bflo(zv[e]));
        const float ob = bfhi(bv[e]) * cbb * siluf_(bfhi(zv[e]));
        ov[e] = cvtpk(oa, ob);
        u2[2 * e] = u1[2 * e]; u2[2 * e + 1] = u1[2 * e + 1]; u1[2 * e] = ua; u1[2 * e + 1] = ub;
      }
      *(u32x4*)(ws_mix(p) + (size_t)(r0 + rr) * LDK + 512 + ch) = ov;
    }
  }
}

constexpr int AT_NST = 5, AT_KB = 8192, AT_BUF = 16384;
constexpr int AT_F = AT_NST * AT_BUF, AT_IMPA = AT_F, AT_IMPB = AT_IMPA + 64 * 65 * 4, AT_VAL = AT_IMPA;
constexpr int AT_SELM = AT_F + 8 * 8192, AT_UNIT = AT_SELM + 512, AT_END = AT_UNIT + 16;
static_assert(AT_END <= SMEM_BYTES, "attention LDS layout exceeds the dynamic LDS size");

__device__ void phase_attn(const Params& p, char* smem, int bid, int nb, int rep) {
  int tid_ = threadIdx.x; asm volatile("" : "+v"(tid_));
  const int tid = tid_, lane = tid & 63, wid = __builtin_amdgcn_readfirstlane(tid >> 6), c32 = lane & 31, h = lane >> 5;
  const float NINF = -__builtin_inff();
  float* impa = (float*)(smem + AT_IMPA);
  float* impb = (float*)(smem + AT_IMPB);
  float* vals = (float*)(smem + AT_VAL);
  unsigned* selm = (unsigned*)(smem + AT_SELM);
  volatile int* s_unit = (volatile int*)(smem + AT_UNIT);
  const unsigned lds0 = (unsigned)(uintptr_t)smem;
  while (true) {
    if (tid == 0) *s_unit = (int)atomicAdd(ws_counter(p) + rep, 1u);
    __syncthreads();
    const int u = __builtin_amdgcn_readfirstlane(*s_unit);
    __syncthreads();
    if (u >= 1024) break;
    const int i = 63 - (u >> 4), bg = u & 15, b = bg >> 1, g = bg & 1;
    const int tl = wid * 8 + (c32 >> 2), hd = c32 & 3;
    const int t = i * 64 + tl;
    const u16* qrow = ws_Q(p) + ((size_t)(bg * 4096 + i * 64) * 4 + wid * 32 + c32) * 64;
    bf16x8 qf[4];
#pragma unroll
    for (int ks = 0; ks < 4; ++ks) qf[ks] = *(const bf16x8*)(qrow + ks * 16 + h * 8);
    const float* gp = ws_gates(p) + (size_t)(b * 4096 + t) * 24 + (g * 4 + hd) * 3;
    const float g0 = gp[0], g1 = gp[1], g2 = gp[2];
    asm volatile("" :: "v"(qf[0]), "v"(qf[1]), "v"(qf[2]), "v"(qf[3]), "v"(g0), "v"(g1), "v"(g2));
    const int ntc = (4 * i + 2) / 64 + 1, nsl = i + 1, nwin = (i < 8 ? i : 8) + 1;
    const int NT = 2 * ntc + nsl + nwin;
    const bool need_sel = i >= 16;

    f32x16 O0, O1;
#pragma unroll
    for (int r = 0; r < 16; ++r) { O0[r] = 0.f; O1[r] = 0.f; }
    float* fl = (float*)(smem + AT_F + wid * 8192) + lane;
    float m_run = NINF, l_run = 0.f, inv_l = 0.f;
    u32x4 kxw; kxw[0] = (h == 0) ? 0x3F80u : 0u; kxw[1] = 0u; kxw[2] = 0u; kxw[3] = 0u;
    const bf16x8 kx = __builtin_bit_cast(bf16x8, kxw);
    float oscale = 1.0f;
    unsigned sel_lo = 0xffffffffu, sel_hi = 0xffffffffu;
#define TILE_PTRS(n, kp, vp) do { \
      if ((n) < 2 * ntc) { const int tt_ = (n) < ntc ? (n) : (n) - ntc; kp = ws_Kc(p) + (size_t)(bg * 4 + tt_) * 4096; vp = ws_Vct(p) + (size_t)(bg * 4 + tt_) * 4096; } \
      else if ((n) < 2 * ntc + nsl) { const int j_ = (n) - 2 * ntc; kp = ws_Ks(p) + ((size_t)bg * 4096 + j_ * 64) * 64; vp = ws_Vst(p) + (size_t)(bg * 64 + j_) * 4096; } \
      else { const int j_ = i - nwin + 1 + ((n) - 2 * ntc - nsl); kp = ws_Kw(p) + ((size_t)bg * 4096 + j_ * 64) * 64; vp = ws_Vwt(p) + (size_t)(bg * 64 + j_) * 4096; } } while (0)
#define TISSUE(n, st_) do { const u16 *kp_, *vp_; TILE_PTRS(n, kp_, vp_); \
      const unsigned d_ = (unsigned)__builtin_amdgcn_readfirstlane((int)(lds0 + (st_) * AT_BUF + wid * 1024)); \
      glds16(kp_ + tid * 8, d_); glds16(vp_ + tid * 8, d_ + AT_KB); } while (0)
    {
      const int npre = NT < AT_NST - 1 ? NT : AT_NST - 1;
      for (int n = 0; n < npre; ++n) TISSUE(n, n);
    }
    int st_cur = 0, st_iss = AT_NST - 1;
    const int ksw = (c32 >> 1) & 7;
    for (int n = 0; n < NT; ++n) {
      {
        const int rem = NT - 1 - n;
        if (rem >= 3) WAIT_VM(6); else if (rem == 2) WAIT_VM(4); else if (rem == 1) WAIT_VM(2); else WAIT_VM(0);
        __builtin_amdgcn_s_barrier();
        if (n + AT_NST - 1 < NT) TISSUE(n + AT_NST - 1, st_iss);
      }
      int mode, base, lo, hi;
      bool full = false, lane_on = true;
      if (n < 2 * ntc) { mode = n < ntc ? 0 : 1; base = (n < ntc ? n : n - ntc) * 64; lo = -1; hi = (t - 31) >> 4; }
      else if (n < 2 * ntc + nsl) { const int j = n - 2 * ntc; mode = 2; base = j * 64; const unsigned bit = j < 32 ? (sel_lo >> j) & 1u : (sel_hi >> (j - 32)) & 1u; lo = -1; hi = bit ? t : -1; full = j < i; lane_on = bit != 0u; }
      else { const int j = i - nwin + 1 + (n - 2 * ntc - nsl); mode = 3; base = j * 64; lo = t - 512; hi = t; full = (j < i) && (j > i - 8); }
      const int lo_rel = lo - (base + 4 * h), hi_rel = hi - (base + 4 * h);
      const bool chk = ((n & 7) == 7) || mode == 0;
#pragma unroll
      for (int r = 0; r < 16; ++r) { O0[r] *= oscale; O1[r] *= oscale; }
      const char* kb = smem + st_cur * AT_BUF;
      const char* vb = kb + AT_KB;
      st_cur = st_cur == AT_NST - 1 ? 0 : st_cur + 1; st_iss = st_iss == AT_NST - 1 ? 0 : st_iss + 1;
      f32x16 S0, S1;
#define ATT_BODY(MASKED) do { \
      _Pragma("unroll") for (int r = 0; r < 16; ++r) { S0[r] = 0.f; S1[r] = 0.f; } \
      const float m_use = (m_run == NINF) ? 0.f : m_run;        \
      { \
          \
        const float negm = (!(MASKED) && !lane_on) ? NINF : -m_use; \
        u32x4 qxw; qxw[0] = (h == 0) ? (cvtpk(negm, 0.f) & 0xffffu) : 0u; qxw[1] = 0u; qxw[2] = 0u; qxw[3] = 0u; \
        const bf16x8 qx = __builtin_bit_cast(bf16x8, qxw); \
        S0 = MFMA32(kx, qx, S0); S1 = MFMA32(kx, qx, S1); \
      } \
      { \
        bf16x8 kf0[4], kf1[4]; \
        _Pragma("unroll") for (int ks = 0; ks < 4; ++ks) { \
          kf0[ks] = *(const bf16x8*)(kb + c32 * 128 + (((ks * 2 + h) ^ ksw) * 16)); \
          kf1[ks] = *(const bf16x8*)(kb + (32 + c32) * 128 + (((ks * 2 + h) ^ ksw) * 16)); \
        } \
        _Pragma("unroll") for (int ks = 0; ks < 4; ++ks) S0 = MFMA32(kf0[ks], qf[ks], S0);     \
        _Pragma("unroll") for (int ks = 0; ks < 4; ++ks) S1 = MFMA32(kf1[ks], qf[ks], S1); \
      } \
        \
      if ((MASKED) == 2) {                       \
        _Pragma("unroll") for (int r = 0; r < 16; ++r) { \
          const int off = (r & 3) + 8 * (r >> 2); \
          S0[r] = (off > lo_rel && off <= hi_rel) ? S0[r] : NINF; \
          S1[r] = (off + 32 > lo_rel && off + 32 <= hi_rel) ? S1[r] : NINF; \
        } \
      } else if (MASKED) {                       \
        _Pragma("unroll") for (int r = 0; r < 16; ++r) { \
          const int off = (r & 3) + 8 * (r >> 2); \
          S0[r] = (off <= hi_rel) ? S0[r] : NINF; \
          S1[r] = (off + 32 <= hi_rel) ? S1[r] : NINF; \
        } \
      } \
      float ps0 = 0.f, ps1 = 0.f; \
      bf16x8 vfa[4]; \
      _Pragma("unroll") for (int kk = 0; kk < 2; ++kk) \
        _Pragma("unroll") for (int dr = 0; dr < 2; ++dr) vfa[kk * 2 + dr] = *(const bf16x8*)(vb + (32 * dr + c32) * 128 + (((2 * kk + h) ^ ksw) * 16)); \
      _Pragma("unroll") for (int r = 0; r < 16; ++r) { S0[r] = __builtin_amdgcn_exp2f(S0[r]); ps0 += S0[r]; } \
      _Pragma("unroll") for (int kk = 0; kk < 2; ++kk) { \
        u32x4 pw; \
        _Pragma("unroll") for (int e = 0; e < 4; ++e) pw[e] = cvtpk(S0[8 * kk + 2 * e], S0[8 * kk + 2 * e + 1]); \
        const bf16x8 pf = __builtin_bit_cast(bf16x8, pw); \
        O0 = MFMA32(vfa[kk * 2], pf, O0); O1 = MFMA32(vfa[kk * 2 + 1], pf, O1); \
      } \
      __builtin_amdgcn_sched_group_barrier(0x100, 12, 0);     \
      __builtin_amdgcn_sched_group_barrier(0x008, 4, 0);      \
      _Pragma("unroll") for (int q_ = 0; q_ < 4; ++q_) { __builtin_amdgcn_sched_group_barrier(0x008, 1, 0); __builtin_amdgcn_sched_group_barrier(0x002, 9, 0); }     \
      __builtin_amdgcn_sched_barrier(0); \
      _Pragma("unroll") for (int r = 0; r < 16; ++r) { S1[r] = __builtin_amdgcn_exp2f(S1[r]); ps1 += S1[r]; } \
      _Pragma("unroll") for (int kk = 0; kk < 2; ++kk) { \
        u32x4 pw; \
        _Pragma("unroll") for (int e = 0; e < 4; ++e) pw[e] = cvtpk(S1[8 * kk + 2 * e], S1[8 * kk + 2 * e + 1]); \
        const bf16x8 pf = __builtin_bit_cast(bf16x8, pw); \
        const bf16x8 va0 = *(const bf16x8*)(vb + c32 * 128 + (((2 * (kk + 2) + h) ^ ksw) * 16)), va1 = *(const bf16x8*)(vb + (32 + c32) * 128 + (((2 * (kk + 2) + h) ^ ksw) * 16)); \
        O0 = MFMA32(va0, pf, O0); O1 = MFMA32(va1, pf, O1); \
      } \
      __builtin_amdgcn_sched_barrier(0); \
      oscale = 1.0f; \
      if (mode != 1) l_run += ps0 + ps1; \
      if (mode != 1 && chk) {                    \
        float mxp = fmaxf(fmaxf(S0[0], S0[1]), S1[0]); \
        mxp = fmaxf(fmaxf(mxp, S1[1]), S0[2]); \
        _Pragma("unroll") for (int r = 2; r < 16; r += 2) { \
          if (r > 2) mxp = fmaxf(fmaxf(mxp, S0[r]), S1[r - 1]); \
          mxp = fmaxf(fmaxf(mxp, S0[r + 1]), S1[r]); \
        } \
        mxp = fmaxf(mxp, S1[15]); \
        mxp = fmaxf(mxp, __shfl_xor(mxp, 32));            \
        const bool mv = (m_run == NINF) ? (mxp > 0.f) : (mxp > 256.0f); \
        const float m_new = bflo(cvtpk(m_use + __builtin_amdgcn_logf(mxp), 0.f));       \
        const float alpha = mv ? __builtin_amdgcn_exp2f(m_use - m_new) : 1.0f; \
        m_run = mv ? m_new : m_run; \
        l_run *= alpha; \
        oscale = alpha; \
      } \
      if ((MASKED) == 1 && mode == 1 && need_sel) {               \
        const int tt = base >> 6; \
        _Pragma("unroll") for (int kr = 0; kr < 2; ++kr) \
          _Pragma("unroll") for (int rg = 0; rg < 4; ++rg) { \
            float pv[4]; \
            _Pragma("unroll") for (int e = 0; e < 4; ++e) { \
              float v = (kr ? S1[rg * 4 + e] : S0[rg * 4 + e]) * inv_l; \
              v += qperm<0xB1>(v); v += qperm<0x4E>(v);            \
              pv[e] = v; \
            } \
            if (hd == 0) { \
              const int nblk = tt * 16 + 8 * kr + 2 * rg + h; \
              impa[tl * 65 + nblk] = pv[0] + pv[1] + pv[2] + 0.5f * pv[3]; \
              impb[tl * 65 + nblk] = 0.5f * pv[3]; \
            } \
          } \
      } } while (0)
      if (full) ATT_BODY(0); else if (mode == 3 && base < i * 64) ATT_BODY(2); else ATT_BODY(1);
#undef ATT_BODY
      if (n == ntc - 1) {
        const float lt = l_run + __shfl_xor(l_run, 32);
        inv_l = lt > 0.f ? 1.0f / lt : 0.f;
        oscale = 0.f;
      } else if (n == 2 * ntc - 1) {
        if (need_sel) {
          __syncthreads();
          for (int q = 0; q < 8; ++q) {
            const int tk = wid * 8 + q, nn = lane;
            const bool forced = (nn == 0) || (nn == i) || (nn == i - 1);
            const bool vis = nn <= i;
            float v = 0.f;
            if (vis) v = impa[tk * 65 + nn] + (nn > 0 ? impb[tk * 65 + nn - 1] : 0.f);
            const unsigned bse = forced ? 0x4E6E6B28u : __float_as_uint(v);
            const unsigned key = (bse & ~127u) | (vis ? 64u : 0u) | (unsigned)(63 - nn);
            unsigned T = 0u;
#pragma unroll 1
            for (int bbit = 31; bbit >= 0; --bbit) {
              const unsigned Tc = T | (1u << bbit);
              const unsigned long long mk = __builtin_amdgcn_ballot_w64(key >= Tc);
              if (__builtin_popcountll(mk) >= 16) T = Tc;
            }
            const unsigned long long sel = __builtin_amdgcn_ballot_w64(key >= T);
            if (lane == 0) { selm[tk * 2] = (unsigned)sel; selm[tk * 2 + 1] = (unsigned)(sel >> 32); }
          }
          __syncthreads();
          sel_lo = selm[tl * 2]; sel_hi = selm[tl * 2 + 1];
        }
        {
          const float wgt = g0 * inv_l * oscale;
#pragma unroll
          for (int r = 0; r < 16; ++r) { fl[r * 64] = wgt * O0[r]; fl[(16 + r) * 64] = wgt * O1[r]; }
          m_run = NINF; l_run = 0.f; oscale = 0.f;
        }
      } else if (n == 2 * ntc + nsl - 1) {
        const float lt = l_run + __shfl_xor(l_run, 32);
        const float wgt = g1 * (lt > 0.f ? 1.0f / lt : 0.f) * oscale;
#pragma unroll
        for (int r = 0; r < 16; ++r) { fl[r * 64] += wgt * O0[r]; fl[(16 + r) * 64] += wgt * O1[r]; }
        m_run = NINF; l_run = 0.f; oscale = 0.f;
      }
    }
#undef TILE_PTRS
#undef TISSUE
    {
      const float lt = l_run + __shfl_xor(l_run, 32);
      const float wgt = g2 * (lt > 0.f ? 1.0f / lt : 0.f) * oscale;
      const size_t rowo = (size_t)(b * 4096 + t);
      const u16* zp = ws_zs(p) + rowo * 512 + (g * 4 + hd) * 64;
      u16* mp = ws_mix(p) + rowo * LDK + (g * 4 + hd) * 64;
#pragma unroll
      for (int dr = 0; dr < 2; ++dr)
#pragma unroll
        for (int rg = 0; rg < 4; ++rg) {
          const int d = 32 * dr + 8 * rg + 4 * h;
          const u32x2 zv = *(const u32x2*)(zp + d);
          const float f0 = fl[(dr * 16 + rg * 4 + 0) * 64] + wgt * (dr ? O1[rg * 4 + 0] : O0[rg * 4 + 0]);
          const float f1 = fl[(dr * 16 + rg * 4 + 1) * 64] + wgt * (dr ? O1[rg * 4 + 1] : O0[rg * 4 + 1]);
          const float f2 = fl[(dr * 16 + rg * 4 + 2) * 64] + wgt * (dr ? O1[rg * 4 + 2] : O0[rg * 4 + 2]);
          const float f3 = fl[(dr * 16 + rg * 4 + 3) * 64] + wgt * (dr ? O1[rg * 4 + 3] : O0[rg * 4 + 3]);
          u32x2 o;
          o[0] = cvtpk(f0 * bflo(zv[0]), f1 * bfhi(zv[0]));
          o[1] = cvtpk(f2 * bflo(zv[1]), f3 * bfhi(zv[1]));
          *(u32x2*)(mp + d) = o;
        }
    }
  }
}

#define XB_TMO      128
#define XB_XCNT(j)  (256  + 64 * (j))
#define XB_XSUB(j)  (1280 + 64 * (j))
#define XB_XGEN(j)  (2304 + 64 * (j))
#define XB_TOP      3328
#define XB_TOPGEN   3392
#define XCD_BAR_WORDS 3456
#define XB_SPIN_CAP (1u << 18)
#define LAS __attribute__((address_space(3)))

__device__ __forceinline__ unsigned xb_ld(unsigned* p)              { return __hip_atomic_load(p, __ATOMIC_RELAXED, __HIP_MEMORY_SCOPE_AGENT); }
__device__ __forceinline__ unsigned xb_add(unsigned* p, unsigned v) { return __hip_atomic_fetch_add(p, v, __ATOMIC_RELAXED, __HIP_MEMORY_SCOPE_AGENT); }
__device__ __forceinline__ unsigned xb_xcc_id() { return (unsigned)__builtin_amdgcn_s_getreg((3 << 11) | 20) & 0xFu; }
#define XB_SPIN(cond, bar) do { unsigned _sp = 0; while (cond) { __builtin_amdgcn_s_sleep(1); \
    if ((++_sp & 255u) == 0u) { if (xb_ld(&(bar)[XB_TMO])) break; if (_sp > XB_SPIN_CAP) { atomicAdd(&(bar)[XB_TMO], 1u); break; } } } } while (0)

struct XcdBarrier {
    unsigned* bar; unsigned x;
    volatile LAS unsigned* st;
};

__device__ __forceinline__ XcdBarrier xcd_barrier_post(unsigned* bar, volatile LAS unsigned* st) {
    XcdBarrier b; b.bar = bar; b.x = xb_xcc_id(); b.st = st;
    if (threadIdx.x == 0) (void)xb_add(&bar[XB_XCNT(b.x)], 1u);
    return b;
}
__device__ __forceinline__ void xcd_barrier_complete(unsigned* bar, unsigned x, unsigned& nloc, unsigned& nx) {
    const unsigned G = gridDim.x * gridDim.y * gridDim.z;
    unsigned sum, cnt, mine, sp = 0u;
    for (;;) {
        sum = 0u; cnt = 0u; mine = 0u;
#pragma unroll
        for (unsigned j = 0; j < 16; ++j) { const unsigned c = xb_ld(&bar[XB_XCNT(j)]); sum += c; cnt += (c > 0u) ? 1u : 0u; mine = (j == x) ? c : mine; }
        if (sum == G) break;
        __builtin_amdgcn_s_sleep(1);
        if ((++sp & 255u) == 0u) { if (xb_ld(&bar[XB_TMO])) break; if (sp > XB_SPIN_CAP) { atomicAdd(&bar[XB_TMO], 1u); break; } }
    }
    nloc = mine > 0u ? mine : 1u; nx = cnt > 0u ? cnt : 1u;
}

__device__ __forceinline__ void xcd_barrier(const XcdBarrier& b) {
    asm volatile("s_waitcnt vmcnt(0)" ::: "memory");
    __syncthreads();
    if (threadIdx.x == 0) {
        unsigned* bar = b.bar;
        __builtin_amdgcn_s_waitcnt(0);
        unsigned nloc = b.st[0], nx = b.st[1];
        if (nloc == 0u) { xcd_barrier_complete(bar, b.x, nloc, nx); b.st[0] = nloc; b.st[1] = nx; }
        const unsigned old = xb_add(&bar[XB_XSUB(b.x)], 1u);
        const unsigned gen = old / nloc;
        if (old + 1u == (gen + 1u) * nloc) {
            __builtin_amdgcn_fence(__ATOMIC_RELEASE, "agent");
            asm volatile("s_waitcnt vmcnt(0)" ::: "memory");
            const unsigned og = xb_add(&bar[XB_TOP], 1u);
            const unsigned tg = og / nx;
            if (og + 1u == (tg + 1u) * nx) xb_add(&bar[XB_TOPGEN], 1u);
            else XB_SPIN(xb_ld(&bar[XB_TOPGEN]) == tg, bar);
            __builtin_amdgcn_fence(__ATOMIC_ACQUIRE, "agent");
            xb_add(&bar[XB_XGEN(b.x)], 1u);
            asm volatile("s_waitcnt vmcnt(0)" ::: "memory");
        } else {
            XB_SPIN(xb_ld(&bar[XB_XGEN(b.x)]) == gen, bar);
            __builtin_amdgcn_fence(__ATOMIC_ACQUIRE, "agent");
            asm volatile("s_waitcnt vmcnt(0)" ::: "memory");
        }
    }
    __syncthreads();
}


#if FUSED
extern "C" __global__ void __launch_bounds__(NTHREADS) hybrid_fwd(Params p) {
  extern __shared__ __attribute__((aligned(16))) char smem[];
  cg::grid_group grid = cg::this_grid();
  const int bid = blockIdx.x, nb = gridDim.x;
  if (threadIdx.x < 4) ((volatile unsigned*)(smem + SMEM_BYTES))[threadIdx.x] = 0u;
  __syncthreads();
  if (bid == 0) { for (int w_ = threadIdx.x; w_ < XCD_BAR_WORDS; w_ += NTHREADS) ws_bar(p)[w_] = 0u; }
  for (int r = 0; r < REP0; ++r) { phase_prep(p, smem, bid, nb); grid.sync(); }
  XcdBarrier xb = xcd_barrier_post(ws_bar(p), (volatile LAS unsigned*)(smem + SMEM_BYTES));
  for (int r = 0; r < REP1; ++r) { gemm_phase<0>(p, smem, bid, nb); xcd_barrier(xb); }
  for (int r = 0; r < REP2; ++r) { phase_cmp_conv(p, smem, bid, nb); xcd_barrier(xb); }
  for (int r = 0; r < REP3; ++r) { phase_attn(p, smem, bid, nb, r); xcd_barrier(xb); }
  for (int r = 0; r < REP4; ++r) { gemm_phase<1>(p, smem, bid, nb); }
}
#else
template <int PH>
__global__ void __launch_bounds__(NTHREADS) phase_kernel(Params p) {
  extern __shared__ __attribute__((aligned(16))) char smem[];
  const int bid = blockIdx.x, nb = gridDim.x;
  if constexpr (PH == 0) phase_prep(p, smem, bid, nb);
  if constexpr (PH == 1) gemm_phase<0>(p, smem, bid, nb);
  if constexpr (PH == 2) phase_cmp_conv(p, smem, bid, nb);
  if constexpr (PH == 3) phase_attn(p, smem, bid, nb, 0);
  if constexpr (PH == 4) gemm_phase<1>(p, smem, bid, nb);
}
#endif

extern "C" void kernel_launch(void* const* d_in, const int* in_sizes, int n_in, void* d_out, int out_size, void* d_ws, size_t ws_size, hipStream_t stream) {
  Params p{};
  p.x = (const float*)d_in[0]; p.norm_w = (const float*)d_in[1]; p.w_in = (const float*)d_in[2]; p.q_norm_w = (const float*)d_in[3];
  p.k_norm_w = (const float*)d_in[4]; p.ck_pos = (const float*)d_in[5]; p.ck_w1 = (const float*)d_in[6]; p.ck_b1 = (const float*)d_in[7];
  p.ck_w2 = (const float*)d_in[8]; p.cv_pos = (const float*)d_in[9]; p.cv_w1 = (const float*)d_in[10]; p.cv_b1 = (const float*)d_in[11];
  p.cv_w2 = (const float*)d_in[12]; p.conv_w = (const float*)d_in[13]; p.conv_b = (const float*)d_in[14]; p.w_out = (const float*)d_in[15];
  p.out = (float*)d_out;
  p.ws = (char*)d_ws;
  const size_t off = WS_TOTAL;
  if (off > ws_size) { fprintf(stderr, "kernel_launch: workspace too small (%zu > %zu)\n", off, ws_size); return; }

#if FUSED
  static int grid_blocks = 0;
  if (!grid_blocks) {
    int dev = 0, cus = 0, per_cu = 0;
    hipGetDevice(&dev);
    hipDeviceGetAttribute(&cus, hipDeviceAttributeMultiprocessorCount, dev);
    hipFuncSetAttribute((const void*)hybrid_fwd, hipFuncAttributeMaxDynamicSharedMemorySize, SMEM_BYTES + 16);
    hipOccupancyMaxActiveBlocksPerMultiprocessor(&per_cu, (const void*)hybrid_fwd, NTHREADS, SMEM_BYTES + 16);
    if (per_cu < 1) per_cu = 1;
    grid_blocks = cus * per_cu;
  }
  void* args[] = {&p};
  hipError_t e = hipLaunchCooperativeKernel((const void*)hybrid_fwd, dim3(grid_blocks), dim3(NTHREADS), args, SMEM_BYTES + 16, stream);
  if (e != hipSuccess) fprintf(stderr, "cooperative launch failed: %s (grid %d)\n", hipGetErrorString(e), grid_blocks);
#else
  static int attr_set = 0;
  if (!attr_set) {
    (void)hipFuncSetAttribute((const void*)phase_kernel<0>, hipFuncAttributeMaxDynamicSharedMemorySize, SMEM_BYTES);
    (void)hipFuncSetAttribute((const void*)phase_kernel<1>, hipFuncAttributeMaxDynamicSharedMemorySize, SMEM_BYTES);
    (void)hipFuncSetAttribute((const void*)phase_kernel<2>, hipFuncAttributeMaxDynamicSharedMemorySize, SMEM_BYTES);
    (void)hipFuncSetAttribute((const void*)phase_kernel<3>, hipFuncAttributeMaxDynamicSharedMemorySize, SMEM_BYTES);
    (void)hipFuncSetAttribute((const void*)phase_kernel<4>, hipFuncAttributeMaxDynamicSharedMemorySize, SMEM_BYTES);
    attr_set = 1;
  }
  const int G = 256;
  phase_kernel<0><<<G, NTHREADS, SMEM_BYTES, stream>>>(p);
  phase_kernel<1><<<G, NTHREADS, SMEM_BYTES, stream>>>(p);
  phase_kernel<2><<<G, NTHREADS, SMEM_BYTES, stream>>>(p);
  phase_kernel<3><<<G, NTHREADS, SMEM_BYTES, stream>>>(p);
  phase_kernel<4><<<G, NTHREADS, SMEM_BYTES, stream>>>(p);
#endif
}
```

```cpp
#include <hip/hip_runtime.h>
#include <hip/hip_cooperative_groups.h>
#include <cstdio>
#include <cstdint>
namespace cg = cooperative_groups;

#ifndef FUSED
#define FUSED 1
#endif
#define REP0 1
#define REP1 1
#define REP2 1
#define REP3 1
#define REP4 1

#define DI __device__ __forceinline__
typedef unsigned short u16;
using bf16x8 = __attribute__((ext_vector_type(8))) short;
using s16x4 = __attribute__((ext_vector_type(4))) short;
using f32x4 = __attribute__((ext_vector_type(4))) float;
using f32x16 = __attribute__((ext_vector_type(16))) float;
using u32x4 = __attribute__((ext_vector_type(4))) unsigned;
using u32x2 = __attribute__((ext_vector_type(2))) unsigned;
typedef __bf16 bf2_t __attribute__((ext_vector_type(2)));
typedef float fl2_t __attribute__((ext_vector_type(2)));

constexpr int NTHREADS = 512;
constexpr int SEQ = 4096, DM = 1024, DIN = 3864, NROWS = 32768;
constexpr int LDK = 1088;
constexpr float EPS = 1e-6f;
constexpr float QSCALE = 0.125f * 1.4426950408889634f;
constexpr int SMEM_BYTES = 148480;

__constant__ float c_invf[8] = {1.0f, 0.1939227432012558f, 0.03760603070259094f, 0.007292664609849453f,
                                0.0014142135623842478f, 0.00027424818836152554f, 5.3182957344688475e-05f, 1.0313385246263351e-05f};

DI unsigned cvtpk(float lo, float hi) {
  fl2_t f = {lo, hi};
  bf2_t b = __builtin_convertvector(f, bf2_t);
  return __builtin_bit_cast(unsigned, b);
}
DI u16 f2bf(float x) { return (u16)(cvtpk(x, 0.f) & 0xffffu); }
DI float bf2f(u16 v) { return __uint_as_float(((unsigned)v) << 16); }
DI float bflo(unsigned v) { return __uint_as_float(v << 16); }
DI float bfhi(unsigned v) { return __uint_as_float(v & 0xffff0000u); }
DI float sigmoidf_(float v) { return __builtin_amdgcn_rcpf(1.0f + __builtin_amdgcn_exp2f(-1.4426950408889634f * v)); }
DI float siluf_(float v) { return v * __builtin_amdgcn_rcpf(1.0f + __builtin_amdgcn_exp2f(-1.4426950408889634f * v)); }
DI void glds16(const void* g, unsigned lds_base) {
  unsigned sv;
  asm volatile("s_mov_b32 %0, m0\n\ts_mov_b32 m0, %2\n\ts_nop 0\n\tglobal_load_lds_dwordx4 %1, off\n\ts_mov_b32 m0, %0" : "=&s"(sv) : "v"(g), "s"(lds_base) : "memory");
}
template <int CTRL> DI float qperm(float v) { return __int_as_float(__builtin_amdgcn_update_dpp(0, __float_as_int(v), CTRL, 0xF, 0xF, true)); }
#define MFMA16(a, b, c) __builtin_amdgcn_mfma_f32_16x16x32_bf16((a), (b), (c), 0, 0, 0)
#define MFMA32(a, b, c) __builtin_amdgcn_mfma_f32_32x32x16_bf16((a), (b), (c), 0, 0, 0)

struct Params {
  const float *x, *norm_w, *w_in, *q_norm_w, *k_norm_w, *ck_pos, *ck_w1, *ck_b1, *ck_w2, *cv_pos, *cv_w1, *cv_b1, *cv_w2, *conv_w, *conv_b, *w_out;
  float* out;
  char* ws;
};
constexpr size_t al256(size_t v) { return (v + 255) & ~(size_t)255; }
constexpr size_t OFF_xb = 0;
DI u16* ws_xb(const Params& p) { return (u16*)(p.ws + OFF_xb); }
constexpr size_t OFF_winT = OFF_xb + al256((size_t)NROWS * LDK * 2);
DI u16* ws_winT(const Params& p) { return (u16*)(p.ws + OFF_winT); }
constexpr size_t OFF_woutT = OFF_winT + al256((size_t)4096 * LDK * 2);
DI u16* ws_woutT(const Params& p) { return (u16*)(p.ws + OFF_woutT); }
constexpr size_t OFF_w1kT = OFF_woutT + al256((size_t)1024 * LDK * 2);
DI u16* ws_w1kT(const Params& p) { return (u16*)(p.ws + OFF_w1kT); }
constexpr size_t OFF_w1vT = OFF_w1kT + al256((size_t)128 * 2048 * 2);
DI u16* ws_w1vT(const Params& p) { return (u16*)(p.ws + OFF_w1vT); }
constexpr size_t OFF_w2kT = OFF_w1vT + al256((size_t)128 * 2048 * 2);
DI u16* ws_w2kT(const Params& p) { return (u16*)(p.ws + OFF_w2kT); }
constexpr size_t OFF_w2vT = OFF_w2kT + al256((size_t)64 * 128 * 2);
DI u16* ws_w2vT(const Params& p) { return (u16*)(p.ws + OFF_w2vT); }
constexpr size_t OFF_Q = OFF_w2vT + al256((size_t)64 * 128 * 2);
DI u16* ws_Q(const Params& p) { return (u16*)(p.ws + OFF_Q); }
constexpr size_t OFF_Ks = OFF_Q + al256((size_t)NROWS * 512 * 2);
DI u16* ws_Ks(const Params& p) { return (u16*)(p.ws + OFF_Ks); }
constexpr size_t OFF_Kw = OFF_Ks + al256((size_t)16 * 4096 * 64 * 2);
DI u16* ws_Kw(const Params& p) { return (u16*)(p.ws + OFF_Kw); }
constexpr size_t OFF_Vst = OFF_Kw + al256((size_t)16 * 4096 * 64 * 2);
DI u16* ws_Vst(const Params& p) { return (u16*)(p.ws + OFF_Vst); }
constexpr size_t OFF_Vwt = OFF_Vst + al256((size_t)16 * 4096 * 64 * 2);
DI u16* ws_Vwt(const Params& p) { return (u16*)(p.ws + OFF_Vwt); }
constexpr size_t OFF_kcraw = OFF_Vwt + al256((size_t)16 * 4096 * 64 * 2);
DI u16* ws_kcraw(const Params& p) { return (u16*)(p.ws + OFF_kcraw); }
constexpr size_t OFF_vcraw = OFF_kcraw + al256((size_t)16 * 4096 * 64 * 2 + 4096);
DI u16* ws_vcraw(const Params& p) { return (u16*)(p.ws + OFF_vcraw); }
constexpr size_t OFF_Kc = OFF_vcraw + al256((size_t)16 * 4096 * 64 * 2 + 4096);
DI u16* ws_Kc(const Params& p) { return (u16*)(p.ws + OFF_Kc); }
constexpr size_t OFF_Vct = OFF_Kc + al256((size_t)16 * 256 * 64 * 2);
DI u16* ws_Vct(const Params& p) { return (u16*)(p.ws + OFF_Vct); }
constexpr size_t OFF_zs = OFF_Vct + al256((size_t)16 * 256 * 64 * 2);
DI u16* ws_zs(const Params& p) { return (u16*)(p.ws + OFF_zs); }
constexpr size_t OFF_cvb = OFF_zs + al256((size_t)NROWS * 512 * 2);
DI u16* ws_cvb(const Params& p) { return (u16*)(p.ws + OFF_cvb); }
constexpr size_t OFF_mix = OFF_cvb + al256((size_t)NROWS * 2048 * 2);
DI u16* ws_mix(const Params& p) { return (u16*)(p.ws + OFF_mix); }
constexpr size_t OFF_rs = OFF_mix + al256((size_t)NROWS * LDK * 2);
DI float* ws_rs(const Params& p) { return (float*)(p.ws + OFF_rs); }
constexpr size_t OFF_ckpart = OFF_rs + al256((size_t)NROWS * 4);
DI float* ws_ckpart(const Params& p) { return (float*)(p.ws + OFF_ckpart); }
constexpr size_t OFF_rope = OFF_ckpart + al256((size_t)16 * 128 * 4);
DI float* ws_rope(const Params& p) { return (float*)(p.ws + OFF_rope); }
constexpr size_t OFF_gates = OFF_rope + al256((size_t)4096 * 8 * 2 * 4);
DI float* ws_gates(const Params& p) { return (float*)(p.ws + OFF_gates); }
constexpr size_t OFF_counter = OFF_gates + al256((size_t)NROWS * 24 * 4);
DI unsigned* ws_counter(const Params& p) { return (unsigned*)(p.ws + OFF_counter); }
constexpr size_t OFF_bar = OFF_counter + al256((size_t)256);
DI unsigned* ws_bar(const Params& p) { return (unsigned*)(p.ws + OFF_bar); }
constexpr size_t WS_TOTAL = OFF_bar + al256((size_t)3456 * 4);


DI void transpose_tile(const float* __restrict__ src, u16* __restrict__ dst, int K, int N, const float* __restrict__ scale, int kt, int nt, char* smem, int ldd) {
  float* tile = (float*)smem;
  const int tid = threadIdx.x;
  float v[8], sc[8];
  const int nn0 = tid & 63, n0_ = nt * 64 + nn0, nc = n0_ < N ? n0_ : N - 1;
#pragma unroll
  for (int i = 0; i < 8; ++i) {
    const int k = kt * 64 + i * 8 + (tid >> 6);
    v[i] = src[(size_t)k * N + nc];
    sc[i] = scale ? scale[k] : 1.0f;
  }
#pragma unroll
  for (int i = 0; i < 8; ++i) tile[(i * 8 + (tid >> 6)) * 65 + nn0] = (n0_ < N) ? v[i] * sc[i] : 0.f;
  __syncthreads();
#pragma unroll
  for (int i = 0; i < 8; ++i) {
    const int nn = i * 8 + (tid >> 6), kk = tid & 63;
    dst[(size_t)(nt * 64 + nn) * ldd + kt * 64 + kk] = f2bf(tile[kk * 65 + nn]);
  }
  __syncthreads();
}

__device__ void phase_prep(const Params& p, char* smem, int bid, int nb) {
  int tid_ = threadIdx.x; asm volatile("" : "+v"(tid_));
  const int tid = tid_, lane = tid & 63, wid = __builtin_amdgcn_readfirstlane(tid >> 6);
  constexpr int J_X = 1024, J_TW = 1024, J_TO = 256, J_T1 = 64, J_T2 = 2, J_CK = 16, J_ROPE = 64;
  constexpr int TOTAL = J_X + J_TW + J_TO + 2 * J_T1 + 2 * J_T2 + J_CK + J_ROPE;
  if (bid == 0 && tid < 8) ws_counter(p)[tid] = 0u;
  for (int j = bid; j < TOTAL; j += nb) {
    constexpr int HEAD = J_CK + J_ROPE;
    int jj = j < HEAD ? (TOTAL - HEAD) + j : j - HEAD;
    if (jj < J_X) {
      const int row0 = jj * 32 + wid * 4;
      float4 v[4][4]; float ss[4];
#pragma unroll
      for (int r = 0; r < 4; ++r) {
        const float4* xr = (const float4*)(p.x + (size_t)(row0 + r) * DM);
#pragma unroll
        for (int i = 0; i < 4; ++i) v[r][i] = xr[i * 64 + lane];
      }
#pragma unroll
      for (int r = 0; r < 4; ++r) {
        float a = 0.f;
#pragma unroll
        for (int i = 0; i < 4; ++i) a += v[r][i].x * v[r][i].x + v[r][i].y * v[r][i].y + v[r][i].z * v[r][i].z + v[r][i].w * v[r][i].w;
#pragma unroll
        for (int o = 32; o >= 1; o >>= 1) a += __shfl_xor(a, o);
        ss[r] = a;
      }
#pragma unroll
      for (int r = 0; r < 4; ++r) {
        if (lane == 0) ws_rs(p)[row0 + r] = rsqrtf(ss[r] * (1.0f / DM) + EPS);
#pragma unroll
        for (int i = 0; i < 4; ++i) {
          u32x2 o; o[0] = cvtpk(v[r][i].x, v[r][i].y); o[1] = cvtpk(v[r][i].z, v[r][i].w);
          const int rr_ = row0 + r;
          *(u32x2*)(ws_xb(p) + ((size_t)((rr_ >> 8) * 16 + i * 4 + (lane >> 4)) * 256 + (rr_ & 255)) * 64 + (lane & 15) * 4) = o;
        }
      }
      continue;
    }
    jj -= J_X;
    if (jj < J_TW) { transpose_tile(p.w_in, ws_winT(p), 1024, DIN, p.norm_w, jj & 15, jj >> 4, smem, LDK); continue; }
    jj -= J_TW;
    if (jj < J_TO) { transpose_tile(p.w_out, ws_woutT(p), 1024, 1024, nullptr, jj & 15, jj >> 4, smem, LDK); continue; }
    jj -= J_TO;
    if (jj < J_T1) { transpose_tile(p.ck_w1, ws_w1kT(p), 2048, 128, nullptr, jj & 31, jj >> 5, smem, 2048); continue; }
    jj -= J_T1;
    if (jj < J_T1) { transpose_tile(p.cv_w1, ws_w1vT(p), 2048, 128, nullptr, jj & 31, jj >> 5, smem, 2048); continue; }
    jj -= J_T1;
    if (jj < J_T2) { transpose_tile(p.ck_w2, ws_w2kT(p), 128, 64, nullptr, jj, 0, smem, 128); continue; }
    jj -= J_T2;
    if (jj < J_T2) { transpose_tile(p.cv_w2, ws_w2vT(p), 128, 64, nullptr, jj, 0, smem, 128); continue; }
    jj -= J_T2;
    if (jj < J_CK) {
      const int which = jj >> 3, chunk = jj & 7, hh = tid & 127, sub = tid >> 7;
      const float* pos = which ? p.cv_pos : p.ck_pos;
      const float* w1 = which ? p.cv_w1 : p.ck_w1;
      float acc = 0.f;
      const int f0 = chunk * 256 + sub * 64;
      float pv_[64], wv_[64];
#pragma unroll
      for (int f = 0; f < 64; ++f) { pv_[f] = pos[f0 + f]; wv_[f] = w1[(size_t)(f0 + f) * 128 + hh]; }
#pragma unroll
      for (int f = 0; f < 64; ++f) acc += pv_[f] * wv_[f];
      float* red = (float*)smem;
      red[sub * 128 + hh] = acc;
      __syncthreads();
      if (tid < 128) ws_ckpart(p)[(which * 8 + chunk) * 128 + tid] = red[tid] + red[128 + tid] + red[256 + tid] + red[384 + tid];
      __syncthreads();
      continue;
    }
    jj -= J_CK;
    {
      const int idx = jj * 512 + tid, pos = idx >> 3, fi = idx & 7;
      const float ang = (float)pos * c_invf[fi];
      float s, c; sincosf(ang, &s, &c);
      ws_rope(p)[idx * 2] = c; ws_rope(p)[idx * 2 + 1] = s;
    }
  }
}

DI int kimg_off(int row, int d) { return row * 64 + (((d >> 3) ^ ((row >> 1) & 7)) * 8) + (d & 7); }
DI int vimg_off(int d, int key) {
  const int kp = (key & ~12) | ((key & 4) << 1) | ((key & 8) >> 1);
  return d * 64 + (((kp >> 3) ^ ((d >> 1) & 7)) * 8) + (kp & 7);
}

constexpr int G_ASZ = 256 * 128, G_BSZ = 256 * 128, G_STAGE = G_ASZ + G_BSZ;
constexpr int G_ROPE = 2 * G_STAGE, G_RS = G_ROPE + 256 * 64;
static_assert(G_RS + 1024 <= SMEM_BYTES, "GEMM LDS layout exceeds the dynamic LDS size");
#define WAIT_VM(n) asm volatile("s_waitcnt vmcnt(" #n ")" ::: "memory")

template <int EPI>
__device__ void gemm_phase(const Params& p, char* smem, int bid, int nb) {
  constexpr int NT = EPI == 0 ? 16 : 4;
  constexpr int MT = 128;
  const u16* __restrict__ A = EPI == 0 ? ws_xb(p) : ws_mix(p);
  const u16* __restrict__ Bt = EPI == 0 ? ws_winT(p) : ws_woutT(p);
  int tid_ = threadIdx.x; asm volatile("" : "+v"(tid_));
  const int tid = tid_, lane = tid & 63, wid = __builtin_amdgcn_readfirstlane(tid >> 6), fr = lane & 15, fq = lane >> 4;
  const int wr = wid >> 2, wc = wid & 3;
  const bool xmap = (nb == 256);
  const int xcd = bid & 7, li = bid >> 3;
  const int ntiles = xmap ? (EPI == 0 ? 8 : 2) : (MT * NT - bid + nb - 1) / nb;
  auto tile_of = [&](int ti, int& m0, int& n0) {
    if (xmap) {
      const int sg = ti * 8 + xcd;
      if (EPI == 0) { m0 = ((sg >> 1) * 4 + (li >> 3)) * 256; n0 = ((sg & 1) * 8 + (li & 7)) * 256; }
      else { m0 = (sg * 8 + (li >> 2)) * 256; n0 = (li & 3) * 256; }
    } else { const int tile = bid + ti * nb; const int mt = tile / NT; m0 = mt * 256; n0 = (tile - mt * NT) * 256; }
  };
  const int nsteps = ntiles * 16;
  const unsigned lds0 = (unsigned)(uintptr_t)smem;
  const int gsw = (lane & 7) ^ ((wid & 1) * 4 + (lane >> 4));
  const int grow = wid * 8 + (lane >> 3);
  auto issue = [&](int step, int stage) {
    int m0, n0; tile_of(step >> 4, m0, n0);
    const int kt = step & 15;
    const u16* ag = EPI == 0 ? A + ((size_t)((m0 >> 8) * 16 + kt) * 256 + grow) * 64 + gsw * 8 : A + (size_t)(m0 + grow) * LDK + kt * 64 + gsw * 8;
    const size_t astep = EPI == 0 ? (size_t)64 * 64 : (size_t)64 * LDK;
    const int brow = EPI == 0 ? ((grow & ~31) | ((grow & 0x0C) << 1) | ((grow & 0x10) >> 2) | (grow & 3)) : grow;
    const u16* bg_ = Bt + (size_t)(n0 + brow) * LDK + kt * 64 + gsw * 8;
    const unsigned dst = (unsigned)__builtin_amdgcn_readfirstlane((int)(lds0 + stage * G_STAGE + wid * 1024));
#pragma unroll
    for (int i = 0; i < 4; ++i) glds16(ag + i * astep, dst + i * 8192);
#pragma unroll
    for (int i = 0; i < 4; ++i) glds16(bg_ + (size_t)i * 64 * LDK, dst + G_ASZ + i * 8192);
    if (EPI == 0 && kt == 8) {
      const int t0 = m0 & 4095;
      const unsigned sd = (unsigned)__builtin_amdgcn_readfirstlane((int)(lds0 + G_ROPE + wid * 1024));
      glds16(ws_rope(p) + (size_t)t0 * 16 + tid * 4, sd);
      glds16(ws_rope(p) + (size_t)t0 * 16 + (512 + tid) * 4, sd + 8192);
      if (wid == 0) glds16(ws_rs(p) + m0 + lane * 4, lds0 + G_RS);
    }
  };
  const int ca0 = ((fq ^ (fr >> 1)) * 16), ca1 = (((4 + fq) ^ (fr >> 1)) * 16);
  f32x4 acc[8][4];
#pragma unroll
  for (int m = 0; m < 8; ++m)
#pragma unroll
    for (int n = 0; n < 4; ++n) acc[m][n] = f32x4{0.f, 0.f, 0.f, 0.f};
  __syncthreads();
  if (nsteps > 0) issue(0, 0);
  for (int s = 0; s < nsteps; ++s) {
    WAIT_VM(0);
    __builtin_amdgcn_s_waitcnt(0x0F70);
    __builtin_amdgcn_s_barrier();
    if (s + 1 < nsteps) issue(s + 1, (s + 1) & 1);
    {
      const char* ab = smem + (s & 1) * G_STAGE + (wr * 128 + fr) * 128;
      const char* bb = smem + (s & 1) * G_STAGE + G_ASZ + (wc * 64 + fr) * 128;
#pragma unroll
      for (int ks = 0; ks < 2; ++ks) {
        bf16x8 af[8], bf[4];
        const int co = ks ? ca1 : ca0;
#pragma unroll
        for (int n = 0; n < 4; ++n) bf[n] = *(const bf16x8*)(bb + n * 16 * 128 + co);
#pragma unroll
        for (int m = 0; m < 8; ++m) af[m] = *(const bf16x8*)(ab + m * 16 * 128 + co);
#pragma unroll
        for (int m = 0; m < 8; ++m)
#pragma unroll
          for (int n = 0; n < 4; ++n) acc[m][n] = MFMA16(bf[n], af[m], acc[m][n]);
      }
    }
    if ((s & 15) != 15) continue;
    int m0, n0; tile_of(s >> 4, m0, n0);
    const int rbase = m0 + wr * 128;
    const int cb = n0 + wc * 64;
    if constexpr (EPI == 1) {
#pragma unroll
      for (int hm = 0; hm < 2; ++hm) {
        float4 xv[4][4];
#pragma unroll
        for (int mm = 0; mm < 4; ++mm) {
          const size_t ro = (size_t)(rbase + (hm * 4 + mm) * 16 + fr) * DM + cb + fq * 4;
#pragma unroll
          for (int n = 0; n < 4; ++n) xv[mm][n] = *(const float4*)(p.x + ro + n * 16);
        }
#pragma unroll
        for (int mm = 0; mm < 4; ++mm) {
          const int m = hm * 4 + mm;
          const size_t ro = (size_t)(rbase + m * 16 + fr) * DM + cb + fq * 4;
#pragma unroll
          for (int n = 0; n < 4; ++n) {
            float4 o; o.x = xv[mm][n].x + acc[m][n][0]; o.y = xv[mm][n].y + acc[m][n][1]; o.z = xv[mm][n].z + acc[m][n][2]; o.w = xv[mm][n].w + acc[m][n][3];
            *(float4*)(p.out + ro + n * 16) = o;
          }
        }
        __builtin_amdgcn_sched_barrier(0);
      }
    } else {
      const int b = m0 >> 12;
      const int tb = rbase & 4095;
      if (cb < 1280) {
        const int seg = cb >> 6;
        const int which = seg < 8 ? -1 : ((seg - 8) >> 1);
        const int g = seg < 8 ? (seg >> 2) : ((seg - 8) & 1);
        const bool need_norm = (seg < 8) || which == 2 || which == 4;
        const float* nw = seg < 8 ? p.q_norm_w : (p.k_norm_w + (which == 2 ? 64 : 128));
        float w[16];
#pragma unroll
        for (int k = 0; k < 16; ++k) w[k] = need_norm ? nw[(k >> 3) * 32 + fq * 8 + (k & 7)] : 1.0f;
        const float qs = seg < 8 ? QSCALE : 1.0f;
#pragma unroll
        for (int m = 0; m < 8; ++m) {
          const int t = tb + m * 16 + fr;
          const int lrow = wr * 128 + m * 16 + fr;
          const float r = *(const float*)(smem + G_RS + lrow * 4);
          float v[16];
#pragma unroll
          for (int k = 0; k < 16; ++k) v[k] = acc[m][(k >> 3) * 2 + ((k & 7) >> 2)][k & 3] * r;
          if (need_norm) {
            float ss = 0.f;
#pragma unroll
            for (int k = 0; k < 16; ++k) ss += v[k] * v[k];
            ss += __shfl_xor(ss, 16); ss += __shfl_xor(ss, 32);
            const float rr = rsqrtf(ss * (1.0f / 64.f) + EPS);
#pragma unroll
            for (int k = 0; k < 16; ++k) v[k] = v[k] * rr * w[k];
            const float4* rp = (const float4*)(smem + G_ROPE + lrow * 64);
            const float4 c01 = rp[0], c23 = rp[1], c45 = rp[2], c67 = rp[3];
            const float cc[8] = {c01.x, c01.z, c23.x, c23.z, c45.x, c45.z, c67.x, c67.z};
            const float sn[8] = {c01.y, c01.w, c23.y, c23.w, c45.y, c45.w, c67.y, c67.w};
#pragma unroll
            for (int e = 0; e < 8; ++e) {
              const float pr = __shfl_xor(v[e], 16);
              const float rot = (fq == 0) ? (v[e] * cc[e] - pr * sn[e]) : (v[e] * cc[e] + pr * sn[e]);
              v[e] = (fq < 2) ? rot : v[e];
            }
#pragma unroll
            for (int k = 0; k < 16; ++k) v[k] *= qs;
          }
          if (which == 3 || which == 5) {
            int lz = 0; asm volatile("" : "+v"(lz));
            u16* vt = (which == 3 ? ws_Vst(p) : ws_Vwt(p)) + (size_t)((b * 2 + g) * 64 + (t >> 6)) * 4096 + lz;
            const int fqx = fq + lz, key = (t & 63) + lz;
#pragma unroll
            for (int k = 0; k < 16; ++k) vt[vimg_off((k >> 3) * 32 + fqx * 8 + (k & 7), key)] = f2bf(v[k]);
          } else {
            u16* dst;
            if (seg < 8) dst = ws_Q(p) + ((size_t)((b * 2 + g) * 4096 + t) * 4 + (seg & 3)) * 64;
            else { u16* buf = which == 0 ? ws_kcraw(p) : which == 1 ? ws_vcraw(p) : which == 2 ? ws_Ks(p) : ws_Kw(p); dst = buf + ((size_t)(b * 2 + g) * 4096 + t) * 64; }
            const bool img = which >= 2;
#pragma unroll
            for (int n2 = 0; n2 < 2; ++n2) {
              u32x4 o;
#pragma unroll
              for (int e = 0; e < 4; ++e) o[e] = cvtpk(v[n2 * 8 + 2 * e], v[n2 * 8 + 2 * e + 1]);
              const int d0 = n2 * 32 + fq * 8;
              const int off = img ? (((d0 >> 3) ^ (((t & 63) >> 1) & 7)) * 8) : d0;
              *(u32x4*)(dst + off) = o;
            }
          }
          __builtin_amdgcn_sched_barrier(0);
        }
      } else {
#pragma unroll
        for (int m = 0; m < 8; ++m) {
          const size_t row = rbase + m * 16 + fr;
          const float r = *(const float*)(smem + G_RS + (wr * 128 + m * 16 + fr) * 4);
#pragma unroll
          for (int n2 = 0; n2 < 2; ++n2) {
            const int c8 = cb + n2 * 32 + fq * 8;
            if (c8 >= DIN) continue;
            float v[8];
#pragma unroll
            for (int e = 0; e < 8; ++e) v[e] = acc[m][n2 * 2 + (e >> 2)][e & 3] * r;
            if (c8 < 1304) {
              float4 o0, o1;
              o0.x = sigmoidf_(v[0]); o0.y = sigmoidf_(v[1]); o0.z = sigmoidf_(v[2]); o0.w = sigmoidf_(v[3]);
              o1.x = sigmoidf_(v[4]); o1.y = sigmoidf_(v[5]); o1.z = sigmoidf_(v[6]); o1.w = sigmoidf_(v[7]);
              float* gp = ws_gates(p) + row * 24 + (c8 - 1280);
              *(float4*)gp = o0; *(float4*)(gp + 4) = o1;
            } else if (c8 < 1816) {
              u32x4 o;
#pragma unroll
              for (int e = 0; e < 4; ++e) o[e] = cvtpk(siluf_(v[2 * e]), siluf_(v[2 * e + 1]));
              *(u32x4*)(ws_zs(p) + row * 512 + (c8 - 1304)) = o;
            } else {
              u32x4 o;
#pragma unroll
              for (int e = 0; e < 4; ++e) o[e] = cvtpk(v[2 * e], v[2 * e + 1]);
              *(u32x4*)(ws_cvb(p) + row * 2048 + (c8 - 1816)) = o;
            }
          }
          __builtin_amdgcn_sched_barrier(0);
        }
      }
    }
#pragma unroll
    for (int m = 0; m < 8; ++m)
#pragma unroll
      for (int n = 0; n < 4; ++n) acc[m][n] = f32x4{0.f, 0.f, 0.f, 0.f};
  }
}

__device__ void phase_cmp_conv(const Params& p, char* smem, int bid, int nb) {
  int tid_ = threadIdx.x; asm volatile("" : "+v"(tid_));
  const int tid = tid_, lane = tid & 63, wid = __builtin_amdgcn_readfirstlane(tid >> 6), fr = lane & 15, fq = lane >> 4;
  float* part = (float*)smem;
  char* hl = smem + 8 * 16 * 132 * 4;
  float* outl = (float*)(hl + 2 * 4352);
  float* biasl = outl + 2 * 1088;
  for (int job = bid; job < 256; job += nb) {
    const int which = wid >> 2, w4 = wid & 3, bg = job >> 4, ct = job & 15;
    const u16* raw = (which ? ws_vcraw(p) : ws_kcraw(p)) + (size_t)bg * 4096 * 64;
    const u16* w1T = which ? ws_w1vT(p) : ws_w1kT(p);
    const u16* w2T = which ? ws_w2vT(p) : ws_w2kT(p);
    const float* b1 = which ? p.cv_b1 : p.ck_b1;
    f32x4 acc[8];
#pragma unroll
    for (int n = 0; n < 8; ++n) acc[n] = f32x4{0.f, 0.f, 0.f, 0.f};
    const int c = ct * 16 + fr;
    const int ht = tid & 255, rrow = ht >> 4, c8 = (ht & 15) * 8;
    const int orow = ht >> 4, d4 = (ht & 15) * 4;
    const int cc = ct * 16 + orow;
#pragma unroll 1
    for (int kb4 = 0; kb4 < 16; kb4 += 2) {
      bf16x8 av[2], bv[2][8];
#pragma unroll
      for (int q = 0; q < 2; ++q) {
        const int ks = w4 * 16 + kb4 + q;
        const int l = ks >> 1, d0 = (ks & 1) * 32 + fq * 8;
        int tt = c * 16 + l; tt = tt > 4095 ? 4095 : tt;
        av[q] = *(const bf16x8*)(raw + (size_t)tt * 64 + d0);
#pragma unroll
        for (int n = 0; n < 8; ++n) bv[q][n] = *(const bf16x8*)(w1T + (size_t)(n * 16 + fr) * 2048 + ks * 32 + fq * 8);
      }
#pragma unroll
      for (int q = 0; q < 2; ++q)
#pragma unroll
        for (int n = 0; n < 8; ++n) acc[n] = MFMA16(av[q], bv[q][n], acc[n]);
      __builtin_amdgcn_sched_group_barrier(0x020, 18, 0);
      __builtin_amdgcn_sched_group_barrier(0x008, 16, 0);
    }
    if (ht < 128) {
      float bq[9];
      bq[0] = b1[ht];
#pragma unroll
      for (int ch = 0; ch < 8; ++ch) bq[1 + ch] = ws_ckpart(p)[(which * 8 + ch) * 128 + ht];
      float bsum = bq[0];
#pragma unroll
      for (int ch = 0; ch < 8; ++ch) bsum += bq[1 + ch];
      biasl[which * 128 + ht] = bsum;
    }
#pragma unroll
    for (int n = 0; n < 8; ++n)
#pragma unroll
      for (int j = 0; j < 4; ++j) part[(wid * 16 + fq * 4 + j) * 132 + n * 16 + fr] = acc[n][j];
    __syncthreads();
    {
      float bias[8];
#pragma unroll
      for (int e = 0; e < 8; ++e) bias[e] = biasl[which * 128 + c8 + e];
      float sum[8];
#pragma unroll
      for (int e = 0; e < 8; ++e) sum[e] = bias[e];
#pragma unroll
      for (int w = 0; w < 4; ++w) {
        const float4 v0 = *(const float4*)(part + ((which * 4 + w) * 16 + rrow) * 132 + c8), v1 = *(const float4*)(part + ((which * 4 + w) * 16 + rrow) * 132 + c8 + 4);
        sum[0] += v0.x; sum[1] += v0.y; sum[2] += v0.z; sum[3] += v0.w; sum[4] += v1.x; sum[5] += v1.y; sum[6] += v1.z; sum[7] += v1.w;
      }
      u32x4 o;
#pragma unroll
      for (int e = 0; e < 4; ++e) o[e] = cvtpk(siluf_(sum[2 * e]), siluf_(sum[2 * e + 1]));
      *(u32x4*)(hl + which * 4352 + rrow * 272 + c8 * 2) = o;
    }
    __syncthreads();
    {
    bf16x8 w2f[4];
#pragma unroll
    for (int ks = 0; ks < 4; ++ks) w2f[ks] = *(const bf16x8*)(w2T + (size_t)(w4 * 16 + fr) * 128 + ks * 32 + fq * 8);
      f32x4 o2 = f32x4{0.f, 0.f, 0.f, 0.f};
#pragma unroll
      for (int ks = 0; ks < 4; ++ks) {
        const bf16x8 a = *(const bf16x8*)(hl + which * 4352 + fr * 272 + (ks * 32 + fq * 8) * 2);
        o2 = MFMA16(a, w2f[ks], o2);
      }
#pragma unroll
      for (int j = 0; j < 4; ++j) outl[which * 1088 + (fq * 4 + j) * 68 + w4 * 16 + fr] = o2[j];
    }
    __syncthreads();
    {
    float nwv[4], nwp[4]; float2 csv[4];
    {
      int pos = cc * 16 + 31; pos = pos > 4095 ? 4095 : pos;
#pragma unroll
      for (int e = 0; e < 4; ++e) {
        const int d = d4 + e;
        nwv[e] = p.k_norm_w[d]; nwp[e] = p.k_norm_w[d ^ 8];
        csv[e] = *(const float2*)(ws_rope(p) + ((size_t)pos * 8 + (d & 7)) * 2);
      }
    }
      const float* ol = outl + which * 1088;
      const float4 v = *(const float4*)(ol + orow * 68 + d4);
      if (which == 0) {
        float ss = v.x * v.x + v.y * v.y + v.z * v.z + v.w * v.w;
        ss += __shfl_xor(ss, 1); ss += __shfl_xor(ss, 2); ss += __shfl_xor(ss, 4); ss += __shfl_xor(ss, 8);
        const float rr = rsqrtf(ss * (1.0f / 64.f) + EPS);
        float o[4] = {v.x * rr * nwv[0], v.y * rr * nwv[1], v.z * rr * nwv[2], v.w * rr * nwv[3]};
        if (d4 < 16) {
#pragma unroll
          for (int e = 0; e < 4; ++e) {
            const int d = d4 + e, dp = d ^ 8;
            const float pr = ol[orow * 68 + dp] * rr * nwp[e];
            o[e] = (d < 8) ? (o[e] * csv[e].x - pr * csv[e].y) : (o[e] * csv[e].x + pr * csv[e].y);
          }
        }
        u32x2 ov; ov[0] = cvtpk(o[0], o[1]); ov[1] = cvtpk(o[2], o[3]);
        if (cc >= 255) { ov[0] = 0u; ov[1] = 0u; }
        *(u32x2*)(ws_Kc(p) + (size_t)(bg * 4 + (cc >> 6)) * 4096 + kimg_off(cc & 63, d4)) = ov;
      } else {
        const float z = (cc >= 255) ? 0.f : 1.f;
        u16* vt = ws_Vct(p) + (size_t)(bg * 4 + (cc >> 6)) * 4096;
        vt[vimg_off(d4 + 0, cc & 63)] = f2bf(v.x * z); vt[vimg_off(d4 + 1, cc & 63)] = f2bf(v.y * z);
        vt[vimg_off(d4 + 2, cc & 63)] = f2bf(v.z * z); vt[vimg_off(d4 + 3, cc & 63)] = f2bf(v.w * z);
      }
    }
    __syncthreads();
  }
  const int gw = bid * 8 + wid, nw = nb * 8;
  for (int chunk = gw; chunk < 2048; chunk += nw) {
    const int r0 = chunk * 16, t0 = r0 & 4095;
    const int ch = lane * 8;
    float cw0[8], cw1[8], cw2[8], cbv[8], u1[8], u2[8];
#pragma unroll
    for (int e = 0; e < 8; ++e) { cw0[e] = p.conv_w[ch + e]; cw1[e] = p.conv_w[512 + ch + e]; cw2[e] = p.conv_w[1024 + ch + e]; cbv[e] = p.conv_b[ch + e]; u1[e] = 0.f; u2[e] = 0.f; }
    if (t0 > 0) {
#pragma unroll
      for (int q = 0; q < 2; ++q) {
        const u16* rp = ws_cvb(p) + (size_t)(r0 - 2 + q) * 2048 + ch;
        const u32x4 hv = *(const u32x4*)(rp), cv = *(const u32x4*)(rp + 1024);
#pragma unroll
        for (int e = 0; e < 4; ++e) {
          const float ua = bflo(hv[e]) * bflo(cv[e]), ub = bfhi(hv[e]) * bfhi(cv[e]);
          if (q == 0) { u2[2 * e] = ua; u2[2 * e + 1] = ub; } else { u1[2 * e] = ua; u1[2 * e + 1] = ub; }
        }
      }
    }
#pragma unroll 4
    for (int rr = 0; rr < 16; ++rr) {
      const u16* rp = ws_cvb(p) + (size_t)(r0 + rr) * 2048 + ch;
      const u32x4 hv = *(const u32x4*)(rp), bv = *(const u32x4*)(rp + 512), cv = *(const u32x4*)(rp + 1024), zv = *(const u32x4*)(rp + 1536);
      u32x4 ov;
#pragma unroll
      for (int e = 0; e < 4; ++e) {
        const float ua = bflo(hv[e]) * bflo(cv[e]), ub = bfhi(hv[e]) * bfhi(cv[e]);
        const float ca = cw0[2 * e] * u2[2 * e] + cw1[2 * e] * u1[2 * e] + cw2[2 * e] * ua + cbv[2 * e];
        const float cbb = cw0[2 * e + 1] * u2[2 * e + 1] + cw1[2 * e + 1] * u1[2 * e + 1] + cw2[2 * e + 1] * ub + cbv[2 * e + 1];
        const float oa = bflo(bv[e]) * ca * siluf_(bflo(zv[e]));
        const float ob = bfhi(bv[e]) * cbb * siluf_(bfhi(zv[e]));
        ov[e] = cvtpk(oa, ob);
        u2[2 * e] = u1[2 * e]; u2[2 * e + 1] = u1[2 * e + 1]; u1[2 * e] = ua; u1[2 * e + 1] = ub;
      }
      *(u32x4*)(ws_mix(p) + (size_t)(r0 + rr) * LDK + 512 + ch) = ov;
    }
  }
}

constexpr int AT_NST = 5, AT_KB = 8192, AT_BUF = 16384;
constexpr int AT_F = AT_NST * AT_BUF, AT_IMPA = AT_F, AT_IMPB = AT_IMPA + 64 * 65 * 4, AT_VAL = AT_IMPA;
constexpr int AT_SELM = AT_F + 8 * 8192, AT_UNIT = AT_SELM + 512, AT_END = AT_UNIT + 16;
static_assert(AT_END <= SMEM_BYTES, "attention LDS layout exceeds the dynamic LDS size");

__device__ void phase_attn(const Params& p, char* smem, int bid, int nb, int rep) {
  int tid_ = threadIdx.x; asm volatile("" : "+v"(tid_));
  const int tid = tid_, lane = tid & 63, wid = __builtin_amdgcn_readfirstlane(tid >> 6), c32 = lane & 31, h = lane >> 5;
  const float NINF = -__builtin_inff();
  float* impa = (float*)(smem + AT_IMPA);
  float* impb = (float*)(smem + AT_IMPB);
  float* vals = (float*)(smem + AT_VAL);
  unsigned* selm = (unsigned*)(smem + AT_SELM);
  volatile int* s_unit = (volatile int*)(smem + AT_UNIT);
  const unsigned lds0 = (unsigned)(uintptr_t)smem;
  while (true) {
    if (tid == 0) *s_unit = (int)atomicAdd(ws_counter(p) + rep, 1u);
    __syncthreads();
    const int u = __builtin_amdgcn_readfirstlane(*s_unit);
    __syncthreads();
    if (u >= 1024) break;
    const int i = 63 - (u >> 4), bg = u & 15, b = bg >> 1, g = bg & 1;
    const int tl = wid * 8 + (c32 >> 2), hd = c32 & 3;
    const int t = i * 64 + tl;
    const u16* qrow = ws_Q(p) + ((size_t)(bg * 4096 + i * 64) * 4 + wid * 32 + c32) * 64;
    bf16x8 qf[4];
#pragma unroll
    for (int ks = 0; ks < 4; ++ks) qf[ks] = *(const bf16x8*)(qrow + ks * 16 + h * 8);
    const float* gp = ws_gates(p) + (size_t)(b * 4096 + t) * 24 + (g * 4 + hd) * 3;
    const float g0 = gp[0], g1 = gp[1], g2 = gp[2];
    asm volatile("" :: "v"(qf[0]), "v"(qf[1]), "v"(qf[2]), "v"(qf[3]), "v"(g0), "v"(g1), "v"(g2));
    const int ntc = (4 * i + 2) / 64 + 1, nsl = i + 1, nwin = (i < 8 ? i : 8) + 1;
    const int NT = 2 * ntc + nsl + nwin;
    const bool need_sel = i >= 16;

    f32x16 O0, O1;
#pragma unroll
    for (int r = 0; r < 16; ++r) { O0[r] = 0.f; O1[r] = 0.f; }
    float* fl = (float*)(smem + AT_F + wid * 8192) + lane;
    float m_run = NINF, l_run = 0.f, inv_l = 0.f;
    u32x4 kxw; kxw[0] = (h == 0) ? 0x3F80u : 0u; kxw[1] = 0u; kxw[2] = 0u; kxw[3] = 0u;
    const bf16x8 kx = __builtin_bit_cast(bf16x8, kxw);
    float oscale = 1.0f;
    unsigned sel_lo = 0xffffffffu, sel_hi = 0xffffffffu;
#define TILE_PTRS(n, kp, vp) do { \
      if ((n) < 2 * ntc) { const int tt_ = (n) < ntc ? (n) : (n) - ntc; kp = ws_Kc(p) + (size_t)(bg * 4 + tt_) * 4096; vp = ws_Vct(p) + (size_t)(bg * 4 + tt_) * 4096; } \
      else if ((n) < 2 * ntc + nsl) { const int j_ = (n) - 2 * ntc; kp = ws_Ks(p) + ((size_t)bg * 4096 + j_ * 64) * 64; vp = ws_Vst(p) + (size_t)(bg * 64 + j_) * 4096; } \
      else { const int j_ = i - nwin + 1 + ((n) - 2 * ntc - nsl); kp = ws_Kw(p) + ((size_t)bg * 4096 + j_ * 64) * 64; vp = ws_Vwt(p) + (size_t)(bg * 64 + j_) * 4096; } } while (0)
#define TISSUE(n, st_) do { const u16 *kp_, *vp_; TILE_PTRS(n, kp_, vp_); \
      const unsigned d_ = (unsigned)__builtin_amdgcn_readfirstlane((int)(lds0 + (st_) * AT_BUF + wid * 1024)); \
      glds16(kp_ + tid * 8, d_); glds16(vp_ + tid * 8, d_ + AT_KB); } while (0)
    {
      const int npre = NT < AT_NST - 1 ? NT : AT_NST - 1;
      for (int n = 0; n < npre; ++n) TISSUE(n, n);
    }
    int st_cur = 0, st_iss = AT_NST - 1;
    const int ksw = (c32 >> 1) & 7;
    for (int n = 0; n < NT; ++n) {
      {
        const int rem = NT - 1 - n;
        if (rem >= 3) WAIT_VM(6); else if (rem == 2) WAIT_VM(4); else if (rem == 1) WAIT_VM(2); else WAIT_VM(0);
        __builtin_amdgcn_s_barrier();
        if (n + AT_NST - 1 < NT) TISSUE(n + AT_NST - 1, st_iss);
      }
      int mode, base, lo, hi;
      bool full = false, lane_on = true;
      if (n < 2 * ntc) { mode = n < ntc ? 0 : 1; base = (n < ntc ? n : n - ntc) * 64; lo = -1; hi = (t - 31) >> 4; }
      else if (n < 2 * ntc + nsl) { const int j = n - 2 * ntc; mode = 2; base = j * 64; const unsigned bit = j < 32 ? (sel_lo >> j) & 1u : (sel_hi >> (j - 32)) & 1u; lo = -1; hi = bit ? t : -1; full = j < i; lane_on = bit != 0u; }
      else { const int j = i - nwin + 1 + (n - 2 * ntc - nsl); mode = 3; base = j * 64; lo = t - 512; hi = t; full = (j < i) && (j > i - 8); }
      const int lo_rel = lo - (base + 4 * h), hi_rel = hi - (base + 4 * h);
      const bool chk = ((n & 7) == 7) || mode == 0;
#pragma unroll
      for (int r = 0; r < 16; ++r) { O0[r] *= oscale; O1[r] *= oscale; }
      const char* kb = smem + st_cur * AT_BUF;
      const char* vb = kb + AT_KB;
      st_cur = st_cur == AT_NST - 1 ? 0 : st_cur + 1; st_iss = st_iss == AT_NST - 1 ? 0 : st_iss + 1;
      f32x16 S0, S1;
#define ATT_BODY(MASKED) do { \
      _Pragma("unroll") for (int r = 0; r < 16; ++r) { S0[r] = 0.f; S1[r] = 0.f; } \
      const float m_use = (m_run == NINF) ? 0.f : m_run;        \
      { \
          \
        const float negm = (!(MASKED) && !lane_on) ? NINF : -m_use; \
        u32x4 qxw; qxw[0] = (h == 0) ? (cvtpk(negm, 0.f) & 0xffffu) : 0u; qxw[1] = 0u; qxw[2] = 0u; qxw[3] = 0u; \
        const bf16x8 qx = __builtin_bit_cast(bf16x8, qxw); \
        S0 = MFMA32(kx, qx, S0); S1 = MFMA32(kx, qx, S1); \
      } \
      { \
        bf16x8 kf0[4], kf1[4]; \
        _Pragma("unroll") for (int ks = 0; ks < 4; ++ks) { \
          kf0[ks] = *(const bf16x8*)(kb + c32 * 128 + (((ks * 2 + h) ^ ksw) * 16)); \
          kf1[ks] = *(const bf16x8*)(kb + (32 + c32) * 128 + (((ks * 2 + h) ^ ksw) * 16)); \
        } \
        _Pragma("unroll") for (int ks = 0; ks < 4; ++ks) S0 = MFMA32(kf0[ks], qf[ks], S0);     \
        _Pragma("unroll") for (int ks = 0; ks < 4; ++ks) S1 = MFMA32(kf1[ks], qf[ks], S1); \
      } \
        \
      if ((MASKED) == 2) {                       \
        _Pragma("unroll") for (int r = 0; r < 16; ++r) { \
          const int off = (r & 3) + 8 * (r >> 2); \
          S0[r] = (off > lo_rel && off <= hi_rel) ? S0[r] : NINF; \
          S1[r] = (off + 32 > lo_rel && off + 32 <= hi_rel) ? S1[r] : NINF; \
        } \
      } else if (MASKED) {                       \
        _Pragma("unroll") for (int r = 0; r < 16; ++r) { \
          const int off = (r & 3) + 8 * (r >> 2); \
          S0[r] = (off <= hi_rel) ? S0[r] : NINF; \
          S1[r] = (off + 32 <= hi_rel) ? S1[r] : NINF; \
        } \
      } \
      float ps0 = 0.f, ps1 = 0.f; \
      bf16x8 vfa[4]; \
      _Pragma("unroll") for (int kk = 0; kk < 2; ++kk) \
        _Pragma("unroll") for (int dr = 0; dr < 2; ++dr) vfa[kk * 2 + dr] = *(const bf16x8*)(vb + (32 * dr + c32) * 128 + (((2 * kk + h) ^ ksw) * 16)); \
      _Pragma("unroll") for (int r = 0; r < 16; ++r) { S0[r] = __builtin_amdgcn_exp2f(S0[r]); ps0 += S0[r]; } \
      _Pragma("unroll") for (int kk = 0; kk < 2; ++kk) { \
        u32x4 pw; \
        _Pragma("unroll") for (int e = 0; e < 4; ++e) pw[e] = cvtpk(S0[8 * kk + 2 * e], S0[8 * kk + 2 * e + 1]); \
        const bf16x8 pf = __builtin_bit_cast(bf16x8, pw); \
        O0 = MFMA32(vfa[kk * 2], pf, O0); O1 = MFMA32(vfa[kk * 2 + 1], pf, O1); \
      } \
      __builtin_amdgcn_sched_group_barrier(0x100, 12, 0);     \
      __builtin_amdgcn_sched_group_barrier(0x008, 4, 0);      \
      _Pragma("unroll") for (int q_ = 0; q_ < 4; ++q_) { __builtin_amdgcn_sched_group_barrier(0x008, 1, 0); __builtin_amdgcn_sched_group_barrier(0x002, 9, 0); }     \
      __builtin_amdgcn_sched_barrier(0); \
      _Pragma("unroll") for (int r = 0; r < 16; ++r) { S1[r] = __builtin_amdgcn_exp2f(S1[r]); ps1 += S1[r]; } \
      _Pragma("unroll") for (int kk = 0; kk < 2; ++kk) { \
        u32x4 pw; \
        _Pragma("unroll") for (int e = 0; e < 4; ++e) pw[e] = cvtpk(S1[8 * kk + 2 * e], S1[8 * kk + 2 * e + 1]); \
        const bf16x8 pf = __builtin_bit_cast(bf16x8, pw); \
        const bf16x8 va0 = *(const bf16x8*)(vb + c32 * 128 + (((2 * (kk + 2) + h) ^ ksw) * 16)), va1 = *(const bf16x8*)(vb + (32 + c32) * 128 + (((2 * (kk + 2) + h) ^ ksw) * 16)); \
        O0 = MFMA32(va0, pf, O0); O1 = MFMA32(va1, pf, O1); \
      } \
      __builtin_amdgcn_sched_barrier(0); \
      oscale = 1.0f; \
      if (mode != 1) l_run += ps0 + ps1; \
      if (mode != 1 && chk) {                    \
        float mxp = fmaxf(fmaxf(S0[0], S0[1]), S1[0]); \
        mxp = fmaxf(fmaxf(mxp, S1[1]), S0[2]); \
        _Pragma("unroll") for (int r = 2; r < 16; r += 2) { \
          if (r > 2) mxp = fmaxf(fmaxf(mxp, S0[r]), S1[r - 1]); \
          mxp = fmaxf(fmaxf(mxp, S0[r + 1]), S1[r]); \
        } \
        mxp = fmaxf(mxp, S1[15]); \
        mxp = fmaxf(mxp, __shfl_xor(mxp, 32));            \
        const bool mv = (m_run == NINF) ? (mxp > 0.f) : (mxp > 256.0f); \
        const float m_new = bflo(cvtpk(m_use + __builtin_amdgcn_logf(mxp), 0.f));       \
        const float alpha = mv ? __builtin_amdgcn_exp2f(m_use - m_new) : 1.0f; \
        m_run = mv ? m_new : m_run; \
        l_run *= alpha; \
        oscale = alpha; \
      } \
      if ((MASKED) == 1 && mode == 1 && need_sel) {               \
        const int tt = base >> 6; \
        _Pragma("unroll") for (int kr = 0; kr < 2; ++kr) \
          _Pragma("unroll") for (int rg = 0; rg < 4; ++rg) { \
            float pv[4]; \
            _Pragma("unroll") for (int e = 0; e < 4; ++e) { \
              float v = (kr ? S1[rg * 4 + e] : S0[rg * 4 + e]) * inv_l; \
              v += qperm<0xB1>(v); v += qperm<0x4E>(v);            \
              pv[e] = v; \
            } \
            if (hd == 0) { \
              const int nblk = tt * 16 + 8 * kr + 2 * rg + h; \
              impa[tl * 65 + nblk] = pv[0] + pv[1] + pv[2] + 0.5f * pv[3]; \
              impb[tl * 65 + nblk] = 0.5f * pv[3]; \
            } \
          } \
      } } while (0)
      if (full) ATT_BODY(0); else if (mode == 3 && base < i * 64) ATT_BODY(2); else ATT_BODY(1);
#undef ATT_BODY
      if (n == ntc - 1) {
        const float lt = l_run + __shfl_xor(l_run, 32);
        inv_l = lt > 0.f ? 1.0f / lt : 0.f;
        oscale = 0.f;
      } else if (n == 2 * ntc - 1) {
        if (need_sel) {
          __syncthreads();
          for (int q = 0; q < 8; ++q) {
            const int tk = wid * 8 + q, nn = lane;
            const bool forced = (nn == 0) || (nn == i) || (nn == i - 1);
            const bool vis = nn <= i;
            float v = 0.f;
            if (vis) v = impa[tk * 65 + nn] + (nn > 0 ? impb[tk * 65 + nn - 1] : 0.f);
            const unsigned bse = forced ? 0x4E6E6B28u : __float_as_uint(v);
            const unsigned key = (bse & ~127u) | (vis ? 64u : 0u) | (unsigned)(63 - nn);
            unsigned T = 0u;
#pragma unroll 1
            for (int bbit = 31; bbit >= 0; --bbit) {
              const unsigned Tc = T | (1u << bbit);
              const unsigned long long mk = __builtin_amdgcn_ballot_w64(key >= Tc);
              if (__builtin_popcountll(mk) >= 16) T = Tc;
            }
            const unsigned long long sel = __builtin_amdgcn_ballot_w64(key >= T);
            if (lane == 0) { selm[tk * 2] = (unsigned)sel; selm[tk * 2 + 1] = (unsigned)(sel >> 32); }
          }
          __syncthreads();
          sel_lo = selm[tl * 2]; sel_hi = selm[tl * 2 + 1];
        }
        {
          const float wgt = g0 * inv_l * oscale;
#pragma unroll
          for (int r = 0; r < 16; ++r) { fl[r * 64] = wgt * O0[r]; fl[(16 + r) * 64] = wgt * O1[r]; }
          m_run = NINF; l_run = 0.f; oscale = 0.f;
        }
      } else if (n == 2 * ntc + nsl - 1) {
        const float lt = l_run + __shfl_xor(l_run, 32);
        const float wgt = g1 * (lt > 0.f ? 1.0f / lt : 0.f) * oscale;
#pragma unroll
        for (int r = 0; r < 16; ++r) { fl[r * 64] += wgt * O0[r]; fl[(16 + r) * 64] += wgt * O1[r]; }
        m_run = NINF; l_run = 0.f; oscale = 0.f;
      }
    }
#undef TILE_PTRS
#undef TISSUE
    {
      const float lt = l_run + __shfl_xor(l_run, 32);
      const float wgt = g2 * (lt > 0.f ? 1.0f / lt : 0.f) * oscale;
      const size_t rowo = (size_t)(b * 4096 + t);
      const u16* zp = ws_zs(p) + rowo * 512 + (g * 4 + hd) * 64;
      u16* mp = ws_mix(p) + rowo * LDK + (g * 4 + hd) * 64;
      u32x2 zv8[8];
#pragma unroll
      for (int q = 0; q < 8; ++q) zv8[q] = *(const u32x2*)(zp + 32 * (q >> 2) + 8 * (q & 3) + 4 * h);
#pragma unroll
      for (int dr = 0; dr < 2; ++dr)
#pragma unroll
        for (int rg = 0; rg < 4; ++rg) {
          const int d = 32 * dr + 8 * rg + 4 * h;
          const u32x2 zv = zv8[dr * 4 + rg];
          const float f0 = fl[(dr * 16 + rg * 4 + 0) * 64] + wgt * (dr ? O1[rg * 4 + 0] : O0[rg * 4 + 0]);
          const float f1 = fl[(dr * 16 + rg * 4 + 1) * 64] + wgt * (dr ? O1[rg * 4 + 1] : O0[rg * 4 + 1]);
          const float f2 = fl[(dr * 16 + rg * 4 + 2) * 64] + wgt * (dr ? O1[rg * 4 + 2] : O0[rg * 4 + 2]);
          const float f3 = fl[(dr * 16 + rg * 4 + 3) * 64] + wgt * (dr ? O1[rg * 4 + 3] : O0[rg * 4 + 3]);
          u32x2 o;
          o[0] = cvtpk(f0 * bflo(zv[0]), f1 * bfhi(zv[0]));
          o[1] = cvtpk(f2 * bflo(zv[1]), f3 * bfhi(zv[1]));
          *(u32x2*)(mp + d) = o;
        }
    }
  }
}

#define XB_TMO      128
#define XB_XCNT(j)  (256  + 64 * (j))
#define XB_XSUB(j)  (1280 + 64 * (j))
#define XB_XGEN(j)  (2304 + 64 * (j))
#define XB_TOP      3328
#define XB_TOPGEN   3392
#define XCD_BAR_WORDS 3456
#define XB_SPIN_CAP (1u << 18)
#define LAS __attribute__((address_space(3)))

__device__ __forceinline__ unsigned xb_ld(unsigned* p)              { return __hip_atomic_load(p, __ATOMIC_RELAXED, __HIP_MEMORY_SCOPE_AGENT); }
__device__ __forceinline__ unsigned xb_add(unsigned* p, unsigned v) { return __hip_atomic_fetch_add(p, v, __ATOMIC_RELAXED, __HIP_MEMORY_SCOPE_AGENT); }
__device__ __forceinline__ unsigned xb_xcc_id() { return (unsigned)__builtin_amdgcn_s_getreg((3 << 11) | 20) & 0xFu; }
#define XB_SPIN(cond, bar) do { unsigned _sp = 0; while (cond) { __builtin_amdgcn_s_sleep(1); \
    if ((++_sp & 255u) == 0u) { if (xb_ld(&(bar)[XB_TMO])) break; if (_sp > XB_SPIN_CAP) { atomicAdd(&(bar)[XB_TMO], 1u); break; } } } } while (0)

struct XcdBarrier {
    unsigned* bar; unsigned x;
    volatile LAS unsigned* st;
};

__device__ __forceinline__ XcdBarrier xcd_barrier_post(unsigned* bar, volatile LAS unsigned* st) {
    XcdBarrier b; b.bar = bar; b.x = xb_xcc_id(); b.st = st;
    if (threadIdx.x == 0) (void)xb_add(&bar[XB_XCNT(b.x)], 1u);
    return b;
}
__device__ __forceinline__ void xcd_barrier_complete(unsigned* bar, unsigned x, unsigned& nloc, unsigned& nx) {
    const unsigned G = gridDim.x * gridDim.y * gridDim.z;
    unsigned sum, cnt, mine, sp = 0u;
    for (;;) {
        sum = 0u; cnt = 0u; mine = 0u;
#pragma unroll
        for (unsigned j = 0; j < 16; ++j) { const unsigned c = xb_ld(&bar[XB_XCNT(j)]); sum += c; cnt += (c > 0u) ? 1u : 0u; mine = (j == x) ? c : mine; }
        if (sum == G) break;
        __builtin_amdgcn_s_sleep(1);
        if ((++sp & 255u) == 0u) { if (xb_ld(&bar[XB_TMO])) break; if (sp > XB_SPIN_CAP) { atomicAdd(&bar[XB_TMO], 1u); break; } }
    }
    nloc = mine > 0u ? mine : 1u; nx = cnt > 0u ? cnt : 1u;
}

__device__ __forceinline__ void xcd_barrier(const XcdBarrier& b) {
    asm volatile("s_waitcnt vmcnt(0)" ::: "memory");
    __syncthreads();
    if (threadIdx.x == 0) {
        unsigned* bar = b.bar;
        __builtin_amdgcn_s_waitcnt(0);
        unsigned nloc = b.st[0], nx = b.st[1];
        if (nloc == 0u) { xcd_barrier_complete(bar, b.x, nloc, nx); b.st[0] = nloc; b.st[1] = nx; }
        const unsigned old = xb_add(&bar[XB_XSUB(b.x)], 1u);
        const unsigned gen = old / nloc;
        if (old + 1u == (gen + 1u) * nloc) {
            __builtin_amdgcn_fence(__ATOMIC_RELEASE, "agent");
            asm volatile("s_waitcnt vmcnt(0)" ::: "memory");
            const unsigned og = xb_add(&bar[XB_TOP], 1u);
            const unsigned tg = og / nx;
            if (og + 1u == (tg + 1u) * nx) xb_add(&bar[XB_TOPGEN], 1u);
            else XB_SPIN(xb_ld(&bar[XB_TOPGEN]) == tg, bar);
            __builtin_amdgcn_fence(__ATOMIC_ACQUIRE, "agent");
            xb_add(&bar[XB_XGEN(b.x)], 1u);
            asm volatile("s_waitcnt vmcnt(0)" ::: "memory");
        } else {
            XB_SPIN(xb_ld(&bar[XB_XGEN(b.x)]) == gen, bar);
            __builtin_amdgcn_fence(__ATOMIC_ACQUIRE, "agent");
            asm volatile("s_waitcnt vmcnt(0)" ::: "memory");
        }
    }
    __syncthreads();
}


#if FUSED
extern "C" __global__ void __launch_bounds__(NTHREADS) hybrid_fwd(Params p) {
  extern __shared__ __attribute__((aligned(16))) char smem[];
  cg::grid_group grid = cg::this_grid();
  const int bid = blockIdx.x, nb = gridDim.x;
  if (threadIdx.x < 4) ((volatile unsigned*)(smem + SMEM_BYTES))[threadIdx.x] = 0u;
  __syncthreads();
  if (bid == 0) { for (int w_ = threadIdx.x; w_ < XCD_BAR_WORDS; w_ += NTHREADS) ws_bar(p)[w_] = 0u; }
  for (int r = 0; r < REP0; ++r) { phase_prep(p, smem, bid, nb); grid.sync(); }
  XcdBarrier xb = xcd_barrier_post(ws_bar(p), (volatile LAS unsigned*)(smem + SMEM_BYTES));
  for (int r = 0; r < REP1; ++r) { gemm_phase<0>(p, smem, bid, nb); xcd_barrier(xb); }
  for (int r = 0; r < REP2; ++r) { phase_cmp_conv(p, smem, bid, nb); xcd_barrier(xb); }
  for (int r = 0; r < REP3; ++r) { phase_attn(p, smem, bid, nb, r); xcd_barrier(xb); }
  for (int r = 0; r < REP4; ++r) { gemm_phase<1>(p, smem, bid, nb); }
}
#else
template <int PH>
__global__ void __launch_bounds__(NTHREADS) phase_kernel(Params p) {
  extern __shared__ __attribute__((aligned(16))) char smem[];
  const int bid = blockIdx.x, nb = gridDim.x;
  if constexpr (PH == 0) phase_prep(p, smem, bid, nb);
  if constexpr (PH == 1) gemm_phase<0>(p, smem, bid, nb);
  if constexpr (PH == 2) phase_cmp_conv(p, smem, bid, nb);
  if constexpr (PH == 3) phase_attn(p, smem, bid, nb, 0);
  if constexpr (PH == 4) gemm_phase<1>(p, smem, bid, nb);
}
#endif

extern "C" void kernel_launch(void* const* d_in, const int* in_sizes, int n_in, void* d_out, int out_size, void* d_ws, size_t ws_size, hipStream_t stream) {
  Params p{};
  p.x = (const float*)d_in[0]; p.norm_w = (const float*)d_in[1]; p.w_in = (const float*)d_in[2]; p.q_norm_w = (const float*)d_in[3];
  p.k_norm_w = (const float*)d_in[4]; p.ck_pos = (const float*)d_in[5]; p.ck_w1 = (const float*)d_in[6]; p.ck_b1 = (const float*)d_in[7];
  p.ck_w2 = (const float*)d_in[8]; p.cv_pos = (const float*)d_in[9]; p.cv_w1 = (const float*)d_in[10]; p.cv_b1 = (const float*)d_in[11];
  p.cv_w2 = (const float*)d_in[12]; p.conv_w = (const float*)d_in[13]; p.conv_b = (const float*)d_in[14]; p.w_out = (const float*)d_in[15];
  p.out = (float*)d_out;
  p.ws = (char*)d_ws;
  const size_t off = WS_TOTAL;
  if (off > ws_size) { fprintf(stderr, "kernel_launch: workspace too small (%zu > %zu)\n", off, ws_size); return; }

#if FUSED
  static int grid_blocks = 0;
  if (!grid_blocks) {
    int dev = 0, cus = 0, per_cu = 0;
    hipGetDevice(&dev);
    hipDeviceGetAttribute(&cus, hipDeviceAttributeMultiprocessorCount, dev);
    hipFuncSetAttribute((const void*)hybrid_fwd, hipFuncAttributeMaxDynamicSharedMemorySize, SMEM_BYTES + 16);
    hipOccupancyMaxActiveBlocksPerMultiprocessor(&per_cu, (const void*)hybrid_fwd, NTHREADS, SMEM_BYTES + 16);
    if (per_cu < 1) per_cu = 1;
    grid_blocks = cus * per_cu;
  }
  void* args[] = {&p};
  hipError_t e = hipLaunchCooperativeKernel((const void*)hybrid_fwd, dim3(grid_blocks), dim3(NTHREADS), args, SMEM_BYTES + 16, stream);
  if (e != hipSuccess) fprintf(stderr, "cooperative launch failed: %s (grid %d)\n", hipGetErrorString(e), grid_blocks);
#else
  static int attr_set = 0;
  if (!attr_set) {
    (void)hipFuncSetAttribute((const void*)phase_kernel<0>, hipFuncAttributeMaxDynamicSharedMemorySize, SMEM_BYTES);
    (void)hipFuncSetAttribute((const void*)phase_kernel<1>, hipFuncAttributeMaxDynamicSharedMemorySize, SMEM_BYTES);
    (void)hipFuncSetAttribute((const void*)phase_kernel<2>, hipFuncAttributeMaxDynamicSharedMemorySize, SMEM_BYTES);
    (void)hipFuncSetAttribute((const void*)phase_kernel<3>, hipFuncAttributeMaxDynamicSharedMemorySize, SMEM_BYTES);
    (void)hipFuncSetAttribute((const void*)phase_kernel<4>, hipFuncAttributeMaxDynamicSharedMemorySize, SMEM_BYTES);
    attr_set = 1;
  }
  const int G = 256;
  phase_kernel<0><<<G, NTHREADS, SMEM_BYTES, stream>>>(p);
  phase_kernel<1><<<G, NTHREADS, SMEM_BYTES, stream>>>(p);
  phase_kernel<2><<<G, NTHREADS, SMEM_BYTES, stream>>>(p);
  phase_kernel<3><<<G, NTHREADS, SMEM_BYTES, stream>>>(p);
  phase_kernel<4><<<G, NTHREADS, SMEM_BYTES, stream>>>(p);
#endif
}
```

```cpp
#include <hip/hip_runtime.h>
#include <hip/hip_cooperative_groups.h>
#include <cstdio>
#include <cstdint>
namespace cg = cooperative_groups;

#ifndef FUSED
#define FUSED 1
#endif
#define REP0 1
#define REP1 1
#define REP2 1
#define REP3 1
#define REP4 1

#define DI __device__ __forceinline__
typedef unsigned short u16;
using bf16x8 = __attribute__((ext_vector_type(8))) short;
using s16x4 = __attribute__((ext_vector_type(4))) short;
using f32x4 = __attribute__((ext_vector_type(4))) float;
using f32x16 = __attribute__((ext_vector_type(16))) float;
using u32x4 = __attribute__((ext_vector_type(4))) unsigned;
using u32x2 = __attribute__((ext_vector_type(2))) unsigned;
typedef __bf16 bf2_t __attribute__((ext_vector_type(2)));
typedef float fl2_t __attribute__((ext_vector_type(2)));

constexpr int NTHREADS = 512;
constexpr int SEQ = 4096, DM = 1024, DIN = 3864, NROWS = 32768;
constexpr int LDK = 1088;
constexpr float EPS = 1e-6f;
constexpr float QSCALE = 0.125f * 1.4426950408889634f;
constexpr int SMEM_BYTES = 148480;

__constant__ float c_invf[8] = {1.0f, 0.1939227432012558f, 0.03760603070259094f, 0.007292664609849453f,
                                0.0014142135623842478f, 0.00027424818836152554f, 5.3182957344688475e-05f, 1.0313385246263351e-05f};

DI unsigned cvtpk(float lo, float hi) {
  fl2_t f = {lo, hi};
  bf2_t b = __builtin_convertvector(f, bf2_t);
  return __builtin_bit_cast(unsigned, b);
}
DI u16 f2bf(float x) { return (u16)(cvtpk(x, 0.f) & 0xffffu); }
DI float bf2f(u16 v) { return __uint_as_float(((unsigned)v) << 16); }
DI float bflo(unsigned v) { return __uint_as_float(v << 16); }
DI float bfhi(unsigned v) { return __uint_as_float(v & 0xffff0000u); }
DI float sigmoidf_(float v) { return __builtin_amdgcn_rcpf(1.0f + __builtin_amdgcn_exp2f(-1.4426950408889634f * v)); }
DI float siluf_(float v) { return v * __builtin_amdgcn_rcpf(1.0f + __builtin_amdgcn_exp2f(-1.4426950408889634f * v)); }
DI void glds16(const void* g, unsigned lds_base) {
  unsigned sv;
  asm volatile("s_mov_b32 %0, m0\n\ts_mov_b32 m0, %2\n\ts_nop 0\n\tglobal_load_lds_dwordx4 %1, off\n\ts_mov_b32 m0, %0" : "=&s"(sv) : "v"(g), "s"(lds_base) : "memory");
}
template <int CTRL> DI float qperm(float v) { return __int_as_float(__builtin_amdgcn_update_dpp(0, __float_as_int(v), CTRL, 0xF, 0xF, true)); }
#define MFMA16(a, b, c) __builtin_amdgcn_mfma_f32_16x16x32_bf16((a), (b), (c), 0, 0, 0)
#define MFMA32(a, b, c) __builtin_amdgcn_mfma_f32_32x32x16_bf16((a), (b), (c), 0, 0, 0)

struct Params {
  const float *x, *norm_w, *w_in, *q_norm_w, *k_norm_w, *ck_pos, *ck_w1, *ck_b1, *ck_w2, *cv_pos, *cv_w1, *cv_b1, *cv_w2, *conv_w, *conv_b, *w_out;
  float* out;
  char* ws;
};
constexpr size_t al256(size_t v) { return (v + 255) & ~(size_t)255; }
constexpr size_t OFF_xb = 0;
DI u16* ws_xb(const Params& p) { return (u16*)(p.ws + OFF_xb); }
constexpr size_t OFF_winT = OFF_xb + al256((size_t)NROWS * LDK * 2);
DI u16* ws_winT(const Params& p) { return (u16*)(p.ws + OFF_winT); }
constexpr size_t OFF_woutT = OFF_winT + al256((size_t)4096 * LDK * 2);
DI u16* ws_woutT(const Params& p) { return (u16*)(p.ws + OFF_woutT); }
constexpr size_t OFF_w1kT = OFF_woutT + al256((size_t)1024 * LDK * 2);
DI u16* ws_w1kT(const Params& p) { return (u16*)(p.ws + OFF_w1kT); }
constexpr size_t OFF_w1vT = OFF_w1kT + al256((size_t)128 * 2048 * 2);
DI u16* ws_w1vT(const Params& p) { return (u16*)(p.ws + OFF_w1vT); }
constexpr size_t OFF_w2kT = OFF_w1vT + al256((size_t)128 * 2048 * 2);
DI u16* ws_w2kT(const Params& p) { return (u16*)(p.ws + OFF_w2kT); }
constexpr size_t OFF_w2vT = OFF_w2kT + al256((size_t)64 * 128 * 2);
DI u16* ws_w2vT(const Params& p) { return (u16*)(p.ws + OFF_w2vT); }
constexpr size_t OFF_Q = OFF_w2vT + al256((size_t)64 * 128 * 2);
DI u16* ws_Q(const Params& p) { return (u16*)(p.ws + OFF_Q); }
constexpr size_t OFF_Ks = OFF_Q + al256((size_t)NROWS * 512 * 2);
DI u16* ws_Ks(const Params& p) { return (u16*)(p.ws + OFF_Ks); }
constexpr size_t OFF_Kw = OFF_Ks + al256((size_t)16 * 4096 * 64 * 2);
DI u16* ws_Kw(const Params& p) { return (u16*)(p.ws + OFF_Kw); }
constexpr size_t OFF_Vst = OFF_Kw + al256((size_t)16 * 4096 * 64 * 2);
DI u16* ws_Vst(const Params& p) { return (u16*)(p.ws + OFF_Vst); }
constexpr size_t OFF_Vwt = OFF_Vst + al256((size_t)16 * 4096 * 64 * 2);
DI u16* ws_Vwt(const Params& p) { return (u16*)(p.ws + OFF_Vwt); }
constexpr size_t OFF_kcraw = OFF_Vwt + al256((size_t)16 * 4096 * 64 * 2);
DI u16* ws_kcraw(const Params& p) { return (u16*)(p.ws + OFF_kcraw); }
constexpr size_t OFF_vcraw = OFF_kcraw + al256((size_t)16 * 4096 * 64 * 2 + 4096);
DI u16* ws_vcraw(const Params& p) { return (u16*)(p.ws + OFF_vcraw); }
constexpr size_t OFF_Kc = OFF_vcraw + al256((size_t)16 * 4096 * 64 * 2 + 4096);
DI u16* ws_Kc(const Params& p) { return (u16*)(p.ws + OFF_Kc); }
constexpr size_t OFF_Vct = OFF_Kc + al256((size_t)16 * 256 * 64 * 2);
DI u16* ws_Vct(const Params& p) { return (u16*)(p.ws + OFF_Vct); }
constexpr size_t OFF_zs = OFF_Vct + al256((size_t)16 * 256 * 64 * 2);
DI u16* ws_zs(const Params& p) { return (u16*)(p.ws + OFF_zs); }
constexpr size_t OFF_cvb = OFF_zs + al256((size_t)NROWS * 512 * 2);
DI u16* ws_cvb(const Params& p) { return (u16*)(p.ws + OFF_cvb); }
constexpr size_t OFF_mix = OFF_cvb + al256((size_t)NROWS * 2048 * 2);
DI u16* ws_mix(const Params& p) { return (u16*)(p.ws + OFF_mix); }
constexpr size_t OFF_rs = OFF_mix + al256((size_t)NROWS * LDK * 2);
DI float* ws_rs(const Params& p) { return (float*)(p.ws + OFF_rs); }
constexpr size_t OFF_ckpart = OFF_rs + al256((size_t)NROWS * 4);
DI float* ws_ckpart(const Params& p) { return (float*)(p.ws + OFF_ckpart); }
constexpr size_t OFF_rope = OFF_ckpart + al256((size_t)16 * 128 * 4);
DI float* ws_rope(const Params& p) { return (float*)(p.ws + OFF_rope); }
constexpr size_t OFF_gates = OFF_rope + al256((size_t)4096 * 8 * 2 * 4);
DI float* ws_gates(const Params& p) { return (float*)(p.ws + OFF_gates); }
constexpr size_t OFF_counter = OFF_gates + al256((size_t)NROWS * 24 * 4);
DI unsigned* ws_counter(const Params& p) { return (unsigned*)(p.ws + OFF_counter); }
constexpr size_t OFF_bar = OFF_counter + al256((size_t)256);
DI unsigned* ws_bar(const Params& p) { return (unsigned*)(p.ws + OFF_bar); }
constexpr size_t WS_TOTAL = OFF_bar + al256((size_t)3456 * 4);


DI void transpose_tile(const float* __restrict__ src, u16* __restrict__ dst, int K, int N, const float* __restrict__ scale, int kt, int nt, char* smem, int ldd) {
  float* tile = (float*)smem;
  const int tid = threadIdx.x;
  float v[8], sc[8];
  const int nn0 = tid & 63, n0_ = nt * 64 + nn0, nc = n0_ < N ? n0_ : N - 1;
#pragma unroll
  for (int i = 0; i < 8; ++i) {
    const int k = kt * 64 + i * 8 + (tid >> 6);
    v[i] = src[(size_t)k * N + nc];
    sc[i] = scale ? scale[k] : 1.0f;
  }
#pragma unroll
  for (int i = 0; i < 8; ++i) tile[(i * 8 + (tid >> 6)) * 65 + nn0] = (n0_ < N) ? v[i] * sc[i] : 0.f;
  __syncthreads();
#pragma unroll
  for (int i = 0; i < 8; ++i) {
    const int nn = i * 8 + (tid >> 6), kk = tid & 63;
    dst[(size_t)(nt * 64 + nn) * ldd + kt * 64 + kk] = f2bf(tile[kk * 65 + nn]);
  }
  __syncthreads();
}

__device__ void phase_prep(const Params& p, char* smem, int bid, int nb) {
  int tid_ = threadIdx.x; asm volatile("" : "+v"(tid_));
  const int tid = tid_, lane = tid & 63, wid = __builtin_amdgcn_readfirstlane(tid >> 6);
  constexpr int J_X = 1024, J_TW = 1024, J_TO = 256, J_T1 = 64, J_T2 = 2, J_CK = 16, J_ROPE = 64;
  constexpr int TOTAL = J_X + J_TW + J_TO + 2 * J_T1 + 2 * J_T2 + J_CK + J_ROPE;
  if (bid == 0 && tid < 8) ws_counter(p)[tid] = 0u;
  for (int j = bid; j < TOTAL; j += nb) {
    constexpr int HEAD = J_CK + J_ROPE;
    int jj = j < HEAD ? (TOTAL - HEAD) + j : j - HEAD;
    if (jj < J_X) {
      const int row0 = jj * 32 + wid * 4;
      float4 v[4][4]; float ss[4];
#pragma unroll
      for (int r = 0; r < 4; ++r) {
        const float4* xr = (const float4*)(p.x + (size_t)(row0 + r) * DM);
#pragma unroll
        for (int i = 0; i < 4; ++i) v[r][i] = xr[i * 64 + lane];
      }
#pragma unroll
      for (int r = 0; r < 4; ++r) {
        float a = 0.f;
#pragma unroll
        for (int i = 0; i < 4; ++i) a += v[r][i].x * v[r][i].x + v[r][i].y * v[r][i].y + v[r][i].z * v[r][i].z + v[r][i].w * v[r][i].w;
#pragma unroll
        for (int o = 32; o >= 1; o >>= 1) a += __shfl_xor(a, o);
        ss[r] = a;
      }
#pragma unroll
      for (int r = 0; r < 4; ++r) {
        if (lane == 0) ws_rs(p)[row0 + r] = rsqrtf(ss[r] * (1.0f / DM) + EPS);
#pragma unroll
        for (int i = 0; i < 4; ++i) {
          u32x2 o; o[0] = cvtpk(v[r][i].x, v[r][i].y); o[1] = cvtpk(v[r][i].z, v[r][i].w);
          const int rr_ = row0 + r;
          *(u32x2*)(ws_xb(p) + ((size_t)((rr_ >> 8) * 16 + i * 4 + (lane >> 4)) * 256 + (rr_ & 255)) * 64 + (lane & 15) * 4) = o;
        }
      }
      continue;
    }
    jj -= J_X;
    if (jj < J_TW) { transpose_tile(p.w_in, ws_winT(p), 1024, DIN, p.norm_w, jj & 15, jj >> 4, smem, LDK); continue; }
    jj -= J_TW;
    if (jj < J_TO) { transpose_tile(p.w_out, ws_woutT(p), 1024, 1024, nullptr, jj & 15, jj >> 4, smem, LDK); continue; }
    jj -= J_TO;
    if (jj < J_T1) { transpose_tile(p.ck_w1, ws_w1kT(p), 2048, 128, nullptr, jj & 31, jj >> 5, smem, 2048); continue; }
    jj -= J_T1;
    if (jj < J_T1) { transpose_tile(p.cv_w1, ws_w1vT(p), 2048, 128, nullptr, jj & 31, jj >> 5, smem, 2048); continue; }
    jj -= J_T1;
    if (jj < J_T2) { transpose_tile(p.ck_w2, ws_w2kT(p), 128, 64, nullptr, jj, 0, smem, 128); continue; }
    jj -= J_T2;
    if (jj < J_T2) { transpose_tile(p.cv_w2, ws_w2vT(p), 128, 64, nullptr, jj, 0, smem, 128); continue; }
    jj -= J_T2;
    if (jj < J_CK) {
      const int which = jj >> 3, chunk = jj & 7, hh = tid & 127, sub = tid >> 7;
      const float* pos = which ? p.cv_pos : p.ck_pos;
      const float* w1 = which ? p.cv_w1 : p.ck_w1;
      float acc = 0.f;
      const int f0 = chunk * 256 + sub * 64;
      float pv_[64], wv_[64];
#pragma unroll
      for (int f = 0; f < 64; ++f) { pv_[f] = pos[f0 + f]; wv_[f] = w1[(size_t)(f0 + f) * 128 + hh]; }
#pragma unroll
      for (int f = 0; f < 64; ++f) acc += pv_[f] * wv_[f];
      float* red = (float*)smem;
      red[sub * 128 + hh] = acc;
      __syncthreads();
      if (tid < 128) ws_ckpart(p)[(which * 8 + chunk) * 128 + tid] = red[tid] + red[128 + tid] + red[256 + tid] + red[384 + tid];
      __syncthreads();
      continue;
    }
    jj -= J_CK;
    {
      const int idx = jj * 512 + tid, pos = idx >> 3, fi = idx & 7;
      const float ang = (float)pos * c_invf[fi];
      float s, c; sincosf(ang, &s, &c);
      ws_rope(p)[idx * 2] = c; ws_rope(p)[idx * 2 + 1] = s;
    }
  }
}

DI int kimg_off(int row, int d) { return row * 64 + (((d >> 3) ^ ((row >> 1) & 7)) * 8) + (d & 7); }
DI int vimg_off(int d, int key) {
  const int kp = (key & ~12) | ((key & 4) << 1) | ((key & 8) >> 1);
  return d * 64 + (((kp >> 3) ^ ((d >> 1) & 7)) * 8) + (kp & 7);
}

constexpr int G_ASZ = 256 * 128, G_BSZ = 256 * 128, G_STAGE = G_ASZ + G_BSZ;
constexpr int G_ROPE = 2 * G_STAGE, G_RS = G_ROPE + 256 * 64;
static_assert(G_RS + 1024 <= SMEM_BYTES, "GEMM LDS layout exceeds the dynamic LDS size");
#define WAIT_VM(n) asm volatile("s_waitcnt vmcnt(" #n ")" ::: "memory")

template <int EPI>
__device__ void gemm_phase(const Params& p, char* smem, int bid, int nb) {
  constexpr int NT = EPI == 0 ? 16 : 4;
  constexpr int MT = 128;
  const u16* __restrict__ A = EPI == 0 ? ws_xb(p) : ws_mix(p);
  const u16* __restrict__ Bt = EPI == 0 ? ws_winT(p) : ws_woutT(p);
  int tid_ = threadIdx.x; asm volatile("" : "+v"(tid_));
  const int tid = tid_, lane = tid & 63, wid = __builtin_amdgcn_readfirstlane(tid >> 6), fr = lane & 15, fq = lane >> 4;
  const int wr = wid >> 2, wc = wid & 3;
  const bool xmap = (nb == 256);
  const int xcd = bid & 7, li = bid >> 3;
  const int ntiles = xmap ? (EPI == 0 ? 8 : 2) : (MT * NT - bid + nb - 1) / nb;
  auto tile_of = [&](int ti, int& m0, int& n0) {
    if (xmap) {
      const int sg = ti * 8 + xcd;
      if (EPI == 0) { m0 = ((sg >> 1) * 4 + (li >> 3)) * 256; n0 = ((sg & 1) * 8 + (li & 7)) * 256; }
      else { m0 = (sg * 8 + (li >> 2)) * 256; n0 = (li & 3) * 256; }
    } else { const int tile = bid + ti * nb; const int mt = tile / NT; m0 = mt * 256; n0 = (tile - mt * NT) * 256; }
  };
  const int nsteps = ntiles * 16;
  const unsigned lds0 = (unsigned)(uintptr_t)smem;
  const int gsw = (lane & 7) ^ ((wid & 1) * 4 + (lane >> 4));
  const int grow = wid * 8 + (lane >> 3);
  auto issue = [&](int step, int stage) {
    int m0, n0; tile_of(step >> 4, m0, n0);
    const int kt = step & 15;
    const u16* ag = EPI == 0 ? A + ((size_t)((m0 >> 8) * 16 + kt) * 256 + grow) * 64 + gsw * 8 : A + (size_t)(m0 + grow) * LDK + kt * 64 + gsw * 8;
    const size_t astep = EPI == 0 ? (size_t)64 * 64 : (size_t)64 * LDK;
    const int brow = EPI == 0 ? ((grow & ~31) | ((grow & 0x0C) << 1) | ((grow & 0x10) >> 2) | (grow & 3)) : grow;
    const u16* bg_ = Bt + (size_t)(n0 + brow) * LDK + kt * 64 + gsw * 8;
    const unsigned dst = (unsigned)__builtin_amdgcn_readfirstlane((int)(lds0 + stage * G_STAGE + wid * 1024));
#pragma unroll
    for (int i = 0; i < 4; ++i) glds16(ag + i * astep, dst + i * 8192);
#pragma unroll
    for (int i = 0; i < 4; ++i) glds16(bg_ + (size_t)i * 64 * LDK, dst + G_ASZ + i * 8192);
    if (EPI == 0 && kt == 8) {
      const int t0 = m0 & 4095;
      const unsigned sd = (unsigned)__builtin_amdgcn_readfirstlane((int)(lds0 + G_ROPE + wid * 1024));
      glds16(ws_rope(p) + (size_t)t0 * 16 + tid * 4, sd);
      glds16(ws_rope(p) + (size_t)t0 * 16 + (512 + tid) * 4, sd + 8192);
      if (wid == 0) glds16(ws_rs(p) + m0 + lane * 4, lds0 + G_RS);
    }
  };
  const int ca0 = ((fq ^ (fr >> 1)) * 16), ca1 = (((4 + fq) ^ (fr >> 1)) * 16);
  f32x4 acc[8][4];
#pragma unroll
  for (int m = 0; m < 8; ++m)
#pragma unroll
    for (int n = 0; n < 4; ++n) acc[m][n] = f32x4{0.f, 0.f, 0.f, 0.f};
  __syncthreads();
  if (nsteps > 0) issue(0, 0);
  for (int s = 0; s < nsteps; ++s) {
    WAIT_VM(0);
    __builtin_amdgcn_s_waitcnt(0x0F70);
    __builtin_amdgcn_s_barrier();
    if (s + 1 < nsteps) issue(s + 1, (s + 1) & 1);
    {
      const char* ab = smem + (s & 1) * G_STAGE + (wr * 128 + fr) * 128;
      const char* bb = smem + (s & 1) * G_STAGE + G_ASZ + (wc * 64 + fr) * 128;
#pragma unroll
      for (int ks = 0; ks < 2; ++ks) {
        bf16x8 af[8], bf[4];
        const int co = ks ? ca1 : ca0;
#pragma unroll
        for (int n = 0; n < 4; ++n) bf[n] = *(const bf16x8*)(bb + n * 16 * 128 + co);
#pragma unroll
        for (int m = 0; m < 8; ++m) af[m] = *(const bf16x8*)(ab + m * 16 * 128 + co);
#pragma unroll
        for (int m = 0; m < 8; ++m)
#pragma unroll
          for (int n = 0; n < 4; ++n) acc[m][n] = MFMA16(bf[n], af[m], acc[m][n]);
      }
    }
    if ((s & 15) != 15) continue;
    int m0, n0; tile_of(s >> 4, m0, n0);
    const int rbase = m0 + wr * 128;
    const int cb = n0 + wc * 64;
    if constexpr (EPI == 1) {
#pragma unroll
      for (int hm = 0; hm < 2; ++hm) {
        float4 xv[4][4];
#pragma unroll
        for (int mm = 0; mm < 4; ++mm) {
          const size_t ro = (size_t)(rbase + (hm * 4 + mm) * 16 + fr) * DM + cb + fq * 4;
#pragma unroll
          for (int n = 0; n < 4; ++n) xv[mm][n] = *(const float4*)(p.x + ro + n * 16);
        }
#pragma unroll
        for (int mm = 0; mm < 4; ++mm) {
          const int m = hm * 4 + mm;
          const size_t ro = (size_t)(rbase + m * 16 + fr) * DM + cb + fq * 4;
#pragma unroll
          for (int n = 0; n < 4; ++n) {
            float4 o; o.x = xv[mm][n].x + acc[m][n][0]; o.y = xv[mm][n].y + acc[m][n][1]; o.z = xv[mm][n].z + acc[m][n][2]; o.w = xv[mm][n].w + acc[m][n][3];
            *(float4*)(p.out + ro + n * 16) = o;
          }
        }
        __builtin_amdgcn_sched_barrier(0);
      }
    } else {
      const int b = m0 >> 12;
      const int tb = rbase & 4095;
      if (cb < 1280) {
        const int seg = cb >> 6;
        const int which = seg < 8 ? -1 : ((seg - 8) >> 1);
        const int g = seg < 8 ? (seg >> 2) : ((seg - 8) & 1);
        const bool need_norm = (seg < 8) || which == 2 || which == 4;
        const float* nw = seg < 8 ? p.q_norm_w : (p.k_norm_w + (which == 2 ? 64 : 128));
        float w[16];
#pragma unroll
        for (int k = 0; k < 16; ++k) w[k] = need_norm ? nw[(k >> 3) * 32 + fq * 8 + (k & 7)] : 1.0f;
        const float qs = seg < 8 ? QSCALE : 1.0f;
#pragma unroll
        for (int m = 0; m < 8; ++m) {
          const int t = tb + m * 16 + fr;
          const int lrow = wr * 128 + m * 16 + fr;
          const float r = *(const float*)(smem + G_RS + lrow * 4);
          float v[16];
#pragma unroll
          for (int k = 0; k < 16; ++k) v[k] = acc[m][(k >> 3) * 2 + ((k & 7) >> 2)][k & 3] * r;
          if (need_norm) {
            float ss = 0.f;
#pragma unroll
            for (int k = 0; k < 16; ++k) ss += v[k] * v[k];
            ss += __shfl_xor(ss, 16); ss += __shfl_xor(ss, 32);
            const float rr = rsqrtf(ss * (1.0f / 64.f) + EPS);
#pragma unroll
            for (int k = 0; k < 16; ++k) v[k] = v[k] * rr * w[k];
            const float4* rp = (const float4*)(smem + G_ROPE + lrow * 64);
            const float4 c01 = rp[0], c23 = rp[1], c45 = rp[2], c67 = rp[3];
            const float cc[8] = {c01.x, c01.z, c23.x, c23.z, c45.x, c45.z, c67.x, c67.z};
            const float sn[8] = {c01.y, c01.w, c23.y, c23.w, c45.y, c45.w, c67.y, c67.w};
#pragma unroll
            for (int e = 0; e < 8; ++e) {
              const float pr = __shfl_xor(v[e], 16);
              const float rot = (fq == 0) ? (v[e] * cc[e] - pr * sn[e]) : (v[e] * cc[e] + pr * sn[e]);
              v[e] = (fq < 2) ? rot : v[e];
            }
#pragma unroll
            for (int k = 0; k < 16; ++k) v[k] *= qs;
          }
          if (which == 3 || which == 5) {
            int lz = 0; asm volatile("" : "+v"(lz));
            u16* vt = (which == 3 ? ws_Vst(p) : ws_Vwt(p)) + (size_t)((b * 2 + g) * 64 + (t >> 6)) * 4096 + lz;
            const int fqx = fq + lz, key = (t & 63) + lz;
#pragma unroll
            for (int k = 0; k < 16; ++k) vt[vimg_off((k >> 3) * 32 + fqx * 8 + (k & 7), key)] = f2bf(v[k]);
          } else {
            u16* dst;
            if (seg < 8) dst = ws_Q(p) + ((size_t)((b * 2 + g) * 4096 + t) * 4 + (seg & 3)) * 64;
            else { u16* buf = which == 0 ? ws_kcraw(p) : which == 1 ? ws_vcraw(p) : which == 2 ? ws_Ks(p) : ws_Kw(p); dst = buf + ((size_t)(b * 2 + g) * 4096 + t) * 64; }
            const bool img = which >= 2;
#pragma unroll
            for (int n2 = 0; n2 < 2; ++n2) {
              u32x4 o;
#pragma unroll
              for (int e = 0; e < 4; ++e) o[e] = cvtpk(v[n2 * 8 + 2 * e], v[n2 * 8 + 2 * e + 1]);
              const int d0 = n2 * 32 + fq * 8;
              const int off = img ? (((d0 >> 3) ^ (((t & 63) >> 1) & 7)) * 8) : d0;
              *(u32x4*)(dst + off) = o;
            }
          }
          __builtin_amdgcn_sched_barrier(0);
        }
      } else {
#pragma unroll
        for (int m = 0; m < 8; ++m) {
          const size_t row = rbase + m * 16 + fr;
          const float r = *(const float*)(smem + G_RS + (wr * 128 + m * 16 + fr) * 4);
#pragma unroll
          for (int n2 = 0; n2 < 2; ++n2) {
            const int c8 = cb + n2 * 32 + fq * 8;
            if (c8 >= DIN) continue;
            float v[8];
#pragma unroll
            for (int e = 0; e < 8; ++e) v[e] = acc[m][n2 * 2 + (e >> 2)][e & 3] * r;
            if (c8 < 1304) {
              float4 o0, o1;
              o0.x = sigmoidf_(v[0]); o0.y = sigmoidf_(v[1]); o0.z = sigmoidf_(v[2]); o0.w = sigmoidf_(v[3]);
              o1.x = sigmoidf_(v[4]); o1.y = sigmoidf_(v[5]); o1.z = sigmoidf_(v[6]); o1.w = sigmoidf_(v[7]);
              float* gp = ws_gates(p) + row * 24 + (c8 - 1280);
              *(float4*)gp = o0; *(float4*)(gp + 4) = o1;
            } else if (c8 < 1816) {
              u32x4 o;
#pragma unroll
              for (int e = 0; e < 4; ++e) o[e] = cvtpk(siluf_(v[2 * e]), siluf_(v[2 * e + 1]));
              *(u32x4*)(ws_zs(p) + row * 512 + (c8 - 1304)) = o;
            } else {
              u32x4 o;
#pragma unroll
              for (int e = 0; e < 4; ++e) o[e] = cvtpk(v[2 * e], v[2 * e + 1]);
              *(u32x4*)(ws_cvb(p) + row * 2048 + (c8 - 1816)) = o;
            }
          }
          __builtin_amdgcn_sched_barrier(0);
        }
      }
    }
#pragma unroll
    for (int m = 0; m < 8; ++m)
#pragma unroll
      for (int n = 0; n < 4; ++n) acc[m][n] = f32x4{0.f, 0.f, 0.f, 0.f};
  }
}

__device__ void phase_cmp_conv(const Params& p, char* smem, int bid, int nb) {
  int tid_ = threadIdx.x; asm volatile("" : "+v"(tid_));
  const int tid = tid_, lane = tid & 63, wid = __builtin_amdgcn_readfirstlane(tid >> 6), fr = lane & 15, fq = lane >> 4;
  float* part = (float*)smem;
  char* hl = smem + 8 * 16 * 132 * 4;
  float* outl = (float*)(hl + 2 * 4352);
  float* biasl = outl + 2 * 1088;
  for (int job = bid; job < 256; job += nb) {
    const int which = wid >> 2, w4 = wid & 3, bg = job >> 4, ct = job & 15;
    const u16* raw = (which ? ws_vcraw(p) : ws_kcraw(p)) + (size_t)bg * 4096 * 64;
    const u16* w1T = which ? ws_w1vT(p) : ws_w1kT(p);
    const u16* w2T = which ? ws_w2vT(p) : ws_w2kT(p);
    const float* b1 = which ? p.cv_b1 : p.ck_b1;
    f32x4 acc[8];
#pragma unroll
    for (int n = 0; n < 8; ++n) acc[n] = f32x4{0.f, 0.f, 0.f, 0.f};
    const int c = ct * 16 + fr;
    const int ht = tid & 255, rrow = ht >> 4, c8 = (ht & 15) * 8;
    const int orow = ht >> 4, d4 = (ht & 15) * 4;
    const int cc = ct * 16 + orow;
#pragma unroll 1
    for (int kb4 = 0; kb4 < 16; kb4 += 4) {
      bf16x8 av[4], bv[4][8];
#pragma unroll
      for (int q = 0; q < 4; ++q) {
        const int ks = w4 * 16 + kb4 + q;
        const int l = ks >> 1, d0 = (ks & 1) * 32 + fq * 8;
        int tt = c * 16 + l; tt = tt > 4095 ? 4095 : tt;
        av[q] = *(const bf16x8*)(raw + (size_t)tt * 64 + d0);
#pragma unroll
        for (int n = 0; n < 8; ++n) bv[q][n] = *(const bf16x8*)(w1T + (size_t)(n * 16 + fr) * 2048 + ks * 32 + fq * 8);
      }
#pragma unroll
      for (int q = 0; q < 4; ++q)
#pragma unroll
        for (int n = 0; n < 8; ++n) acc[n] = MFMA16(av[q], bv[q][n], acc[n]);
      __builtin_amdgcn_sched_group_barrier(0x020, 36, 0);
      __builtin_amdgcn_sched_group_barrier(0x008, 32, 0);
    }
    if (ht < 128) {
      float bq[9];
      bq[0] = b1[ht];
#pragma unroll
      for (int ch = 0; ch < 8; ++ch) bq[1 + ch] = ws_ckpart(p)[(which * 8 + ch) * 128 + ht];
      float bsum = bq[0];
#pragma unroll
      for (int ch = 0; ch < 8; ++ch) bsum += bq[1 + ch];
      biasl[which * 128 + ht] = bsum;
    }
#pragma unroll
    for (int n = 0; n < 8; ++n)
#pragma unroll
      for (int j = 0; j < 4; ++j) part[(wid * 16 + fq * 4 + j) * 132 + n * 16 + fr] = acc[n][j];
    __syncthreads();
    {
      float bias[8];
#pragma unroll
      for (int e = 0; e < 8; ++e) bias[e] = biasl[which * 128 + c8 + e];
      float sum[8];
#pragma unroll
      for (int e = 0; e < 8; ++e) sum[e] = bias[e];
#pragma unroll
      for (int w = 0; w < 4; ++w) {
        const float4 v0 = *(const float4*)(part + ((which * 4 + w) * 16 + rrow) * 132 + c8), v1 = *(const float4*)(part + ((which * 4 + w) * 16 + rrow) * 132 + c8 + 4);
        sum[0] += v0.x; sum[1] += v0.y; sum[2] += v0.z; sum[3] += v0.w; sum[4] += v1.x; sum[5] += v1.y; sum[6] += v1.z; sum[7] += v1.w;
      }
      u32x4 o;
#pragma unroll
      for (int e = 0; e < 4; ++e) o[e] = cvtpk(siluf_(sum[2 * e]), siluf_(sum[2 * e + 1]));
      *(u32x4*)(hl + which * 4352 + rrow * 272 + c8 * 2) = o;
    }
    __syncthreads();
    {
    bf16x8 w2f[4];
#pragma unroll
    for (int ks = 0; ks < 4; ++ks) w2f[ks] = *(const bf16x8*)(w2T + (size_t)(w4 * 16 + fr) * 128 + ks * 32 + fq * 8);
      f32x4 o2 = f32x4{0.f, 0.f, 0.f, 0.f};
#pragma unroll
      for (int ks = 0; ks < 4; ++ks) {
        const bf16x8 a = *(const bf16x8*)(hl + which * 4352 + fr * 272 + (ks * 32 + fq * 8) * 2);
        o2 = MFMA16(a, w2f[ks], o2);
      }
#pragma unroll
      for (int j = 0; j < 4; ++j) outl[which * 1088 + (fq * 4 + j) * 68 + w4 * 16 + fr] = o2[j];
    }
    __syncthreads();
    {
    float nwv[4], nwp[4]; float2 csv[4];
    {
      int pos = cc * 16 + 31; pos = pos > 4095 ? 4095 : pos;
#pragma unroll
      for (int e = 0; e < 4; ++e) {
        const int d = d4 + e;
        nwv[e] = p.k_norm_w[d]; nwp[e] = p.k_norm_w[d ^ 8];
        csv[e] = *(const float2*)(ws_rope(p) + ((size_t)pos * 8 + (d & 7)) * 2);
      }
    }
      const float* ol = outl + which * 1088;
      const float4 v = *(const float4*)(ol + orow * 68 + d4);
      if (which == 0) {
        float ss = v.x * v.x + v.y * v.y + v.z * v.z + v.w * v.w;
        ss += __shfl_xor(ss, 1); ss += __shfl_xor(ss, 2); ss += __shfl_xor(ss, 4); ss += __shfl_xor(ss, 8);
        const float rr = rsqrtf(ss * (1.0f / 64.f) + EPS);
        float o[4] = {v.x * rr * nwv[0], v.y * rr * nwv[1], v.z * rr * nwv[2], v.w * rr * nwv[3]};
        if (d4 < 16) {
#pragma unroll
          for (int e = 0; e < 4; ++e) {
            const int d = d4 + e, dp = d ^ 8;
            const float pr = ol[orow * 68 + dp] * rr * nwp[e];
            o[e] = (d < 8) ? (o[e] * csv[e].x - pr * csv[e].y) : (o[e] * csv[e].x + pr * csv[e].y);
          }
        }
        u32x2 ov; ov[0] = cvtpk(o[0], o[1]); ov[1] = cvtpk(o[2], o[3]);
        if (cc >= 255) { ov[0] = 0u; ov[1] = 0u; }
        *(u32x2*)(ws_Kc(p) + (size_t)(bg * 4 + (cc >> 6)) * 4096 + kimg_off(cc & 63, d4)) = ov;
      } else {
        const float z = (cc >= 255) ? 0.f : 1.f;
        u16* vt = ws_Vct(p) + (size_t)(bg * 4 + (cc >> 6)) * 4096;
        vt[vimg_off(d4 + 0, cc & 63)] = f2bf(v.x * z); vt[vimg_off(d4 + 1, cc & 63)] = f2bf(v.y * z);
        vt[vimg_off(d4 + 2, cc & 63)] = f2bf(v.z * z); vt[vimg_off(d4 + 3, cc & 63)] = f2bf(v.w * z);
      }
    }
    __syncthreads();
  }
  const int gw = bid * 8 + wid, nw = nb * 8;
  for (int chunk = gw; chunk < 2048; chunk += nw) {
    const int r0 = chunk * 16, t0 = r0 & 4095;
    const int ch = lane * 8;
    float cw0[8], cw1[8], cw2[8], cbv[8], u1[8], u2[8];
#pragma unroll
    for (int e = 0; e < 8; ++e) { cw0[e] = p.conv_w[ch + e]; cw1[e] = p.conv_w[512 + ch + e]; cw2[e] = p.conv_w[1024 + ch + e]; cbv[e] = p.conv_b[ch + e]; u1[e] = 0.f; u2[e] = 0.f; }
    if (t0 > 0) {
#pragma unroll
      for (int q = 0; q < 2; ++q) {
        const u16* rp = ws_cvb(p) + (size_t)(r0 - 2 + q) * 2048 + ch;
        const u32x4 hv = *(const u32x4*)(rp), cv = *(const u32x4*)(rp + 1024);
#pragma unroll
        for (int e = 0; e < 4; ++e) {
          const float ua = bflo(hv[e]) * bflo(cv[e]), ub = bfhi(hv[e]) * bfhi(cv[e]);
          if (q == 0) { u2[2 * e] = ua; u2[2 * e + 1] = ub; } else { u1[2 * e] = ua; u1[2 * e + 1] = ub; }
        }
      }
    }
#pragma unroll 1
    for (int rb = 0; rb < 16; rb += 8) {
      u32x4 hvv[8], bvv[8], cvv[8], zvv[8];
#pragma unroll
      for (int q = 0; q < 8; ++q) {
        const u16* rp = ws_cvb(p) + (size_t)(r0 + rb + q) * 2048 + ch;
        hvv[q] = *(const u32x4*)(rp); bvv[q] = *(const u32x4*)(rp + 512); cvv[q] = *(const u32x4*)(rp + 1024); zvv[q] = *(const u32x4*)(rp + 1536);
      }
#pragma unroll
      for (int q = 0; q < 8; ++q) {
        const u32x4 hv = hvv[q], bv = bvv[q], cv = cvv[q], zv = zvv[q];
        u32x4 ov;
#pragma unroll
        for (int e = 0; e < 4; ++e) {
          const float ua = bflo(hv[e]) * bflo(cv[e]), ub = bfhi(hv[e]) * bfhi(cv[e]);
          const float ca = cw0[2 * e] * u2[2 * e] + cw1[2 * e] * u1[2 * e] + cw2[2 * e] * ua + cbv[2 * e];
          const float cbb = cw0[2 * e + 1] * u2[2 * e + 1] + cw1[2 * e + 1] * u1[2 * e + 1] + cw2[2 * e + 1] * ub + cbv[2 * e + 1];
          const float oa = bflo(bv[e]) * ca * siluf_(bflo(zv[e]));
          const float ob = bfhi(bv[e]) * cbb * siluf_(bfhi(zv[e]));
          ov[e] = cvtpk(oa, ob);
          u2[2 * e] = u1[2 * e]; u2[2 * e + 1] = u1[2 * e + 1]; u1[2 * e] = ua; u1[2 * e + 1] = ub;
        }
        *(u32x4*)(ws_mix(p) + (size_t)(r0 + rb + q) * LDK + 512 + ch) = ov;
      }
    }
  }
}

constexpr int AT_NST = 5, AT_KB = 8192, AT_BUF = 16384;
constexpr int AT_F = AT_NST * AT_BUF, AT_IMPA = AT_F, AT_IMPB = AT_IMPA + 64 * 65 * 4, AT_VAL = AT_IMPA;
constexpr int AT_SELM = AT_F + 8 * 8192, AT_UNIT = AT_SELM + 512, AT_END = AT_UNIT + 16;
static_assert(AT_END <= SMEM_BYTES, "attention LDS layout exceeds the dynamic LDS size");

__device__ void phase_attn(const Params& p, char* smem, int bid, int nb, int rep) {
  int tid_ = threadIdx.x; asm volatile("" : "+v"(tid_));
  const int tid = tid_, lane = tid & 63, wid = __builtin_amdgcn_readfirstlane(tid >> 6), c32 = lane & 31, h = lane >> 5;
  const float NINF = -__builtin_inff();
  float* impa = (float*)(smem + AT_IMPA);
  float* impb = (float*)(smem + AT_IMPB);
  float* vals = (float*)(smem + AT_VAL);
  unsigned* selm = (unsigned*)(smem + AT_SELM);
  volatile int* s_unit = (volatile int*)(smem + AT_UNIT);
  const unsigned lds0 = (unsigned)(uintptr_t)smem;
  while (true) {
    if (tid == 0) *s_unit = (int)atomicAdd(ws_counter(p) + rep, 1u);
    __syncthreads();
    const int u = __builtin_amdgcn_readfirstlane(*s_unit);
    __syncthreads();
    if (u >= 1024) break;
    const int i = 63 - (u >> 4), bg = u & 15, b = bg >> 1, g = bg & 1;
    const int tl = wid * 8 + (c32 >> 2), hd = c32 & 3;
    const int t = i * 64 + tl;
    const u16* qrow = ws_Q(p) + ((size_t)(bg * 4096 + i * 64) * 4 + wid * 32 + c32) * 64;
    bf16x8 qf[4];
#pragma unroll
    for (int ks = 0; ks < 4; ++ks) qf[ks] = *(const bf16x8*)(qrow + ks * 16 + h * 8);
    const float* gp = ws_gates(p) + (size_t)(b * 4096 + t) * 24 + (g * 4 + hd) * 3;
    const float g0 = gp[0], g1 = gp[1], g2 = gp[2];
    asm volatile("" :: "v"(qf[0]), "v"(qf[1]), "v"(qf[2]), "v"(qf[3]), "v"(g0), "v"(g1), "v"(g2));
    const int ntc = (4 * i + 2) / 64 + 1, nsl = i + 1, nwin = (i < 8 ? i : 8) + 1;
    const int NT = 2 * ntc + nsl + nwin;
    const bool need_sel = i >= 16;

    f32x16 O0, O1;
#pragma unroll
    for (int r = 0; r < 16; ++r) { O0[r] = 0.f; O1[r] = 0.f; }
    float* fl = (float*)(smem + AT_F + wid * 8192) + lane;
    float m_run = NINF, l_run = 0.f, inv_l = 0.f;
    u32x4 kxw; kxw[0] = (h == 0) ? 0x3F80u : 0u; kxw[1] = 0u; kxw[2] = 0u; kxw[3] = 0u;
    const bf16x8 kx = __builtin_bit_cast(bf16x8, kxw);
    float oscale = 1.0f;
    unsigned sel_lo = 0xffffffffu, sel_hi = 0xffffffffu;
#define TILE_PTRS(n, kp, vp) do { \
      if ((n) < 2 * ntc) { const int tt_ = (n) < ntc ? (n) : (n) - ntc; kp = ws_Kc(p) + (size_t)(bg * 4 + tt_) * 4096; vp = ws_Vct(p) + (size_t)(bg * 4 + tt_) * 4096; } \
      else if ((n) < 2 * ntc + nsl) { const int j_ = (n) - 2 * ntc; kp = ws_Ks(p) + ((size_t)bg * 4096 + j_ * 64) * 64; vp = ws_Vst(p) + (size_t)(bg * 64 + j_) * 4096; } \
      else { const int j_ = i - nwin + 1 + ((n) - 2 * ntc - nsl); kp = ws_Kw(p) + ((size_t)bg * 4096 + j_ * 64) * 64; vp = ws_Vwt(p) + (size_t)(bg * 64 + j_) * 4096; } } while (0)
#define TISSUE(n, st_) do { const u16 *kp_, *vp_; TILE_PTRS(n, kp_, vp_); \
      const unsigned d_ = (unsigned)__builtin_amdgcn_readfirstlane((int)(lds0 + (st_) * AT_BUF + wid * 1024)); \
      glds16(kp_ + tid * 8, d_); glds16(vp_ + tid * 8, d_ + AT_KB); } while (0)
    {
      const int npre = NT < AT_NST - 1 ? NT : AT_NST - 1;
      for (int n = 0; n < npre; ++n) TISSUE(n, n);
    }
    int st_cur = 0, st_iss = AT_NST - 1;
    const int ksw = (c32 >> 1) & 7;
    for (int n = 0; n < NT; ++n) {
      {
        const int rem = NT - 1 - n;
        if (rem >= 3) WAIT_VM(6); else if (rem == 2) WAIT_VM(4); else if (rem == 1) WAIT_VM(2); else WAIT_VM(0);
        __builtin_amdgcn_s_barrier();
        if (n + AT_NST - 1 < NT) TISSUE(n + AT_NST - 1, st_iss);
      }
      int mode, base, lo, hi;
      bool full = false, lane_on = true;
      if (n < 2 * ntc) { mode = n < ntc ? 0 : 1; base = (n < ntc ? n : n - ntc) * 64; lo = -1; hi = (t - 31) >> 4; }
      else if (n < 2 * ntc + nsl) { const int j = n - 2 * ntc; mode = 2; base = j * 64; const unsigned bit = j < 32 ? (sel_lo >> j) & 1u : (sel_hi >> (j - 32)) & 1u; lo = -1; hi = bit ? t : -1; full = j < i; lane_on = bit != 0u; }
      else { const int j = i - nwin + 1 + (n - 2 * ntc - nsl); mode = 3; base = j * 64; lo = t - 512; hi = t; full = (j < i) && (j > i - 8); }
      const int lo_rel = lo - (base + 4 * h), hi_rel = hi - (base + 4 * h);
      const bool chk = ((n & 7) == 7) || mode == 0;
#pragma unroll
      for (int r = 0; r < 16; ++r) { O0[r] *= oscale; O1[r] *= oscale; }
      const char* kb = smem + st_cur * AT_BUF;
      const char* vb = kb + AT_KB;
      st_cur = st_cur == AT_NST - 1 ? 0 : st_cur + 1; st_iss = st_iss == AT_NST - 1 ? 0 : st_iss + 1;
      f32x16 S0, S1;
#define ATT_BODY(MASKED) do { \
      _Pragma("unroll") for (int r = 0; r < 16; ++r) { S0[r] = 0.f; S1[r] = 0.f; } \
      const float m_use = (m_run == NINF) ? 0.f : m_run;        \
      { \
          \
        const float negm = (!(MASKED) && !lane_on) ? NINF : -m_use; \
        u32x4 qxw; qxw[0] = (h == 0) ? (cvtpk(negm, 0.f) & 0xffffu) : 0u; qxw[1] = 0u; qxw[2] = 0u; qxw[3] = 0u; \
        const bf16x8 qx = __builtin_bit_cast(bf16x8, qxw); \
        S0 = MFMA32(kx, qx, S0); S1 = MFMA32(kx, qx, S1); \
      } \
      { \
        bf16x8 kf0[4], kf1[4]; \
        _Pragma("unroll") for (int ks = 0; ks < 4; ++ks) { \
          kf0[ks] = *(const bf16x8*)(kb + c32 * 128 + (((ks * 2 + h) ^ ksw) * 16)); \
          kf1[ks] = *(const bf16x8*)(kb + (32 + c32) * 128 + (((ks * 2 + h) ^ ksw) * 16)); \
        } \
        _Pragma("unroll") for (int ks = 0; ks < 4; ++ks) S0 = MFMA32(kf0[ks], qf[ks], S0);     \
        _Pragma("unroll") for (int ks = 0; ks < 4; ++ks) S1 = MFMA32(kf1[ks], qf[ks], S1); \
      } \
        \
      if ((MASKED) == 2) {                       \
        _Pragma("unroll") for (int r = 0; r < 16; ++r) { \
          const int off = (r & 3) + 8 * (r >> 2); \
          S0[r] = (off > lo_rel && off <= hi_rel) ? S0[r] : NINF; \
          S1[r] = (off + 32 > lo_rel && off + 32 <= hi_rel) ? S1[r] : NINF; \
        } \
      } else if (MASKED) {                       \
        _Pragma("unroll") for (int r = 0; r < 16; ++r) { \
          const int off = (r & 3) + 8 * (r >> 2); \
          S0[r] = (off <= hi_rel) ? S0[r] : NINF; \
          S1[r] = (off + 32 <= hi_rel) ? S1[r] : NINF; \
        } \
      } \
      float ps0 = 0.f, ps1 = 0.f; \
      bf16x8 vfa[4]; \
      _Pragma("unroll") for (int kk = 0; kk < 2; ++kk) \
        _Pragma("unroll") for (int dr = 0; dr < 2; ++dr) vfa[kk * 2 + dr] = *(const bf16x8*)(vb + (32 * dr + c32) * 128 + (((2 * kk + h) ^ ksw) * 16)); \
      _Pragma("unroll") for (int r = 0; r < 16; ++r) { S0[r] = __builtin_amdgcn_exp2f(S0[r]); ps0 += S0[r]; } \
      _Pragma("unroll") for (int kk = 0; kk < 2; ++kk) { \
        u32x4 pw; \
        _Pragma("unroll") for (int e = 0; e < 4; ++e) pw[e] = cvtpk(S0[8 * kk + 2 * e], S0[8 * kk + 2 * e + 1]); \
        const bf16x8 pf = __builtin_bit_cast(bf16x8, pw); \
        O0 = MFMA32(vfa[kk * 2], pf, O0); O1 = MFMA32(vfa[kk * 2 + 1], pf, O1); \
      } \
      __builtin_amdgcn_sched_group_barrier(0x100, 12, 0);     \
      __builtin_amdgcn_sched_group_barrier(0x008, 4, 0);      \
      _Pragma("unroll") for (int q_ = 0; q_ < 4; ++q_) { __builtin_amdgcn_sched_group_barrier(0x008, 1, 0); __builtin_amdgcn_sched_group_barrier(0x002, 9, 0); }     \
      __builtin_amdgcn_sched_barrier(0); \
      _Pragma("unroll") for (int r = 0; r < 16; ++r) { S1[r] = __builtin_amdgcn_exp2f(S1[r]); ps1 += S1[r]; } \
      _Pragma("unroll") for (int kk = 0; kk < 2; ++kk) { \
        u32x4 pw; \
        _Pragma("unroll") for (int e = 0; e < 4; ++e) pw[e] = cvtpk(S1[8 * kk + 2 * e], S1[8 * kk + 2 * e + 1]); \
        const bf16x8 pf = __builtin_bit_cast(bf16x8, pw); \
        const bf16x8 va0 = *(const bf16x8*)(vb + c32 * 128 + (((2 * (kk + 2) + h) ^ ksw) * 16)), va1 = *(const bf16x8*)(vb + (32 + c32) * 128 + (((2 * (kk + 2) + h) ^ ksw) * 16)); \
        O0 = MFMA32(va0, pf, O0); O1 = MFMA32(va1, pf, O1); \
      } \
      __builtin_amdgcn_sched_barrier(0); \
      oscale = 1.0f; \
      if (mode != 1) l_run += ps0 + ps1; \
      if (mode != 1 && chk) {                    \
        float mxp = fmaxf(fmaxf(S0[0], S0[1]), S1[0]); \
        mxp = fmaxf(fmaxf(mxp, S1[1]), S0[2]); \
        _Pragma("unroll") for (int r = 2; r < 16; r += 2) { \
          if (r > 2) mxp = fmaxf(fmaxf(mxp, S0[r]), S1[r - 1]); \
          mxp = fmaxf(fmaxf(mxp, S0[r + 1]), S1[r]); \
        } \
        mxp = fmaxf(mxp, S1[15]); \
        mxp = fmaxf(mxp, __shfl_xor(mxp, 32));            \
        const bool mv = (m_run == NINF) ? (mxp > 0.f) : (mxp > 256.0f); \
        const float m_new = bflo(cvtpk(m_use + __builtin_amdgcn_logf(mxp), 0.f));       \
        const float alpha = mv ? __builtin_amdgcn_exp2f(m_use - m_new) : 1.0f; \
        m_run = mv ? m_new : m_run; \
        l_run *= alpha; \
        oscale = alpha; \
      } \
      if ((MASKED) == 1 && mode == 1 && need_sel) {               \
        const int tt = base >> 6; \
        _Pragma("unroll") for (int kr = 0; kr < 2; ++kr) \
          _Pragma("unroll") for (int rg = 0; rg < 4; ++rg) { \
            float pv[4]; \
            _Pragma("unroll") for (int e = 0; e < 4; ++e) { \
              float v = (kr ? S1[rg * 4 + e] : S0[rg * 4 + e]) * inv_l; \
              v += qperm<0xB1>(v); v += qperm<0x4E>(v);            \
              pv[e] = v; \
            } \
            if (hd == 0) { \
              const int nblk = tt * 16 + 8 * kr + 2 * rg + h; \
              impa[tl * 65 + nblk] = pv[0] + pv[1] + pv[2] + 0.5f * pv[3]; \
              impb[tl * 65 + nblk] = 0.5f * pv[3]; \
            } \
          } \
      } } while (0)
      if (full) ATT_BODY(0); else if (mode == 3 && base < i * 64) ATT_BODY(2); else ATT_BODY(1);
#undef ATT_BODY
      if (n == ntc - 1) {
        const float lt = l_run + __shfl_xor(l_run, 32);
        inv_l = lt > 0.f ? 1.0f / lt : 0.f;
        oscale = 0.f;
      } else if (n == 2 * ntc - 1) {
        if (need_sel) {
          __syncthreads();
          for (int q = 0; q < 8; ++q) {
            const int tk = wid * 8 + q, nn = lane;
            const bool forced = (nn == 0) || (nn == i) || (nn == i - 1);
            const bool vis = nn <= i;
            float v = 0.f;
            if (vis) v = impa[tk * 65 + nn] + (nn > 0 ? impb[tk * 65 + nn - 1] : 0.f);
            const unsigned bse = forced ? 0x4E6E6B28u : __float_as_uint(v);
            const unsigned key = (bse & ~127u) | (vis ? 64u : 0u) | (unsigned)(63 - nn);
            unsigned T = 0u;
#pragma unroll 1
            for (int bbit = 31; bbit >= 0; --bbit) {
              const unsigned Tc = T | (1u << bbit);
              const unsigned long long mk = __builtin_amdgcn_ballot_w64(key >= Tc);
              if (__builtin_popcountll(mk) >= 16) T = Tc;
            }
            const unsigned long long sel = __builtin_amdgcn_ballot_w64(key >= T);
            if (lane == 0) { selm[tk * 2] = (unsigned)sel; selm[tk * 2 + 1] = (unsigned)(sel >> 32); }
          }
          __syncthreads();
          sel_lo = selm[tl * 2]; sel_hi = selm[tl * 2 + 1];
        }
        {
          const float wgt = g0 * inv_l * oscale;
#pragma unroll
          for (int r = 0; r < 16; ++r) { fl[r * 64] = wgt * O0[r]; fl[(16 + r) * 64] = wgt * O1[r]; }
          m_run = NINF; l_run = 0.f; oscale = 0.f;
        }
      } else if (n == 2 * ntc + nsl - 1) {
        const float lt = l_run + __shfl_xor(l_run, 32);
        const float wgt = g1 * (lt > 0.f ? 1.0f / lt : 0.f) * oscale;
#pragma unroll
        for (int r = 0; r < 16; ++r) { fl[r * 64] += wgt * O0[r]; fl[(16 + r) * 64] += wgt * O1[r]; }
        m_run = NINF; l_run = 0.f; oscale = 0.f;
      }
    }
#undef TILE_PTRS
#undef TISSUE
    {
      const float lt = l_run + __shfl_xor(l_run, 32);
      const float wgt = g2 * (lt > 0.f ? 1.0f / lt : 0.f) * oscale;
      const size_t rowo = (size_t)(b * 4096 + t);
      const u16* zp = ws_zs(p) + rowo * 512 + (g * 4 + hd) * 64;
      u16* mp = ws_mix(p) + rowo * LDK + (g * 4 + hd) * 64;
      u32x2 zv8[8];
#pragma unroll
      for (int q = 0; q < 8; ++q) zv8[q] = *(const u32x2*)(zp + 32 * (q >> 2) + 8 * (q & 3) + 4 * h);
#pragma unroll
      for (int dr = 0; dr < 2; ++dr)
#pragma unroll
        for (int rg = 0; rg < 4; ++rg) {
          const int d = 32 * dr + 8 * rg + 4 * h;
          const u32x2 zv = zv8[dr * 4 + rg];
          const float f0 = fl[(dr * 16 + rg * 4 + 0) * 64] + wgt * (dr ? O1[rg * 4 + 0] : O0[rg * 4 + 0]);
          const float f1 = fl[(dr * 16 + rg * 4 + 1) * 64] + wgt * (dr ? O1[rg * 4 + 1] : O0[rg * 4 + 1]);
          const float f2 = fl[(dr * 16 + rg * 4 + 2) * 64] + wgt * (dr ? O1[rg * 4 + 2] : O0[rg * 4 + 2]);
          const float f3 = fl[(dr * 16 + rg * 4 + 3) * 64] + wgt * (dr ? O1[rg * 4 + 3] : O0[rg * 4 + 3]);
          u32x2 o;
          o[0] = cvtpk(f0 * bflo(zv[0]), f1 * bfhi(zv[0]));
          o[1] = cvtpk(f2 * bflo(zv[1]), f3 * bfhi(zv[1]));
          *(u32x2*)(mp + d) = o;
        }
    }
  }
}

#define XB_TMO      128
#define XB_XCNT(j)  (256  + 64 * (j))
#define XB_XSUB(j)  (1280 + 64 * (j))
#define XB_XGEN(j)  (2304 + 64 * (j))
#define XB_TOP      3328
#define XB_TOPGEN   3392
#define XCD_BAR_WORDS 3456
#define XB_SPIN_CAP (1u << 18)
#define LAS __attribute__((address_space(3)))

__device__ __forceinline__ unsigned xb_ld(unsigned* p)              { return __hip_atomic_load(p, __ATOMIC_RELAXED, __HIP_MEMORY_SCOPE_AGENT); }
__device__ __forceinline__ unsigned xb_add(unsigned* p, unsigned v) { return __hip_atomic_fetch_add(p, v, __ATOMIC_RELAXED, __HIP_MEMORY_SCOPE_AGENT); }
__device__ __forceinline__ unsigned xb_xcc_id() { return (unsigned)__builtin_amdgcn_s_getreg((3 << 11) | 20) & 0xFu; }
#define XB_SPIN(cond, bar) do { unsigned _sp = 0; while (cond) { __builtin_amdgcn_s_sleep(1); \
    if ((++_sp & 255u) == 0u) { if (xb_ld(&(bar)[XB_TMO])) break; if (_sp > XB_SPIN_CAP) { atomicAdd(&(bar)[XB_TMO], 1u); break; } } } } while (0)

struct XcdBarrier {
    unsigned* bar; unsigned x;
    volatile LAS unsigned* st;
};

__device__ __forceinline__ XcdBarrier xcd_barrier_post(unsigned* bar, volatile LAS unsigned* st) {
    XcdBarrier b; b.bar = bar; b.x = xb_xcc_id(); b.st = st;
    if (threadIdx.x == 0) (void)xb_add(&bar[XB_XCNT(b.x)], 1u);
    return b;
}
__device__ __forceinline__ void xcd_barrier_complete(unsigned* bar, unsigned x, unsigned& nloc, unsigned& nx) {
    const unsigned G = gridDim.x * gridDim.y * gridDim.z;
    unsigned sum, cnt, mine, sp = 0u;
    for (;;) {
        sum = 0u; cnt = 0u; mine = 0u;
#pragma unroll
        for (unsigned j = 0; j < 16; ++j) { const unsigned c = xb_ld(&bar[XB_XCNT(j)]); sum += c; cnt += (c > 0u) ? 1u : 0u; mine = (j == x) ? c : mine; }
        if (sum == G) break;
        __builtin_amdgcn_s_sleep(1);
        if ((++sp & 255u) == 0u) { if (xb_ld(&bar[XB_TMO])) break; if (sp > XB_SPIN_CAP) { atomicAdd(&bar[XB_TMO], 1u); break; } }
    }
    nloc = mine > 0u ? mine : 1u; nx = cnt > 0u ? cnt : 1u;
}

__device__ __forceinline__ void xcd_barrier(const XcdBarrier& b) {
    asm volatile("s_waitcnt vmcnt(0)" ::: "memory");
    __syncthreads();
    if (threadIdx.x == 0) {
        unsigned* bar = b.bar;
        __builtin_amdgcn_s_waitcnt(0);
        unsigned nloc = b.st[0], nx = b.st[1];
        if (nloc == 0u) { xcd_barrier_complete(bar, b.x, nloc, nx); b.st[0] = nloc; b.st[1] = nx; }
        const unsigned old = xb_add(&bar[XB_XSUB(b.x)], 1u);
        const unsigned gen = old / nloc;
        if (old + 1u == (gen + 1u) * nloc) {
            __builtin_amdgcn_fence(__ATOMIC_RELEASE, "agent");
            asm volatile("s_waitcnt vmcnt(0)" ::: "memory");
            const unsigned og = xb_add(&bar[XB_TOP], 1u);
            const unsigned tg = og / nx;
            if (og + 1u == (tg + 1u) * nx) xb_add(&bar[XB_TOPGEN], 1u);
            else XB_SPIN(xb_ld(&bar[XB_TOPGEN]) == tg, bar);
            __builtin_amdgcn_fence(__ATOMIC_ACQUIRE, "agent");
            xb_add(&bar[XB_XGEN(b.x)], 1u);
            asm volatile("s_waitcnt vmcnt(0)" ::: "memory");
        } else {
            XB_SPIN(xb_ld(&bar[XB_XGEN(b.x)]) == gen, bar);
            __builtin_amdgcn_fence(__ATOMIC_ACQUIRE, "agent");
            asm volatile("s_waitcnt vmcnt(0)" ::: "memory");
        }
    }
    __syncthreads();
}


#if FUSED
extern "C" __global__ void __launch_bounds__(NTHREADS) hybrid_fwd(Params p) {
  extern __shared__ __attribute__((aligned(16))) char smem[];
  cg::grid_group grid = cg::this_grid();
  const int bid = blockIdx.x, nb = gridDim.x;
  if (threadIdx.x < 4) ((volatile unsigned*)(smem + SMEM_BYTES))[threadIdx.x] = 0u;
  __syncthreads();
  if (bid == 0) { for (int w_ = threadIdx.x; w_ < XCD_BAR_WORDS; w_ += NTHREADS) ws_bar(p)[w_] = 0u; }
  for (int r = 0; r < REP0; ++r) { phase_prep(p, smem, bid, nb); grid.sync(); }
  XcdBarrier xb = xcd_barrier_post(ws_bar(p), (volatile LAS unsigned*)(smem + SMEM_BYTES));
  for (int r = 0; r < REP1; ++r) { gemm_phase<0>(p, smem, bid, nb); xcd_barrier(xb); }
  for (int r = 0; r < REP2; ++r) { phase_cmp_conv(p, smem, bid, nb); xcd_barrier(xb); }
  for (int r = 0; r < REP3; ++r) { phase_attn(p, smem, bid, nb, r); xcd_barrier(xb); }
  for (int r = 0; r < REP4; ++r) { gemm_phase<1>(p, smem, bid, nb); }
}
#else
template <int PH>
__global__ void __launch_bounds__(NTHREADS) phase_kernel(Params p) {
  extern __shared__ __attribute__((aligned(16))) char smem[];
  const int bid = blockIdx.x, nb = gridDim.x;
  if constexpr (PH == 0) phase_prep(p, smem, bid, nb);
  if constexpr (PH == 1) gemm_phase<0>(p, smem, bid, nb);
  if constexpr (PH == 2) phase_cmp_conv(p, smem, bid, nb);
  if constexpr (PH == 3) phase_attn(p, smem, bid, nb, 0);
  if constexpr (PH == 4) gemm_phase<1>(p, smem, bid, nb);
}
#endif

extern "C" void kernel_launch(void* const* d_in, const int* in_sizes, int n_in, void* d_out, int out_size, void* d_ws, size_t ws_size, hipStream_t stream) {
  Params p{};
  p.x = (const float*)d_in[0]; p.norm_w = (const float*)d_in[1]; p.w_in = (const float*)d_in[2]; p.q_norm_w = (const float*)d_in[3];
  p.k_norm_w = (const float*)d_in[4]; p.ck_pos = (const float*)d_in[5]; p.ck_w1 = (const float*)d_in[6]; p.ck_b1 = (const float*)d_in[7];
  p.ck_w2 = (const float*)d_in[8]; p.cv_pos = (const float*)d_in[9]; p.cv_w1 = (const float*)d_in[10]; p.cv_b1 = (const float*)d_in[11];
  p.cv_w2 = (const float*)d_in[12]; p.conv_w = (const float*)d_in[13]; p.conv_b = (const float*)d_in[14]; p.w_out = (const float*)d_in[15];
  p.out = (float*)d_out;
  p.ws = (char*)d_ws;
  const size_t off = WS_TOTAL;
  if (off > ws_size) { fprintf(stderr, "kernel_launch: workspace too small (%zu > %zu)\n", off, ws_size); return; }

#if FUSED
  static int grid_blocks = 0;
  if (!grid_blocks) {
    int dev = 0, cus = 0, per_cu = 0;
    hipGetDevice(&dev);
    hipDeviceGetAttribute(&cus, hipDeviceAttributeMultiprocessorCount, dev);
    hipFuncSetAttribute((const void*)hybrid_fwd, hipFuncAttributeMaxDynamicSharedMemorySize, SMEM_BYTES + 16);
    hipOccupancyMaxActiveBlocksPerMultiprocessor(&per_cu, (const void*)hybrid_fwd, NTHREADS, SMEM_BYTES + 16);
    if (per_cu < 1) per_cu = 1;
    grid_blocks = cus * per_cu;
  }
  void* args[] = {&p};
  hipError_t e = hipLaunchCooperativeKernel((const void*)hybrid_fwd, dim3(grid_blocks), dim3(NTHREADS), args, SMEM_BYTES + 16, stream);
  if (e != hipSuccess) fprintf(stderr, "cooperative launch failed: %s (grid %d)\n", hipGetErrorString(e), grid_blocks);
#else
  static int attr_set = 0;
  if (!attr_set) {
    (void)hipFuncSetAttribute((const void*)phase_kernel<0>, hipFuncAttributeMaxDynamicSharedMemorySize, SMEM_BYTES);
    (void)hipFuncSetAttribute((const void*)phase_kernel<1>, hipFuncAttributeMaxDynamicSharedMemorySize, SMEM_BYTES);
    (void)hipFuncSetAttribute((const void*)phase_kernel<2>, hipFuncAttributeMaxDynamicSharedMemorySize, SMEM_BYTES);
    (void)hipFuncSetAttribute((const void*)phase_kernel<3>, hipFuncAttributeMaxDynamicSharedMemorySize, SMEM_BYTES);
    (void)hipFuncSetAttribute((const void*)phase_kernel<4>, hipFuncAttributeMaxDynamicSharedMemorySize, SMEM_BYTES);
    attr_set = 1;
  }
  const int G = 256;
  phase_kernel<0><<<G, NTHREADS, SMEM_BYTES, stream>>>(p);
  phase_kernel<1><<<G, NTHREADS, SMEM_BYTES, stream>>>(p);
  phase_kernel<2><<<G, NTHREADS, SMEM_BYTES, stream>>>(p);
  phase_kernel<3><<<G, NTHREADS, SMEM_BYTES, stream>>>(p);
  phase_kernel<4><<<G, NTHREADS, SMEM_BYTES, stream>>>(p);
#endif
}
```

```cpp
#include <hip/hip_runtime.h>
#include <hip/hip_cooperative_groups.h>
#include <cstdio>
#include <cstdint>
namespace cg = cooperative_groups;

#ifndef FUSED
#define FUSED 1
#endif
#define REP0 1
#define REP1 1
#define REP2 1
#define REP3 1
#define REP4 1

#define DI __device__ __forceinline__
typedef unsigned short u16;
using bf16x8 = __attribute__((ext_vector_type(8))) short;
using s16x4 = __attribute__((ext_vector_type(4))) short;
using f32x4 = __attribute__((ext_vector_type(4))) float;
using f32x16 = __attribute__((ext_vector_type(16))) float;
using u32x4 = __attribute__((ext_vector_type(4))) unsigned;
using u32x2 = __attribute__((ext_vector_type(2))) unsigned;
typedef __bf16 bf2_t __attribute__((ext_vector_type(2)));
typedef float fl2_t __attribute__((ext_vector_type(2)));

constexpr int NTHREADS = 512;
constexpr int SEQ = 4096, DM = 1024, DIN = 3864, NROWS = 32768;
constexpr int LDK = 1088;
constexpr float EPS = 1e-6f;
constexpr float QSCALE = 0.125f * 1.4426950408889634f;
constexpr int SMEM_BYTES = 148480;

__constant__ float c_invf[8] = {1.0f, 0.1939227432012558f, 0.03760603070259094f, 0.007292664609849453f,
                                0.0014142135623842478f, 0.00027424818836152554f, 5.3182957344688475e-05f, 1.0313385246263351e-05f};

DI unsigned cvtpk(float lo, float hi) {
  fl2_t f = {lo, hi};
  bf2_t b = __builtin_convertvector(f, bf2_t);
  return __builtin_bit_cast(unsigned, b);
}
DI u16 f2bf(float x) { return (u16)(cvtpk(x, 0.f) & 0xffffu); }
DI float bf2f(u16 v) { return __uint_as_float(((unsigned)v) << 16); }
DI float bflo(unsigned v) { return __uint_as_float(v << 16); }
DI float bfhi(unsigned v) { return __uint_as_float(v & 0xffff0000u); }
DI float sigmoidf_(float v) { return __builtin_amdgcn_rcpf(1.0f + __builtin_amdgcn_exp2f(-1.4426950408889634f * v)); }
DI float siluf_(float v) { return v * __builtin_amdgcn_rcpf(1.0f + __builtin_amdgcn_exp2f(-1.4426950408889634f * v)); }
DI void glds16(const void* g, unsigned lds_base) {
  unsigned sv;
  asm volatile("s_mov_b32 %0, m0\n\ts_mov_b32 m0, %2\n\ts_nop 0\n\tglobal_load_lds_dwordx4 %1, off\n\ts_mov_b32 m0, %0" : "=&s"(sv) : "v"(g), "s"(lds_base) : "memory");
}
template <int CTRL> DI float qperm(float v) { return __int_as_float(__builtin_amdgcn_update_dpp(0, __float_as_int(v), CTRL, 0xF, 0xF, true)); }
#define MFMA16(a, b, c) __builtin_amdgcn_mfma_f32_16x16x32_bf16((a), (b), (c), 0, 0, 0)
#define MFMA32(a, b, c) __builtin_amdgcn_mfma_f32_32x32x16_bf16((a), (b), (c), 0, 0, 0)

struct Params {
  const float *x, *norm_w, *w_in, *q_norm_w, *k_norm_w, *ck_pos, *ck_w1, *ck_b1, *ck_w2, *cv_pos, *cv_w1, *cv_b1, *cv_w2, *conv_w, *conv_b, *w_out;
  float* out;
  char* ws;
};
constexpr size_t al256(size_t v) { return (v + 255) & ~(size_t)255; }
constexpr size_t OFF_xb = 0;
DI u16* ws_xb(const Params& p) { return (u16*)(p.ws + OFF_xb); }
constexpr size_t OFF_winT = OFF_xb + al256((size_t)NROWS * LDK * 2);
DI u16* ws_winT(const Params& p) { return (u16*)(p.ws + OFF_winT); }
constexpr size_t OFF_woutT = OFF_winT + al256((size_t)4096 * LDK * 2);
DI u16* ws_woutT(const Params& p) { return (u16*)(p.ws + OFF_woutT); }
constexpr size_t OFF_w1kT = OFF_woutT + al256((size_t)1024 * LDK * 2);
DI u16* ws_w1kT(const Params& p) { return (u16*)(p.ws + OFF_w1kT); }
constexpr size_t OFF_w1vT = OFF_w1kT + al256((size_t)128 * 2048 * 2);
DI u16* ws_w1vT(const Params& p) { return (u16*)(p.ws + OFF_w1vT); }
constexpr size_t OFF_w2kT = OFF_w1vT + al256((size_t)128 * 2048 * 2);
DI u16* ws_w2kT(const Params& p) { return (u16*)(p.ws + OFF_w2kT); }
constexpr size_t OFF_w2vT = OFF_w2kT + al256((size_t)64 * 128 * 2);
DI u16* ws_w2vT(const Params& p) { return (u16*)(p.ws + OFF_w2vT); }
constexpr size_t OFF_Q = OFF_w2vT + al256((size_t)64 * 128 * 2);
DI u16* ws_Q(const Params& p) { return (u16*)(p.ws + OFF_Q); }
constexpr size_t OFF_Ks = OFF_Q + al256((size_t)NROWS * 512 * 2);
DI u16* ws_Ks(const Params& p) { return (u16*)(p.ws + OFF_Ks); }
constexpr size_t OFF_Kw = OFF_Ks + al256((size_t)16 * 4096 * 64 * 2);
DI u16* ws_Kw(const Params& p) { return (u16*)(p.ws + OFF_Kw); }
constexpr size_t OFF_Vst = OFF_Kw + al256((size_t)16 * 4096 * 64 * 2);
DI u16* ws_Vst(const Params& p) { return (u16*)(p.ws + OFF_Vst); }
constexpr size_t OFF_Vwt = OFF_Vst + al256((size_t)16 * 4096 * 64 * 2);
DI u16* ws_Vwt(const Params& p) { return (u16*)(p.ws + OFF_Vwt); }
constexpr size_t OFF_kcraw = OFF_Vwt + al256((size_t)16 * 4096 * 64 * 2);
DI u16* ws_kcraw(const Params& p) { return (u16*)(p.ws + OFF_kcraw); }
constexpr size_t OFF_vcraw = OFF_kcraw + al256((size_t)16 * 4096 * 64 * 2 + 4096);
DI u16* ws_vcraw(const Params& p) { return (u16*)(p.ws + OFF_vcraw); }
constexpr size_t OFF_Kc = OFF_vcraw + al256((size_t)16 * 4096 * 64 * 2 + 4096);
DI u16* ws_Kc(const Params& p) { return (u16*)(p.ws + OFF_Kc); }
constexpr size_t OFF_Vct = OFF_Kc + al256((size_t)16 * 256 * 64 * 2);
DI u16* ws_Vct(const Params& p) { return (u16*)(p.ws + OFF_Vct); }
constexpr size_t OFF_zs = OFF_Vct + al256((size_t)16 * 256 * 64 * 2);
DI u16* ws_zs(const Params& p) { return (u16*)(p.ws + OFF_zs); }
constexpr size_t OFF_cvb = OFF_zs + al256((size_t)NROWS * 512 * 2);
DI u16* ws_cvb(const Params& p) { return (u16*)(p.ws + OFF_cvb); }
constexpr size_t OFF_mix = OFF_cvb + al256((size_t)NROWS * 2048 * 2);
DI u16* ws_mix(const Params& p) { return (u16*)(p.ws + OFF_mix); }
constexpr size_t OFF_rs = OFF_mix + al256((size_t)NROWS * LDK * 2);
DI float* ws_rs(const Params& p) { return (float*)(p.ws + OFF_rs); }
constexpr size_t OFF_ckpart = OFF_rs + al256((size_t)NROWS * 4);
DI float* ws_ckpart(const Params& p) { return (float*)(p.ws + OFF_ckpart); }
constexpr size_t OFF_rope = OFF_ckpart + al256((size_t)16 * 128 * 4);
DI float* ws_rope(const Params& p) { return (float*)(p.ws + OFF_rope); }
constexpr size_t OFF_gates = OFF_rope + al256((size_t)4096 * 8 * 2 * 4);
DI float* ws_gates(const Params& p) { return (float*)(p.ws + OFF_gates); }
constexpr size_t OFF_counter = OFF_gates + al256((size_t)NROWS * 24 * 4);
DI unsigned* ws_counter(const Params& p) { return (unsigned*)(p.ws + OFF_counter); }
constexpr size_t OFF_bar = OFF_counter + al256((size_t)256);
DI unsigned* ws_bar(const Params& p) { return (unsigned*)(p.ws + OFF_bar); }
constexpr size_t WS_TOTAL = OFF_bar + al256((size_t)3456 * 4);


DI void transpose_tile(const float* __restrict__ src, u16* __restrict__ dst, int K, int N, const float* __restrict__ scale, int kt, int nt, char* smem, int ldd) {
  float* tile = (float*)smem;
  const int tid = threadIdx.x;
  float v[8], sc[8];
  const int nn0 = tid & 63, n0_ = nt * 64 + nn0, nc = n0_ < N ? n0_ : N - 1;
#pragma unroll
  for (int i = 0; i < 8; ++i) {
    const int k = kt * 64 + i * 8 + (tid >> 6);
    v[i] = src[(size_t)k * N + nc];
    sc[i] = scale ? scale[k] : 1.0f;
  }
#pragma unroll
  for (int i = 0; i < 8; ++i) tile[(i * 8 + (tid >> 6)) * 65 + nn0] = (n0_ < N) ? v[i] * sc[i] : 0.f;
  __syncthreads();
#pragma unroll
  for (int i = 0; i < 8; ++i) {
    const int nn = i * 8 + (tid >> 6), kk = tid & 63;
    dst[(size_t)(nt * 64 + nn) * ldd + kt * 64 + kk] = f2bf(tile[kk * 65 + nn]);
  }
  __syncthreads();
}

__device__ void phase_prep(const Params& p, char* smem, int bid, int nb) {
  int tid_ = threadIdx.x; asm volatile("" : "+v"(tid_));
  const int tid = tid_, lane = tid & 63, wid = __builtin_amdgcn_readfirstlane(tid >> 6);
  constexpr int J_X = 1024, J_TW = 1024, J_TO = 256, J_T1 = 64, J_T2 = 2, J_CK = 16, J_ROPE = 64;
  constexpr int TOTAL = J_X + J_TW + J_TO + 2 * J_T1 + 2 * J_T2 + J_CK + J_ROPE;
  if (bid == 0 && tid < 8) ws_counter(p)[tid] = 0u;
  for (int j = bid; j < TOTAL; j += nb) {
    constexpr int HEAD = J_CK + J_ROPE;
    int jj = j < HEAD ? (TOTAL - HEAD) + j : j - HEAD;
    if (jj < J_X) {
      const int row0 = jj * 32 + wid * 4;
      float4 v[4][4]; float ss[4];
#pragma unroll
      for (int r = 0; r < 4; ++r) {
        const float4* xr = (const float4*)(p.x + (size_t)(row0 + r) * DM);
#pragma unroll
        for (int i = 0; i < 4; ++i) v[r][i] = xr[i * 64 + lane];
      }
#pragma unroll
      for (int r = 0; r < 4; ++r) {
        float a = 0.f;
#pragma unroll
        for (int i = 0; i < 4; ++i) a += v[r][i].x * v[r][i].x + v[r][i].y * v[r][i].y + v[r][i].z * v[r][i].z + v[r][i].w * v[r][i].w;
#pragma unroll
        for (int o = 32; o >= 1; o >>= 1) a += __shfl_xor(a, o);
        ss[r] = a;
      }
#pragma unroll
      for (int r = 0; r < 4; ++r) {
        if (lane == 0) ws_rs(p)[row0 + r] = rsqrtf(ss[r] * (1.0f / DM) + EPS);
#pragma unroll
        for (int i = 0; i < 4; ++i) {
          u32x2 o; o[0] = cvtpk(v[r][i].x, v[r][i].y); o[1] = cvtpk(v[r][i].z, v[r][i].w);
          const int rr_ = row0 + r;
          *(u32x2*)(ws_xb(p) + ((size_t)((rr_ >> 8) * 16 + i * 4 + (lane >> 4)) * 256 + (rr_ & 255)) * 64 + (lane & 15) * 4) = o;
        }
      }
      continue;
    }
    jj -= J_X;
    if (jj < J_TW) { transpose_tile(p.w_in, ws_winT(p), 1024, DIN, p.norm_w, jj & 15, jj >> 4, smem, LDK); continue; }
    jj -= J_TW;
    if (jj < J_TO) { transpose_tile(p.w_out, ws_woutT(p), 1024, 1024, nullptr, jj & 15, jj >> 4, smem, LDK); continue; }
    jj -= J_TO;
    if (jj < J_T1) { transpose_tile(p.ck_w1, ws_w1kT(p), 2048, 128, nullptr, jj & 31, jj >> 5, smem, 2048); continue; }
    jj -= J_T1;
    if (jj < J_T1) { transpose_tile(p.cv_w1, ws_w1vT(p), 2048, 128, nullptr, jj & 31, jj >> 5, smem, 2048); continue; }
    jj -= J_T1;
    if (jj < J_T2) { transpose_tile(p.ck_w2, ws_w2kT(p), 128, 64, nullptr, jj, 0, smem, 128); continue; }
    jj -= J_T2;
    if (jj < J_T2) { transpose_tile(p.cv_w2, ws_w2vT(p), 128, 64, nullptr, jj, 0, smem, 128); continue; }
    jj -= J_T2;
    if (jj < J_CK) {
      const int which = jj >> 3, chunk = jj & 7, hh = tid & 127, sub = tid >> 7;
      const float* pos = which ? p.cv_pos : p.ck_pos;
      const float* w1 = which ? p.cv_w1 : p.ck_w1;
      float acc = 0.f;
      const int f0 = chunk * 256 + sub * 64;
      float pv_[64], wv_[64];
#pragma unroll
      for (int f = 0; f < 64; ++f) { pv_[f] = pos[f0 + f]; wv_[f] = w1[(size_t)(f0 + f) * 128 + hh]; }
#pragma unroll
      for (int f = 0; f < 64; ++f) acc += pv_[f] * wv_[f];
      float* red = (float*)smem;
      red[sub * 128 + hh] = acc;
      __syncthreads();
      if (tid < 128) ws_ckpart(p)[(which * 8 + chunk) * 128 + tid] = red[tid] + red[128 + tid] + red[256 + tid] + red[384 + tid];
      __syncthreads();
      continue;
    }
    jj -= J_CK;
    {
      const int idx = jj * 512 + tid, pos = idx >> 3, fi = idx & 7;
      const float ang = (float)pos * c_invf[fi];
      float s, c; sincosf(ang, &s, &c);
      ws_rope(p)[idx * 2] = c; ws_rope(p)[idx * 2 + 1] = s;
    }
  }
}

DI int kimg_off(int row, int d) { return row * 64 + (((d >> 3) ^ ((row >> 1) & 7)) * 8) + (d & 7); }
DI int vimg_off(int d, int key) {
  const int kp = (key & ~12) | ((key & 4) << 1) | ((key & 8) >> 1);
  return d * 64 + (((kp >> 3) ^ ((d >> 1) & 7)) * 8) + (kp & 7);
}

constexpr int G_ASZ = 256 * 128, G_BSZ = 256 * 128, G_STAGE = G_ASZ + G_BSZ;
constexpr int G_ROPE = 2 * G_STAGE, G_RS = G_ROPE + 256 * 64;
static_assert(G_RS + 1024 <= SMEM_BYTES, "GEMM LDS layout exceeds the dynamic LDS size");
#define WAIT_VM(n) asm volatile("s_waitcnt vmcnt(" #n ")" ::: "memory")

template <int EPI>
__device__ void gemm_phase(const Params& p, char* smem, int bid, int nb) {
  constexpr int NT = EPI == 0 ? 16 : 4;
  constexpr int MT = 128;
  const u16* __restrict__ A = EPI == 0 ? ws_xb(p) : ws_mix(p);
  const u16* __restrict__ Bt = EPI == 0 ? ws_winT(p) : ws_woutT(p);
  int tid_ = threadIdx.x; asm volatile("" : "+v"(tid_));
  const int tid = tid_, lane = tid & 63, wid = __builtin_amdgcn_readfirstlane(tid >> 6), fr = lane & 15, fq = lane >> 4;
  const int wr = wid >> 2, wc = wid & 3;
  const bool xmap = (nb == 256);
  const int xcd = bid & 7, li = bid >> 3;
  const int ntiles = xmap ? (EPI == 0 ? 8 : 2) : (MT * NT - bid + nb - 1) / nb;
  auto tile_of = [&](int ti, int& m0, int& n0) {
    if (xmap) {
      const int sg = ti * 8 + xcd;
      if (EPI == 0) { m0 = ((sg >> 1) * 4 + (li >> 3)) * 256; n0 = ((sg & 1) * 8 + (li & 7)) * 256; }
      else { m0 = (sg * 8 + (li >> 2)) * 256; n0 = (li & 3) * 256; }
    } else { const int tile = bid + ti * nb; const int mt = tile / NT; m0 = mt * 256; n0 = (tile - mt * NT) * 256; }
  };
  const int nsteps = ntiles * 16;
  const unsigned lds0 = (unsigned)(uintptr_t)smem;
  const int gsw = (lane & 7) ^ ((wid & 1) * 4 + (lane >> 4));
  const int grow = wid * 8 + (lane >> 3);
  auto issue = [&](int step, int stage) {
    int m0, n0; tile_of(step >> 4, m0, n0);
    const int kt = step & 15;
    const u16* ag = EPI == 0 ? A + ((size_t)((m0 >> 8) * 16 + kt) * 256 + grow) * 64 + gsw * 8 : A + (size_t)(m0 + grow) * LDK + kt * 64 + gsw * 8;
    const size_t astep = EPI == 0 ? (size_t)64 * 64 : (size_t)64 * LDK;
    const int brow = EPI == 0 ? ((grow & ~31) | ((grow & 0x0C) << 1) | ((grow & 0x10) >> 2) | (grow & 3)) : grow;
    const u16* bg_ = Bt + (size_t)(n0 + brow) * LDK + kt * 64 + gsw * 8;
    const unsigned dst = (unsigned)__builtin_amdgcn_readfirstlane((int)(lds0 + stage * G_STAGE + wid * 1024));
#pragma unroll
    for (int i = 0; i < 4; ++i) glds16(ag + i * astep, dst + i * 8192);
#pragma unroll
    for (int i = 0; i < 4; ++i) glds16(bg_ + (size_t)i * 64 * LDK, dst + G_ASZ + i * 8192);
    if (EPI == 0 && kt == 8) {
      const int t0 = m0 & 4095;
      const unsigned sd = (unsigned)__builtin_amdgcn_readfirstlane((int)(lds0 + G_ROPE + wid * 1024));
      glds16(ws_rope(p) + (size_t)t0 * 16 + tid * 4, sd);
      glds16(ws_rope(p) + (size_t)t0 * 16 + (512 + tid) * 4, sd + 8192);
      if (wid == 0) glds16(ws_rs(p) + m0 + lane * 4, lds0 + G_RS);
    }
  };
  const int ca0 = ((fq ^ (fr >> 1)) * 16), ca1 = (((4 + fq) ^ (fr >> 1)) * 16);
  f32x4 acc[8][4];
#pragma unroll
  for (int m = 0; m < 8; ++m)
#pragma unroll
    for (int n = 0; n < 4; ++n) acc[m][n] = f32x4{0.f, 0.f, 0.f, 0.f};
  __syncthreads();
  if (nsteps > 0) issue(0, 0);
  for (int s = 0; s < nsteps; ++s) {
    WAIT_VM(0);
    __builtin_amdgcn_s_waitcnt(0x0F70);
    __builtin_amdgcn_s_barrier();
    {
      const char* ab = smem + (s & 1) * G_STAGE + (wr * 128 + fr) * 128;
      const char* bb = smem + (s & 1) * G_STAGE + G_ASZ + (wc * 64 + fr) * 128;
      bf16x8 af[8], bf[4];
#pragma unroll
      for (int n = 0; n < 4; ++n) bf[n] = *(const bf16x8*)(bb + n * 16 * 128 + ca0);
#pragma unroll
      for (int m = 0; m < 8; ++m) af[m] = *(const bf16x8*)(ab + m * 16 * 128 + ca0);
      if (s + 1 < nsteps) issue(s + 1, (s + 1) & 1);
#pragma unroll
      for (int m = 0; m < 8; ++m)
#pragma unroll
        for (int n = 0; n < 4; ++n) acc[m][n] = MFMA16(bf[n], af[m], acc[m][n]);
#pragma unroll
      for (int n = 0; n < 4; ++n) bf[n] = *(const bf16x8*)(bb + n * 16 * 128 + ca1);
#pragma unroll
      for (int m = 0; m < 8; ++m) af[m] = *(const bf16x8*)(ab + m * 16 * 128 + ca1);
#pragma unroll
      for (int m = 0; m < 8; ++m)
#pragma unroll
        for (int n = 0; n < 4; ++n) acc[m][n] = MFMA16(bf[n], af[m], acc[m][n]);
    }
    if ((s & 15) != 15) continue;
    int m0, n0; tile_of(s >> 4, m0, n0);
    const int rbase = m0 + wr * 128;
    const int cb = n0 + wc * 64;
    if constexpr (EPI == 1) {
#pragma unroll
      for (int hm = 0; hm < 2; ++hm) {
        float4 xv[4][4];
#pragma unroll
        for (int mm = 0; mm < 4; ++mm) {
          const size_t ro = (size_t)(rbase + (hm * 4 + mm) * 16 + fr) * DM + cb + fq * 4;
#pragma unroll
          for (int n = 0; n < 4; ++n) xv[mm][n] = *(const float4*)(p.x + ro + n * 16);
        }
#pragma unroll
        for (int mm = 0; mm < 4; ++mm) {
          const int m = hm * 4 + mm;
          const size_t ro = (size_t)(rbase + m * 16 + fr) * DM + cb + fq * 4;
#pragma unroll
          for (int n = 0; n < 4; ++n) {
            float4 o; o.x = xv[mm][n].x + acc[m][n][0]; o.y = xv[mm][n].y + acc[m][n][1]; o.z = xv[mm][n].z + acc[m][n][2]; o.w = xv[mm][n].w + acc[m][n][3];
            *(float4*)(p.out + ro + n * 16) = o;
          }
        }
        __builtin_amdgcn_sched_barrier(0);
      }
    } else {
      const int b = m0 >> 12;
      const int tb = rbase & 4095;
      if (cb < 1280) {
        const int seg = cb >> 6;
        const int which = seg < 8 ? -1 : ((seg - 8) >> 1);
        const int g = seg < 8 ? (seg >> 2) : ((seg - 8) & 1);
        const bool need_norm = (seg < 8) || which == 2 || which == 4;
        const float* nw = seg < 8 ? p.q_norm_w : (p.k_norm_w + (which == 2 ? 64 : 128));
        float w[16];
#pragma unroll
        for (int k = 0; k < 16; ++k) w[k] = need_norm ? nw[(k >> 3) * 32 + fq * 8 + (k & 7)] : 1.0f;
        const float qs = seg < 8 ? QSCALE : 1.0f;
#pragma unroll
        for (int m = 0; m < 8; ++m) {
          const int t = tb + m * 16 + fr;
          const int lrow = wr * 128 + m * 16 + fr;
          const float r = *(const float*)(smem + G_RS + lrow * 4);
          float v[16];
#pragma unroll
          for (int k = 0; k < 16; ++k) v[k] = acc[m][(k >> 3) * 2 + ((k & 7) >> 2)][k & 3] * r;
          if (need_norm) {
            float ss = 0.f;
#pragma unroll
            for (int k = 0; k < 16; ++k) ss += v[k] * v[k];
            ss += __shfl_xor(ss, 16); ss += __shfl_xor(ss, 32);
            const float rr = rsqrtf(ss * (1.0f / 64.f) + EPS);
#pragma unroll
            for (int k = 0; k < 16; ++k) v[k] = v[k] * rr * w[k];
            const float4* rp = (const float4*)(smem + G_ROPE + lrow * 64);
            const float4 c01 = rp[0], c23 = rp[1], c45 = rp[2], c67 = rp[3];
            const float cc[8] = {c01.x, c01.z, c23.x, c23.z, c45.x, c45.z, c67.x, c67.z};
            const float sn[8] = {c01.y, c01.w, c23.y, c23.w, c45.y, c45.w, c67.y, c67.w};
#pragma unroll
            for (int e = 0; e < 8; ++e) {
              const float pr = __shfl_xor(v[e], 16);
              const float rot = (fq == 0) ? (v[e] * cc[e] - pr * sn[e]) : (v[e] * cc[e] + pr * sn[e]);
              v[e] = (fq < 2) ? rot : v[e];
            }
#pragma unroll
            for (int k = 0; k < 16; ++k) v[k] *= qs;
          }
          if (which == 3 || which == 5) {
            int lz = 0; asm volatile("" : "+v"(lz));
            u16* vt = (which == 3 ? ws_Vst(p) : ws_Vwt(p)) + (size_t)((b * 2 + g) * 64 + (t >> 6)) * 4096 + lz;
            const int fqx = fq + lz, key = (t & 63) + lz;
#pragma unroll
            for (int k = 0; k < 16; ++k) vt[vimg_off((k >> 3) * 32 + fqx * 8 + (k & 7), key)] = f2bf(v[k]);
          } else {
            u16* dst;
            if (seg < 8) dst = ws_Q(p) + ((size_t)((b * 2 + g) * 4096 + t) * 4 + (seg & 3)) * 64;
            else { u16* buf = which == 0 ? ws_kcraw(p) : which == 1 ? ws_vcraw(p) : which == 2 ? ws_Ks(p) : ws_Kw(p); dst = buf + ((size_t)(b * 2 + g) * 4096 + t) * 64; }
            const bool img = which >= 2;
#pragma unroll
            for (int n2 = 0; n2 < 2; ++n2) {
              u32x4 o;
#pragma unroll
              for (int e = 0; e < 4; ++e) o[e] = cvtpk(v[n2 * 8 + 2 * e], v[n2 * 8 + 2 * e + 1]);
              const int d0 = n2 * 32 + fq * 8;
              const int off = img ? (((d0 >> 3) ^ (((t & 63) >> 1) & 7)) * 8) : d0;
              *(u32x4*)(dst + off) = o;
            }
          }
          __builtin_amdgcn_sched_barrier(0);
        }
      } else {
#pragma unroll
        for (int m = 0; m < 8; ++m) {
          const size_t row = rbase + m * 16 + fr;
          const float r = *(const float*)(smem + G_RS + (wr * 128 + m * 16 + fr) * 4);
#pragma unroll
          for (int n2 = 0; n2 < 2; ++n2) {
            const int c8 = cb + n2 * 32 + fq * 8;
            if (c8 >= DIN) continue;
            float v[8];
#pragma unroll
            for (int e = 0; e < 8; ++e) v[e] = acc[m][n2 * 2 + (e >> 2)][e & 3] * r;
            if (c8 < 1304) {
              float4 o0, o1;
              o0.x = sigmoidf_(v[0]); o0.y = sigmoidf_(v[1]); o0.z = sigmoidf_(v[2]); o0.w = sigmoidf_(v[3]);
              o1.x = sigmoidf_(v[4]); o1.y = sigmoidf_(v[5]); o1.z = sigmoidf_(v[6]); o1.w = sigmoidf_(v[7]);
              float* gp = ws_gates(p) + row * 24 + (c8 - 1280);
              *(float4*)gp = o0; *(float4*)(gp + 4) = o1;
            } else if (c8 < 1816) {
              u32x4 o;
#pragma unroll
              for (int e = 0; e < 4; ++e) o[e] = cvtpk(siluf_(v[2 * e]), siluf_(v[2 * e + 1]));
              *(u32x4*)(ws_zs(p) + row * 512 + (c8 - 1304)) = o;
            } else {
              u32x4 o;
#pragma unroll
              for (int e = 0; e < 4; ++e) o[e] = cvtpk(v[2 * e], v[2 * e + 1]);
              *(u32x4*)(ws_cvb(p) + row * 2048 + (c8 - 1816)) = o;
            }
          }
          __builtin_amdgcn_sched_barrier(0);
        }
      }
    }
#pragma unroll
    for (int m = 0; m < 8; ++m)
#pragma unroll
      for (int n = 0; n < 4; ++n) acc[m][n] = f32x4{0.f, 0.f, 0.f, 0.f};
  }
}

__device__ void phase_cmp_conv(const Params& p, char* smem, int bid, int nb) {
  int tid_ = threadIdx.x; asm volatile("" : "+v"(tid_));
  const int tid = tid_, lane = tid & 63, wid = __builtin_amdgcn_readfirstlane(tid >> 6), fr = lane & 15, fq = lane >> 4;
  float* part = (float*)smem;
  char* hl = smem + 8 * 16 * 132 * 4;
  float* outl = (float*)(hl + 2 * 4352);
  float* biasl = outl + 2 * 1088;
  for (int job = bid; job < 256; job += nb) {
    const int which = wid >> 2, w4 = wid & 3, bg = job >> 4, ct = job & 15;
    const u16* raw = (which ? ws_vcraw(p) : ws_kcraw(p)) + (size_t)bg * 4096 * 64;
    const u16* w1T = which ? ws_w1vT(p) : ws_w1kT(p);
    const u16* w2T = which ? ws_w2vT(p) : ws_w2kT(p);
    const float* b1 = which ? p.cv_b1 : p.ck_b1;
    f32x4 acc[8];
#pragma unroll
    for (int n = 0; n < 8; ++n) acc[n] = f32x4{0.f, 0.f, 0.f, 0.f};
    const int c = ct * 16 + fr;
    const int ht = tid & 255, rrow = ht >> 4, c8 = (ht & 15) * 8;
    const int orow = ht >> 4, d4 = (ht & 15) * 4;
    const int cc = ct * 16 + orow;
#pragma unroll 1
    for (int kb4 = 0; kb4 < 16; kb4 += 4) {
      bf16x8 av[4], bv[4][8];
#pragma unroll
      for (int q = 0; q < 4; ++q) {
        const int ks = w4 * 16 + kb4 + q;
        const int l = ks >> 1, d0 = (ks & 1) * 32 + fq * 8;
        int tt = c * 16 + l; tt = tt > 4095 ? 4095 : tt;
        av[q] = *(const bf16x8*)(raw + (size_t)tt * 64 + d0);
#pragma unroll
        for (int n = 0; n < 8; ++n) bv[q][n] = *(const bf16x8*)(w1T + (size_t)(n * 16 + fr) * 2048 + ks * 32 + fq * 8);
      }
#pragma unroll
      for (int q = 0; q < 4; ++q)
#pragma unroll
        for (int n = 0; n < 8; ++n) acc[n] = MFMA16(av[q], bv[q][n], acc[n]);
      __builtin_amdgcn_sched_group_barrier(0x020, 36, 0);
      __builtin_amdgcn_sched_group_barrier(0x008, 32, 0);
    }
    if (ht < 128) {
      float bq[9];
      bq[0] = b1[ht];
#pragma unroll
      for (int ch = 0; ch < 8; ++ch) bq[1 + ch] = ws_ckpart(p)[(which * 8 + ch) * 128 + ht];
      float bsum = bq[0];
#pragma unroll
      for (int ch = 0; ch < 8; ++ch) bsum += bq[1 + ch];
      biasl[which * 128 + ht] = bsum;
    }
#pragma unroll
    for (int n = 0; n < 8; ++n)
#pragma unroll
      for (int j = 0; j < 4; ++j) part[(wid * 16 + fq * 4 + j) * 132 + n * 16 + fr] = acc[n][j];
    __syncthreads();
    {
      float bias[8];
#pragma unroll
      for (int e = 0; e < 8; ++e) bias[e] = biasl[which * 128 + c8 + e];
      float sum[8];
#pragma unroll
      for (int e = 0; e < 8; ++e) sum[e] = bias[e];
#pragma unroll
      for (int w = 0; w < 4; ++w) {
        const float4 v0 = *(const float4*)(part + ((which * 4 + w) * 16 + rrow) * 132 + c8), v1 = *(const float4*)(part + ((which * 4 + w) * 16 + rrow) * 132 + c8 + 4);
        sum[0] += v0.x; sum[1] += v0.y; sum[2] += v0.z; sum[3] += v0.w; sum[4] += v1.x; sum[5] += v1.y; sum[6] += v1.z; sum[7] += v1.w;
      }
      u32x4 o;
#pragma unroll
      for (int e = 0; e < 4; ++e) o[e] = cvtpk(siluf_(sum[2 * e]), siluf_(sum[2 * e + 1]));
      *(u32x4*)(hl + which * 4352 + rrow * 272 + c8 * 2) = o;
    }
    __syncthreads();
    {
    bf16x8 w2f[4];
#pragma unroll
    for (int ks = 0; ks < 4; ++ks) w2f[ks] = *(const bf16x8*)(w2T + (size_t)(w4 * 16 + fr) * 128 + ks * 32 + fq * 8);
      f32x4 o2 = f32x4{0.f, 0.f, 0.f, 0.f};
#pragma unroll
      for (int ks = 0; ks < 4; ++ks) {
        const bf16x8 a = *(const bf16x8*)(hl + which * 4352 + fr * 272 + (ks * 32 + fq * 8) * 2);
        o2 = MFMA16(a, w2f[ks], o2);
      }
#pragma unroll
      for (int j = 0; j < 4; ++j) outl[which * 1088 + (fq * 4 + j) * 68 + w4 * 16 + fr] = o2[j];
    }
    __syncthreads();
    {
    float nwv[4], nwp[4]; float2 csv[4];
    {
      int pos = cc * 16 + 31; pos = pos > 4095 ? 4095 : pos;
#pragma unroll
      for (int e = 0; e < 4; ++e) {
        const int d = d4 + e;
        nwv[e] = p.k_norm_w[d]; nwp[e] = p.k_norm_w[d ^ 8];
        csv[e] = *(const float2*)(ws_rope(p) + ((size_t)pos * 8 + (d & 7)) * 2);
      }
    }
      const float* ol = outl + which * 1088;
      const float4 v = *(const float4*)(ol + orow * 68 + d4);
      if (which == 0) {
        float ss = v.x * v.x + v.y * v.y + v.z * v.z + v.w * v.w;
        ss += __shfl_xor(ss, 1); ss += __shfl_xor(ss, 2); ss += __shfl_xor(ss, 4); ss += __shfl_xor(ss, 8);
        const float rr = rsqrtf(ss * (1.0f / 64.f) + EPS);
        float o[4] = {v.x * rr * nwv[0], v.y * rr * nwv[1], v.z * rr * nwv[2], v.w * rr * nwv[3]};
        if (d4 < 16) {
#pragma unroll
          for (int e = 0; e < 4; ++e) {
            const int d = d4 + e, dp = d ^ 8;
            const float pr = ol[orow * 68 + dp] * rr * nwp[e];
            o[e] = (d < 8) ? (o[e] * csv[e].x - pr * csv[e].y) : (o[e] * csv[e].x + pr * csv[e].y);
          }
        }
        u32x2 ov; ov[0] = cvtpk(o[0], o[1]); ov[1] = cvtpk(o[2], o[3]);
        if (cc >= 255) { ov[0] = 0u; ov[1] = 0u; }
        *(u32x2*)(ws_Kc(p) + (size_t)(bg * 4 + (cc >> 6)) * 4096 + kimg_off(cc & 63, d4)) = ov;
      } else {
        const float z = (cc >= 255) ? 0.f : 1.f;
        u16* vt = ws_Vct(p) + (size_t)(bg * 4 + (cc >> 6)) * 4096;
        vt[vimg_off(d4 + 0, cc & 63)] = f2bf(v.x * z); vt[vimg_off(d4 + 1, cc & 63)] = f2bf(v.y * z);
        vt[vimg_off(d4 + 2, cc & 63)] = f2bf(v.z * z); vt[vimg_off(d4 + 3, cc & 63)] = f2bf(v.w * z);
      }
    }
    __syncthreads();
  }
  const int gw = bid * 8 + wid, nw = nb * 8;
  for (int chunk = gw; chunk < 2048; chunk += nw) {
    const int r0 = chunk * 16, t0 = r0 & 4095;
    const int ch = lane * 8;
    float cw0[8], cw1[8], cw2[8], cbv[8], u1[8], u2[8];
#pragma unroll
    for (int e = 0; e < 8; ++e) { cw0[e] = p.conv_w[ch + e]; cw1[e] = p.conv_w[512 + ch + e]; cw2[e] = p.conv_w[1024 + ch + e]; cbv[e] = p.conv_b[ch + e]; u1[e] = 0.f; u2[e] = 0.f; }
    if (t0 > 0) {
#pragma unroll
      for (int q = 0; q < 2; ++q) {
        const u16* rp = ws_cvb(p) + (size_t)(r0 - 2 + q) * 2048 + ch;
        const u32x4 hv = *(const u32x4*)(rp), cv = *(const u32x4*)(rp + 1024);
#pragma unroll
        for (int e = 0; e < 4; ++e) {
          const float ua = bflo(hv[e]) * bflo(cv[e]), ub = bfhi(hv[e]) * bfhi(cv[e]);
          if (q == 0) { u2[2 * e] = ua; u2[2 * e + 1] = ub; } else { u1[2 * e] = ua; u1[2 * e + 1] = ub; }
        }
      }
    }
#pragma unroll 1
    for (int rb = 0; rb < 16; rb += 8) {
      u32x4 hvv[8], bvv[8], cvv[8], zvv[8];
#pragma unroll
      for (int q = 0; q < 8; ++q) {
        const u16* rp = ws_cvb(p) + (size_t)(r0 + rb + q) * 2048 + ch;
        hvv[q] = *(const u32x4*)(rp); bvv[q] = *(const u32x4*)(rp + 512); cvv[q] = *(const u32x4*)(rp + 1024); zvv[q] = *(const u32x4*)(rp + 1536);
      }
#pragma unroll
      for (int q = 0; q < 8; ++q) {
        const u32x4 hv = hvv[q], bv = bvv[q], cv = cvv[q], zv = zvv[q];
        u32x4 ov;
#pragma unroll
        for (int e = 0; e < 4; ++e) {
          const float ua = bflo(hv[e]) * bflo(cv[e]), ub = bfhi(hv[e]) * bfhi(cv[e]);
          const float ca = cw0[2 * e] * u2[2 * e] + cw1[2 * e] * u1[2 * e] + cw2[2 * e] * ua + cbv[2 * e];
          const float cbb = cw0[2 * e + 1] * u2[2 * e + 1] + cw1[2 * e + 1] * u1[2 * e + 1] + cw2[2 * e + 1] * ub + cbv[2 * e + 1];
          const float oa = bflo(bv[e]) * ca * siluf_(bflo(zv[e]));
          const float ob = bfhi(bv[e]) * cbb * siluf_(bfhi(zv[e]));
          ov[e] = cvtpk(oa, ob);
          u2[2 * e] = u1[2 * e]; u2[2 * e + 1] = u1[2 * e + 1]; u1[2 * e] = ua; u1[2 * e + 1] = ub;
        }
        *(u32x4*)(ws_mix(p) + (size_t)(r0 + rb + q) * LDK + 512 + ch) = ov;
      }
    }
  }
}

constexpr int AT_NST = 5, AT_KB = 8192, AT_BUF = 16384;
constexpr int AT_F = AT_NST * AT_BUF, AT_IMPA = AT_F, AT_IMPB = AT_IMPA + 64 * 65 * 4, AT_VAL = AT_IMPA;
constexpr int AT_SELM = AT_F + 8 * 8192, AT_UNIT = AT_SELM + 512, AT_END = AT_UNIT + 16;
static_assert(AT_END <= SMEM_BYTES, "attention LDS layout exceeds the dynamic LDS size");

__device__ void phase_attn(const Params& p, char* smem, int bid, int nb, int rep) {
  int tid_ = threadIdx.x; asm volatile("" : "+v"(tid_));
  const int tid = tid_, lane = tid & 63, wid = __builtin_amdgcn_readfirstlane(tid >> 6), c32 = lane & 31, h = lane >> 5;
  const float NINF = -__builtin_inff();
  float* impa = (float*)(smem + AT_IMPA);
  float* impb = (float*)(smem + AT_IMPB);
  float* vals = (float*)(smem + AT_VAL);
  unsigned* selm = (unsigned*)(smem + AT_SELM);
  volatile int* s_unit = (volatile int*)(smem + AT_UNIT);
  const unsigned lds0 = (unsigned)(uintptr_t)smem;
  while (true) {
    if (tid == 0) *s_unit = (int)atomicAdd(ws_counter(p) + rep, 1u);
    __syncthreads();
    const int u = __builtin_amdgcn_readfirstlane(*s_unit);
    __syncthreads();
    if (u >= 1024) break;
    const int i = 63 - (u >> 4), bg = u & 15, b = bg >> 1, g = bg & 1;
    const int tl = wid * 8 + (c32 >> 2), hd = c32 & 3;
    const int t = i * 64 + tl;
    const u16* qrow = ws_Q(p) + ((size_t)(bg * 4096 + i * 64) * 4 + wid * 32 + c32) * 64;
    bf16x8 qf[4];
#pragma unroll
    for (int ks = 0; ks < 4; ++ks) qf[ks] = *(const bf16x8*)(qrow + ks * 16 + h * 8);
    const float* gp = ws_gates(p) + (size_t)(b * 4096 + t) * 24 + (g * 4 + hd) * 3;
    const float g0 = gp[0], g1 = gp[1], g2 = gp[2];
    asm volatile("" :: "v"(qf[0]), "v"(qf[1]), "v"(qf[2]), "v"(qf[3]), "v"(g0), "v"(g1), "v"(g2));
    const int ntc = (4 * i + 2) / 64 + 1, nsl = i + 1, nwin = (i < 8 ? i : 8) + 1;
    const int NT = 2 * ntc + nsl + nwin;
    const bool need_sel = i >= 16;

    f32x16 O0, O1;
#pragma unroll
    for (int r = 0; r < 16; ++r) { O0[r] = 0.f; O1[r] = 0.f; }
    float* fl = (float*)(smem + AT_F + wid * 8192) + lane;
    float m_run = NINF, l_run = 0.f, inv_l = 0.f;
    u32x4 kxw; kxw[0] = (h == 0) ? 0x3F80u : 0u; kxw[1] = 0u; kxw[2] = 0u; kxw[3] = 0u;
    const bf16x8 kx = __builtin_bit_cast(bf16x8, kxw);
    float oscale = 1.0f;
    unsigned sel_lo = 0xffffffffu, sel_hi = 0xffffffffu;
#define TILE_PTRS(n, kp, vp) do { \
      if ((n) < 2 * ntc) { const int tt_ = (n) < ntc ? (n) : (n) - ntc; kp = ws_Kc(p) + (size_t)(bg * 4 + tt_) * 4096; vp = ws_Vct(p) + (size_t)(bg * 4 + tt_) * 4096; } \
      else if ((n) < 2 * ntc + nsl) { const int j_ = (n) - 2 * ntc; kp = ws_Ks(p) + ((size_t)bg * 4096 + j_ * 64) * 64; vp = ws_Vst(p) + (size_t)(bg * 64 + j_) * 4096; } \
      else { const int j_ = i - nwin + 1 + ((n) - 2 * ntc - nsl); kp = ws_Kw(p) + ((size_t)bg * 4096 + j_ * 64) * 64; vp = ws_Vwt(p) + (size_t)(bg * 64 + j_) * 4096; } } while (0)
#define TISSUE(n, st_) do { const u16 *kp_, *vp_; TILE_PTRS(n, kp_, vp_); \
      const unsigned d_ = (unsigned)__builtin_amdgcn_readfirstlane((int)(lds0 + (st_) * AT_BUF + wid * 1024)); \
      glds16(kp_ + tid * 8, d_); glds16(vp_ + tid * 8, d_ + AT_KB); } while (0)
    {
      const int npre = NT < AT_NST - 1 ? NT : AT_NST - 1;
      for (int n = 0; n < npre; ++n) TISSUE(n, n);
    }
    int st_cur = 0, st_iss = AT_NST - 1;
    const int ksw = (c32 >> 1) & 7;
    for (int n = 0; n < NT; ++n) {
      {
        const int rem = NT - 1 - n;
        if (rem >= 3) WAIT_VM(6); else if (rem == 2) WAIT_VM(4); else if (rem == 1) WAIT_VM(2); else WAIT_VM(0);
        __builtin_amdgcn_s_barrier();
        if (n + AT_NST - 1 < NT) TISSUE(n + AT_NST - 1, st_iss);
      }
      int mode, base, lo, hi;
      bool full = false, lane_on = true;
      if (n < 2 * ntc) { mode = n < ntc ? 0 : 1; base = (n < ntc ? n : n - ntc) * 64; lo = -1; hi = (t - 31) >> 4; }
      else if (n < 2 * ntc + nsl) { const int j = n - 2 * ntc; mode = 2; base = j * 64; const unsigned bit = j < 32 ? (sel_lo >> j) & 1u : (sel_hi >> (j - 32)) & 1u; lo = -1; hi = bit ? t : -1; full = j < i; lane_on = bit != 0u; }
      else { const int j = i - nwin + 1 + (n - 2 * ntc - nsl); mode = 3; base = j * 64; lo = t - 512; hi = t; full = (j < i) && (j > i - 8); }
      const int lo_rel = lo - (base + 4 * h), hi_rel = hi - (base + 4 * h);
      const bool chk = ((n & 7) == 7) || mode == 0;
#pragma unroll
      for (int r = 0; r < 16; ++r) { O0[r] *= oscale; O1[r] *= oscale; }
      const char* kb = smem + st_cur * AT_BUF;
      const char* vb = kb + AT_KB;
      st_cur = st_cur == AT_NST - 1 ? 0 : st_cur + 1; st_iss = st_iss == AT_NST - 1 ? 0 : st_iss + 1;
      f32x16 S0, S1;
#define ATT_BODY(MASKED) do { \
      _Pragma("unroll") for (int r = 0; r < 16; ++r) { S0[r] = 0.f; S1[r] = 0.f; } \
      const float m_use = (m_run == NINF) ? 0.f : m_run;        \
      { \
          \
        const float negm = (!(MASKED) && !lane_on) ? NINF : -m_use; \
        u32x4 qxw; qxw[0] = (h == 0) ? (cvtpk(negm, 0.f) & 0xffffu) : 0u; qxw[1] = 0u; qxw[2] = 0u; qxw[3] = 0u; \
        const bf16x8 qx = __builtin_bit_cast(bf16x8, qxw); \
        S0 = MFMA32(kx, qx, S0); S1 = MFMA32(kx, qx, S1); \
      } \
      { \
        bf16x8 kf0[4], kf1[4]; \
        _Pragma("unroll") for (int ks = 0; ks < 4; ++ks) { \
          kf0[ks] = *(const bf16x8*)(kb + c32 * 128 + (((ks * 2 + h) ^ ksw) * 16)); \
          kf1[ks] = *(const bf16x8*)(kb + (32 + c32) * 128 + (((ks * 2 + h) ^ ksw) * 16)); \
        } \
        _Pragma("unroll") for (int ks = 0; ks < 4; ++ks) S0 = MFMA32(kf0[ks], qf[ks], S0);     \
        _Pragma("unroll") for (int ks = 0; ks < 4; ++ks) S1 = MFMA32(kf1[ks], qf[ks], S1); \
      } \
        \
      if ((MASKED) == 2) {                       \
        _Pragma("unroll") for (int r = 0; r < 16; ++r) { \
          const int off = (r & 3) + 8 * (r >> 2); \
          S0[r] = (off > lo_rel && off <= hi_rel) ? S0[r] : NINF; \
          S1[r] = (off + 32 > lo_rel && off + 32 <= hi_rel) ? S1[r] : NINF; \
        } \
      } else if (MASKED) {                       \
        _Pragma("unroll") for (int r = 0; r < 16; ++r) { \
          const int off = (r & 3) + 8 * (r >> 2); \
          S0[r] = (off <= hi_rel) ? S0[r] : NINF; \
          S1[r] = (off + 32 <= hi_rel) ? S1[r] : NINF; \
        } \
      } \
      float ps0 = 0.f, ps1 = 0.f; \
      bf16x8 vfa[4]; \
      _Pragma("unroll") for (int kk = 0; kk < 2; ++kk) \
        _Pragma("unroll") for (int dr = 0; dr < 2; ++dr) vfa[kk * 2 + dr] = *(const bf16x8*)(vb + (32 * dr + c32) * 128 + (((2 * kk + h) ^ ksw) * 16)); \
      _Pragma("unroll") for (int r = 0; r < 16; ++r) { S0[r] = __builtin_amdgcn_exp2f(S0[r]); ps0 += S0[r]; } \
      _Pragma("unroll") for (int kk = 0; kk < 2; ++kk) { \
        u32x4 pw; \
        _Pragma("unroll") for (int e = 0; e < 4; ++e) pw[e] = cvtpk(S0[8 * kk + 2 * e], S0[8 * kk + 2 * e + 1]); \
        const bf16x8 pf = __builtin_bit_cast(bf16x8, pw); \
        O0 = MFMA32(vfa[kk * 2], pf, O0); O1 = MFMA32(vfa[kk * 2 + 1], pf, O1); \
      } \
      __builtin_amdgcn_sched_group_barrier(0x100, 12, 0);     \
      __builtin_amdgcn_sched_group_barrier(0x008, 4, 0);      \
      _Pragma("unroll") for (int q_ = 0; q_ < 4; ++q_) { __builtin_amdgcn_sched_group_barrier(0x008, 1, 0); __builtin_amdgcn_sched_group_barrier(0x002, 9, 0); }     \
      __builtin_amdgcn_sched_barrier(0); \
      _Pragma("unroll") for (int r = 0; r < 16; ++r) { S1[r] = __builtin_amdgcn_exp2f(S1[r]); ps1 += S1[r]; } \
      _Pragma("unroll") for (int kk = 0; kk < 2; ++kk) { \
        u32x4 pw; \
        _Pragma("unroll") for (int e = 0; e < 4; ++e) pw[e] = cvtpk(S1[8 * kk + 2 * e], S1[8 * kk + 2 * e + 1]); \
        const bf16x8 pf = __builtin_bit_cast(bf16x8, pw); \
        const bf16x8 va0 = *(const bf16x8*)(vb + c32 * 128 + (((2 * (kk + 2) + h) ^ ksw) * 16)), va1 = *(const bf16x8*)(vb + (32 + c32) * 128 + (((2 * (kk + 2) + h) ^ ksw) * 16)); \
        O0 = MFMA32(va0, pf, O0); O1 = MFMA32(va1, pf, O1); \
      } \
      __builtin_amdgcn_sched_barrier(0); \
      oscale = 1.0f; \
      if (mode != 1) l_run += ps0 + ps1; \
      if (mode != 1 && chk) {                    \
        float mxp = fmaxf(fmaxf(S0[0], S0[1]), S1[0]); \
        mxp = fmaxf(fmaxf(mxp, S1[1]), S0[2]); \
        _Pragma("unroll") for (int r = 2; r < 16; r += 2) { \
          if (r > 2) mxp = fmaxf(fmaxf(mxp, S0[r]), S1[r - 1]); \
          mxp = fmaxf(fmaxf(mxp, S0[r + 1]), S1[r]); \
        } \
        mxp = fmaxf(mxp, S1[15]); \
        mxp = fmaxf(mxp, __shfl_xor(mxp, 32));            \
        const bool mv = (m_run == NINF) ? (mxp > 0.f) : (mxp > 256.0f); \
        const float m_new = bflo(cvtpk(m_use + __builtin_amdgcn_logf(mxp), 0.f));       \
        const float alpha = mv ? __builtin_amdgcn_exp2f(m_use - m_new) : 1.0f; \
        m_run = mv ? m_new : m_run; \
        l_run *= alpha; \
        oscale = alpha; \
      } \
      if ((MASKED) == 1 && mode == 1 && need_sel) {               \
        const int tt = base >> 6; \
        _Pragma("unroll") for (int kr = 0; kr < 2; ++kr) \
          _Pragma("unroll") for (int rg = 0; rg < 4; ++rg) { \
            float pv[4]; \
            _Pragma("unroll") for (int e = 0; e < 4; ++e) { \
              float v = (kr ? S1[rg * 4 + e] : S0[rg * 4 + e]) * inv_l; \
              v += qperm<0xB1>(v); v += qperm<0x4E>(v);            \
              pv[e] = v; \
            } \
            if (hd == 0) { \
              const int nblk = tt * 16 + 8 * kr + 2 * rg + h; \
              impa[tl * 65 + nblk] = pv[0] + pv[1] + pv[2] + 0.5f * pv[3]; \
              impb[tl * 65 + nblk] = 0.5f * pv[3]; \
            } \
          } \
      } } while (0)
      if (full) ATT_BODY(0); else if (mode == 3 && base < i * 64) ATT_BODY(2); else ATT_BODY(1);
#undef ATT_BODY
      if (n == ntc - 1) {
        const float lt = l_run + __shfl_xor(l_run, 32);
        inv_l = lt > 0.f ? 1.0f / lt : 0.f;
        oscale = 0.f;
      } else if (n == 2 * ntc - 1) {
        if (need_sel) {
          __syncthreads();
          for (int q = 0; q < 8; ++q) {
            const int tk = wid * 8 + q, nn = lane;
            const bool forced = (nn == 0) || (nn == i) || (nn == i - 1);
            const bool vis = nn <= i;
            float v = 0.f;
            if (vis) v = impa[tk * 65 + nn] + (nn > 0 ? impb[tk * 65 + nn - 1] : 0.f);
            const unsigned bse = forced ? 0x4E6E6B28u : __float_as_uint(v);
            const unsigned key = (bse & ~127u) | (vis ? 64u : 0u) | (unsigned)(63 - nn);
            unsigned T = 0u;
#pragma unroll 1
            for (int bbit = 31; bbit >= 0; --bbit) {
              const unsigned Tc = T | (1u << bbit);
              const unsigned long long mk = __builtin_amdgcn_ballot_w64(key >= Tc);
              if (__builtin_popcountll(mk) >= 16) T = Tc;
            }
            const unsigned long long sel = __builtin_amdgcn_ballot_w64(key >= T);
            if (lane == 0) { selm[tk * 2] = (unsigned)sel; selm[tk * 2 + 1] = (unsigned)(sel >> 32); }
          }
          __syncthreads();
          sel_lo = selm[tl * 2]; sel_hi = selm[tl * 2 + 1];
        }
        {
          const float wgt = g0 * inv_l * oscale;
#pragma unroll
          for (int r = 0; r < 16; ++r) { fl[r * 64] = wgt * O0[r]; fl[(16 + r) * 64] = wgt * O1[r]; }
          m_run = NINF; l_run = 0.f; oscale = 0.f;
        }
      } else if (n == 2 * ntc + nsl - 1) {
        const float lt = l_run + __shfl_xor(l_run, 32);
        const float wgt = g1 * (lt > 0.f ? 1.0f / lt : 0.f) * oscale;
#pragma unroll
        for (int r = 0; r < 16; ++r) { fl[r * 64] += wgt * O0[r]; fl[(16 + r) * 64] += wgt * O1[r]; }
        m_run = NINF; l_run = 0.f; oscale = 0.f;
      }
    }
#undef TILE_PTRS
#undef TISSUE
    {
      const float lt = l_run + __shfl_xor(l_run, 32);
      const float wgt = g2 * (lt > 0.f ? 1.0f / lt : 0.f) * oscale;
      const size_t rowo = (size_t)(b * 4096 + t);
      const u16* zp = ws_zs(p) + rowo * 512 + (g * 4 + hd) * 64;
      u16* mp = ws_mix(p) + rowo * LDK + (g * 4 + hd) * 64;
      u32x2 zv8[8];
#pragma unroll
      for (int q = 0; q < 8; ++q) zv8[q] = *(const u32x2*)(zp + 32 * (q >> 2) + 8 * (q & 3) + 4 * h);
#pragma unroll
      for (int dr = 0; dr < 2; ++dr)
#pragma unroll
        for (int rg = 0; rg < 4; ++rg) {
          const int d = 32 * dr + 8 * rg + 4 * h;
          const u32x2 zv = zv8[dr * 4 + rg];
          const float f0 = fl[(dr * 16 + rg * 4 + 0) * 64] + wgt * (dr ? O1[rg * 4 + 0] : O0[rg * 4 + 0]);
          const float f1 = fl[(dr * 16 + rg * 4 + 1) * 64] + wgt * (dr ? O1[rg * 4 + 1] : O0[rg * 4 + 1]);
          const float f2 = fl[(dr * 16 + rg * 4 + 2) * 64] + wgt * (dr ? O1[rg * 4 + 2] : O0[rg * 4 + 2]);
          const float f3 = fl[(dr * 16 + rg * 4 + 3) * 64] + wgt * (dr ? O1[rg * 4 + 3] : O0[rg * 4 + 3]);
          u32x2 o;
          o[0] = cvtpk(f0 * bflo(zv[0]), f1 * bfhi(zv[0]));
          o[1] = cvtpk(f2 * bflo(zv[1]), f3 * bfhi(zv[1]));
          *(u32x2*)(mp + d) = o;
        }
    }
  }
}

#define XB_TMO      128
#define XB_XCNT(j)  (256  + 64 * (j))
#define XB_XSUB(j)  (1280 + 64 * (j))
#define XB_XGEN(j)  (2304 + 64 * (j))
#define XB_TOP      3328
#define XB_TOPGEN   3392
#define XCD_BAR_WORDS 3456
#define XB_SPIN_CAP (1u << 18)
#define LAS __attribute__((address_space(3)))

__device__ __forceinline__ unsigned xb_ld(unsigned* p)              { return __hip_atomic_load(p, __ATOMIC_RELAXED, __HIP_MEMORY_SCOPE_AGENT); }
__device__ __forceinline__ unsigned xb_add(unsigned* p, unsigned v) { return __hip_atomic_fetch_add(p, v, __ATOMIC_RELAXED, __HIP_MEMORY_SCOPE_AGENT); }
__device__ __forceinline__ unsigned xb_xcc_id() { return (unsigned)__builtin_amdgcn_s_getreg((3 << 11) | 20) & 0xFu; }
#define XB_SPIN(cond, bar) do { unsigned _sp = 0; while (cond) { __builtin_amdgcn_s_sleep(1); \
    if ((++_sp & 255u) == 0u) { if (xb_ld(&(bar)[XB_TMO])) break; if (_sp > XB_SPIN_CAP) { atomicAdd(&(bar)[XB_TMO], 1u); break; } } } } while (0)

struct XcdBarrier {
    unsigned* bar; unsigned x;
    volatile LAS unsigned* st;
};

__device__ __forceinline__ XcdBarrier xcd_barrier_post(unsigned* bar, volatile LAS unsigned* st) {
    XcdBarrier b; b.bar = bar; b.x = xb_xcc_id(); b.st = st;
    if (threadIdx.x == 0) (void)xb_add(&bar[XB_XCNT(b.x)], 1u);
    return b;
}
__device__ __forceinline__ void xcd_barrier_complete(unsigned* bar, unsigned x, unsigned& nloc, unsigned& nx) {
    const unsigned G = gridDim.x * gridDim.y * gridDim.z;
    unsigned sum, cnt, mine, sp = 0u;
    for (;;) {
        sum = 0u; cnt = 0u; mine = 0u;
#pragma unroll
        for (unsigned j = 0; j < 16; ++j) { const unsigned c = xb_ld(&bar[XB_XCNT(j)]); sum += c; cnt += (c > 0u) ? 1u : 0u; mine = (j == x) ? c : mine; }
        if (sum == G) break;
        __builtin_amdgcn_s_sleep(1);
        if ((++sp & 255u) == 0u) { if (xb_ld(&bar[XB_TMO])) break; if (sp > XB_SPIN_CAP) { atomicAdd(&bar[XB_TMO], 1u); break; } }
    }
    nloc = mine > 0u ? mine : 1u; nx = cnt > 0u ? cnt : 1u;
}

__device__ __forceinline__ void xcd_barrier(const XcdBarrier& b) {
    asm volatile("s_waitcnt vmcnt(0)" ::: "memory");
    __syncthreads();
    if (threadIdx.x == 0) {
        unsigned* bar = b.bar;
        __builtin_amdgcn_s_waitcnt(0);
        unsigned nloc = b.st[0], nx = b.st[1];
        if (nloc == 0u) { xcd_barrier_complete(bar, b.x, nloc, nx); b.st[0] = nloc; b.st[1] = nx; }
        const unsigned old = xb_add(&bar[XB_XSUB(b.x)], 1u);
        const unsigned gen = old / nloc;
        if (old + 1u == (gen + 1u) * nloc) {
            __builtin_amdgcn_fence(__ATOMIC_RELEASE, "agent");
            asm volatile("s_waitcnt vmcnt(0)" ::: "memory");
            const unsigned og = xb_add(&bar[XB_TOP], 1u);
            const unsigned tg = og / nx;
            if (og + 1u == (tg + 1u) * nx) xb_add(&bar[XB_TOPGEN], 1u);
            else XB_SPIN(xb_ld(&bar[XB_TOPGEN]) == tg, bar);
            __builtin_amdgcn_fence(__ATOMIC_ACQUIRE, "agent");
            xb_add(&bar[XB_XGEN(b.x)], 1u);
            asm volatile("s_waitcnt vmcnt(0)" ::: "memory");
        } else {
            XB_SPIN(xb_ld(&bar[XB_XGEN(b.x)]) == gen, bar);
            __builtin_amdgcn_fence(__ATOMIC_ACQUIRE, "agent");
            asm volatile("s_waitcnt vmcnt(0)" ::: "memory");
        }
    }
    __syncthreads();
}


#if FUSED
extern "C" __global__ void __launch_bounds__(NTHREADS) hybrid_fwd(Params p) {
  extern __shared__ __attribute__((aligned(16))) char smem[];
  cg::grid_group grid = cg::this_grid();
  const int bid = blockIdx.x, nb = gridDim.x;
  if (threadIdx.x < 4) ((volatile unsigned*)(smem + SMEM_BYTES))[threadIdx.x] = 0u;
  __syncthreads();
  if (bid == 0) { for (int w_ = threadIdx.x; w_ < XCD_BAR_WORDS; w_ += NTHREADS) ws_bar(p)[w_] = 0u; }
  for (int r = 0; r < REP0; ++r) { phase_prep(p, smem, bid, nb); grid.sync(); }
  XcdBarrier xb = xcd_barrier_post(ws_bar(p), (volatile LAS unsigned*)(smem + SMEM_BYTES));
  for (int r = 0; r < REP1; ++r) { gemm_phase<0>(p, smem, bid, nb); xcd_barrier(xb); }
  for (int r = 0; r < REP2; ++r) { phase_cmp_conv(p, smem, bid, nb); xcd_barrier(xb); }
  for (int r = 0; r < REP3; ++r) { phase_attn(p, smem, bid, nb, r); xcd_barrier(xb); }
  for (int r = 0; r < REP4; ++r) { gemm_phase<1>(p, smem, bid, nb); }
}
#else
template <int PH>
__global__ void __launch_bounds__(NTHREADS) phase_kernel(Params p) {
  extern __shared__ __attribute__((aligned(16))) char smem[];
  const int bid = blockIdx.x, nb = gridDim.x;
  if constexpr (PH == 0) phase_prep(p, smem, bid, nb);
  if constexpr (PH == 1) gemm_phase<0>(p, smem, bid, nb);
  if constexpr (PH == 2) phase_cmp_conv(p, smem, bid, nb);
  if constexpr (PH == 3) phase_attn(p, smem, bid, nb, 0);
  if constexpr (PH == 4) gemm_phase<1>(p, smem, bid, nb);
}
#endif

extern "C" void kernel_launch(void* const* d_in, const int* in_sizes, int n_in, void* d_out, int out_size, void* d_ws, size_t ws_size, hipStream_t stream) {
  Params p{};
  p.x = (const float*)d_in[0]; p.norm_w = (const float*)d_in[1]; p.w_in = (const float*)d_in[2]; p.q_norm_w = (const float*)d_in[3];
  p.k_norm_w = (const float*)d_in[4]; p.ck_pos = (const float*)d_in[5]; p.ck_w1 = (const float*)d_in[6]; p.ck_b1 = (const float*)d_in[7];
  p.ck_w2 = (const float*)d_in[8]; p.cv_pos = (const float*)d_in[9]; p.cv_w1 = (const float*)d_in[10]; p.cv_b1 = (const float*)d_in[11];
  p.cv_w2 = (const float*)d_in[12]; p.conv_w = (const float*)d_in[13]; p.conv_b = (const float*)d_in[14]; p.w_out = (const float*)d_in[15];
  p.out = (float*)d_out;
  p.ws = (char*)d_ws;
  const size_t off = WS_TOTAL;
  if (off > ws_size) { fprintf(stderr, "kernel_launch: workspace too small (%zu > %zu)\n", off, ws_size); return; }

#if FUSED
  static int grid_blocks = 0;
  if (!grid_blocks) {
    int dev = 0, cus = 0, per_cu = 0;
    hipGetDevice(&dev);
    hipDeviceGetAttribute(&cus, hipDeviceAttributeMultiprocessorCount, dev);
    hipFuncSetAttribute((const void*)hybrid_fwd, hipFuncAttributeMaxDynamicSharedMemorySize, SMEM_BYTES + 16);
    hipOccupancyMaxActiveBlocksPerMultiprocessor(&per_cu, (const void*)hybrid_fwd, NTHREADS, SMEM_BYTES + 16);
    if (per_cu < 1) per_cu = 1;
    grid_blocks = cus * per_cu;
  }
  void* args[] = {&p};
  hipError_t e = hipLaunchCooperativeKernel((const void*)hybrid_fwd, dim3(grid_blocks), dim3(NTHREADS), args, SMEM_BYTES + 16, stream);
  if (e != hipSuccess) fprintf(stderr, "cooperative launch failed: %s (grid %d)\n", hipGetErrorString(e), grid_blocks);
#else
  static int attr_set = 0;
  if (!attr_set) {
    (void)hipFuncSetAttribute((const void*)phase_kernel<0>, hipFuncAttributeMaxDynamicSharedMemorySize, SMEM_BYTES);
    (void)hipFuncSetAttribute((const void*)phase_kernel<1>, hipFuncAttributeMaxDynamicSharedMemorySize, SMEM_BYTES);
    (void)hipFuncSetAttribute((const void*)phase_kernel<2>, hipFuncAttributeMaxDynamicSharedMemorySize, SMEM_BYTES);
    (void)hipFuncSetAttribute((const void*)phase_kernel<3>, hipFuncAttributeMaxDynamicSharedMemorySize, SMEM_BYTES);
    (void)hipFuncSetAttribute((const void*)phase_kernel<4>, hipFuncAttributeMaxDynamicSharedMemorySize, SMEM_BYTES);
    attr_set = 1;
  }
  const int G = 256;
  phase_kernel<0><<<G, NTHREADS, SMEM_BYTES, stream>>>(p);
  phase_kernel<1><<<G, NTHREADS, SMEM_BYTES, stream>>>(p);
  phase_kernel<2><<<G, NTHREADS, SMEM_BYTES, stream>>>(p);
  phase_kernel<3><<<G, NTHREADS, SMEM_BYTES, stream>>>(p);
  phase_kernel<4><<<G, NTHREADS, SMEM_BYTES, stream>>>(p);
#endif
}
```

```cpp
#include <hip/hip_runtime.h>
#include <hip/hip_cooperative_groups.h>
#include <cstdio>
#include <cstdint>
namespace cg = cooperative_groups;

#ifndef FUSED
#define FUSED 1
#endif
#define REP0 1
#define REP1 1
#define REP2 1
#define REP3 1
#define REP4 1

#define DI __device__ __forceinline__
typedef unsigned short u16;
using bf16x8 = __attribute__((ext_vector_type(8))) short;
using s16x4 = __attribute__((ext_vector_type(4))) short;
using f32x4 = __attribute__((ext_vector_type(4))) float;
using f32x16 = __attribute__((ext_vector_type(16))) float;
using u32x4 = __attribute__((ext_vector_type(4))) unsigned;
using u32x2 = __attribute__((ext_vector_type(2))) unsigned;
typedef __bf16 bf2_t __attribute__((ext_vector_type(2)));
typedef float fl2_t __attribute__((ext_vector_type(2)));

constexpr int NTHREADS = 512;
constexpr int SEQ = 4096, DM = 1024, DIN = 3864, NROWS = 32768;
constexpr int LDK = 1088;
constexpr float EPS = 1e-6f;
constexpr float QSCALE = 0.125f * 1.4426950408889634f;
constexpr int SMEM_BYTES = 148480;

__constant__ float c_invf[8] = {1.0f, 0.1939227432012558f, 0.03760603070259094f, 0.007292664609849453f,
                                0.0014142135623842478f, 0.00027424818836152554f, 5.3182957344688475e-05f, 1.0313385246263351e-05f};

DI unsigned cvtpk(float lo, float hi) {
  fl2_t f = {lo, hi};
  bf2_t b = __builtin_convertvector(f, bf2_t);
  return __builtin_bit_cast(unsigned, b);
}
DI u16 f2bf(float x) { return (u16)(cvtpk(x, 0.f) & 0xffffu); }
DI float bf2f(u16 v) { return __uint_as_float(((unsigned)v) << 16); }
DI float bflo(unsigned v) { return __uint_as_float(v << 16); }
DI float bfhi(unsigned v) { return __uint_as_float(v & 0xffff0000u); }
DI float sigmoidf_(float v) { return __builtin_amdgcn_rcpf(1.0f + __builtin_amdgcn_exp2f(-1.4426950408889634f * v)); }
DI float siluf_(float v) { return v * __builtin_amdgcn_rcpf(1.0f + __builtin_amdgcn_exp2f(-1.4426950408889634f * v)); }
DI void glds16(const void* g, unsigned lds_base) {
  unsigned sv;
  asm volatile("s_mov_b32 %0, m0\n\ts_mov_b32 m0, %2\n\ts_nop 0\n\tglobal_load_lds_dwordx4 %1, off\n\ts_mov_b32 m0, %0" : "=&s"(sv) : "v"(g), "s"(lds_base) : "memory");
}
template <int CTRL> DI float qperm(float v) { return __int_as_float(__builtin_amdgcn_update_dpp(0, __float_as_int(v), CTRL, 0xF, 0xF, true)); }
#define MFMA16(a, b, c) __builtin_amdgcn_mfma_f32_16x16x32_bf16((a), (b), (c), 0, 0, 0)
#define MFMA32(a, b, c) __builtin_amdgcn_mfma_f32_32x32x16_bf16((a), (b), (c), 0, 0, 0)

struct Params {
  const float *x, *norm_w, *w_in, *q_norm_w, *k_norm_w, *ck_pos, *ck_w1, *ck_b1, *ck_w2, *cv_pos, *cv_w1, *cv_b1, *cv_w2, *conv_w, *conv_b, *w_out;
  float* out;
  char* ws;
};
constexpr size_t al256(size_t v) { return (v + 255) & ~(size_t)255; }
constexpr size_t OFF_xb = 0;
DI u16* ws_xb(const Params& p) { return (u16*)(p.ws + OFF_xb); }
constexpr size_t OFF_winT = OFF_xb + al256((size_t)NROWS * LDK * 2);
DI u16* ws_winT(const Params& p) { return (u16*)(p.ws + OFF_winT); }
constexpr size_t OFF_woutT = OFF_winT + al256((size_t)4096 * LDK * 2);
DI u16* ws_woutT(const Params& p) { return (u16*)(p.ws + OFF_woutT); }
constexpr size_t OFF_w1kT = OFF_woutT + al256((size_t)1024 * LDK * 2);
DI u16* ws_w1kT(const Params& p) { return (u16*)(p.ws + OFF_w1kT); }
constexpr size_t OFF_w1vT = OFF_w1kT + al256((size_t)128 * 2048 * 2);
DI u16* ws_w1vT(const Params& p) { return (u16*)(p.ws + OFF_w1vT); }
constexpr size_t OFF_w2kT = OFF_w1vT + al256((size_t)128 * 2048 * 2);
DI u16* ws_w2kT(const Params& p) { return (u16*)(p.ws + OFF_w2kT); }
constexpr size_t OFF_w2vT = OFF_w2kT + al256((size_t)64 * 128 * 2);
DI u16* ws_w2vT(const Params& p) { return (u16*)(p.ws + OFF_w2vT); }
constexpr size_t OFF_Q = OFF_w2vT + al256((size_t)64 * 128 * 2);
DI u16* ws_Q(const Params& p) { return (u16*)(p.ws + OFF_Q); }
constexpr size_t OFF_Ks = OFF_Q + al256((size_t)NROWS * 512 * 2);
DI u16* ws_Ks(const Params& p) { return (u16*)(p.ws + OFF_Ks); }
constexpr size_t OFF_Kw = OFF_Ks + al256((size_t)16 * 4096 * 64 * 2);
DI u16* ws_Kw(const Params& p) { return (u16*)(p.ws + OFF_Kw); }
constexpr size_t OFF_Vst = OFF_Kw + al256((size_t)16 * 4096 * 64 * 2);
DI u16* ws_Vst(const Params& p) { return (u16*)(p.ws + OFF_Vst); }
constexpr size_t OFF_Vwt = OFF_Vst + al256((size_t)16 * 4096 * 64 * 2);
DI u16* ws_Vwt(const Params& p) { return (u16*)(p.ws + OFF_Vwt); }
constexpr size_t OFF_kcraw = OFF_Vwt + al256((size_t)16 * 4096 * 64 * 2);
DI u16* ws_kcraw(const Params& p) { return (u16*)(p.ws + OFF_kcraw); }
constexpr size_t OFF_vcraw = OFF_kcraw + al256((size_t)16 * 4096 * 64 * 2 + 4096);
DI u16* ws_vcraw(const Params& p) { return (u16*)(p.ws + OFF_vcraw); }
constexpr size_t OFF_Kc = OFF_vcraw + al256((size_t)16 * 4096 * 64 * 2 + 4096);
DI u16* ws_Kc(const Params& p) { return (u16*)(p.ws + OFF_Kc); }
constexpr size_t OFF_Vct = OFF_Kc + al256((size_t)16 * 256 * 64 * 2);
DI u16* ws_Vct(const Params& p) { return (u16*)(p.ws + OFF_Vct); }
constexpr size_t OFF_zs = OFF_Vct + al256((size_t)16 * 256 * 64 * 2);
DI u16* ws_zs(const Params& p) { return (u16*)(p.ws + OFF_zs); }
constexpr size_t OFF_cvb = OFF_zs + al256((size_t)NROWS * 512 * 2);
DI u16* ws_cvb(const Params& p) { return (u16*)(p.ws + OFF_cvb); }
constexpr size_t OFF_mix = OFF_cvb + al256((size_t)NROWS * 2048 * 2);
DI u16* ws_mix(const Params& p) { return (u16*)(p.ws + OFF_mix); }
constexpr size_t OFF_rs = OFF_mix + al256((size_t)NROWS * LDK * 2);
DI float* ws_rs(const Params& p) { return (float*)(p.ws + OFF_rs); }
constexpr size_t OFF_ckpart = OFF_rs + al256((size_t)NROWS * 4);
DI float* ws_ckpart(const Params& p) { return (float*)(p.ws + OFF_ckpart); }
constexpr size_t OFF_rope = OFF_ckpart + al256((size_t)16 * 128 * 4);
DI float* ws_rope(const Params& p) { return (float*)(p.ws + OFF_rope); }
constexpr size_t OFF_gates = OFF_rope + al256((size_t)4096 * 8 * 2 * 4);
DI float* ws_gates(const Params& p) { return (float*)(p.ws + OFF_gates); }
constexpr size_t OFF_counter = OFF_gates + al256((size_t)NROWS * 24 * 4);
DI unsigned* ws_counter(const Params& p) { return (unsigned*)(p.ws + OFF_counter); }
constexpr size_t OFF_bar = OFF_counter + al256((size_t)256);
DI unsigned* ws_bar(const Params& p) { return (unsigned*)(p.ws + OFF_bar); }
constexpr size_t WS_TOTAL = OFF_bar + al256((size_t)3456 * 4);


DI void transpose_tile(const float* __restrict__ src, u16* __restrict__ dst, int K, int N, const float* __restrict__ scale, int kt, int nt, char* smem, int ldd) {
  float* tile = (float*)smem;
  const int tid = threadIdx.x;
  float v[8], sc[8];
  const int nn0 = tid & 63, n0_ = nt * 64 + nn0, nc = n0_ < N ? n0_ : N - 1;
#pragma unroll
  for (int i = 0; i < 8; ++i) {
    const int k = kt * 64 + i * 8 + (tid >> 6);
    v[i] = src[(size_t)k * N + nc];
    sc[i] = scale ? scale[k] : 1.0f;
  }
#pragma unroll
  for (int i = 0; i < 8; ++i) tile[(i * 8 + (tid >> 6)) * 65 + nn0] = (n0_ < N) ? v[i] * sc[i] : 0.f;
  __syncthreads();
#pragma unroll
  for (int i = 0; i < 8; ++i) {
    const int nn = i * 8 + (tid >> 6), kk = tid & 63;
    dst[(size_t)(nt * 64 + nn) * ldd + kt * 64 + kk] = f2bf(tile[kk * 65 + nn]);
  }
  __syncthreads();
}

__device__ void phase_prep(const Params& p, char* smem, int bid, int nb) {
  int tid_ = threadIdx.x; asm volatile("" : "+v"(tid_));
  const int tid = tid_, lane = tid & 63, wid = __builtin_amdgcn_readfirstlane(tid >> 6);
  constexpr int J_X = 1024, J_TW = 1024, J_TO = 256, J_T1 = 64, J_T2 = 2, J_CK = 16, J_ROPE = 64;
  constexpr int TOTAL = J_X + J_TW + J_TO + 2 * J_T1 + 2 * J_T2 + J_CK + J_ROPE;
  if (bid == 0 && tid < 8) ws_counter(p)[tid] = 0u;
  for (int j = bid; j < TOTAL; j += nb) {
    constexpr int HEAD = J_CK + J_ROPE;
    int jj = j < HEAD ? (TOTAL - HEAD) + j : j - HEAD;
    if (jj < J_X) {
      const int row0 = jj * 32 + wid * 4;
      float4 v[4][4]; float ss[4];
#pragma unroll
      for (int r = 0; r < 4; ++r) {
        const float4* xr = (const float4*)(p.x + (size_t)(row0 + r) * DM);
#pragma unroll
        for (int i = 0; i < 4; ++i) v[r][i] = xr[i * 64 + lane];
      }
#pragma unroll
      for (int r = 0; r < 4; ++r) {
        float a = 0.f;
#pragma unroll
        for (int i = 0; i < 4; ++i) a += v[r][i].x * v[r][i].x + v[r][i].y * v[r][i].y + v[r][i].z * v[r][i].z + v[r][i].w * v[r][i].w;
#pragma unroll
        for (int o = 32; o >= 1; o >>= 1) a += __shfl_xor(a, o);
        ss[r] = a;
      }
#pragma unroll
      for (int r = 0; r < 4; ++r) {
        if (lane == 0) ws_rs(p)[row0 + r] = rsqrtf(ss[r] * (1.0f / DM) + EPS);
#pragma unroll
        for (int i = 0; i < 4; ++i) {
          u32x2 o; o[0] = cvtpk(v[r][i].x, v[r][i].y); o[1] = cvtpk(v[r][i].z, v[r][i].w);
          const int rr_ = row0 + r;
          *(u32x2*)(ws_xb(p) + ((size_t)((rr_ >> 8) * 16 + i * 4 + (lane >> 4)) * 256 + (rr_ & 255)) * 64 + (lane & 15) * 4) = o;
        }
      }
      continue;
    }
    jj -= J_X;
    if (jj < J_TW) { transpose_tile(p.w_in, ws_winT(p), 1024, DIN, p.norm_w, jj & 15, jj >> 4, smem, LDK); continue; }
    jj -= J_TW;
    if (jj < J_TO) { transpose_tile(p.w_out, ws_woutT(p), 1024, 1024, nullptr, jj & 15, jj >> 4, smem, LDK); continue; }
    jj -= J_TO;
    if (jj < J_T1) { transpose_tile(p.ck_w1, ws_w1kT(p), 2048, 128, nullptr, jj & 31, jj >> 5, smem, 2048); continue; }
    jj -= J_T1;
    if (jj < J_T1) { transpose_tile(p.cv_w1, ws_w1vT(p), 2048, 128, nullptr, jj & 31, jj >> 5, smem, 2048); continue; }
    jj -= J_T1;
    if (jj < J_T2) { transpose_tile(p.ck_w2, ws_w2kT(p), 128, 64, nullptr, jj, 0, smem, 128); continue; }
    jj -= J_T2;
    if (jj < J_T2) { transpose_tile(p.cv_w2, ws_w2vT(p), 128, 64, nullptr, jj, 0, smem, 128); continue; }
    jj -= J_T2;
    if (jj < J_CK) {
      const int which = jj >> 3, chunk = jj & 7, hh = tid & 127, sub = tid >> 7;
      const float* pos = which ? p.cv_pos : p.ck_pos;
      const float* w1 = which ? p.cv_w1 : p.ck_w1;
      float acc = 0.f;
      const int f0 = chunk * 256 + sub * 64;
      float pv_[64], wv_[64];
#pragma unroll
      for (int f = 0; f < 64; ++f) { pv_[f] = pos[f0 + f]; wv_[f] = w1[(size_t)(f0 + f) * 128 + hh]; }
#pragma unroll
      for (int f = 0; f < 64; ++f) acc += pv_[f] * wv_[f];
      float* red = (float*)smem;
      red[sub * 128 + hh] = acc;
      __syncthreads();
      if (tid < 128) ws_ckpart(p)[(which * 8 + chunk) * 128 + tid] = red[tid] + red[128 + tid] + red[256 + tid] + red[384 + tid];
      __syncthreads();
      continue;
    }
    jj -= J_CK;
    {
      const int idx = jj * 512 + tid, pos = idx >> 3, fi = idx & 7;
      const float ang = (float)pos * c_invf[fi];
      float s, c; sincosf(ang, &s, &c);
      ws_rope(p)[idx * 2] = c; ws_rope(p)[idx * 2 + 1] = s;
    }
  }
}

DI int kimg_off(int row, int d) { return row * 64 + (((d >> 3) ^ ((row >> 1) & 7)) * 8) + (d & 7); }
DI int vimg_off(int d, int key) {
  const int kp = (key & ~12) | ((key & 4) << 1) | ((key & 8) >> 1);
  return d * 64 + (((kp >> 3) ^ ((d >> 1) & 7)) * 8) + (kp & 7);
}

constexpr int G_ASZ = 256 * 128, G_BSZ = 256 * 128, G_STAGE = G_ASZ + G_BSZ;
constexpr int G_ROPE = 2 * G_STAGE, G_RS = G_ROPE + 256 * 64;
static_assert(G_RS + 1024 <= SMEM_BYTES, "GEMM LDS layout exceeds the dynamic LDS size");
#define WAIT_VM(n) asm volatile("s_waitcnt vmcnt(" #n ")" ::: "memory")

template <int EPI>
__device__ void gemm_phase(const Params& p, char* smem, int bid, int nb) {
  constexpr int NT = EPI == 0 ? 16 : 4;
  constexpr int MT = 128;
  const u16* __restrict__ A = EPI == 0 ? ws_xb(p) : ws_mix(p);
  const u16* __restrict__ Bt = EPI == 0 ? ws_winT(p) : ws_woutT(p);
  int tid_ = threadIdx.x; asm volatile("" : "+v"(tid_));
  const int tid = tid_, lane = tid & 63, wid = __builtin_amdgcn_readfirstlane(tid >> 6), fr = lane & 15, fq = lane >> 4;
  const int wr = wid >> 2, wc = wid & 3;
  const bool xmap = (nb == 256);
  const int xcd = bid & 7, li = bid >> 3;
  const int ntiles = xmap ? (EPI == 0 ? 8 : 2) : (MT * NT - bid + nb - 1) / nb;
  auto tile_of = [&](int ti, int& m0, int& n0) {
    if (xmap) {
      const int sg = ti * 8 + xcd;
      if (EPI == 0) { m0 = ((sg >> 1) * 4 + (li >> 3)) * 256; n0 = ((sg & 1) * 8 + (li & 7)) * 256; }
      else { m0 = (sg * 8 + (li >> 2)) * 256; n0 = (li & 3) * 256; }
    } else { const int tile = bid + ti * nb; const int mt = tile / NT; m0 = mt * 256; n0 = (tile - mt * NT) * 256; }
  };
  const int nsteps = ntiles * 16;
  const unsigned lds0 = (unsigned)(uintptr_t)smem;
  const int gsw = (lane & 7) ^ ((wid & 1) * 4 + (lane >> 4));
  const int grow = wid * 8 + (lane >> 3);
  auto issue = [&](int step, int stage) {
    int m0, n0; tile_of(step >> 4, m0, n0);
    const int kt = step & 15;
    const u16* ag = EPI == 0 ? A + ((size_t)((m0 >> 8) * 16 + kt) * 256 + grow) * 64 + gsw * 8 : A + (size_t)(m0 + grow) * LDK + kt * 64 + gsw * 8;
    const size_t astep = EPI == 0 ? (size_t)64 * 64 : (size_t)64 * LDK;
    const int brow = EPI == 0 ? ((grow & ~31) | ((grow & 0x0C) << 1) | ((grow & 0x10) >> 2) | (grow & 3)) : grow;
    const u16* bg_ = Bt + (size_t)(n0 + brow) * LDK + kt * 64 + gsw * 8;
    const unsigned dst = (unsigned)__builtin_amdgcn_readfirstlane((int)(lds0 + stage * G_STAGE + wid * 1024));
#pragma unroll
    for (int i = 0; i < 4; ++i) glds16(ag + i * astep, dst + i * 8192);
#pragma unroll
    for (int i = 0; i < 4; ++i) glds16(bg_ + (size_t)i * 64 * LDK, dst + G_ASZ + i * 8192);
    if (EPI == 0 && kt == 8) {
      const int t0 = m0 & 4095;
      const unsigned sd = (unsigned)__builtin_amdgcn_readfirstlane((int)(lds0 + G_ROPE + wid * 1024));
      glds16(ws_rope(p) + (size_t)t0 * 16 + tid * 4, sd);
      glds16(ws_rope(p) + (size_t)t0 * 16 + (512 + tid) * 4, sd + 8192);
      if (wid == 0) glds16(ws_rs(p) + m0 + lane * 4, lds0 + G_RS);
    }
  };
  const int ca0 = ((fq ^ (fr >> 1)) * 16), ca1 = (((4 + fq) ^ (fr >> 1)) * 16);
  f32x4 acc[8][4];
#pragma unroll
  for (int m = 0; m < 8; ++m)
#pragma unroll
    for (int n = 0; n < 4; ++n) acc[m][n] = f32x4{0.f, 0.f, 0.f, 0.f};
  __syncthreads();
  if (nsteps > 0) issue(0, 0);
  for (int s = 0; s < nsteps; ++s) {
    WAIT_VM(0);
    __builtin_amdgcn_s_waitcnt(0x0F70);
    __builtin_amdgcn_s_barrier();
    {
      const char* ab = smem + (s & 1) * G_STAGE + (wr * 128 + fr) * 128;
      const char* bb = smem + (s & 1) * G_STAGE + G_ASZ + (wc * 64 + fr) * 128;
      bf16x8 af[8], bf[4];
#pragma unroll
      for (int n = 0; n < 4; ++n) bf[n] = *(const bf16x8*)(bb + n * 16 * 128 + ca0);
#pragma unroll
      for (int m = 0; m < 8; ++m) af[m] = *(const bf16x8*)(ab + m * 16 * 128 + ca0);
      if (s + 1 < nsteps) issue(s + 1, (s + 1) & 1);
#pragma unroll
      for (int m = 0; m < 8; ++m)
#pragma unroll
        for (int n = 0; n < 4; ++n) acc[m][n] = MFMA16(bf[n], af[m], acc[m][n]);
#pragma unroll
      for (int n = 0; n < 4; ++n) bf[n] = *(const bf16x8*)(bb + n * 16 * 128 + ca1);
#pragma unroll
      for (int m = 0; m < 8; ++m) af[m] = *(const bf16x8*)(ab + m * 16 * 128 + ca1);
#pragma unroll
      for (int m = 0; m < 8; ++m)
#pragma unroll
        for (int n = 0; n < 4; ++n) acc[m][n] = MFMA16(bf[n], af[m], acc[m][n]);
    }
    if ((s & 15) != 15) continue;
    int m0, n0; tile_of(s >> 4, m0, n0);
    const int rbase = m0 + wr * 128;
    const int cb = n0 + wc * 64;
    if constexpr (EPI == 1) {
#pragma unroll
      for (int hm = 0; hm < 2; ++hm) {
        float4 xv[4][4];
#pragma unroll
        for (int mm = 0; mm < 4; ++mm) {
          const size_t ro = (size_t)(rbase + (hm * 4 + mm) * 16 + fr) * DM + cb + fq * 4;
#pragma unroll
          for (int n = 0; n < 4; ++n) xv[mm][n] = *(const float4*)(p.x + ro + n * 16);
        }
#pragma unroll
        for (int mm = 0; mm < 4; ++mm) {
          const int m = hm * 4 + mm;
          const size_t ro = (size_t)(rbase + m * 16 + fr) * DM + cb + fq * 4;
#pragma unroll
          for (int n = 0; n < 4; ++n) {
            float4 o; o.x = xv[mm][n].x + acc[m][n][0]; o.y = xv[mm][n].y + acc[m][n][1]; o.z = xv[mm][n].z + acc[m][n][2]; o.w = xv[mm][n].w + acc[m][n][3];
            *(float4*)(p.out + ro + n * 16) = o;
          }
        }
        __builtin_amdgcn_sched_barrier(0);
      }
    } else {
      const int b = m0 >> 12;
      const int tb = rbase & 4095;
      if (cb < 1280) {
        const int seg = cb >> 6;
        const int which = seg < 8 ? -1 : ((seg - 8) >> 1);
        const int g = seg < 8 ? (seg >> 2) : ((seg - 8) & 1);
        const bool need_norm = (seg < 8) || which == 2 || which == 4;
        const float* nw = seg < 8 ? p.q_norm_w : (p.k_norm_w + (which == 2 ? 64 : 128));
        float w[16];
#pragma unroll
        for (int k = 0; k < 16; ++k) w[k] = need_norm ? nw[(k >> 3) * 32 + fq * 8 + (k & 7)] : 1.0f;
        const float qs = seg < 8 ? QSCALE : 1.0f;
#pragma unroll
        for (int m = 0; m < 8; ++m) {
          const int t = tb + m * 16 + fr;
          const int lrow = wr * 128 + m * 16 + fr;
          const float r = *(const float*)(smem + G_RS + lrow * 4);
          float v[16];
#pragma unroll
          for (int k = 0; k < 16; ++k) v[k] = acc[m][(k >> 3) * 2 + ((k & 7) >> 2)][k & 3] * r;
          if (need_norm) {
            float ss = 0.f;
#pragma unroll
            for (int k = 0; k < 16; ++k) ss += v[k] * v[k];
            ss += __shfl_xor(ss, 16); ss += __shfl_xor(ss, 32);
            const float rr = rsqrtf(ss * (1.0f / 64.f) + EPS);
#pragma unroll
            for (int k = 0; k < 16; ++k) v[k] = v[k] * rr * w[k];
            const float4* rp = (const float4*)(smem + G_ROPE + lrow * 64);
            const float4 c01 = rp[0], c23 = rp[1], c45 = rp[2], c67 = rp[3];
            const float cc[8] = {c01.x, c01.z, c23.x, c23.z, c45.x, c45.z, c67.x, c67.z};
            const float sn[8] = {c01.y, c01.w, c23.y, c23.w, c45.y, c45.w, c67.y, c67.w};
#pragma unroll
            for (int e = 0; e < 8; ++e) {
              const float pr = __shfl_xor(v[e], 16);
              const float rot = (fq == 0) ? (v[e] * cc[e] - pr * sn[e]) : (v[e] * cc[e] + pr * sn[e]);
              v[e] = (fq < 2) ? rot : v[e];
            }
#pragma unroll
            for (int k = 0; k < 16; ++k) v[k] *= qs;
          }
          if (which == 3 || which == 5) {
            int lz = 0; asm volatile("" : "+v"(lz));
            u16* vt = (which == 3 ? ws_Vst(p) : ws_Vwt(p)) + (size_t)((b * 2 + g) * 64 + (t >> 6)) * 4096 + lz;
            const int fqx = fq + lz, key = (t & 63) + lz;
#pragma unroll
            for (int k = 0; k < 16; ++k) vt[vimg_off((k >> 3) * 32 + fqx * 8 + (k & 7), key)] = f2bf(v[k]);
          } else {
            u16* dst;
            if (seg < 8) dst = ws_Q(p) + ((size_t)((b * 2 + g) * 4096 + t) * 4 + (seg & 3)) * 64;
            else { u16* buf = which == 0 ? ws_kcraw(p) : which == 1 ? ws_vcraw(p) : which == 2 ? ws_Ks(p) : ws_Kw(p); dst = buf + ((size_t)(b * 2 + g) * 4096 + t) * 64; }
            const bool img = which >= 2;
#pragma unroll
            for (int n2 = 0; n2 < 2; ++n2) {
              u32x4 o;
#pragma unroll
              for (int e = 0; e < 4; ++e) o[e] = cvtpk(v[n2 * 8 + 2 * e], v[n2 * 8 + 2 * e + 1]);
              const int d0 = n2 * 32 + fq * 8;
              const int off = img ? (((d0 >> 3) ^ (((t & 63) >> 1) & 7)) * 8) : d0;
              *(u32x4*)(dst + off) = o;
            }
          }
          __builtin_amdgcn_sched_barrier(0);
        }
      } else {
#pragma unroll
        for (int m = 0; m < 8; ++m) {
          const size_t row = rbase + m * 16 + fr;
          const float r = *(const float*)(smem + G_RS + (wr * 128 + m * 16 + fr) * 4);
#pragma unroll
          for (int n2 = 0; n2 < 2; ++n2) {
            const int c8 = cb + n2 * 32 + fq * 8;
            if (c8 >= DIN) continue;
            float v[8];
#pragma unroll
            for (int e = 0; e < 8; ++e) v[e] = acc[m][n2 * 2 + (e >> 2)][e & 3] * r;
            if (c8 < 1304) {
              float4 o0, o1;
              o0.x = sigmoidf_(v[0]); o0.y = sigmoidf_(v[1]); o0.z = sigmoidf_(v[2]); o0.w = sigmoidf_(v[3]);
              o1.x = sigmoidf_(v[4]); o1.y = sigmoidf_(v[5]); o1.z = sigmoidf_(v[6]); o1.w = sigmoidf_(v[7]);
              float* gp = ws_gates(p) + row * 24 + (c8 - 1280);
              *(float4*)gp = o0; *(float4*)(gp + 4) = o1;
            } else if (c8 < 1816) {
              u32x4 o;
#pragma unroll
              for (int e = 0; e < 4; ++e) o[e] = cvtpk(siluf_(v[2 * e]), siluf_(v[2 * e + 1]));
              *(u32x4*)(ws_zs(p) + row * 512 + (c8 - 1304)) = o;
            } else {
              u32x4 o;
#pragma unroll
              for (int e = 0; e < 4; ++e) o[e] = cvtpk(v[2 * e], v[2 * e + 1]);
              *(u32x4*)(ws_cvb(p) + row * 2048 + (c8 - 1816)) = o;
            }
          }
          __builtin_amdgcn_sched_barrier(0);
        }
      }
    }
#pragma unroll
    for (int m = 0; m < 8; ++m)
#pragma unroll
      for (int n = 0; n < 4; ++n) acc[m][n] = f32x4{0.f, 0.f, 0.f, 0.f};
  }
}

__device__ void phase_cmp_conv(const Params& p, char* smem, int bid, int nb) {
  int tid_ = threadIdx.x; asm volatile("" : "+v"(tid_));
  const int tid = tid_, lane = tid & 63, wid = __builtin_amdgcn_readfirstlane(tid >> 6), fr = lane & 15, fq = lane >> 4;
  float* part = (float*)smem;
  char* hl = smem + 8 * 16 * 132 * 4;
  float* outl = (float*)(hl + 2 * 4352);
  float* biasl = outl + 2 * 1088;
  for (int job = bid; job < 256; job += nb) {
    const int which = wid >> 2, w4 = wid & 3, bg = job >> 4, ct = job & 15;
    const u16* raw = (which ? ws_vcraw(p) : ws_kcraw(p)) + (size_t)bg * 4096 * 64;
    const u16* w1T = which ? ws_w1vT(p) : ws_w1kT(p);
    const u16* w2T = which ? ws_w2vT(p) : ws_w2kT(p);
    const float* b1 = which ? p.cv_b1 : p.ck_b1;
    f32x4 acc[8];
#pragma unroll
    for (int n = 0; n < 8; ++n) acc[n] = f32x4{0.f, 0.f, 0.f, 0.f};
    const int c = ct * 16 + fr;
    const int ht = tid & 255, rrow = ht >> 4, c8 = (ht & 15) * 8;
    const int orow = ht >> 4, d4 = (ht & 15) * 4;
    const int cc = ct * 16 + orow;
#pragma unroll 1
    for (int kb4 = 0; kb4 < 16; kb4 += 4) {
      bf16x8 av[4], bv[4][8];
#pragma unroll
      for (int q = 0; q < 4; ++q) {
        const int ks = w4 * 16 + kb4 + q;
        const int l = ks >> 1, d0 = (ks & 1) * 32 + fq * 8;
        int tt = c * 16 + l; tt = tt > 4095 ? 4095 : tt;
        av[q] = *(const bf16x8*)(raw + (size_t)tt * 64 + d0);
#pragma unroll
        for (int n = 0; n < 8; ++n) bv[q][n] = *(const bf16x8*)(w1T + (size_t)(n * 16 + fr) * 2048 + ks * 32 + fq * 8);
      }
#pragma unroll
      for (int q = 0; q < 4; ++q)
#pragma unroll
        for (int n = 0; n < 8; ++n) acc[n] = MFMA16(av[q], bv[q][n], acc[n]);
      __builtin_amdgcn_sched_group_barrier(0x020, 36, 0);
      __builtin_amdgcn_sched_group_barrier(0x008, 32, 0);
    }
    if (ht < 128) {
      float bq[9];
      bq[0] = b1[ht];
#pragma unroll
      for (int ch = 0; ch < 8; ++ch) bq[1 + ch] = ws_ckpart(p)[(which * 8 + ch) * 128 + ht];
      float bsum = bq[0];
#pragma unroll
      for (int ch = 0; ch < 8; ++ch) bsum += bq[1 + ch];
      biasl[which * 128 + ht] = bsum;
    }
#pragma unroll
    for (int n = 0; n < 8; ++n)
#pragma unroll
      for (int j = 0; j < 4; ++j) part[(wid * 16 + fq * 4 + j) * 132 + n * 16 + fr] = acc[n][j];
    __syncthreads();
    {
      float bias[8];
#pragma unroll
      for (int e = 0; e < 8; ++e) bias[e] = biasl[which * 128 + c8 + e];
      float sum[8];
#pragma unroll
      for (int e = 0; e < 8; ++e) sum[e] = bias[e];
#pragma unroll
      for (int w = 0; w < 4; ++w) {
        const float4 v0 = *(const float4*)(part + ((which * 4 + w) * 16 + rrow) * 132 + c8), v1 = *(const float4*)(part + ((which * 4 + w) * 16 + rrow) * 132 + c8 + 4);
        sum[0] += v0.x; sum[1] += v0.y; sum[2] += v0.z; sum[3] += v0.w; sum[4] += v1.x; sum[5] += v1.y; sum[6] += v1.z; sum[7] += v1.w;
      }
      u32x4 o;
#pragma unroll
      for (int e = 0; e < 4; ++e) o[e] = cvtpk(siluf_(sum[2 * e]), siluf_(sum[2 * e + 1]));
      *(u32x4*)(hl + which * 4352 + rrow * 272 + c8 * 2) = o;
    }
    __syncthreads();
    {
    bf16x8 w2f[4];
#pragma unroll
    for (int ks = 0; ks < 4; ++ks) w2f[ks] = *(const bf16x8*)(w2T + (size_t)(w4 * 16 + fr) * 128 + ks * 32 + fq * 8);
      f32x4 o2 = f32x4{0.f, 0.f, 0.f, 0.f};
#pragma unroll
      for (int ks = 0; ks < 4; ++ks) {
        const bf16x8 a = *(const bf16x8*)(hl + which * 4352 + fr * 272 + (ks * 32 + fq * 8) * 2);
        o2 = MFMA16(a, w2f[ks], o2);
      }
#pragma unroll
      for (int j = 0; j < 4; ++j) outl[which * 1088 + (fq * 4 + j) * 68 + w4 * 16 + fr] = o2[j];
    }
    __syncthreads();
    {
    float nwv[4], nwp[4]; float2 csv[4];
    {
      int pos = cc * 16 + 31; pos = pos > 4095 ? 4095 : pos;
#pragma unroll
      for (int e = 0; e < 4; ++e) {
        const int d = d4 + e;
        nwv[e] = p.k_norm_w[d]; nwp[e] = p.k_norm_w[d ^ 8];
        csv[e] = *(const float2*)(ws_rope(p) + ((size_t)pos * 8 + (d & 7)) * 2);
      }
    }
      const float* ol = outl + which * 1088;
      const float4 v = *(const float4*)(ol + orow * 68 + d4);
      if (which == 0) {
        float ss = v.x * v.x + v.y * v.y + v.z * v.z + v.w * v.w;
        ss += __shfl_xor(ss, 1); ss += __shfl_xor(ss, 2); ss += __shfl_xor(ss, 4); ss += __shfl_xor(ss, 8);
        const float rr = rsqrtf(ss * (1.0f / 64.f) + EPS);
        float o[4] = {v.x * rr * nwv[0], v.y * rr * nwv[1], v.z * rr * nwv[2], v.w * rr * nwv[3]};
        if (d4 < 16) {
#pragma unroll
          for (int e = 0; e < 4; ++e) {
            const int d = d4 + e, dp = d ^ 8;
            const float pr = ol[orow * 68 + dp] * rr * nwp[e];
            o[e] = (d < 8) ? (o[e] * csv[e].x - pr * csv[e].y) : (o[e] * csv[e].x + pr * csv[e].y);
          }
        }
        u32x2 ov; ov[0] = cvtpk(o[0], o[1]); ov[1] = cvtpk(o[2], o[3]);
        if (cc >= 255) { ov[0] = 0u; ov[1] = 0u; }
        *(u32x2*)(ws_Kc(p) + (size_t)(bg * 4 + (cc >> 6)) * 4096 + kimg_off(cc & 63, d4)) = ov;
      } else {
        const float z = (cc >= 255) ? 0.f : 1.f;
        u16* vt = ws_Vct(p) + (size_t)(bg * 4 + (cc >> 6)) * 4096;
        vt[vimg_off(d4 + 0, cc & 63)] = f2bf(v.x * z); vt[vimg_off(d4 + 1, cc & 63)] = f2bf(v.y * z);
        vt[vimg_off(d4 + 2, cc & 63)] = f2bf(v.z * z); vt[vimg_off(d4 + 3, cc & 63)] = f2bf(v.w * z);
      }
    }
    __syncthreads();
  }
  const int gw = bid * 8 + wid, nw = nb * 8;
  for (int chunk = gw; chunk < 2048; chunk += nw) {
    const int r0 = chunk * 16, t0 = r0 & 4095;
    const int ch = lane * 8;
    float cw0[8], cw1[8], cw2[8], cbv[8], u1[8], u2[8];
#pragma unroll
    for (int e = 0; e < 8; ++e) { cw0[e] = p.conv_w[ch + e]; cw1[e] = p.conv_w[512 + ch + e]; cw2[e] = p.conv_w[1024 + ch + e]; cbv[e] = p.conv_b[ch + e]; u1[e] = 0.f; u2[e] = 0.f; }
    if (t0 > 0) {
#pragma unroll
      for (int q = 0; q < 2; ++q) {
        const u16* rp = ws_cvb(p) + (size_t)(r0 - 2 + q) * 2048 + ch;
        const u32x4 hv = *(const u32x4*)(rp), cv = *(const u32x4*)(rp + 1024);
#pragma unroll
        for (int e = 0; e < 4; ++e) {
          const float ua = bflo(hv[e]) * bflo(cv[e]), ub = bfhi(hv[e]) * bfhi(cv[e]);
          if (q == 0) { u2[2 * e] = ua; u2[2 * e + 1] = ub; } else { u1[2 * e] = ua; u1[2 * e + 1] = ub; }
        }
      }
    }
#pragma unroll 1
    for (int rb = 0; rb < 16; rb += 8) {
      u32x4 hvv[8], bvv[8], cvv[8], zvv[8];
#pragma unroll
      for (int q = 0; q < 8; ++q) {
        const u16* rp = ws_cvb(p) + (size_t)(r0 + rb + q) * 2048 + ch;
        hvv[q] = *(const u32x4*)(rp); bvv[q] = *(const u32x4*)(rp + 512); cvv[q] = *(const u32x4*)(rp + 1024); zvv[q] = *(const u32x4*)(rp + 1536);
      }
#pragma unroll
      for (int q = 0; q < 8; ++q) {
        const u32x4 hv = hvv[q], bv = bvv[q], cv = cvv[q], zv = zvv[q];
        u32x4 ov;
#pragma unroll
        for (int e = 0; e < 4; ++e) {
          const float ua = bflo(hv[e]) * bflo(cv[e]), ub = bfhi(hv[e]) * bfhi(cv[e]);
          const float ca = cw0[2 * e] * u2[2 * e] + cw1[2 * e] * u1[2 * e] + cw2[2 * e] * ua + cbv[2 * e];
          const float cbb = cw0[2 * e + 1] * u2[2 * e + 1] + cw1[2 * e + 1] * u1[2 * e + 1] + cw2[2 * e + 1] * ub + cbv[2 * e + 1];
          const float oa = bflo(bv[e]) * ca * siluf_(bflo(zv[e]));
          const float ob = bfhi(bv[e]) * cbb * siluf_(bfhi(zv[e]));
          ov[e] = cvtpk(oa, ob);
          u2[2 * e] = u1[2 * e]; u2[2 * e + 1] = u1[2 * e + 1]; u1[2 * e] = ua; u1[2 * e + 1] = ub;
        }
        *(u32x4*)(ws_mix(p) + (size_t)(r0 + rb + q) * LDK + 512 + ch) = ov;
      }
    }
  }
}

constexpr int AT_NST = 5, AT_KB = 8192, AT_BUF = 16384;
constexpr int AT_F = AT_NST * AT_BUF, AT_IMPA = AT_F, AT_IMPB = AT_IMPA + 64 * 65 * 4, AT_VAL = AT_IMPA;
constexpr int AT_SELM = AT_F + 8 * 8192, AT_UNIT = AT_SELM + 512, AT_END = AT_UNIT + 16;
static_assert(AT_END <= SMEM_BYTES, "attention LDS layout exceeds the dynamic LDS size");

__device__ void phase_attn(const Params& p, char* smem, int bid, int nb, int rep) {
  int tid_ = threadIdx.x; asm volatile("" : "+v"(tid_));
  const int tid = tid_, lane = tid & 63, wid = __builtin_amdgcn_readfirstlane(tid >> 6), c32 = lane & 31, h = lane >> 5;
  const float NINF = -__builtin_inff();
  float* impa = (float*)(smem + AT_IMPA);
  float* impb = (float*)(smem + AT_IMPB);
  float* vals = (float*)(smem + AT_VAL);
  unsigned* selm = (unsigned*)(smem + AT_SELM);
  volatile int* s_unit = (volatile int*)(smem + AT_UNIT);
  const unsigned lds0 = (unsigned)(uintptr_t)smem;
  while (true) {
    if (tid == 0) *s_unit = (int)atomicAdd(ws_counter(p) + rep, 1u);
    __syncthreads();
    const int u = __builtin_amdgcn_readfirstlane(*s_unit);
    __syncthreads();
    if (u >= 1024) break;
    const int i = 63 - (u >> 4), bg = u & 15, b = bg >> 1, g = bg & 1;
    const int tl = wid * 8 + (c32 >> 2), hd = c32 & 3;
    const int t = i * 64 + tl;
    const u16* qrow = ws_Q(p) + ((size_t)(bg * 4096 + i * 64) * 4 + wid * 32 + c32) * 64;
    bf16x8 qf[4];
#pragma unroll
    for (int ks = 0; ks < 4; ++ks) qf[ks] = *(const bf16x8*)(qrow + ks * 16 + h * 8);
    const float* gp = ws_gates(p) + (size_t)(b * 4096 + t) * 24 + (g * 4 + hd) * 3;
    const float g0 = gp[0], g1 = gp[1], g2 = gp[2];
    asm volatile("" :: "v"(qf[0]), "v"(qf[1]), "v"(qf[2]), "v"(qf[3]), "v"(g0), "v"(g1), "v"(g2));
    const int ntc = (4 * i + 2) / 64 + 1, nsl = i + 1, nwin = (i < 8 ? i : 8) + 1;
    const int NT = 2 * ntc + nsl + nwin;
    const bool need_sel = i >= 16;

    f32x16 O0, O1;
#pragma unroll
    for (int r = 0; r < 16; ++r) { O0[r] = 0.f; O1[r] = 0.f; }
    float* fl = (float*)(smem + AT_F + wid * 8192) + lane;
    float m_run = NINF, l_run = 0.f, inv_l = 0.f;
    u32x4 kxw; kxw[0] = (h == 0) ? 0x3F80u : 0u; kxw[1] = 0u; kxw[2] = 0u; kxw[3] = 0u;
    const bf16x8 kx = __builtin_bit_cast(bf16x8, kxw);
    float oscale = 1.0f;
    unsigned sel_lo = 0xffffffffu, sel_hi = 0xffffffffu;
#define TILE_PTRS(n, kp, vp) do { \
      if ((n) < 2 * ntc) { const int tt_ = (n) < ntc ? (n) : (n) - ntc; kp = ws_Kc(p) + (size_t)(bg * 4 + tt_) * 4096; vp = ws_Vct(p) + (size_t)(bg * 4 + tt_) * 4096; } \
      else if ((n) < 2 * ntc + nsl) { const int j_ = (n) - 2 * ntc; kp = ws_Ks(p) + ((size_t)bg * 4096 + j_ * 64) * 64; vp = ws_Vst(p) + (size_t)(bg * 64 + j_) * 4096; } \
      else { const int j_ = i - nwin + 1 + ((n) - 2 * ntc - nsl); kp = ws_Kw(p) + ((size_t)bg * 4096 + j_ * 64) * 64; vp = ws_Vwt(p) + (size_t)(bg * 64 + j_) * 4096; } } while (0)
#define TISSUE(n, st_) do { const u16 *kp_, *vp_; TILE_PTRS(n, kp_, vp_); \
      const unsigned d_ = (unsigned)__builtin_amdgcn_readfirstlane((int)(lds0 + (st_) * AT_BUF + wid * 1024)); \
      glds16(kp_ + tid * 8, d_); glds16(vp_ + tid * 8, d_ + AT_KB); } while (0)
    {
      const int npre = NT < AT_NST - 1 ? NT : AT_NST - 1;
      for (int n = 0; n < npre; ++n) TISSUE(n, n);
    }
    int st_cur = 0, st_iss = AT_NST - 1;
    const int ksw = (c32 >> 1) & 7;
    for (int n = 0; n < NT; ++n) {
      {
        const int rem = NT - 1 - n;
        if (rem >= 3) WAIT_VM(6); else if (rem == 2) WAIT_VM(4); else if (rem == 1) WAIT_VM(2); else WAIT_VM(0);
        __builtin_amdgcn_s_barrier();
      }
      int mode, base, lo, hi;
      bool full = false, lane_on = true;
      if (n < 2 * ntc) { mode = n < ntc ? 0 : 1; base = (n < ntc ? n : n - ntc) * 64; lo = -1; hi = (t - 31) >> 4; }
      else if (n < 2 * ntc + nsl) { const int j = n - 2 * ntc; mode = 2; base = j * 64; const unsigned bit = j < 32 ? (sel_lo >> j) & 1u : (sel_hi >> (j - 32)) & 1u; lo = -1; hi = bit ? t : -1; full = j < i; lane_on = bit != 0u; }
      else { const int j = i - nwin + 1 + (n - 2 * ntc - nsl); mode = 3; base = j * 64; lo = t - 512; hi = t; full = (j < i) && (j > i - 8); }
      const int lo_rel = lo - (base + 4 * h), hi_rel = hi - (base + 4 * h);
      const bool chk = ((n & 7) == 7) || mode == 0;
#pragma unroll
      for (int r = 0; r < 16; ++r) { O0[r] *= oscale; O1[r] *= oscale; }
      const char* kb = smem + st_cur * AT_BUF;
      const char* vb = kb + AT_KB;
      const bool do_iss = n + AT_NST - 1 < NT; const int iss_n = n + AT_NST - 1, iss_st = st_iss;
      st_cur = st_cur == AT_NST - 1 ? 0 : st_cur + 1; st_iss = st_iss == AT_NST - 1 ? 0 : st_iss + 1;
      f32x16 S0, S1;
#define ATT_BODY(MASKED) do { \
      _Pragma("unroll") for (int r = 0; r < 16; ++r) { S0[r] = 0.f; S1[r] = 0.f; } \
      const float m_use = (m_run == NINF) ? 0.f : m_run;        \
      { \
          \
        const float negm = (!(MASKED) && !lane_on) ? NINF : -m_use; \
        u32x4 qxw; qxw[0] = (h == 0) ? (cvtpk(negm, 0.f) & 0xffffu) : 0u; qxw[1] = 0u; qxw[2] = 0u; qxw[3] = 0u; \
        const bf16x8 qx = __builtin_bit_cast(bf16x8, qxw); \
        S0 = MFMA32(kx, qx, S0); S1 = MFMA32(kx, qx, S1); \
      } \
      { \
        bf16x8 kf0[4], kf1[4]; \
        _Pragma("unroll") for (int ks = 0; ks < 4; ++ks) { \
          kf0[ks] = *(const bf16x8*)(kb + c32 * 128 + (((ks * 2 + h) ^ ksw) * 16)); \
          kf1[ks] = *(const bf16x8*)(kb + (32 + c32) * 128 + (((ks * 2 + h) ^ ksw) * 16)); \
        } \
        if (do_iss) TISSUE(iss_n, iss_st); \
        _Pragma("unroll") for (int ks = 0; ks < 4; ++ks) S0 = MFMA32(kf0[ks], qf[ks], S0);     \
        _Pragma("unroll") for (int ks = 0; ks < 4; ++ks) S1 = MFMA32(kf1[ks], qf[ks], S1); \
      } \
        \
      if ((MASKED) == 2) {                       \
        _Pragma("unroll") for (int r = 0; r < 16; ++r) { \
          const int off = (r & 3) + 8 * (r >> 2); \
          S0[r] = (off > lo_rel && off <= hi_rel) ? S0[r] : NINF; \
          S1[r] = (off + 32 > lo_rel && off + 32 <= hi_rel) ? S1[r] : NINF; \
        } \
      } else if (MASKED) {                       \
        _Pragma("unroll") for (int r = 0; r < 16; ++r) { \
          const int off = (r & 3) + 8 * (r >> 2); \
          S0[r] = (off <= hi_rel) ? S0[r] : NINF; \
          S1[r] = (off + 32 <= hi_rel) ? S1[r] : NINF; \
        } \
      } \
      float ps0 = 0.f, ps1 = 0.f; \
      bf16x8 vfa[4]; \
      _Pragma("unroll") for (int kk = 0; kk < 2; ++kk) \
        _Pragma("unroll") for (int dr = 0; dr < 2; ++dr) vfa[kk * 2 + dr] = *(const bf16x8*)(vb + (32 * dr + c32) * 128 + (((2 * kk + h) ^ ksw) * 16)); \
      _Pragma("unroll") for (int r = 0; r < 16; ++r) { S0[r] = __builtin_amdgcn_exp2f(S0[r]); ps0 += S0[r]; } \
      _Pragma("unroll") for (int kk = 0; kk < 2; ++kk) { \
        u32x4 pw; \
        _Pragma("unroll") for (int e = 0; e < 4; ++e) pw[e] = cvtpk(S0[8 * kk + 2 * e], S0[8 * kk + 2 * e + 1]); \
        const bf16x8 pf = __builtin_bit_cast(bf16x8, pw); \
        O0 = MFMA32(vfa[kk * 2], pf, O0); O1 = MFMA32(vfa[kk * 2 + 1], pf, O1); \
      } \
      __builtin_amdgcn_sched_group_barrier(0x100, 12, 0);     \
      __builtin_amdgcn_sched_group_barrier(0x008, 4, 0);      \
      _Pragma("unroll") for (int q_ = 0; q_ < 4; ++q_) { __builtin_amdgcn_sched_group_barrier(0x008, 1, 0); __builtin_amdgcn_sched_group_barrier(0x002, 9, 0); }     \
      __builtin_amdgcn_sched_barrier(0); \
      _Pragma("unroll") for (int r = 0; r < 16; ++r) { S1[r] = __builtin_amdgcn_exp2f(S1[r]); ps1 += S1[r]; } \
      _Pragma("unroll") for (int kk = 0; kk < 2; ++kk) { \
        u32x4 pw; \
        _Pragma("unroll") for (int e = 0; e < 4; ++e) pw[e] = cvtpk(S1[8 * kk + 2 * e], S1[8 * kk + 2 * e + 1]); \
        const bf16x8 pf = __builtin_bit_cast(bf16x8, pw); \
        const bf16x8 va0 = *(const bf16x8*)(vb + c32 * 128 + (((2 * (kk + 2) + h) ^ ksw) * 16)), va1 = *(const bf16x8*)(vb + (32 + c32) * 128 + (((2 * (kk + 2) + h) ^ ksw) * 16)); \
        O0 = MFMA32(va0, pf, O0); O1 = MFMA32(va1, pf, O1); \
      } \
      __builtin_amdgcn_sched_barrier(0); \
      oscale = 1.0f; \
      if (mode != 1) l_run += ps0 + ps1; \
      if (mode != 1 && chk) {                    \
        float mxp = fmaxf(fmaxf(S0[0], S0[1]), S1[0]); \
        mxp = fmaxf(fmaxf(mxp, S1[1]), S0[2]); \
        _Pragma("unroll") for (int r = 2; r < 16; r += 2) { \
          if (r > 2) mxp = fmaxf(fmaxf(mxp, S0[r]), S1[r - 1]); \
          mxp = fmaxf(fmaxf(mxp, S0[r + 1]), S1[r]); \
        } \
        mxp = fmaxf(mxp, S1[15]); \
        mxp = fmaxf(mxp, __shfl_xor(mxp, 32));            \
        const bool mv = (m_run == NINF) ? (mxp > 0.f) : (mxp > 256.0f); \
        const float m_new = bflo(cvtpk(m_use + __builtin_amdgcn_logf(mxp), 0.f));       \
        const float alpha = mv ? __builtin_amdgcn_exp2f(m_use - m_new) : 1.0f; \
        m_run = mv ? m_new : m_run; \
        l_run *= alpha; \
        oscale = alpha; \
      } \
      if ((MASKED) == 1 && mode == 1 && need_sel) {               \
        const int tt = base >> 6; \
        _Pragma("unroll") for (int kr = 0; kr < 2; ++kr) \
          _Pragma("unroll") for (int rg = 0; rg < 4; ++rg) { \
            float pv[4]; \
            _Pragma("unroll") for (int e = 0; e < 4; ++e) { \
              float v = (kr ? S1[rg * 4 + e] : S0[rg * 4 + e]) * inv_l; \
              v += qperm<0xB1>(v); v += qperm<0x4E>(v);            \
              pv[e] = v; \
            } \
            if (hd == 0) { \
              const int nblk = tt * 16 + 8 * kr + 2 * rg + h; \
              impa[tl * 65 + nblk] = pv[0] + pv[1] + pv[2] + 0.5f * pv[3]; \
              impb[tl * 65 + nblk] = 0.5f * pv[3]; \
            } \
          } \
      } } while (0)
      if (full) ATT_BODY(0); else if (mode == 3 && base < i * 64) ATT_BODY(2); else ATT_BODY(1);
#undef ATT_BODY
      if (n == ntc - 1) {
        const float lt = l_run + __shfl_xor(l_run, 32);
        inv_l = lt > 0.f ? 1.0f / lt : 0.f;
        oscale = 0.f;
      } else if (n == 2 * ntc - 1) {
        if (need_sel) {
          __syncthreads();
          for (int q = 0; q < 8; ++q) {
            const int tk = wid * 8 + q, nn = lane;
            const bool forced = (nn == 0) || (nn == i) || (nn == i - 1);
            const bool vis = nn <= i;
            float v = 0.f;
            if (vis) v = impa[tk * 65 + nn] + (nn > 0 ? impb[tk * 65 + nn - 1] : 0.f);
            const unsigned bse = forced ? 0x4E6E6B28u : __float_as_uint(v);
            const unsigned key = (bse & ~127u) | (vis ? 64u : 0u) | (unsigned)(63 - nn);
            unsigned T = 0u;
#pragma unroll 1
            for (int bbit = 31; bbit >= 0; --bbit) {
              const unsigned Tc = T | (1u << bbit);
              const unsigned long long mk = __builtin_amdgcn_ballot_w64(key >= Tc);
              if (__builtin_popcountll(mk) >= 16) T = Tc;
            }
            const unsigned long long sel = __builtin_amdgcn_ballot_w64(key >= T);
            if (lane == 0) { selm[tk * 2] = (unsigned)sel; selm[tk * 2 + 1] = (unsigned)(sel >> 32); }
          }
          __syncthreads();
          sel_lo = selm[tl * 2]; sel_hi = selm[tl * 2 + 1];
        }
        {
          const float wgt = g0 * inv_l * oscale;
#pragma unroll
          for (int r = 0; r < 16; ++r) { fl[r * 64] = wgt * O0[r]; fl[(16 + r) * 64] = wgt * O1[r]; }
          m_run = NINF; l_run = 0.f; oscale = 0.f;
        }
      } else if (n == 2 * ntc + nsl - 1) {
        const float lt = l_run + __shfl_xor(l_run, 32);
        const float wgt = g1 * (lt > 0.f ? 1.0f / lt : 0.f) * oscale;
#pragma unroll
        for (int r = 0; r < 16; ++r) { fl[r * 64] += wgt * O0[r]; fl[(16 + r) * 64] += wgt * O1[r]; }
        m_run = NINF; l_run = 0.f; oscale = 0.f;
      }
    }
#undef TILE_PTRS
#undef TISSUE
    {
      const float lt = l_run + __shfl_xor(l_run, 32);
      const float wgt = g2 * (lt > 0.f ? 1.0f / lt : 0.f) * oscale;
      const size_t rowo = (size_t)(b * 4096 + t);
      const u16* zp = ws_zs(p) + rowo * 512 + (g * 4 + hd) * 64;
      u16* mp = ws_mix(p) + rowo * LDK + (g * 4 + hd) * 64;
      u32x2 zv8[8];
#pragma unroll
      for (int q = 0; q < 8; ++q) zv8[q] = *(const u32x2*)(zp + 32 * (q >> 2) + 8 * (q & 3) + 4 * h);
#pragma unroll
      for (int dr = 0; dr < 2; ++dr)
#pragma unroll
        for (int rg = 0; rg < 4; ++rg) {
          const int d = 32 * dr + 8 * rg + 4 * h;
          const u32x2 zv = zv8[dr * 4 + rg];
          const float f0 = fl[(dr * 16 + rg * 4 + 0) * 64] + wgt * (dr ? O1[rg * 4 + 0] : O0[rg * 4 + 0]);
          const float f1 = fl[(dr * 16 + rg * 4 + 1) * 64] + wgt * (dr ? O1[rg * 4 + 1] : O0[rg * 4 + 1]);
          const float f2 = fl[(dr * 16 + rg * 4 + 2) * 64] + wgt * (dr ? O1[rg * 4 + 2] : O0[rg * 4 + 2]);
          const float f3 = fl[(dr * 16 + rg * 4 + 3) * 64] + wgt * (dr ? O1[rg * 4 + 3] : O0[rg * 4 + 3]);
          u32x2 o;
          o[0] = cvtpk(f0 * bflo(zv[0]), f1 * bfhi(zv[0]));
          o[1] = cvtpk(f2 * bflo(zv[1]), f3 * bfhi(zv[1]));
          *(u32x2*)(mp + d) = o;
        }
    }
  }
}

#define XB_TMO      128
#define XB_XCNT(j)  (256  + 64 * (j))
#define XB_XSUB(j)  (1280 + 64 * (j))
#define XB_XGEN(j)  (2304 + 64 * (j))
#define XB_TOP      3328
#define XB_TOPGEN   3392
#define XCD_BAR_WORDS 3456
#define XB_SPIN_CAP (1u << 18)
#define LAS __attribute__((address_space(3)))

__device__ __forceinline__ unsigned xb_ld(unsigned* p)              { return __hip_atomic_load(p, __ATOMIC_RELAXED, __HIP_MEMORY_SCOPE_AGENT); }
__device__ __forceinline__ unsigned xb_add(unsigned* p, unsigned v) { return __hip_atomic_fetch_add(p, v, __ATOMIC_RELAXED, __HIP_MEMORY_SCOPE_AGENT); }
__device__ __forceinline__ unsigned xb_xcc_id() { return (unsigned)__builtin_amdgcn_s_getreg((3 << 11) | 20) & 0xFu; }
#define XB_SPIN(cond, bar) do { unsigned _sp = 0; while (cond) { __builtin_amdgcn_s_sleep(1); \
    if ((++_sp & 255u) == 0u) { if (xb_ld(&(bar)[XB_TMO])) break; if (_sp > XB_SPIN_CAP) { atomicAdd(&(bar)[XB_TMO], 1u); break; } } } } while (0)

struct XcdBarrier {
    unsigned* bar; unsigned x;
    volatile LAS unsigned* st;
};

__device__ __forceinline__ XcdBarrier xcd_barrier_post(unsigned* bar, volatile LAS unsigned* st) {
    XcdBarrier b; b.bar = bar; b.x = xb_xcc_id(); b.st = st;
    if (threadIdx.x == 0) (void)xb_add(&bar[XB_XCNT(b.x)], 1u);
    return b;
}
__device__ __forceinline__ void xcd_barrier_complete(unsigned* bar, unsigned x, unsigned& nloc, unsigned& nx) {
    const unsigned G = gridDim.x * gridDim.y * gridDim.z;
    unsigned sum, cnt, mine, sp = 0u;
    for (;;) {
        sum = 0u; cnt = 0u; mine = 0u;
#pragma unroll
        for (unsigned j = 0; j < 16; ++j) { const unsigned c = xb_ld(&bar[XB_XCNT(j)]); sum += c; cnt += (c > 0u) ? 1u : 0u; mine = (j == x) ? c : mine; }
        if (sum == G) break;
        __builtin_amdgcn_s_sleep(1);
        if ((++sp & 255u) == 0u) { if (xb_ld(&bar[XB_TMO])) break; if (sp > XB_SPIN_CAP) { atomicAdd(&bar[XB_TMO], 1u); break; } }
    }
    nloc = mine > 0u ? mine : 1u; nx = cnt > 0u ? cnt : 1u;
}

__device__ __forceinline__ void xcd_barrier(const XcdBarrier& b) {
    asm volatile("s_waitcnt vmcnt(0)" ::: "memory");
    __syncthreads();
    if (threadIdx.x == 0) {
        unsigned* bar = b.bar;
        __builtin_amdgcn_s_waitcnt(0);
        unsigned nloc = b.st[0], nx = b.st[1];
        if (nloc == 0u) { xcd_barrier_complete(bar, b.x, nloc, nx); b.st[0] = nloc; b.st[1] = nx; }
        const unsigned old = xb_add(&bar[XB_XSUB(b.x)], 1u);
        const unsigned gen = old / nloc;
        if (old + 1u == (gen + 1u) * nloc) {
            __builtin_amdgcn_fence(__ATOMIC_RELEASE, "agent");
            asm volatile("s_waitcnt vmcnt(0)" ::: "memory");
            const unsigned og = xb_add(&bar[XB_TOP], 1u);
            const unsigned tg = og / nx;
            if (og + 1u == (tg + 1u) * nx) xb_add(&bar[XB_TOPGEN], 1u);
            else XB_SPIN(xb_ld(&bar[XB_TOPGEN]) == tg, bar);
            __builtin_amdgcn_fence(__ATOMIC_ACQUIRE, "agent");
            xb_add(&bar[XB_XGEN(b.x)], 1u);
            asm volatile("s_waitcnt vmcnt(0)" ::: "memory");
        } else {
            XB_SPIN(xb_ld(&bar[XB_XGEN(b.x)]) == gen, bar);
            __builtin_amdgcn_fence(__ATOMIC_ACQUIRE, "agent");
            asm volatile("s_waitcnt vmcnt(0)" ::: "memory");
        }
    }
    __syncthreads();
}


#if FUSED
extern "C" __global__ void __launch_bounds__(NTHREADS) hybrid_fwd(Params p) {
  extern __shared__ __attribute__((aligned(16))) char smem[];
  cg::grid_group grid = cg::this_grid();
  const int bid = blockIdx.x, nb = gridDim.x;
  if (threadIdx.x < 4) ((volatile unsigned*)(smem + SMEM_BYTES))[threadIdx.x] = 0u;
  __syncthreads();
  if (bid == 0) { for (int w_ = threadIdx.x; w_ < XCD_BAR_WORDS; w_ += NTHREADS) ws_bar(p)[w_] = 0u; }
  for (int r = 0; r < REP0; ++r) { phase_prep(p, smem, bid, nb); grid.sync(); }
  XcdBarrier xb = xcd_barrier_post(ws_bar(p), (volatile LAS unsigned*)(smem + SMEM_BYTES));
  for (int r = 0; r < REP1; ++r) { gemm_phase<0>(p, smem, bid, nb); xcd_barrier(xb); }
  for (int r = 0; r < REP2; ++r) { phase_cmp_conv(p, smem, bid, nb); xcd_barrier(xb); }
  for (int r = 0; r < REP3; ++r) { phase_attn(p, smem, bid, nb, r); xcd_barrier(xb); }
  for (int r = 0; r < REP4; ++r) { gemm_phase<1>(p, smem, bid, nb); }
}
#else
template <int PH>
__global__ void __launch_bounds__(NTHREADS) phase_kernel(Params p) {
  extern __shared__ __attribute__((aligned(16))) char smem[];
  const int bid = blockIdx.x, nb = gridDim.x;
  if constexpr (PH == 0) phase_prep(p, smem, bid, nb);
  if constexpr (PH == 1) gemm_phase<0>(p, smem, bid, nb);
  if constexpr (PH == 2) phase_cmp_conv(p, smem, bid, nb);
  if constexpr (PH == 3) phase_attn(p, smem, bid, nb, 0);
  if constexpr (PH == 4) gemm_phase<1>(p, smem, bid, nb);
}
#endif

extern "C" void kernel_launch(void* const* d_in, const int* in_sizes, int n_in, void* d_out, int out_size, void* d_ws, size_t ws_size, hipStream_t stream) {
  Params p{};
  p.x = (const float*)d_in[0]; p.norm_w = (const float*)d_in[1]; p.w_in = (const float*)d_in[2]; p.q_norm_w = (const float*)d_in[3];
  p.k_norm_w = (const float*)d_in[4]; p.ck_pos = (const float*)d_in[5]; p.ck_w1 = (const float*)d_in[6]; p.ck_b1 = (const float*)d_in[7];
  p.ck_w2 = (const float*)d_in[8]; p.cv_pos = (const float*)d_in[9]; p.cv_w1 = (const float*)d_in[10]; p.cv_b1 = (const float*)d_in[11];
  p.cv_w2 = (const float*)d_in[12]; p.conv_w = (const float*)d_in[13]; p.conv_b = (const float*)d_in[14]; p.w_out = (const float*)d_in[15];
  p.out = (float*)d_out;
  p.ws = (char*)d_ws;
  const size_t off = WS_TOTAL;
  if (off > ws_size) { fprintf(stderr, "kernel_launch: workspace too small (%zu > %zu)\n", off, ws_size); return; }

#if FUSED
  static int grid_blocks = 0;
  if (!grid_blocks) {
    int dev = 0, cus = 0, per_cu = 0;
    hipGetDevice(&dev);
    hipDeviceGetAttribute(&cus, hipDeviceAttributeMultiprocessorCount, dev);
    hipFuncSetAttribute((const void*)hybrid_fwd, hipFuncAttributeMaxDynamicSharedMemorySize, SMEM_BYTES + 16);
    hipOccupancyMaxActiveBlocksPerMultiprocessor(&per_cu, (const void*)hybrid_fwd, NTHREADS, SMEM_BYTES + 16);
    if (per_cu < 1) per_cu = 1;
    grid_blocks = cus * per_cu;
  }
  void* args[] = {&p};
  hipError_t e = hipLaunchCooperativeKernel((const void*)hybrid_fwd, dim3(grid_blocks), dim3(NTHREADS), args, SMEM_BYTES + 16, stream);
  if (e != hipSuccess) fprintf(stderr, "cooperative launch failed: %s (grid %d)\n", hipGetErrorString(e), grid_blocks);
#else
  static int attr_set = 0;
  if (!attr_set) {
    (void)hipFuncSetAttribute((const void*)phase_kernel<0>, hipFuncAttributeMaxDynamicSharedMemorySize, SMEM_BYTES);
    (void)hipFuncSetAttribute((const void*)phase_kernel<1>, hipFuncAttributeMaxDynamicSharedMemorySize, SMEM_BYTES);
    (void)hipFuncSetAttribute((const void*)phase_kernel<2>, hipFuncAttributeMaxDynamicSharedMemorySize, SMEM_BYTES);
    (void)hipFuncSetAttribute((const void*)phase_kernel<3>, hipFuncAttributeMaxDynamicSharedMemorySize, SMEM_BYTES);
    (void)hipFuncSetAttribute((const void*)phase_kernel<4>, hipFuncAttributeMaxDynamicSharedMemorySize, SMEM_BYTES);
    attr_set = 1;
  }
  const int G = 256;
  phase_kernel<0><<<G, NTHREADS, SMEM_BYTES, stream>>>(p);
  phase_kernel<1><<<G, NTHREADS, SMEM_BYTES, stream>>>(p);
  phase_kernel<2><<<G, NTHREADS, SMEM_BYTES, stream>>>(p);
  phase_kernel<3><<<G, NTHREADS, SMEM_BYTES, stream>>>(p);
  phase_kernel<4><<<G, NTHREADS, SMEM_BYTES, stream>>>(p);
#endif
}
```
